# Optimizing an MI355X kernel written in HIP

```python
import math
import jax, jax.numpy as jnp
from jax import lax
import numpy as np

D_MODEL = 1024
BATCH = 2
SEQ = 8192
DEPTH = 4
DEC_BATCH = 128
DEC_SEQ = 8
PAST_LEN = 8192
PAGE_SIZE = 128

N_EVEN = (DEPTH + 1) // 2
N_ODD = DEPTH // 2

ML_HEADS = 4
ML_DK = 128
ML_DV = 128
ML_WIDTH = ML_HEADS * ML_DV
ML_CHUNK = 64

SC_WIDTH = D_MODEL // 2
CONV_W = 3

ATT_HEADS = 16
KV_HEADS = 4
HEAD_DIM = 64
GROUP = ATT_HEADS // KV_HEADS
WINDOW = 128
WIN_BUF = min(WINDOW, PAST_LEN)
ROPE_THETA = 10000.0

D_FF = 2816

EPS = 1e-6
IN_A = 4 * ML_WIDTH + 2 * ML_HEADS + 3 * SC_WIDTH
QKV_W = (ATT_HEADS + 2 * KV_HEADS) * HEAD_DIM

kernel_name = 'hybrid_mlstm_shortconv_swa_decoder_step'


def rms_norm(x, g):
    xf = x.astype(jnp.float32)
    y = xf * lax.rsqrt(jnp.mean(xf * xf, axis=-1, keepdims=True) + EPS)
    return (y * g.astype(jnp.float32)).astype(x.dtype)


def rope(x, pos):
    half = HEAD_DIM // 2
    inv = ROPE_THETA ** (-jnp.arange(half, dtype=jnp.float32) / half)
    ang = pos.astype(jnp.float32)[:, None] * inv[None, :]
    cos = jnp.cos(ang)[:, None, :]
    sin = jnp.sin(ang)[:, None, :]
    xf = x.astype(jnp.float32)
    x1, x2 = xf[..., :half], xf[..., half:]
    return jnp.concatenate([x1 * cos - x2 * sin, x2 * cos + x1 * sin], axis=-1).astype(x.dtype)


def causal_conv(u, prev, w):
    S = u.shape[1]
    up = jnp.concatenate([prev.astype(u.dtype), u], axis=1)
    y = up[:, 0:S] * w[0]
    for j in range(1, CONV_W):
        y = y + up[:, j:j + S] * w[j]
    return y, up[:, S:]


def mlstm_chunk_step(carry, inp):
    C, n, m = carry
    q, k, v, ig, lf = inp
    L = q.shape[-2]
    causal = jnp.tril(jnp.ones((L, L), dtype=bool))
    b = jnp.cumsum(lf, axis=-1)
    dlog = jnp.where(causal, b[..., :, None] - b[..., None, :] + ig[..., None, :], -jnp.inf)
    g = b + m[..., None]
    m_t = jnp.maximum(jnp.max(dlog, axis=-1), g)
    w = jnp.exp(dlog - m_t[..., None])
    wg = jnp.exp(g - m_t)
    s = jnp.einsum('bhtd,bhsd->bhts', q, k) * w
    num = wg[..., None] * jnp.einsum('bhtd,bhde->bhte', q, C) + jnp.einsum('bhts,bhse->bhte', s, v)
    den = wg * jnp.einsum('bhtd,bhd->bht', q, n) + jnp.sum(s, axis=-1)
    h = num / jnp.maximum(jnp.abs(den), jnp.exp(-m_t))[..., None]
    bL = b[..., -1]
    a = bL[..., None] - b + ig
    m_new = jnp.maximum(bL + m, jnp.max(a, axis=-1))
    wc = jnp.exp(bL + m - m_new)
    ws = jnp.exp(a - m_new[..., None])
    C_new = wc[..., None, None] * C + jnp.einsum('bhs,bhsd,bhse->bhde', ws, k, v)
    n_new = wc[..., None] * n + jnp.einsum('bhs,bhsd->bhd', ws, k)
    return (C_new, n_new, m_new), h


def mlstm(q, k, v, ig, lf, C0, n0, m0):
    B, H, S, _ = q.shape
    L = math.gcd(S, ML_CHUNK)
    NC = S // L

    def chunks(a):
        return jnp.moveaxis(a.reshape((B, H, NC, L) + a.shape[3:]), 2, 0)

    (C, n, m), h = lax.scan(mlstm_chunk_step, (C0, n0, m0),
                            (chunks(q), chunks(k), chunks(v), chunks(ig), chunks(lf)))
    h = jnp.moveaxis(h, 0, 2).reshape(B, H, S, h.shape[-1])
    return h, C, n, m


def mixer_ab(h, C0, n0, m0, sc_prev, w_in, b_if, out_norm, conv_w, w_out):
    B, S, _ = h.shape
    f32 = jnp.float32
    z = h @ w_in
    splits = [int(i) for i in np.cumsum([ML_WIDTH] * 4 + [2 * ML_HEADS] + [SC_WIDTH] * 2)]
    zq, zk, zv, zo, zg, zb, zc, zx = jnp.split(z, splits, axis=-1)

    def heads(a):
        return a.reshape(B, S, ML_HEADS, -1).transpose(0, 2, 1, 3).astype(f32)

    gates = (zg.astype(f32) + b_if.astype(f32)).transpose(0, 2, 1)
    ig = gates[:, :ML_HEADS]
    lf = jax.nn.log_sigmoid(gates[:, ML_HEADS:])
    hm, C, n, m = mlstm(heads(zq), heads(zk) * (ML_DK ** -0.5), heads(zv), ig, lf,
                        C0.astype(f32), n0.astype(f32), m0.astype(f32))
    hm = rms_norm(hm.transpose(0, 2, 1, 3).astype(h.dtype), out_norm.reshape(ML_HEADS, ML_DV))
    hm = (hm * jax.nn.sigmoid(zo).reshape(B, S, ML_HEADS, ML_DV)).reshape(B, S, ML_WIDTH)
    u, sc_new = causal_conv(zc * zx, sc_prev, conv_w)
    y = jnp.concatenate([hm, zb * u], axis=-1) @ w_out
    return y, C, n, m, sc_new


def qkv_heads(h, w_qkv, q_norm, k_norm, pos):
    B, S, _ = h.shape
    z = h @ w_qkv
    q, k, v = jnp.split(z, [ATT_HEADS * HEAD_DIM, (ATT_HEADS + KV_HEADS) * HEAD_DIM], axis=-1)
    q = rope(rms_norm(q.reshape(B, S, ATT_HEADS, HEAD_DIM), q_norm), pos)
    k = rope(rms_norm(k.reshape(B, S, KV_HEADS, HEAD_DIM), k_norm), pos)
    v = v.reshape(B, S, KV_HEADS, HEAD_DIM)
    return q, k, v


def sink_attention(q, k, v, mask, sink):
    s = jnp.einsum('...tkgd,...skd->...kgts', q, k).astype(jnp.float32) * (HEAD_DIM ** -0.5)
    s = jnp.where(mask, s, -jnp.inf)
    sk = jnp.broadcast_to(sink.astype(jnp.float32).reshape(KV_HEADS, GROUP, 1, 1), s.shape[:-1] + (1,))
    p = jax.nn.softmax(jnp.concatenate([s, sk], axis=-1), axis=-1)[..., :-1]
    return jnp.einsum('...kgts,...skd->...tkgd', p.astype(v.dtype), v)


def attn_prompt(h, w_qkv, q_norm, k_norm, sink, w_out):
    B, S, _ = h.shape
    pos = jnp.arange(S, dtype=jnp.int32)
    q, k, v = qkv_heads(h, w_qkv, q_norm, k_norm, pos)
    NB = S // WINDOW
    qb = q.reshape(B, NB, WINDOW, KV_HEADS, GROUP, HEAD_DIM)

    def with_prev(a):
        ab = a.reshape(B, NB, WINDOW, KV_HEADS, HEAD_DIM)
        prev = jnp.concatenate([jnp.zeros_like(ab[:, :1]), ab[:, :-1]], axis=1)
        return jnp.concatenate([prev, ab], axis=2)

    blk = jnp.arange(NB)[:, None, None]
    qpos = blk * WINDOW + jnp.arange(WINDOW)[None, :, None]
    kpos = (blk - 1) * WINDOW + jnp.arange(2 * WINDOW)[None, None, :]
    d = qpos - kpos
    mask = (d >= 0) & (d < WINDOW) & (kpos >= 0)
    o = sink_attention(qb, with_prev(k), with_prev(v), mask[:, None, None], sink)
    y = o.reshape(B, S, ATT_HEADS * HEAD_DIM) @ w_out
    return y, k[:, S - WIN_BUF:], v[:, S - WIN_BUF:]


def attn_sample(h, buf_k, buf_v, w_qkv, q_norm, k_norm, sink, w_out):
    B, L, _ = h.shape
    WB = buf_k.shape[1]
    pos = PAST_LEN + jnp.arange(L, dtype=jnp.int32)
    q, k, v = qkv_heads(h, w_qkv, q_norm, k_norm, pos)
    kk = jnp.concatenate([buf_k.astype(k.dtype), k], axis=1)
    vv = jnp.concatenate([buf_v.astype(v.dtype), v], axis=1)
    kpos = PAST_LEN - WB + jnp.arange(WB + L, dtype=jnp.int32)
    d = pos[:, None] - kpos[None, :]
    mask = (d >= 0) & (d < WINDOW)
    o = sink_attention(q.reshape(B, L, KV_HEADS, GROUP, HEAD_DIM), kk, vv, mask, sink)
    y = o.reshape(B, L, ATT_HEADS * HEAD_DIM) @ w_out
    return y, kk[:, L:], vv[:, L:]


def conv_ffn(h, prev, w_up, conv_w, w_down):
    u = h @ w_up
    u, new_prev = causal_conv(u, prev, conv_w)
    g, a = jnp.split(u, 2, axis=-1)
    return (jax.nn.silu(g) * a) @ w_down, new_prev


def run_trunk(x, c, prompt, st_C, st_n, st_m, st_sc, st_wk, st_wv, st_ffn,
              norm1, norm2, w_ada, b_ada, a_w_in, a_b_if, a_out_norm, a_conv_w, a_w_out,
              c_w_qkv, c_q_norm, c_k_norm, c_sink, c_w_out, f_w_up, f_conv_w, f_w_down):
    Cs, ns, ms, scs, wks, wvs, ffs = [], [], [], [], [], [], []
    for l in range(DEPTH):
        mod = jax.nn.silu(c) @ w_ada[l] + b_ada[l]
        sh1, sc1, g1, sh2, sc2, g2 = jnp.split(mod[:, None, :], 6, axis=-1)
        h = rms_norm(x, norm1[l]) * (1 + sc1) + sh1
        if l % 2 == 0:
            i = l // 2
            y, C, n, m, sc_new = mixer_ab(h, st_C[i], st_n[i], st_m[i], st_sc[i], a_w_in[i], a_b_if[i],
                                          a_out_norm[i], a_conv_w[i], a_w_out[i])
            Cs.append(C)
            ns.append(n)
            ms.append(m)
            scs.append(sc_new)
        else:
            j = l // 2
            if prompt:
                y, wk, wv = attn_prompt(h, c_w_qkv[j], c_q_norm[j], c_k_norm[j], c_sink[j], c_w_out[j])
            else:
                y, wk, wv = attn_sample(h, st_wk[j], st_wv[j], c_w_qkv[j], c_q_norm[j], c_k_norm[j],
                                        c_sink[j], c_w_out[j])
            wks.append(wk)
            wvs.append(wv)
        x = x + g1 * y
        h = rms_norm(x, norm2[l]) * (1 + sc2) + sh2
        y, fp = conv_ffn(h, st_ffn[l], f_w_up[l], f_conv_w[l], f_w_down[l])
        ffs.append(fp)
        x = x + g2 * y
    return (x, jnp.stack(Cs), jnp.stack(ns), jnp.stack(ms), jnp.stack(scs),
            jnp.stack(wks), jnp.stack(wvs), jnp.stack(ffs))


def setup_inputs(seed: int = 0) -> dict:
    key = jax.random.key(seed)
    ks = iter(jax.random.split(key, 40))
    nrm = lambda shape, s=1.0: jax.random.normal(next(ks), shape, jnp.float32) * s
    D = D_MODEL
    b_if = jnp.concatenate([nrm((N_EVEN, ML_HEADS), 0.1),
                            3.0 + nrm((N_EVEN, ML_HEADS), 0.5)], axis=-1)
    return {
        'x_prompt': nrm((BATCH, SEQ, D)),
        'x_sample': nrm((DEC_BATCH, DEC_SEQ, D)),
        'c_prompt': nrm((BATCH, D)),
        'c_sample': nrm((DEC_BATCH, D)),
        'state_mlstm_C': nrm((N_EVEN, DEC_BATCH, ML_HEADS, ML_DK, ML_DV), 0.1),
        'state_mlstm_n': nrm((N_EVEN, DEC_BATCH, ML_HEADS, ML_DK), 0.3),
        'state_mlstm_m': nrm((N_EVEN, DEC_BATCH, ML_HEADS), 1.0),
        'state_sconv': nrm((N_EVEN, DEC_BATCH, CONV_W - 1, SC_WIDTH)),
        'cache_win_k': nrm((N_ODD, DEC_BATCH, WIN_BUF, KV_HEADS, HEAD_DIM)),
        'cache_win_v': nrm((N_ODD, DEC_BATCH, WIN_BUF, KV_HEADS, HEAD_DIM)),
        'state_ffn_conv': nrm((DEPTH, DEC_BATCH, CONV_W - 1, 2 * D_FF)),
        'norm1': 1.0 + nrm((DEPTH, D), 0.02),
        'norm2': 1.0 + nrm((DEPTH, D), 0.02),
        'w_ada': nrm((DEPTH, D, 6 * D), 0.5 * D ** -0.5),
        'b_ada': nrm((DEPTH, 6 * D), 0.02),
        'a_w_in': nrm((N_EVEN, D, IN_A), D ** -0.5),
        'a_b_if': b_if,
        'a_out_norm': 1.0 + nrm((N_EVEN, ML_WIDTH), 0.02),
        'a_conv_w': nrm((N_EVEN, CONV_W, SC_WIDTH), CONV_W ** -0.5),
        'a_w_out': nrm((N_EVEN, ML_WIDTH + SC_WIDTH, D), (ML_WIDTH + SC_WIDTH) ** -0.5),
        'c_w_qkv': nrm((N_ODD, D, QKV_W), D ** -0.5),
        'c_q_norm': 1.0 + nrm((N_ODD, HEAD_DIM), 0.02),
        'c_k_norm': 1.0 + nrm((N_ODD, HEAD_DIM), 0.02),
        'c_sink': nrm((N_ODD, ATT_HEADS), 0.5),
        'c_w_out': nrm((N_ODD, ATT_HEADS * HEAD_DIM, D), (ATT_HEADS * HEAD_DIM) ** -0.5),
        'f_w_up': nrm((DEPTH, D, 2 * D_FF), D ** -0.5),
        'f_conv_w': nrm((DEPTH, CONV_W, 2 * D_FF), CONV_W ** -0.5),
        'f_w_down': nrm((DEPTH, D_FF, D), D_FF ** -0.5),
    }


def reference(x_prompt, x_sample, c_prompt, c_sample, state_mlstm_C, state_mlstm_n, state_mlstm_m,
              state_sconv, cache_win_k, cache_win_v, state_ffn_conv,
              norm1, norm2, w_ada, b_ada, a_w_in, a_b_if, a_out_norm, a_conv_w, a_w_out,
              c_w_qkv, c_q_norm, c_k_norm, c_sink, c_w_out, f_w_up, f_conv_w, f_w_down):
    B = x_prompt.shape[0]
    f32 = jnp.float32
    z_C = jnp.zeros((N_EVEN, B, ML_HEADS, ML_DK, ML_DV), f32)
    z_n = jnp.zeros((N_EVEN, B, ML_HEADS, ML_DK), f32)
    z_m = jnp.zeros((N_EVEN, B, ML_HEADS), f32)
    z_sc = jnp.zeros((N_EVEN, B, CONV_W - 1, SC_WIDTH), x_prompt.dtype)
    z_ffn = jnp.zeros((DEPTH, B, CONV_W - 1, 2 * D_FF), x_prompt.dtype)

    y_prompt, p_C, p_n, p_m, p_sc, p_wk, p_wv, p_ffn = run_trunk(
        x_prompt, c_prompt, True, z_C, z_n, z_m, z_sc, None, None, z_ffn,
        norm1, norm2, w_ada, b_ada, a_w_in, a_b_if, a_out_norm, a_conv_w, a_w_out,
        c_w_qkv, c_q_norm, c_k_norm, c_sink, c_w_out, f_w_up, f_conv_w, f_w_down)

    y_sample, s_C, s_n, s_m, s_sc, s_wk, s_wv, s_ffn = run_trunk(
        x_sample, c_sample, False, state_mlstm_C, state_mlstm_n, state_mlstm_m, state_sconv,
        cache_win_k, cache_win_v, state_ffn_conv,
        norm1, norm2, w_ada, b_ada, a_w_in, a_b_if, a_out_norm, a_conv_w, a_w_out,
        c_w_qkv, c_q_norm, c_k_norm, c_sink, c_w_out, f_w_up, f_conv_w, f_w_down)

    return (y_prompt, y_sample, p_C, p_n, p_m, p_sc, p_wk, p_wv, p_ffn,
            s_C, s_n, s_m, s_sc, s_wk, s_wv, s_ffn)
```

```cpp
#include <hip/hip_runtime.h>
#include <hip/hip_cooperative_groups.h>
#include <cstdio>
#include <cstdint>
namespace cg = cooperative_groups;
__device__ __forceinline__ int otid() { int t = threadIdx.x; asm volatile("" : "+v"(t)); return t; }
__device__ __forceinline__ int obid() { int b = blockIdx.x; asm volatile("" : "+s"(b)); return b; }
__device__ __forceinline__ float shx(float v, int o) { const int l = otid() & 63; return __builtin_bit_cast(float, __builtin_amdgcn_ds_bpermute((l ^ o) << 2, __builtin_bit_cast(int, v))); }
__device__ __forceinline__ float shi(float v, int src) { return __builtin_bit_cast(float, __builtin_amdgcn_ds_bpermute(src << 2, __builtin_bit_cast(int, v))); }
__device__ __forceinline__ float shup(float v, int o) { const int l = otid() & 63; const int src = l >= o ? l - o : l; return __builtin_bit_cast(float, __builtin_amdgcn_ds_bpermute(src << 2, __builtin_bit_cast(int, v))); }
namespace pg8 {
#define PG8_LAS __attribute__((address_space(3)))
typedef unsigned short bf16_t;
typedef short bf16x8 __attribute__((ext_vector_type(8)));
typedef float f32x4 __attribute__((ext_vector_type(4)));
typedef unsigned u32x4 __attribute__((ext_vector_type(4)));
constexpr int BM = 256, BK = 64, HALF = 128, HTB = HALF * BK * 2  , STAGE_BYTES = 8 * HTB, NXCD = 8, WGM = 8;

__host__ __device__ __forceinline__ int lds_byte(int r, int c) { const int st = (r >> 4) * 2 + (c >> 5), rr = r & 15, cc = c & 31, ob = rr * 64 + cc * 2; return st * 1024 + (ob ^ (((ob >> 9) & 1) << 5)); }
__host__ __device__ __forceinline__ void stage_rc(int b, int& R, int& C) { const int st = b / 1024, sb = b % 1024, swz = sb ^ (((sb >> 9) & 1) << 5); R = (st >> 1) * 16 + swz / 64; C = (st & 1) * 32 + (swz % 64) / 2; }
__host__ __device__ __forceinline__ int perm32(int rho) { const int n = rho >> 4, i = rho & 15; return 8 * (i >> 2) + 4 * n + (i & 3); }

struct Unit { int pm, pn; };
struct Gemm { const bf16_t* A; const bf16_t* Bt; int M, N, K; };

struct StaticOrder {
    int nM, nN, nwg, G, c;
    __host__ __device__ void init(int M, int N, int G_, int c_) { nM = M / BM; nN = N / BM; nwg = nM * nN; G = G_; c = c_; }
    __host__ __device__ bool next(int i, Unit& u) const {
        const long L = (long)i * G + c; if (L >= nwg) return false;
        int wgid = (int)L; { const int q = nwg / NXCD, r = nwg % NXCD, xcd = wgid % NXCD, off = wgid / NXCD; wgid = (xcd < r ? xcd * (q + 1) : r * (q + 1) + (xcd - r) * q) + off; }
        const int nig = WGM * nN, gid = wgid / nig, fm = gid * WGM, gsz = (nM - fm) < WGM ? (nM - fm) : WGM;
        u.pm = fm + ((wgid % nig) % gsz); u.pn = (wgid % nig) / gsz; return true;
    }
    __device__ __forceinline__ void a_ready(const Unit&) const {}
    __device__ __forceinline__ void done(const Unit&) const {}
};

__device__ __forceinline__ unsigned cvt_pk_bf16(float lo, float hi) { unsigned r; asm volatile("v_cvt_pk_bf16_f32 %0, %1, %2" : "=v"(r) : "v"(lo), "v"(hi)); return r; }
template <class Epi, class Sched, bool ALIGN_EPI = false, bool SP2 = false>
__device__ __forceinline__ void gemm_phase(PG8_LAS unsigned char* lds, const Gemm g, const Sched& S, const Epi& E) {
    const int tid = otid(), wid = __builtin_amdgcn_readfirstlane(tid >> 6), lane = tid & 63, wr = wid >> 2, wc = wid & 3, fr = lane & 15, fq = lane >> 4;
    const int K = g.K, nt = K / BK;
    unsigned voffA[2], voffB[2];
#pragma unroll
    for (int i = 0; i < 2; ++i) { int R, C; stage_rc(tid * 16 + i * 8192, R, C); const int Rb = Epi::PERM ? ((R & ~31) + perm32(R & 31)) : R;
        const int Ra = 8 * (16 * (R >> 6) + (R & 15)) + ((R >> 4) & 3);
        voffA[i] = (unsigned)(Ra * K + C) * 2u; voffB[i] = (unsigned)(Rb * K + C) * 2u; }
    const size_t kstep = (size_t)(BK * 2);
    const size_t hstep = (size_t)HALF * K * 2;
    const size_t hstepA = (size_t)4 * K * 2;
    const size_t tstep = 2 * hstep;
    const unsigned ldsw = (unsigned)wid * 1024u;
    const int aoff = lds_byte(wr * 64 + fr, fq * 8), boff = lds_byte(wc * 32 + fr, fq * 8);
#define PG8_SA(b, h) (((b) * 2 + (h)) * HTB)
#define PG8_SB(b, h) ((4 + (b) * 2 + (h)) * HTB)
#define PG8_STAGE(bufoff, gbase, voff) do { _Pragma("unroll") for (int _i = 0; _i < 2; ++_i) \
        __builtin_amdgcn_global_load_lds((const unsigned*)((const char*)(gbase) + (voff)[_i]), (PG8_LAS unsigned*)(lds + (bufoff) + ldsw + _i * 8192), 16, 0, 0); } while (0)
#define PG8_LDA(dst, b, h) do { _Pragma("unroll") for (int m = 0; m < 4; ++m) _Pragma("unroll") for (int k = 0; k < 2; ++k) dst[m][k] = *(const PG8_LAS bf16x8*)(lds + PG8_SA(b, h) + aoff + m * 2048 + k * 1024); } while (0)
#define PG8_LDB(dst, b, h) do { _Pragma("unroll") for (int n = 0; n < 2; ++n) _Pragma("unroll") for (int k = 0; k < 2; ++k) dst[n][k] = *(const PG8_LAS bf16x8*)(lds + PG8_SB(b, h) + boff + n * 2048 + k * 1024); } while (0)
#define PG8_MMA(ai, bj, At, Bt) do { __builtin_amdgcn_s_setprio(1); _Pragma("unroll") for (int m = 0; m < 4; ++m) _Pragma("unroll") for (int n = 0; n < 2; ++n) _Pragma("unroll") for (int k = 0; k < 2; ++k) \
        acc[ai][bj][m][n] = __builtin_amdgcn_mfma_f32_16x16x32_bf16(Bt[n][k], At[m][k], acc[ai][bj][m][n], 0, 0, 0); __builtin_amdgcn_s_setprio(0); } while (0)
#define PG8_WAIT_V(n) asm volatile("s_waitcnt vmcnt(" #n ")" ::: "memory")
#define PG8_WAIT_L(n) asm volatile("s_waitcnt lgkmcnt(" #n ")" ::: "memory")
#define PG8_BAR __builtin_amdgcn_s_barrier()
#define PG8_SCHED __builtin_amdgcn_sched_barrier(0)
    Unit cur, nxt; int ui = 0;
    if (!S.next(0, cur)) return;
    f32x4 acc[2][2][4][2];
#pragma unroll
    for (int a = 0; a < 2; ++a)
#pragma unroll
        for (int b = 0; b < 2; ++b)
#pragma unroll
            for (int m = 0; m < 4; ++m)
#pragma unroll
                for (int n = 0; n < 2; ++n) acc[a][b][m][n] = (f32x4){0.f, 0.f, 0.f, 0.f};
    bf16x8 At[4][2], B0[2][2], B1[2][2];
    const char* cA = (const char*)g.A + (size_t)cur.pm * tstep; const char* cB = (const char*)g.Bt + (size_t)cur.pn * tstep;
    S.a_ready(cur);
    if constexpr (SP2) {
        PG8_STAGE(PG8_SB(0, 0), cB, voffB); PG8_STAGE(PG8_SB(0, 1), cB + hstep, voffB); PG8_STAGE(PG8_SA(0, 0), cA, voffA); PG8_STAGE(PG8_SA(0, 1), cA + hstepA, voffA);
        if (wr == 1) PG8_BAR;
        PG8_WAIT_V(2); PG8_BAR;
        PG8_STAGE(PG8_SB(1, 0), cB + kstep, voffB); PG8_STAGE(PG8_SA(1, 0), cA + kstep, voffA); PG8_STAGE(PG8_SB(1, 1), cB + hstep + kstep, voffB);
        PG8_WAIT_V(6); PG8_BAR;
    } else {
        PG8_STAGE(PG8_SB(0, 0), cB, voffB); PG8_STAGE(PG8_SA(0, 0), cA, voffA); PG8_STAGE(PG8_SB(0, 1), cB + hstep, voffB); PG8_STAGE(PG8_SA(0, 1), cA + hstepA, voffA);
        if (wr == 1) PG8_BAR;
        PG8_WAIT_V(4); PG8_BAR;
        PG8_STAGE(PG8_SB(1, 0), cB + kstep, voffB); PG8_STAGE(PG8_SA(1, 0), cA + kstep, voffA); PG8_STAGE(PG8_SB(1, 1), cB + hstep + kstep, voffB);
        PG8_WAIT_V(6); PG8_BAR;
    }
    for (;;) {
        const bool has_next = S.next(ui + 1, nxt);
        const char* nA = has_next ? (const char*)g.A + (size_t)nxt.pm * tstep : cA; const char* nB = has_next ? (const char*)g.Bt + (size_t)nxt.pn * tstep : cB;
        for (int t = 0; t < nt; t += 2) {
            const bool last = (t == nt - 2);
            const char* a1 = cA + (size_t)(t + 1) * kstep;
            const char* a2 = last ? nA : cA + (size_t)(t + 2) * kstep; const char* b2 = last ? nB : cB + (size_t)(t + 2) * kstep;
            const char* a3 = a2 + kstep; const char* b3 = b2 + kstep;
            if (last && has_next) S.a_ready(nxt);
            if constexpr (SP2) {
            PG8_LDB(B0, 0, 0); PG8_LDB(B1, 0, 1); PG8_SCHED; PG8_LDA(At, 0, 0); PG8_STAGE(PG8_SA(1, 1), a1 + hstepA, voffA);
            PG8_WAIT_V(8); PG8_WAIT_L(0); PG8_BAR; PG8_MMA(0, 0, At, B0); PG8_MMA(0, 1, At, B1); PG8_BAR; PG8_SCHED;
            PG8_LDA(At, 0, 1); PG8_STAGE(PG8_SB(0, 0), b2, voffB); PG8_STAGE(PG8_SB(0, 1), b2 + hstep, voffB); PG8_STAGE(PG8_SA(0, 0), a2, voffA);
            PG8_WAIT_V(8); PG8_WAIT_L(0); PG8_BAR; PG8_MMA(1, 0, At, B0); PG8_MMA(1, 1, At, B1); PG8_BAR; PG8_SCHED;
            PG8_LDB(B0, 1, 0); PG8_LDB(B1, 1, 1); PG8_SCHED; PG8_LDA(At, 1, 0); PG8_STAGE(PG8_SA(0, 1), a2 + hstepA, voffA);
            PG8_WAIT_V(8); PG8_WAIT_L(0); PG8_BAR; PG8_MMA(0, 0, At, B0); PG8_MMA(0, 1, At, B1); PG8_BAR; PG8_SCHED;
            PG8_LDA(At, 1, 1); PG8_STAGE(PG8_SB(1, 0), b3, voffB); PG8_STAGE(PG8_SB(1, 1), b3 + hstep, voffB); PG8_STAGE(PG8_SA(1, 0), a3, voffA);
            PG8_WAIT_V(8); PG8_WAIT_L(0); PG8_BAR; PG8_MMA(1, 0, At, B0); PG8_MMA(1, 1, At, B1); PG8_BAR; PG8_SCHED;
            } else {
            PG8_LDB(B0, 0, 0); PG8_SCHED; PG8_LDA(At, 0, 0); PG8_STAGE(PG8_SA(1, 1), a1 + hstepA, voffA);
            PG8_WAIT_L(8); PG8_BAR; PG8_WAIT_L(0); PG8_MMA(0, 0, At, B0); PG8_BAR; PG8_SCHED;
            PG8_LDB(B1, 0, 1); PG8_STAGE(PG8_SB(0, 0), b2, voffB);
            PG8_BAR; PG8_WAIT_L(0); PG8_MMA(0, 1, At, B1); PG8_BAR;
            PG8_LDA(At, 0, 1); PG8_STAGE(PG8_SA(0, 0), a2, voffA);
            PG8_BAR; PG8_WAIT_L(0); PG8_MMA(1, 0, At, B0); PG8_BAR; PG8_SCHED;
            PG8_STAGE(PG8_SB(0, 1), b2 + hstep, voffB);
            PG8_WAIT_V(6); PG8_BAR; PG8_MMA(1, 1, At, B1); PG8_BAR;
            PG8_LDB(B0, 1, 0); PG8_SCHED; PG8_LDA(At, 1, 0); PG8_STAGE(PG8_SA(0, 1), a2 + hstepA, voffA);
            PG8_WAIT_L(8); PG8_BAR; PG8_WAIT_L(0); PG8_MMA(0, 0, At, B0); PG8_BAR; PG8_SCHED;
            PG8_LDB(B1, 1, 1); PG8_STAGE(PG8_SB(1, 0), b3, voffB);
            PG8_BAR; PG8_WAIT_L(0); PG8_MMA(0, 1, At, B1); PG8_BAR;
            PG8_LDA(At, 1, 1); PG8_STAGE(PG8_SA(1, 0), a3, voffA);
            PG8_BAR; PG8_WAIT_L(0); PG8_MMA(1, 0, At, B0); PG8_BAR; PG8_SCHED;
            PG8_STAGE(PG8_SB(1, 1), b3 + hstep, voffB);
            PG8_WAIT_V(6); PG8_BAR; PG8_MMA(1, 1, At, B1); PG8_BAR;
            }
        }
        if constexpr (ALIGN_EPI) { if (wr == 0) PG8_BAR; }
        if constexpr (!Epi::AFTER_DRAIN) { E(acc, cur, wr, wc, fr, fq); S.done(cur); }
        if (!has_next) break;
#pragma unroll
        for (int a = 0; a < 2; ++a)
#pragma unroll
            for (int b = 0; b < 2; ++b)
#pragma unroll
                for (int m = 0; m < 4; ++m)
#pragma unroll
                    for (int n = 0; n < 2; ++n) acc[a][b][m][n] = (f32x4){0.f, 0.f, 0.f, 0.f};
        cur = nxt; cA = nA; cB = nB; ++ui;
        if constexpr (ALIGN_EPI) { if (wr == 1) PG8_BAR; }
    }
    PG8_WAIT_V(0);
    if constexpr (!ALIGN_EPI) { if (wr == 0) PG8_BAR; }
    PG8_BAR;
    if constexpr (Epi::AFTER_DRAIN) { E.fused(acc, cur, wr, wc, fr, fq, lds, wid, lane); S.done(cur); }
#undef PG8_SA
#undef PG8_SB
#undef PG8_STAGE
#undef PG8_LDA
#undef PG8_LDB
#undef PG8_MMA
#undef PG8_WAIT_V
#undef PG8_WAIT_L
#undef PG8_BAR
#undef PG8_SCHED
}
}

typedef unsigned short bf16;
typedef float f32x4 __attribute__((ext_vector_type(4)));
typedef float f32x2 __attribute__((ext_vector_type(2)));
typedef unsigned u32x4 __attribute__((ext_vector_type(4)));
typedef unsigned u32x2 __attribute__((ext_vector_type(2)));
typedef short bf16x8 __attribute__((ext_vector_type(8)));

constexpr int R = 17408, RP = 16384, NSEQ = 130, SEQL = 8192;
constexpr int DM = 1024, INA = 3592, ZW = 3584, QKVW = 1536, FF = 2816, FF2 = 5632, MODW = 24576;
constexpr float EPS = 1e-6f;
constexpr int NWAVES = 8, NTHR = 512;
constexpr int LDS_BYTES = 147456;

constexpr size_t O_Y = 0;
constexpr size_t O_PC = (size_t)R * 1024;
constexpr size_t O_PN = O_PC + 262144;
constexpr size_t O_PM = O_PN + 2048;
constexpr size_t O_PSC = O_PM + 16;
constexpr size_t O_PWK = O_PSC + 4096;
constexpr size_t O_PWV = O_PWK + 131072;
constexpr size_t O_PFFN = O_PWV + 131072;
constexpr size_t O_SC = O_PFFN + 90112;
constexpr size_t O_SN = O_SC + 16777216;
constexpr size_t O_SM = O_SN + 131072;
constexpr size_t O_SSC = O_SM + 1024;
constexpr size_t O_SWK = O_SSC + 262144;
constexpr size_t O_SWV = O_SWK + 8388608;
constexpr size_t O_SFFN = O_SWV + 8388608;
constexpr size_t O_END = O_SFFN + 5767168;

constexpr size_t MiB = 1u << 20;
constexpr size_t WS_WIN = 1 * MiB, WS_WAO = 15 * MiB, WS_WQKV = 19 * MiB, WS_WCO = 25 * MiB, WS_WUP = 29 * MiB, WS_WDN = 73 * MiB;
constexpr size_t WS_AC = 95 * MiB, WS_MOD = 96 * MiB, WS_TAB = 109 * MiB, WS_H = 112 * MiB, WS_CAT = 146 * MiB, WS_GATES = 180 * MiB;
constexpr size_t WS_ZU = 181 * MiB;
constexpr size_t WS_ACT = 368 * MiB;
constexpr size_t WS_DCT = WS_ACT, WS_CST = WS_ACT + 64 * MiB, WS_NS = WS_ACT + 96 * MiB, WS_DN = WS_NS + MiB / 2, WS_CS = WS_NS + MiB, WS_MS = WS_CS + 65536;
constexpr size_t WS_UB = 466 * MiB;
constexpr size_t WS_END = 472 * MiB;

__constant__ double ROPE_INV[32] = {1.0, 0.7498942093324559, 0.5623413251903491, 0.4216965034285822, 0.31622776601683794, 0.23713737056616552, 0.1778279410038923, 0.1333521432163324, 0.1, 0.07498942093324558, 0.05623413251903491, 0.042169650342858224, 0.03162277660168379, 0.023713737056616554, 0.01778279410038923, 0.01333521432163324, 0.01, 0.007498942093324558, 0.005623413251903491, 0.004216965034285823, 0.0031622776601683794, 0.0023713737056616554, 0.0017782794100389228, 0.001333521432163324, 0.001, 0.0007498942093324559, 0.0005623413251903491, 0.00042169650342858224, 0.00031622776601683794, 0.00023713737056616554, 0.00017782794100389227, 0.0001333521432163324};
#ifndef PROBE_PRE
#define PROBE_PRE 0
#define PROBE_EVEN 0
#define PROBE_ODD 0
#endif
#ifndef PROBE_BAR
#define PROBE_BAR 0
#endif
struct Params { const float* in[28]; float* out; unsigned char* ws; int lo, hi; };

__device__ __forceinline__ unsigned f2bf(float f) { unsigned u = __builtin_bit_cast(unsigned, f); return (u + 0x7fffu + ((u >> 16) & 1u)) >> 16; }
__device__ __forceinline__ unsigned pk2(float lo, float hi) { unsigned r; asm("v_cvt_pk_bf16_f32 %0, %1, %2" : "=v"(r) : "v"(lo), "v"(hi)); return r; }
__device__ __forceinline__ unsigned pk2_sw(float lo, float hi) { return f2bf(lo) | (f2bf(hi) << 16); }
__device__ __forceinline__ float bf2f(unsigned h) { return __builtin_bit_cast(float, h << 16); }
__device__ __forceinline__ float bflo(unsigned w) { return __builtin_bit_cast(float, w << 16); }
__device__ __forceinline__ float bfhi(unsigned w) { return __builtin_bit_cast(float, w & 0xffff0000u); }
template <int CTRL> __device__ __forceinline__ float dppf(float x) { return __builtin_bit_cast(float, __builtin_amdgcn_mov_dpp(__builtin_bit_cast(int, x), CTRL, 0xF, 0xF, true)); }
__device__ __forceinline__ float rdl(float x, int l) { return __builtin_bit_cast(float, __builtin_amdgcn_readlane(__builtin_bit_cast(int, x), l)); }
__device__ __forceinline__ float wave_sum(float v) {
    v += dppf<0xB1>(v); v += dppf<0x4E>(v); v += dppf<0x141>(v); v += dppf<0x140>(v);
    return (rdl(v, 0) + rdl(v, 16)) + (rdl(v, 32) + rdl(v, 48));
}
__device__ __forceinline__ float wave_max(float v) {
    v = fmaxf(v, dppf<0xB1>(v)); v = fmaxf(v, dppf<0x4E>(v)); v = fmaxf(v, dppf<0x141>(v)); v = fmaxf(v, dppf<0x140>(v));
    return fmaxf(fmaxf(rdl(v, 0), rdl(v, 16)), fmaxf(rdl(v, 32), rdl(v, 48)));
}
__device__ __forceinline__ float logsigmoidf(float f) { return fminf(f, 0.f) - log1pf(__expf(-fabsf(f))); }
__device__ __forceinline__ float sigmoidf_(float x) { return __builtin_amdgcn_rcpf(1.f + __builtin_amdgcn_exp2f(x * -1.4426950408889634f)); }
__device__ __forceinline__ int seq_of(int row) { return row < RP ? (row >> 13) : 2 + ((row - RP) >> 3); }
#define LAS __attribute__((address_space(3)))
#define LDS_WAIT() asm volatile("s_waitcnt lgkmcnt(0)" ::: "memory")

__device__ __forceinline__ float dpp_shr1f(float x) { return __builtin_bit_cast(float, __builtin_amdgcn_mov_dpp(__builtin_bit_cast(int, x), 0x111, 0xF, 0xF, false)); }
__device__ __forceinline__ f32x4 dpp_shr1(const f32x4 v) { f32x4 r; r.x = dpp_shr1f(v.x); r.y = dpp_shr1f(v.y); r.z = dpp_shr1f(v.z); r.w = dpp_shr1f(v.w); return r; }
struct EpiMain {
    static constexpr bool PERM = true, AFTER_DRAIN = false;
    int mode;
    bf16* O; int ldc; float* X; const float* gate;
    const float* qn; const float* kn; int lyr; unsigned char* wsb;
    const float* cw; const float* stp; float* sout;
    __device__ __forceinline__ void operator()(const pg8::f32x4 (&acc)[2][2][4][2], const pg8::Unit& u, int wr, int wc, int fr, int fq) const {
        const int rowb = u.pm * 256 + 8 * (16 * wr + fr), col0 = u.pn * 256 + wc * 32 + 8 * fq;
        if (mode == 0) {
#pragma unroll
            for (int ai = 0; ai < 2; ++ai)
#pragma unroll
                for (int m = 0; m < 4; ++m) { bf16* rowp = O + (size_t)(rowb + 4 * ai + m) * ldc + col0;
#pragma unroll
                    for (int bj = 0; bj < 2; ++bj) { const pg8::f32x4 v0 = acc[ai][bj][m][0], v1 = acc[ai][bj][m][1]; u32x4 w;
                        w.x = pg8::cvt_pk_bf16(v0[0], v0[1]); w.y = pg8::cvt_pk_bf16(v0[2], v0[3]); w.z = pg8::cvt_pk_bf16(v1[0], v1[1]); w.w = pg8::cvt_pk_bf16(v1[2], v1[3]);
                        *(u32x4*)(rowp + bj * 128) = w; } }
        } else if (mode == 1) {
            f32x4 gv[2][2];
            { const float* gp = gate + (size_t)(u.pm >> 5) * MODW + col0;
#pragma unroll
              for (int bj = 0; bj < 2; ++bj)
#pragma unroll
                  for (int n = 0; n < 2; ++n) gv[bj][n] = *(const f32x4*)(gp + bj * 128 + 4 * n); }
#pragma unroll
            for (int am = 0; am < 4; ++am) { const int ai = am >> 1, m0 = (am & 1) * 2;
                f32x4 xv[2][2][2];
#pragma unroll
                for (int mm = 0; mm < 2; ++mm) { const float* xp = X + (size_t)(rowb + 4 * ai + m0 + mm) * DM + col0;
#pragma unroll
                    for (int bj = 0; bj < 2; ++bj)
#pragma unroll
                        for (int n = 0; n < 2; ++n) xv[mm][bj][n] = *(const f32x4*)(xp + bj * 128 + 4 * n); }
#pragma unroll
                for (int mm = 0; mm < 2; ++mm) { float* xp = X + (size_t)(rowb + 4 * ai + m0 + mm) * DM + col0;
#pragma unroll
                    for (int bj = 0; bj < 2; ++bj)
#pragma unroll
                        for (int n = 0; n < 2; ++n) *(f32x4*)(xp + bj * 128 + 4 * n) = xv[mm][bj][n] + gv[bj][n] * acc[ai][bj][m0 + mm][n]; }
            }
        } else if (mode == 3) {
            int fq3 = fq; asm volatile("" : "+v"(fq3));
            const int head = 4 * u.pn + wc; const bool prm = u.pm < 64;
            const f32x2* TAB = (const f32x2*)(wsb + WS_TAB);
            const int sq = prm ? (u.pm >> 5) : ((rowb - RP) >> 3);
            const float* nwp = (head < 16 ? qn : kn) + 8 * fq3;
            f32x4 ca, sa, cb, sb;
            { const int pos0 = prm ? (rowb & (SEQL - 1)) : SEQL; const f32x4* tp = (const f32x4*)(TAB + pos0 * 32 + 8 * fq3); const f32x4 c0 = tp[0], c1 = tp[1], c2 = tp[2], c3 = tp[3];
              ca = (f32x4){c0[0], c0[2], c1[0], c1[2]}; sa = (f32x4){c0[1], c0[3], c1[1], c1[3]}; cb = (f32x4){c2[0], c2[2], c3[0], c3[2]}; sb = (f32x4){c2[1], c2[3], c3[1], c3[3]};
            }
#pragma unroll
            for (int j = 0; j < 8; ++j) { const int row = rowb + j, t = prm ? (row & (SEQL - 1)) : j;
                f32x4 x1a = acc[j >> 2][0][j & 3][0], x1b = acc[j >> 2][0][j & 3][1], x2a = acc[j >> 2][1][j & 3][0], x2b = acc[j >> 2][1][j & 3][1];
                if (head < 20) {
                    float ss = (x1a[0] * x1a[0] + x1a[1] * x1a[1]) + (x1a[2] * x1a[2] + x1a[3] * x1a[3]) + (x1b[0] * x1b[0] + x1b[1] * x1b[1]) + (x1b[2] * x1b[2] + x1b[3] * x1b[3])
                             + (x2a[0] * x2a[0] + x2a[1] * x2a[1]) + (x2a[2] * x2a[2] + x2a[3] * x2a[3]) + (x2b[0] * x2b[0] + x2b[1] * x2b[1]) + (x2b[2] * x2b[2] + x2b[3] * x2b[3]);
                    ss += shx(ss, 16); ss += shx(ss, 32);
                    const float rstd = rsqrtf(ss * (1.f / 64.f) + EPS);
                    const f32x4 y1a = x1a * rstd * *(const f32x4*)nwp, y1b = x1b * rstd * *(const f32x4*)(nwp + 4), y2a = x2a * rstd * *(const f32x4*)(nwp + 32), y2b = x2b * rstd * *(const f32x4*)(nwp + 36);
                    x1a = y1a * ca - y2a * sa; x1b = y1b * cb - y2b * sb; x2a = y2a * ca + y1a * sa; x2b = y2b * cb + y1b * sb;
                }
                bf16* zp = O + (size_t)row * QKVW + head * 64 + 8 * fq3;
                *(u32x4*)zp = (u32x4){pk2(x1a[0], x1a[1]), pk2(x1a[2], x1a[3]), pk2(x1b[0], x1b[1]), pk2(x1b[2], x1b[3])};
                *(u32x4*)(zp + 32) = (u32x4){pk2(x2a[0], x2a[1]), pk2(x2a[2], x2a[3]), pk2(x2b[0], x2b[1]), pk2(x2b[2], x2b[3])};
                if (head >= 16 && (!prm || t >= SEQL - 128)) {
                    float* dst = X + (head < 20 ? (prm ? O_PWK : O_SWK) : (prm ? O_PWV : O_SWV)) + (prm ? ((size_t)(lyr * 2 + sq) * 128 + (t - (SEQL - 128))) * 256 : ((size_t)(lyr * 128 + sq) * 128 + 120 + j) * 256) + ((head - 16) & 3) * 64 + 8 * fq3;
                    *(f32x4*)dst = x1a; *(f32x4*)(dst + 4) = x1b; *(f32x4*)(dst + 32) = x2a; *(f32x4*)(dst + 36) = x2b; }
                if (head < 20) { const f32x4* t1 = (const f32x4*)(TAB + 32 + 8 * fq3); const f32x4 e0 = t1[0], e1 = t1[1], e2 = t1[2], e3 = t1[3];
                    const f32x4 dca = (f32x4){e0[0], e0[2], e1[0], e1[2]}, dsa = (f32x4){e0[1], e0[3], e1[1], e1[3]}, dcb = (f32x4){e2[0], e2[2], e3[0], e3[2]}, dsb = (f32x4){e2[1], e2[3], e3[1], e3[3]};
                    const f32x4 na = ca * dca - sa * dsa, nb = cb * dcb - sb * dsb; sa = sa * dca + ca * dsa; sb = sb * dcb + cb * dsb; ca = na; cb = nb; }
                asm volatile("" ::: "memory");
            }
        } else {
            const bool smp = u.pm >= 64; const int sq = (rowb - RP) >> 3;
            bf16* UB = (bf16*)(wsb + WS_UB); bf16* ACT = (bf16*)(wsb + WS_ACT);
#pragma unroll
            for (int n = 0; n < 2; ++n) {
                const int cf = u.pn * 128 + wc * 32 + 8 * fq + 4 * n;
                const f32x4 wg0 = *(const f32x4*)(cw + cf), wg1 = *(const f32x4*)(cw + FF2 + cf), wg2 = *(const f32x4*)(cw + 2 * FF2 + cf);
                const f32x4 wa0 = *(const f32x4*)(cw + FF + cf), wa1 = *(const f32x4*)(cw + FF2 + FF + cf), wa2 = *(const f32x4*)(cw + 2 * FF2 + FF + cf);
                f32x4 g2, g1, a2, a1;
                if (smp) { const float* st = stp + (size_t)sq * 2 * FF2; g2 = *(const f32x4*)(st + cf); a2 = *(const f32x4*)(st + FF + cf); g1 = *(const f32x4*)(st + FF2 + cf); a1 = *(const f32x4*)(st + FF2 + FF + cf); }
                else { g2 = dpp_shr1(acc[1][0][2][n]); g1 = dpp_shr1(acc[1][0][3][n]); a2 = dpp_shr1(acc[1][1][2][n]); a1 = dpp_shr1(acc[1][1][3][n]); }
#pragma unroll
                for (int j = 0; j < 8; ++j) { const f32x4 G = acc[j >> 2][0][j & 3][n], A = acc[j >> 2][1][j & 3][n];
                    const f32x4 cg = wg0 * g2 + wg1 * g1 + wg2 * G, ca = wa0 * a2 + wa1 * a1 + wa2 * A;
                    if (smp || fr != 0 || j >= 2)
                        *(u32x2*)(ACT + (size_t)(rowb + j) * FF + cf) = (u32x2){pg8::cvt_pk_bf16(cg[0] * sigmoidf_(cg[0]) * ca[0], cg[1] * sigmoidf_(cg[1]) * ca[1]), pg8::cvt_pk_bf16(cg[2] * sigmoidf_(cg[2]) * ca[2], cg[3] * sigmoidf_(cg[3]) * ca[3])};
                    if (smp) { if (j >= 6) { float* d = sout + ((size_t)sq * 2 + (j - 6)) * FF2; *(f32x4*)(d + cf) = G; *(f32x4*)(d + FF + cf) = A; } }
                    else if ((fr == 0 && j < 2) || (fr == 15 && j >= 6)) { bf16* d = UB + ((size_t)(u.pm * 2 + wr) * 4 + (j < 2 ? j : j - 4)) * FF2;
                        *(u32x2*)(d + cf) = (u32x2){pk2(G[0], G[1]), pk2(G[2], G[3])}; *(u32x2*)(d + FF + cf) = (u32x2){pk2(A[0], A[1]), pk2(A[2], A[3])}; }
                    g2 = g1; g1 = G; a2 = a1; a1 = A; }
            }
        }
    }
};
struct EpiMod {
    static constexpr bool PERM = true, AFTER_DRAIN = false;
    float* O; const float* bias;
    __device__ __forceinline__ void operator()(const pg8::f32x4 (&acc)[2][2][4][2], const pg8::Unit& u, int wr, int wc, int fr, int fq) const {
        const int rowb = u.pm * 256 + 8 * (16 * wr + fr), col0 = u.pn * 256 + wc * 32 + 8 * fq;
#pragma unroll
        for (int ai = 0; ai < 2; ++ai)
#pragma unroll
            for (int m = 0; m < 4; ++m) { const int row = rowb + 4 * ai + m;
                if (row < NSEQ) {
#pragma unroll
                    for (int bj = 0; bj < 2; ++bj)
#pragma unroll
                        for (int n = 0; n < 2; ++n) { const f32x4 b = *(const f32x4*)(bias + col0 + bj * 128 + 4 * n);
                            *(f32x4*)(O + (size_t)row * MODW + col0 + bj * 128 + 4 * n) = acc[ai][bj][m][n] + b; } } }
    }
};


__device__ __forceinline__ void mini_gemm(const bf16* A, const bf16* Bt, int K, float* X, const float* gate, unsigned char* smem) {
    const int tid = otid(), lane = tid & 63, wave = tid >> 6, fr = lane & 15, fq = lane >> 4;
    float* part = (float*)smem;
    const int nks = K / 256;
    for (int u = obid(); u < 256; u += gridDim.x) {
        const int rm = u >> 4, cn = u & 15;
        const bf16* Ap = A + (size_t)(RP + 64 * rm + fr) * K + wave * (K / 8) + 8 * fq;
        const bf16* Bp = Bt + (size_t)(64 * cn + fr) * K + wave * (K / 8) + 8 * fq;
        f32x4 acc[4][4];
#pragma unroll
        for (int i = 0; i < 4; ++i)
#pragma unroll
            for (int j = 0; j < 4; ++j) acc[i][j] = (f32x4){0.f, 0.f, 0.f, 0.f};
        bf16x8 a0[4], b0[4], a1[4], b1[4];
#define MG_LD(a, b, ks) do { _Pragma("unroll") for (int i_ = 0; i_ < 4; ++i_) { a[i_] = *(const bf16x8*)(Ap + (size_t)(16 * i_) * K + 32 * (ks)); b[i_] = *(const bf16x8*)(Bp + (size_t)(16 * i_) * K + 32 * (ks)); } } while (0)
#define MG_MMA(a, b) do { _Pragma("unroll") for (int i_ = 0; i_ < 4; ++i_) _Pragma("unroll") for (int j_ = 0; j_ < 4; ++j_) acc[i_][j_] = __builtin_amdgcn_mfma_f32_16x16x32_bf16(b[j_], a[i_], acc[i_][j_], 0, 0, 0); } while (0)
        MG_LD(a0, b0, 0);
        for (int ks = 0; ks < nks; ks += 2) {
            if (ks + 1 < nks) MG_LD(a1, b1, ks + 1);
            MG_MMA(a0, b0);
            if (ks + 2 < nks) MG_LD(a0, b0, ks + 2);
            if (ks + 1 < nks) MG_MMA(a1, b1);
        }
#undef MG_LD
#undef MG_MMA
#pragma unroll
        for (int i = 0; i < 4; ++i)
#pragma unroll
            for (int j = 0; j < 4; ++j) *(f32x4*)(part + (wave * 64 + 16 * i + fr) * 68 + 16 * j + 4 * fq) = acc[i][j];
        __syncthreads();
        {
            const int row = tid >> 3, c0 = (tid & 7) * 8;
            f32x4 s0 = (f32x4){0.f, 0.f, 0.f, 0.f}, s1 = s0;
#pragma unroll
            for (int w = 0; w < 8; ++w) { s0 = s0 + *(const f32x4*)(part + (w * 64 + row) * 68 + c0); s1 = s1 + *(const f32x4*)(part + (w * 64 + row) * 68 + c0 + 4); }
            const int grow = RP + 64 * rm + row, col = 64 * cn + c0; const int sq = 2 + ((grow - RP) >> 3);
            const float* gp = gate + (size_t)sq * MODW + col; float* xp = X + (size_t)grow * DM + col;
            const f32x4 g0 = *(const f32x4*)gp, g1 = *(const f32x4*)(gp + 4);
            *(f32x4*)xp = *(const f32x4*)xp + g0 * s0; *(f32x4*)(xp + 4) = *(const f32x4*)(xp + 4) + g1 * s1;
        }
        __syncthreads();
    }
}
struct TDesc { const float* W; bf16* WT; int ldw, K; };
constexpr int I_IN = 1792, I_AO = 512, I_QKV = 768, I_CO = 512, I_UP = 2816, I_DN = 1408, I_ADA = 3072;
constexpr int TN1 = 2 * I_IN, TN2 = TN1 + 2 * I_AO, TN3 = TN2 + 2 * I_QKV, TN4 = TN3 + 2 * I_CO, TN5 = TN4 + 4 * I_UP, TN6 = TN5 + 4 * I_DN, TN7 = TN6 + 4 * I_ADA;
__device__ __forceinline__ void tdecode(const Params& p, int it, TDesc& d) {
    unsigned char* ws = p.ws; int r = it, ncols; const float* W; bf16* WT; int ldw, K = DM; bool wup = false, wqkv = false;
    if (r < TN1) { const int i = r / I_IN; r -= i * I_IN; W = p.in[15] + (size_t)i * DM * INA; WT = (bf16*)(ws + WS_WIN) + (size_t)i * ZW * DM; ldw = INA;
        if (r < 1024) ncols = 2048; else { W += 2056; WT += (size_t)2048 * DM; r -= 1024; ncols = 1536; } }
    else if (r < TN2) { r -= TN1; const int i = r / I_AO; r -= i * I_AO; W = p.in[19] + (size_t)i * DM * DM; WT = (bf16*)(ws + WS_WAO) + (size_t)i * DM * DM; ldw = DM; ncols = DM; }
    else if (r < TN3) { r -= TN2; const int i = r / I_QKV; r -= i * I_QKV; W = p.in[20] + (size_t)i * DM * QKVW; WT = (bf16*)(ws + WS_WQKV) + (size_t)i * QKVW * DM; ldw = QKVW; ncols = QKVW; wqkv = true; }
    else if (r < TN4) { r -= TN3; const int i = r / I_CO; r -= i * I_CO; W = p.in[24] + (size_t)i * DM * DM; WT = (bf16*)(ws + WS_WCO) + (size_t)i * DM * DM; ldw = DM; ncols = DM; }
    else if (r < TN5) { r -= TN4; const int i = r / I_UP; r -= i * I_UP; W = p.in[25] + (size_t)i * DM * FF2; WT = (bf16*)(ws + WS_WUP) + (size_t)i * FF2 * DM; ldw = FF2; ncols = FF2; wup = true; }
    else if (r < TN6) { r -= TN5; const int i = r / I_DN; r -= i * I_DN; W = p.in[27] + (size_t)i * FF * DM; WT = (bf16*)(ws + WS_WDN) + (size_t)i * DM * FF; ldw = DM; ncols = DM; K = FF; }
    else { r -= TN6; const int i = r / I_ADA; r -= i * I_ADA; W = p.in[13] + (size_t)i * DM * 6144; WT = (bf16*)(ws + WS_ZU) + (size_t)i * 6144 * DM; ldw = 6144; ncols = 6144; }
    const int nblk = ncols / 32, kb = r / nblk, nb = r - kb * nblk;
    int drow = 32 * nb;
    if (wup) drow = (nb < 88) ? 256 * (nb >> 2) + 32 * (nb & 3) : 256 * ((nb - 88) >> 2) + 128 + 32 * ((nb - 88) & 3);
    if (wqkv) { const int head = nb >> 1; drow = 256 * (head >> 2) + 128 * (nb & 1) + 32 * (head & 3); }
    d.W = W + (size_t)(64 * kb) * ldw + 32 * nb; d.WT = WT + (size_t)drow * K + 64 * kb; d.ldw = ldw; d.K = K;
}
__device__ __forceinline__ void tload(const TDesc& d, int lane, float (&v)[32]) {
#pragma unroll
    for (int i = 0; i < 32; ++i) v[i] = d.W[(size_t)(2 * i + (lane >> 5)) * d.ldw + (lane & 31)];
}
__device__ __forceinline__ void tstore(const TDesc& d, int lane, const float (&v)[32], float* scr) {
#pragma unroll
    for (int i = 0; i < 32; ++i) scr[(2 * i + (lane >> 5)) * 33 + (lane & 31)] = v[i];
    LDS_WAIT();
    const int c = lane & 7;
#pragma unroll
    for (int j = 0; j < 4; ++j) { const int n = (lane >> 3) + 8 * j; const float* s = scr + (8 * c) * 33 + n;
        u32x4 o; o.x = pk2(s[0 * 33], s[1 * 33]); o.y = pk2(s[2 * 33], s[3 * 33]); o.z = pk2(s[4 * 33], s[5 * 33]); o.w = pk2(s[6 * 33], s[7 * 33]);
        *(u32x4*)(d.WT + (size_t)n * d.K + 8 * c) = o; }
    LDS_WAIT();
}

__device__ __forceinline__ void prologue(const Params& p, unsigned char* smem) {
    const int tid = otid(), lane = tid & 63, wave = tid >> 6;
    const int gw = obid() * NWAVES + wave, NGW = gridDim.x * NWAVES;
    float* scr = (float*)(smem + wave * 16384);
    unsigned char* ws = p.ws;
    {
        float va[32], vb[32]; TDesc da, db;
        int it = gw;
        if (it < TN7) { tdecode(p, it, da); tload(da, lane, va); }
        while (it < TN7) {
            int nx = it + NGW;
            if (nx < TN7) { tdecode(p, nx, db); tload(db, lane, vb); }
            tstore(da, lane, va, scr);
            it = nx; nx = it + NGW;
            if (it >= TN7) break;
            if (nx < TN7) { tdecode(p, nx, da); tload(da, lane, va); }
            tstore(db, lane, vb, scr);
            it = nx;
        }
    }
    const int gt = obid() * NTHR + tid, NT = gridDim.x * NTHR;
    bf16* Ac = (bf16*)(ws + WS_AC);
    for (int idx = gt; idx < 256 * DM; idx += NT) { const int row = idx >> 10, col = idx & 1023; float v = 0.f;
        if (row < 2) v = p.in[2][row * DM + col]; else if (row < NSEQ) v = p.in[3][(row - 2) * DM + col];
        Ac[idx] = (bf16)f2bf(v * sigmoidf_(v)); }
    f32x2* TAB = (f32x2*)(ws + WS_TAB);
    for (int idx = gt; idx < 8200 * 32; idx += NT) { const int pos = idx >> 5, i = idx & 31;
        const double ang = (double)pos * ROPE_INV[i];
        const double n = rint(ang * 0.6366197723675814); double r = fma(-n, 1.5707963267948966, ang); r = fma(-n, 6.123233995736766e-17, r); const double r2 = r * r;
        const double sn = r * (1.0 + r2 * (-1.0 / 6 + r2 * (1.0 / 120 + r2 * (-1.0 / 5040 + r2 * (1.0 / 362880 + r2 * (-1.0 / 39916800 + r2 * (1.0 / 6227020800.0)))))));
        const double cn = 1.0 + r2 * (-0.5 + r2 * (1.0 / 24 + r2 * (-1.0 / 720 + r2 * (1.0 / 40320 + r2 * (-1.0 / 3628800 + r2 * (1.0 / 479001600.0 + r2 * (-1.0 / 87178291200.0)))))));
        const int qd = ((int)n) & 3; const double c = (qd == 0) ? cn : (qd == 1) ? -sn : (qd == 2) ? -cn : sn, s = (qd == 0) ? sn : (qd == 1) ? cn : (qd == 2) ? -sn : -cn;
        TAB[idx] = (f32x2){(float)c, (float)s}; }
}

__device__ __forceinline__ void norm_phase(const Params& p, int l, int which, unsigned char* smem) {
    const int tid = otid(), lane = tid & 63, wave = tid >> 6;
    const int gw = obid() * NWAVES + wave, NGW = gridDim.x * NWAVES;
    const bool do_gates = (which == 1) && !(l & 1);
    const bool first = (which == 1) && (l == 0);
    float* X = p.out;
    const float* MOD = (const float*)(p.ws + WS_MOD);
    bf16* H = (bf16*)(p.ws + WS_H);
    float* gwl = (float*)smem;
    if (do_gates) {
        const float* W = p.in[15] + (size_t)(l >> 1) * DM * INA + 2048;
        for (int idx = tid; idx < 8192; idx += NTHR) gwl[idx] = W[(size_t)(idx >> 3) * INA + (idx & 7)];
        __syncthreads();
    }
    const float* nw = (which == 1 ? p.in[11] : p.in[12]) + l * DM;
    const int off_sh = l * 6144 + (which == 1 ? 0 : 3072), off_sc = off_sh + 1024;
    f32x4 nwv[4];
#pragma unroll
    for (int j = 0; j < 4; ++j) nwv[j] = *(const f32x4*)(nw + 4 * lane + 256 * j);
    f32x4 vn[4], vn2[4];
#define NORM_SRC(r_) (first ? ((r_) < RP ? p.in[0] + (size_t)(r_) * DM : p.in[1] + (size_t)((r_) - RP) * DM) : X + (size_t)(r_) * DM)
    { const int row = gw; if (row < R) { const float* src = NORM_SRC(row);
#pragma unroll
        for (int j = 0; j < 4; ++j) vn[j] = *(const f32x4*)(src + 4 * lane + 256 * j); }
      const int row2 = gw + NGW; if (row2 < R) { const float* src = NORM_SRC(row2);
#pragma unroll
        for (int j = 0; j < 4; ++j) vn2[j] = *(const f32x4*)(src + 4 * lane + 256 * j); } }
    for (int row = gw; row < R; row += NGW) {
        const int sq = seq_of(row);
        f32x4 v[4]; float ss = 0.f;
#pragma unroll
        for (int j = 0; j < 4; ++j) { v[j] = vn[j]; vn[j] = vn2[j]; }
        { const int nrow = row + 2 * NGW; if (nrow < R) { const float* src = NORM_SRC(nrow);
#pragma unroll
            for (int j = 0; j < 4; ++j) vn2[j] = *(const f32x4*)(src + 4 * lane + 256 * j); } }
#pragma unroll
        for (int j = 0; j < 4; ++j) ss += (v[j].x * v[j].x + v[j].y * v[j].y) + (v[j].z * v[j].z + v[j].w * v[j].w);
        if (first) {
#pragma unroll
            for (int j = 0; j < 4; ++j) *(f32x4*)(X + (size_t)row * DM + 4 * lane + 256 * j) = v[j];
        }
        const float rstd = rsqrtf(wave_sum(ss) * (1.f / DM) + EPS);
        const float* mrow = MOD + (size_t)sq * MODW;
        float ga[8];
#pragma unroll
        for (int g = 0; g < 8; ++g) ga[g] = 0.f;
#pragma unroll
        for (int j = 0; j < 4; ++j) {
            const f32x4 sc = *(const f32x4*)(mrow + off_sc + 4 * lane + 256 * j), sh = *(const f32x4*)(mrow + off_sh + 4 * lane + 256 * j);
            f32x4 h = v[j] * rstd * nwv[j] * (sc + 1.f) + sh;
            *(u32x2*)(H + (size_t)row * DM + 4 * lane + 256 * j) = (u32x2){pk2(h.x, h.y), pk2(h.z, h.w)};
            if (do_gates) {
#pragma unroll
                for (int e = 0; e < 4; ++e) { const float* wp = gwl + (4 * lane + 256 * j + e) * 8; const f32x4 w0 = *(const f32x4*)wp, w1 = *(const f32x4*)(wp + 4); const float hv = h[e];
                    ga[0] += hv * w0.x; ga[1] += hv * w0.y; ga[2] += hv * w0.z; ga[3] += hv * w0.w; ga[4] += hv * w1.x; ga[5] += hv * w1.y; ga[6] += hv * w1.z; ga[7] += hv * w1.w; }
            }
        }
        if (do_gates) {
            const float* bif = p.in[16] + (l >> 1) * 8;
#pragma unroll
            for (int g = 0; g < 8; ++g) ga[g] = wave_sum(ga[g]);
            if (lane == 0) { float* G = (float*)(p.ws + WS_GATES) + (size_t)row * 8;
                *(f32x4*)G = (f32x4){ga[0] + bif[0], ga[1] + bif[1], ga[2] + bif[2], ga[3] + bif[3]}; *(f32x4*)(G + 4) = (f32x4){ga[4] + bif[4], ga[5] + bif[5], ga[6] + bif[6], ga[7] + bif[7]}; }
        }
    }
    __syncthreads();
}

__device__ __forceinline__ float scan_add(float v, int lane) {
#pragma unroll
    for (int o = 1; o < 64; o <<= 1) { const float t = shup(v, o); if (lane >= o) v += t; }
    return v;
}
__device__ __forceinline__ float scan_max(float v, int lane) {
#pragma unroll
    for (int o = 1; o < 64; o <<= 1) { const float t = shup(v, o); if (lane >= o) v = fmaxf(v, t); }
    return v;
}
constexpr float KSCALE = 0.08838834764831845f;

__device__ __forceinline__ void head_out(const Params& p, int i, int h, int row, int lane, float hv0, float hv1, unsigned zo, f32x2 on) {
    const float ss = wave_sum(hv0 * hv0 + hv1 * hv1);
    const float rstd = rsqrtf(ss * (1.f / 128.f) + EPS);
    unsigned* CAT = (unsigned*)((bf16*)(p.ws + WS_CAT) + (size_t)row * DM + h * 128);
    CAT[lane] = pk2(hv0 * rstd * on.x * sigmoidf_(bflo(zo)), hv1 * rstd * on.y * sigmoidf_(bfhi(zo)));
}
__device__ __forceinline__ void mlstm_local(const Params& p, int i, int item, unsigned char* smem) {
    const int tid = otid(), lane = tid & 63, wave = tid >> 6, fr = lane & 15, fq = lane >> 4;
    const int b = item >> 9, h = (item >> 7) & 3, c = item & 127, r0 = b * SEQL + c * 64;
    float* ws_l = (float*)smem;
    bf16* kT = (bf16*)(smem + 1024);
    bf16* vT = kT + 128 * 72;
    const float* G = (const float*)(p.ws + WS_GATES);
    const bf16* Z = (const bf16*)(p.ws + WS_ZU);
    if (wave == 0) {
        const float ig = G[(size_t)(r0 + lane) * 8 + h], lf = logsigmoidf(G[(size_t)(r0 + lane) * 8 + 4 + h]);
        const float bs = scan_add(lf, lane), bL = shi(bs, 63);
        const float a = bL - bs + ig, amax = wave_max(a);
        ws_l[lane] = __expf(a - amax);
        if (lane == 0) { float* CS = (float*)(p.ws + WS_CS); CS[item * 2] = bL; CS[item * 2 + 1] = amax; }
    }
    __syncthreads();
    { u32x4 wv[4];
#pragma unroll
      for (int it = 0; it < 4; ++it) { const int q = tid + it * NTHR, which = q >> 10, idx = q & 1023, s = idx & 63, ch = idx >> 6; wv[it] = *(const u32x4*)(Z + (size_t)(r0 + s) * ZW + (which ? 1024 : 512) + h * 128 + ch * 8); }
#pragma unroll
      for (int it = 0; it < 4; ++it) { const int q = tid + it * NTHR, which = q >> 10, idx = q & 1023, s = idx & 63, ch = idx >> 6; const u32x4 w = wv[it];
        bf16* dst = (which ? vT : kT) + (ch * 8) * 72 + s;
        if (which) {
            dst[0 * 72] = (bf16)(w.x & 0xffff); dst[1 * 72] = (bf16)(w.x >> 16); dst[2 * 72] = (bf16)(w.y & 0xffff); dst[3 * 72] = (bf16)(w.y >> 16);
            dst[4 * 72] = (bf16)(w.z & 0xffff); dst[5 * 72] = (bf16)(w.z >> 16); dst[6 * 72] = (bf16)(w.w & 0xffff); dst[7 * 72] = (bf16)(w.w >> 16);
        } else { const float sc = ws_l[s] * KSCALE;
            dst[0 * 72] = (bf16)f2bf(bflo(w.x) * sc); dst[1 * 72] = (bf16)f2bf(bfhi(w.x) * sc); dst[2 * 72] = (bf16)f2bf(bflo(w.y) * sc); dst[3 * 72] = (bf16)f2bf(bfhi(w.y) * sc);
            dst[4 * 72] = (bf16)f2bf(bflo(w.z) * sc); dst[5 * 72] = (bf16)f2bf(bfhi(w.z) * sc); dst[6 * 72] = (bf16)f2bf(bflo(w.w) * sc); dst[7 * 72] = (bf16)f2bf(bfhi(w.w) * sc); } } }
    __syncthreads();
    f32x4 acc[8];
#pragma unroll
    for (int mt = 0; mt < 8; ++mt) acc[mt] = (f32x4){0.f, 0.f, 0.f, 0.f};
#pragma unroll
    for (int ks = 0; ks < 2; ++ks) { const bf16x8 B = *(const bf16x8*)(vT + (16 * wave + fr) * 72 + 32 * ks + 8 * fq);
#pragma unroll
        for (int mt = 0; mt < 8; ++mt) { const bf16x8 A = *(const bf16x8*)(kT + (16 * mt + fr) * 72 + 32 * ks + 8 * fq); acc[mt] = __builtin_amdgcn_mfma_f32_16x16x32_bf16(A, B, acc[mt], 0, 0, 0); } }
    bf16* dCt = (bf16*)(p.ws + WS_DCT) + (size_t)item * 16384;
#pragma unroll
    for (int mt = 0; mt < 8; ++mt) *(u32x2*)(dCt + (16 * wave + fr) * 128 + 16 * mt + 4 * fq) = (u32x2){pk2_sw(acc[mt][0], acc[mt][1]), pk2_sw(acc[mt][2], acc[mt][3])};
    if (tid < 128) { float s = 0.f;
        for (int t = 0; t < 64; ++t) s += bf2f(kT[tid * 72 + t]);
        ((float*)(p.ws + WS_DN))[item * 128 + tid] = s; }
    __syncthreads();
}

__device__ __forceinline__ void mlstm_scan(const Params& p, int i) {
    const float* CS = (const float*)(p.ws + WS_CS); const bf16* dCt = (const bf16*)(p.ws + WS_DCT); const float* DN = (const float*)(p.ws + WS_DN);
    bf16* CSt = (bf16*)(p.ws + WS_CST); float* NS = (float*)(p.ws + WS_NS); float* MS = (float*)(p.ws + WS_MS);
    for (int idx = obid() * NTHR + otid(); idx < 8 * 16384; idx += gridDim.x * NTHR) {
        const int bh = idx >> 14, e = idx & 16383;
        float C = 0.f, m = 0.f, nacc = 0.f;
        float dv[16], dnv[16], dv2[16], dnv2[16];
#define SC_LD(D, DNV, c0_) do { _Pragma("unroll") for (int k_ = 0; k_ < 16; ++k_) { D[k_] = bf2f(dCt[(size_t)(bh * 128 + (c0_) + k_) * 16384 + e]); DNV[k_] = (e < 128) ? DN[(bh * 128 + (c0_) + k_) * 128 + e] : 0.f; } } while (0)
#define SC_RUN(D, DNV, c0_) do { _Pragma("unroll") for (int k_ = 0; k_ < 16; ++k_) { const int item = bh * 128 + (c0_) + k_; const float bL = CS[item * 2], amax = CS[item * 2 + 1]; \
                CSt[(size_t)item * 16384 + e] = (bf16)f2bf(C); if (e < 128) NS[item * 128 + e] = nacc; if (e == 0) MS[item] = m; \
                const float mn = fmaxf(bL + m, amax), f1 = __expf(bL + m - mn), f2 = __expf(amax - mn); C = f1 * C + f2 * D[k_]; nacc = f1 * nacc + f2 * DNV[k_]; m = mn; } } while (0)
        SC_LD(dv, dnv, 0);
        for (int c0 = 0; c0 < 128; c0 += 32) {
            SC_LD(dv2, dnv2, c0 + 16);
            SC_RUN(dv, dnv, c0);
            if (c0 + 32 < 128) SC_LD(dv, dnv, c0 + 32);
            SC_RUN(dv2, dnv2, c0 + 16);
        }
#undef SC_LD
#undef SC_RUN
        const int b = bh >> 2, h = bh & 3; const size_t sidx = (size_t)((i * 2 + b) * 4 + h);
        p.out[O_PC + sidx * 16384 + (size_t)(e & 127) * 128 + (e >> 7)] = C;
        if (e < 128) p.out[O_PN + sidx * 128 + e] = nacc;
        if (e == 0) p.out[O_PM + sidx] = m;
    }
}

__device__ __forceinline__ void mlstm_out(const Params& p, int i, int item, unsigned char* smem) {
    const int tid = otid(), lane = tid & 63, wave = tid >> 6, fr = lane & 15, fq = lane >> 4;
    const int b = item >> 9, h = (item >> 7) & 3, c = item & 127, r0 = b * SEQL + c * 64;
    float* d_l = (float*)smem;
    float* M_l = d_l + 64;
    float* wg_l = d_l + 128;
    float* mt_l = d_l + 192;
    float* den_l = d_l + 256;
    float* rs_l = d_l + 320;
    float* qn_l = d_l + 448;
    bf16* q_l = (bf16*)(smem + 2048);
    bf16* k_l = q_l + 64 * 136;
    bf16* vT = k_l + 64 * 136;
    bf16* Sw = vT + 128 * 72;
    float* hbuf = (float*)(Sw + 64 * 72);
    const float* G = (const float*)(p.ws + WS_GATES);
    const bf16* Z = (const bf16*)(p.ws + WS_ZU);
    bf16x8 Bc[4];
    { const bf16* cp = (const bf16*)(p.ws + WS_CST) + (size_t)item * 16384 + (16 * wave + fr) * 128 + 8 * fq;
#pragma unroll
      for (int ks = 0; ks < 4; ++ks) Bc[ks] = *(const bf16x8*)(cp + 32 * ks); }
    if (wave == 0) {
        const float ig = G[(size_t)(r0 + lane) * 8 + h], lf = logsigmoidf(G[(size_t)(r0 + lane) * 8 + 4 + h]);
        const float bs = scan_add(lf, lane), d = ig - bs, gmax = scan_max(d, lane);
        const float mc = ((const float*)(p.ws + WS_MS))[item];
        const float Mt = fmaxf(mc, gmax);
        d_l[lane] = d; M_l[lane] = Mt; wg_l[lane] = __expf(mc - Mt); mt_l[lane] = bs + Mt;
    }
    { u32x4 wv[6];
#pragma unroll
      for (int it = 0; it < 6; ++it) { const int q = tid + it * NTHR, which = q >> 10, idx = q & 1023, s = (which == 2) ? (idx & 63) : (idx >> 4), ch = (which == 2) ? (idx >> 6) : (idx & 15); wv[it] = *(const u32x4*)(Z + (size_t)(r0 + s) * ZW + which * 512 + h * 128 + ch * 8); }
#pragma unroll
      for (int it = 0; it < 6; ++it) { const int q = tid + it * NTHR, which = q >> 10, idx = q & 1023, s = (which == 2) ? (idx & 63) : (idx >> 4), ch = (which == 2) ? (idx >> 6) : (idx & 15); const u32x4 w = wv[it];
        if (which == 0) *(u32x4*)(q_l + s * 136 + ch * 8) = w;
        else if (which == 1) { u32x4 o; o.x = pk2(bflo(w.x) * KSCALE, bfhi(w.x) * KSCALE); o.y = pk2(bflo(w.y) * KSCALE, bfhi(w.y) * KSCALE);
            o.z = pk2(bflo(w.z) * KSCALE, bfhi(w.z) * KSCALE); o.w = pk2(bflo(w.w) * KSCALE, bfhi(w.w) * KSCALE); *(u32x4*)(k_l + s * 136 + ch * 8) = o; }
        else { bf16* dst = vT + (ch * 8) * 72 + s;
            dst[0 * 72] = (bf16)(w.x & 0xffff); dst[1 * 72] = (bf16)(w.x >> 16); dst[2 * 72] = (bf16)(w.y & 0xffff); dst[3 * 72] = (bf16)(w.y >> 16);
            dst[4 * 72] = (bf16)(w.z & 0xffff); dst[5 * 72] = (bf16)(w.z >> 16); dst[6 * 72] = (bf16)(w.w & 0xffff); dst[7 * 72] = (bf16)(w.w >> 16); } } }
    __syncthreads();
    {
        const int mt = wave >> 1, nt0 = 2 * (wave & 1);
        f32x4 a2[2] = {(f32x4){0.f, 0.f, 0.f, 0.f}, (f32x4){0.f, 0.f, 0.f, 0.f}};
#pragma unroll
        for (int ks = 0; ks < 4; ++ks) { const bf16x8 A = *(const bf16x8*)(q_l + (16 * mt + fr) * 136 + 32 * ks + 8 * fq);
#pragma unroll
            for (int n = 0; n < 2; ++n) { const bf16x8 B = *(const bf16x8*)(k_l + (16 * (nt0 + n) + fr) * 136 + 32 * ks + 8 * fq); a2[n] = __builtin_amdgcn_mfma_f32_16x16x32_bf16(A, B, a2[n], 0, 0, 0); } }
        float rsum[4] = {0.f, 0.f, 0.f, 0.f};
#pragma unroll
        for (int n = 0; n < 2; ++n) { const int s = 16 * (nt0 + n) + fr; const float ds = d_l[s];
#pragma unroll
            for (int j = 0; j < 4; ++j) { const int t = 16 * mt + 4 * fq + j; const float wv = (s <= t) ? __expf(ds - M_l[t]) : 0.f; const float val = a2[n][j] * wv; rsum[j] += val; Sw[t * 72 + s] = (bf16)f2bf(val); } }
#pragma unroll
        for (int j = 0; j < 4; ++j) { float v = rsum[j]; v += shx(v, 1); v += shx(v, 2); v += shx(v, 4); v += shx(v, 8); if (fr == 0) rs_l[(wave & 1) * 64 + 16 * mt + 4 * fq + j] = v; }
        { const int t = tid >> 3, part = tid & 7; const float* NS = (const float*)(p.ws + WS_NS) + item * 128 + part * 16;
          const u32x4 qa = *(const u32x4*)(q_l + t * 136 + part * 16), qb = *(const u32x4*)(q_l + t * 136 + part * 16 + 8);
          const f32x4 n0 = *(const f32x4*)NS, n1 = *(const f32x4*)(NS + 4), n2 = *(const f32x4*)(NS + 8), n3 = *(const f32x4*)(NS + 12);
          float v = bflo(qa.x) * n0.x + bfhi(qa.x) * n0.y + bflo(qa.y) * n0.z + bfhi(qa.y) * n0.w + bflo(qa.z) * n1.x + bfhi(qa.z) * n1.y + bflo(qa.w) * n1.z + bfhi(qa.w) * n1.w
                  + bflo(qb.x) * n2.x + bfhi(qb.x) * n2.y + bflo(qb.y) * n2.z + bfhi(qb.y) * n2.w + bflo(qb.z) * n3.x + bfhi(qb.z) * n3.y + bflo(qb.w) * n3.z + bfhi(qb.w) * n3.w;
          v += shx(v, 1); v += shx(v, 2); v += shx(v, 4); if (part == 0) qn_l[t] = v; }
    }
    __syncthreads();
    if (tid < 64) { const int t = tid; const float den = wg_l[t] * qn_l[t] + (rs_l[t] + rs_l[64 + t]); den_l[t] = __builtin_amdgcn_rcpf(fmaxf(fabsf(den), __expf(-mt_l[t]))); }
    f32x4 acc[4];
#pragma unroll
    for (int mt = 0; mt < 4; ++mt) acc[mt] = (f32x4){0.f, 0.f, 0.f, 0.f};
#pragma unroll
    for (int ks = 0; ks < 4; ++ks) { const bf16x8 B = Bc[ks];
#pragma unroll
        for (int mt = 0; mt < 4; ++mt) { const bf16x8 A = *(const bf16x8*)(q_l + (16 * mt + fr) * 136 + 32 * ks + 8 * fq); acc[mt] = __builtin_amdgcn_mfma_f32_16x16x32_bf16(A, B, acc[mt], 0, 0, 0); } }
#pragma unroll
    for (int mt = 0; mt < 4; ++mt)
#pragma unroll
        for (int j = 0; j < 4; ++j) acc[mt][j] *= wg_l[16 * mt + 4 * fq + j];
#pragma unroll
    for (int ks = 0; ks < 2; ++ks) { const bf16x8 B = *(const bf16x8*)(vT + (16 * wave + fr) * 72 + 32 * ks + 8 * fq);
#pragma unroll
        for (int mt = 0; mt < 4; ++mt) { const bf16x8 A = *(const bf16x8*)(Sw + (16 * mt + fr) * 72 + 32 * ks + 8 * fq); acc[mt] = __builtin_amdgcn_mfma_f32_16x16x32_bf16(A, B, acc[mt], 0, 0, 0); } }
    __syncthreads();
#pragma unroll
    for (int mt = 0; mt < 4; ++mt)
#pragma unroll
        for (int j = 0; j < 4; ++j) { const int t = 16 * mt + 4 * fq + j; hbuf[t * 132 + 16 * wave + fr] = acc[mt][j] * den_l[t]; }
    __syncthreads();
    { unsigned zo[8]; const f32x2 on = *(const f32x2*)(p.in[17] + i * 512 + h * 128 + 2 * lane);
#pragma unroll
      for (int tt = 0; tt < 8; ++tt) zo[tt] = *(const unsigned*)(Z + (size_t)(r0 + 8 * wave + tt) * ZW + 1536 + h * 128 + 2 * lane);
#pragma unroll
      for (int tt = 0; tt < 8; ++tt) { const int t = 8 * wave + tt; const f32x2 hv = *(const f32x2*)(hbuf + t * 132 + 2 * lane); head_out(p, i, h, r0 + t, lane, hv.x, hv.y, zo[tt], on); } }
    __syncthreads();
}

__device__ __forceinline__ void mlstm_sample(const Params& p, int i, int item, unsigned char* smem) {
    const int tid = otid(), lane = tid & 63, wave = tid >> 6;
    const int s = item >> 2, h = item & 3, r0 = RP + 8 * s;
    float* qq = (float*)smem;
    float* kk = qq + 1024;
    float* vv = kk + 1024;
    float* qT = vv + 1024;
    float* kwT = qT + 1024;
    float* part = kwT + 1024;
    float* S_l = part + 4096;
    float* sc = S_l + 64;
    const bf16* Z = (const bf16*)(p.ws + WS_ZU);
    const float* G = (const float*)(p.ws + WS_GATES);
    const size_t sidx = (size_t)((i * 128 + s) * 4 + h);
    const float* n0 = p.in[5] + sidx * 128;
    { bf16 zv[6];
#pragma unroll
      for (int it = 0; it < 6; ++it) { const int q = tid + it * NTHR, which = q >> 10, t = (q >> 7) & 7, d = q & 127; zv[it] = Z[(size_t)(r0 + t) * ZW + which * 512 + h * 128 + d]; }
#pragma unroll
      for (int it = 0; it < 6; ++it) { const int q = tid + it * NTHR, which = q >> 10; float v = bf2f(zv[it]); if (which == 1) v *= KSCALE; qq[q] = v; } }
    if (wave == 0) {
        const int t = lane & 7;
        const float ig = G[(size_t)(r0 + t) * 8 + h], lf = logsigmoidf(G[(size_t)(r0 + t) * 8 + 4 + h]);
        float bs = 0.f;
        for (int u = 0; u < 8; ++u) { const float x = shi(lf, u); if (u <= t) bs += x; }
        const float d = ig - bs; float gmax = -INFINITY;
        for (int u = 0; u < 8; ++u) { const float x = shi(d, u); if (u <= t) gmax = fmaxf(gmax, x); }
        const float m0 = p.in[6][sidx];
        const float Mt = fmaxf(m0, gmax), bL = shi(bs, 7), a = bL - bs + ig;
        float amax = -INFINITY;
        for (int u = 0; u < 8; ++u) amax = fmaxf(amax, shi(a, u));
        const float mnew = fmaxf(bL + m0, amax);
        if (lane < 8) { sc[t] = d; sc[8 + t] = Mt; sc[16 + t] = __expf(m0 - Mt); sc[24 + t] = bs + Mt; sc[32 + t] = __expf(a - mnew); }
        if (lane == 0) { sc[56] = __expf(bL + m0 - mnew); sc[57] = mnew; }
    }
    __syncthreads();
    { const int pr = tid >> 3, part = tid & 7, t = pr >> 3, u = pr & 7; float dot = 0.f;
#pragma unroll
        for (int d = 0; d < 16; ++d) dot += qq[t * 128 + part * 16 + d] * kk[u * 128 + part * 16 + d];
        dot += shx(dot, 1); dot += shx(dot, 2); dot += shx(dot, 4);
        if (part == 0) S_l[pr] = (u <= t) ? dot * __expf(sc[u] - sc[8 + t]) : 0.f; }
    if (tid < 64) { const int t = tid >> 3, part = tid & 7; float dot = 0.f;
#pragma unroll
        for (int d = 0; d < 16; ++d) dot += qq[t * 128 + part * 16 + d] * n0[part * 16 + d];
        dot += shx(dot, 1); dot += shx(dot, 2); dot += shx(dot, 4);
        if (part == 0) sc[40 + t] = dot; }
    for (int idx = tid; idx < 1024; idx += NTHR) { const int dk = idx >> 3, t = idx & 7; qT[idx] = qq[t * 128 + dk]; kwT[idx] = kk[t * 128 + dk] * sc[32 + t]; }
    __syncthreads();
    if (tid < 8) { float rs = 0.f; for (int u = 0; u < 8; ++u) rs += S_l[tid * 8 + u];
        const float den = sc[16 + tid] * sc[40 + tid] + rs; sc[48 + tid] = fmaxf(fabsf(den), __expf(-sc[24 + tid])); }
    {
        const int e = tid & 127, g = tid >> 7; const float wc = sc[56];
        float vr[8], acc[8];
#pragma unroll
        for (int u = 0; u < 8; ++u) { vr[u] = vv[u * 128 + e]; acc[u] = 0.f; }
        const float* Cin = p.in[4] + sidx * 16384; float* Cout = p.out + O_SC + sidx * 16384;
        float cin[32];
#pragma unroll
        for (int k = 0; k < 32; ++k) cin[k] = Cin[(g * 32 + k) * 128 + e];
#pragma unroll
        for (int k = 0; k < 32; ++k) { const int dk = g * 32 + k; const float cv = cin[k];
            const f32x4 q0 = *(const f32x4*)(qT + dk * 8), q1 = *(const f32x4*)(qT + dk * 8 + 4), k0 = *(const f32x4*)(kwT + dk * 8), k1 = *(const f32x4*)(kwT + dk * 8 + 4);
            acc[0] += q0.x * cv; acc[1] += q0.y * cv; acc[2] += q0.z * cv; acc[3] += q0.w * cv; acc[4] += q1.x * cv; acc[5] += q1.y * cv; acc[6] += q1.z * cv; acc[7] += q1.w * cv;
            float cn = wc * cv;
            cn += k0.x * vr[0] + k0.y * vr[1] + k0.z * vr[2] + k0.w * vr[3] + k1.x * vr[4] + k1.y * vr[5] + k1.z * vr[6] + k1.w * vr[7];
            Cout[dk * 128 + e] = cn; }
#pragma unroll
        for (int u = 0; u < 8; ++u) part[(g * 8 + u) * 128 + e] = acc[u];
        if (tid < 128) { float nn = wc * n0[tid];
#pragma unroll
            for (int u = 0; u < 8; ++u) nn += kwT[tid * 8 + u];
            p.out[O_SN + sidx * 128 + tid] = nn; }
        if (tid == 0) p.out[O_SM + sidx] = sc[57];
    }
    __syncthreads();
    {
        const int t = wave; float hv[2];
        const unsigned zo = *(const unsigned*)(Z + (size_t)(r0 + t) * ZW + 1536 + h * 128 + 2 * lane); const f32x2 on = *(const f32x2*)(p.in[17] + i * 512 + h * 128 + 2 * lane);
#pragma unroll
        for (int k = 0; k < 2; ++k) { const int e = 2 * lane + k;
            float num = (part[(0 * 8 + t) * 128 + e] + part[(1 * 8 + t) * 128 + e]) + (part[(2 * 8 + t) * 128 + e] + part[(3 * 8 + t) * 128 + e]);
            num *= sc[16 + t];
#pragma unroll
            for (int u = 0; u < 8; ++u) num += S_l[t * 8 + u] * vv[u * 128 + e];
            hv[k] = num / sc[48 + t]; }
        head_out(p, i, h, r0 + t, lane, hv[0], hv[1], zo, on);
    }
    __syncthreads();
}

__device__ __forceinline__ void shortconv(const Params& p, int i) {
    const bf16* Z = (const bf16*)(p.ws + WS_ZU); bf16* CAT = (bf16*)(p.ws + WS_CAT);
    const float* cw = p.in[18] + i * 3 * 512;
    for (int idx = obid() * NTHR + otid(); idx < R * 64; idx += gridDim.x * NTHR) {
        const int row = idx >> 6, ch = (idx & 63) * 8;
        const bool prm = row < RP; const int t = prm ? (row & (SEQL - 1)) : ((row - RP) & 7), S = prm ? SEQL : 8, sq = prm ? (row >> 13) : ((row - RP) >> 3);
        float pr[3][8];
#pragma unroll
        for (int j = 0; j < 3; ++j) { const int tt = t - 2 + j;
            if (tt >= 0) { const bf16* zr = Z + (size_t)(row - 2 + j) * ZW; const u32x4 a = *(const u32x4*)(zr + 2560 + ch), b = *(const u32x4*)(zr + 3072 + ch);
                pr[j][0] = bflo(a.x) * bflo(b.x); pr[j][1] = bfhi(a.x) * bfhi(b.x); pr[j][2] = bflo(a.y) * bflo(b.y); pr[j][3] = bfhi(a.y) * bfhi(b.y);
                pr[j][4] = bflo(a.z) * bflo(b.z); pr[j][5] = bfhi(a.z) * bfhi(b.z); pr[j][6] = bflo(a.w) * bflo(b.w); pr[j][7] = bfhi(a.w) * bfhi(b.w); }
            else if (!prm) { const float* st = p.in[7] + ((size_t)(i * 128 + sq) * 2 + (2 + tt)) * 512 + ch; const f32x4 a = *(const f32x4*)st, b = *(const f32x4*)(st + 4);
                pr[j][0] = a.x; pr[j][1] = a.y; pr[j][2] = a.z; pr[j][3] = a.w; pr[j][4] = b.x; pr[j][5] = b.y; pr[j][6] = b.z; pr[j][7] = b.w; }
            else {
#pragma unroll
                for (int e = 0; e < 8; ++e) pr[j][e] = 0.f; } }
        const u32x4 zb = *(const u32x4*)(Z + (size_t)row * ZW + 2048 + ch);
        float zbf[8] = {bflo(zb.x), bfhi(zb.x), bflo(zb.y), bfhi(zb.y), bflo(zb.z), bfhi(zb.z), bflo(zb.w), bfhi(zb.w)};
        float o[8];
#pragma unroll
        for (int e = 0; e < 8; ++e) o[e] = zbf[e] * (cw[ch + e] * pr[0][e] + cw[512 + ch + e] * pr[1][e] + cw[1024 + ch + e] * pr[2][e]);
        *(u32x4*)(CAT + (size_t)row * DM + 512 + ch) = (u32x4){pk2(o[0], o[1]), pk2(o[2], o[3]), pk2(o[4], o[5]), pk2(o[6], o[7])};
        if (t >= S - 2) { float* dst = p.out + (prm ? O_PSC + ((size_t)(i * 2 + sq) * 2 + (t - (S - 2))) * 512 : O_SSC + ((size_t)(i * 128 + sq) * 2 + (t - (S - 2))) * 512) + ch;
            *(f32x4*)dst = (f32x4){pr[2][0], pr[2][1], pr[2][2], pr[2][3]}; *(f32x4*)(dst + 4) = (f32x4){pr[2][4], pr[2][5], pr[2][6], pr[2][7]}; }
    }
}

__device__ __forceinline__ void unpack8(const u32x4 w, float (&v)[8]) { v[0] = bflo(w.x); v[1] = bfhi(w.x); v[2] = bflo(w.y); v[3] = bfhi(w.y); v[4] = bflo(w.z); v[5] = bfhi(w.z); v[6] = bflo(w.w); v[7] = bfhi(w.w); }
__device__ __forceinline__ void ld8f(const float* s, float (&v)[8]) { const f32x4 a = *(const f32x4*)s, b = *(const f32x4*)(s + 4); v[0] = a.x; v[1] = a.y; v[2] = a.z; v[3] = a.w; v[4] = b.x; v[5] = b.y; v[6] = b.z; v[7] = b.w; }
__device__ __forceinline__ void st8f(float* d, const float (&v)[8]) { *(f32x4*)d = (f32x4){v[0], v[1], v[2], v[3]}; *(f32x4*)(d + 4) = (f32x4){v[4], v[5], v[6], v[7]}; }

__device__ __forceinline__ void cache_shift(const Params& p, int jl, int bsel, int nsel) {
    const int tid = otid();
    for (int idx = bsel * NTHR + tid; idx < 2 * 128 * 7680; idx += nsel * NTHR) { const int kv = idx / (128 * 7680), r = idx - kv * (128 * 7680), s = r / 7680, q = r - s * 7680;
        const float* src = (kv ? p.in[9] : p.in[8]) + ((size_t)(jl * 128 + s) * 128 + 8) * 256 + 4 * q; float* dst = p.out + (kv ? O_SWV : O_SWK) + ((size_t)(jl * 128 + s) * 128) * 256 + 4 * q;
        *(f32x4*)dst = *(const f32x4*)src; }
}

template <int NH>
__device__ __forceinline__ void attn_wave(const bf16* K_l, const bf16* Vt_l, int ldvt, int kt0, const bf16x8 (*Bq)[2], int qidx, int kmin, const float* sinkp, bf16* orow, bool store, int fr, int fq) {
    f32x4 s[NH][9];
    float sk[NH], mx[NH];
#pragma unroll
    for (int h = 0; h < NH; ++h) { sk[h] = sinkp[h] * 1.4426950408889634f; mx[h] = sk[h]; }
#pragma unroll
    for (int kt = 0; kt < 9; ++kt) {
        const bf16x8 A0 = *(const bf16x8*)(K_l + (16 * (kt0 + kt) + fr) * 72 + 8 * fq), A1 = *(const bf16x8*)(K_l + (16 * (kt0 + kt) + fr) * 72 + 32 + 8 * fq);
#pragma unroll
        for (int h = 0; h < NH; ++h) { f32x4 a = (f32x4){0.f, 0.f, 0.f, 0.f};
            a = __builtin_amdgcn_mfma_f32_16x16x32_bf16(A0, Bq[h][0], a, 0, 0, 0); a = __builtin_amdgcn_mfma_f32_16x16x32_bf16(A1, Bq[h][1], a, 0, 0, 0);
#pragma unroll
            for (int j = 0; j < 4; ++j) { const int kidx = 16 * (kt0 + kt) + 4 * fq + j;
                const bool valid = (kt == 0) ? ((kidx > qidx - 128) && (kidx >= kmin)) : (kt == 8) ? (kidx <= qidx) : (kidx >= kmin);
                a[j] = valid ? a[j] * 0.18033688011112042f : -INFINITY; mx[h] = fmaxf(mx[h], a[j]); }
            s[h][kt] = a; } }
    float inv[NH];
#pragma unroll
    for (int h = 0; h < NH; ++h) { mx[h] = fmaxf(mx[h], shx(mx[h], 16)); mx[h] = fmaxf(mx[h], shx(mx[h], 32)); }
#pragma unroll
    for (int h = 0; h < NH; ++h) { float sum = 0.f;
#pragma unroll
        for (int kt = 0; kt < 9; ++kt)
#pragma unroll
            for (int j = 0; j < 4; ++j) { const float e = __builtin_amdgcn_exp2f(s[h][kt][j] - mx[h]); s[h][kt][j] = e; sum += e; }
        inv[h] = sum; }
#pragma unroll
    for (int h = 0; h < NH; ++h) { float sum = inv[h]; sum += shx(sum, 16); sum += shx(sum, 32); inv[h] = __builtin_amdgcn_rcpf(sum + __builtin_amdgcn_exp2f(sk[h] - mx[h])); }
    bf16x8 Bp[NH][5];
#pragma unroll
    for (int h = 0; h < NH; ++h)
#pragma unroll
        for (int pp = 0; pp < 5; ++pp) { u32x4 w; w.x = pk2(s[h][2 * pp][0], s[h][2 * pp][1]); w.y = pk2(s[h][2 * pp][2], s[h][2 * pp][3]);
            if (pp < 4) { w.z = pk2(s[h][2 * pp + 1][0], s[h][2 * pp + 1][1]); w.w = pk2(s[h][2 * pp + 1][2], s[h][2 * pp + 1][3]); } else { w.z = 0u; w.w = 0u; }
            Bp[h][pp] = __builtin_bit_cast(bf16x8, w); }
#pragma unroll
    for (int dt = 0; dt < 4; ++dt) { f32x4 a[NH];
#pragma unroll
        for (int h = 0; h < NH; ++h) a[h] = (f32x4){0.f, 0.f, 0.f, 0.f};
#pragma unroll
        for (int pp = 0; pp < 5; ++pp) { const bf16* vp = Vt_l + (16 * dt + fr) * ldvt + 16 * (kt0 + 2 * pp) + 4 * fq;
            const u32x2 lo = *(const u32x2*)vp, hi = *(const u32x2*)(vp + 16); const bf16x8 V = __builtin_bit_cast(bf16x8, (u32x4){lo.x, lo.y, hi.x, hi.y});
#pragma unroll
            for (int h = 0; h < NH; ++h) a[h] = __builtin_amdgcn_mfma_f32_16x16x32_bf16(V, Bp[h][pp], a[h], 0, 0, 0); }
        if (store) {
#pragma unroll
            for (int h = 0; h < NH; ++h) *(u32x2*)(orow + 64 * h + 16 * dt + 4 * fq) = (u32x2){pk2(a[h][0] * inv[h], a[h][1] * inv[h]), pk2(a[h][2] * inv[h], a[h][3] * inv[h])}; } }
}

__device__ __forceinline__ void attn_phase(const Params& p, int jl, unsigned char* smem) {
    const bf16* Z = (const bf16*)(p.ws + WS_ZU); bf16* CAT = (bf16*)(p.ws + WS_CAT);
    const float* sinkp = p.in[23] + jl * 16;
    for (int u = obid(); u < 768; u += gridDim.x) { const int tidu = otid(), lane = tidu & 63, wave = tidu >> 6, fr = lane & 15, fq = lane >> 4;
        if (u < 512) {
            const int b = u >> 8, kvh = (u >> 6) & 3, qb = u & 63, q0 = qb * 128, rb = b * SEQL;
            bf16x8 Bq[4][2];
            { const bf16* qp = Z + (size_t)(rb + q0 + 16 * wave + fr) * QKVW + kvh * 256 + 8 * fq;
#pragma unroll
              for (int hq = 0; hq < 4; ++hq) { Bq[hq][0] = *(const bf16x8*)(qp + hq * 64); Bq[hq][1] = *(const bf16x8*)(qp + hq * 64 + 32); } }
            bf16* K_l = (bf16*)smem;
            bf16* Vt_l = K_l + 256 * 72;
            { u32x4 wv[8];
#pragma unroll
              for (int it = 0; it < 8; ++it) { const int q = tidu + it * NTHR, which = q >> 11, idx = q & 2047, kidx = which ? (idx & 255) : (idx >> 3), ch = which ? (idx >> 8) : (idx & 7); const int pos = q0 - 128 + kidx;
                wv[it] = (u32x4){0u, 0u, 0u, 0u};
                if (pos >= 0) wv[it] = *(const u32x4*)(Z + (size_t)(rb + pos) * QKVW + (which ? 1280 : 1024) + kvh * 64 + ch * 8); }
#pragma unroll
              for (int it = 0; it < 8; ++it) { const int q = tidu + it * NTHR, which = q >> 11, idx = q & 2047, kidx = which ? (idx & 255) : (idx >> 3), ch = which ? (idx >> 8) : (idx & 7); const u32x4 w = wv[it];
                if (!which) *(u32x4*)(K_l + kidx * 72 + ch * 8) = w;
                else { bf16* dst = Vt_l + (ch * 8) * 296 + kidx;
                    dst[0 * 296] = (bf16)(w.x & 0xffff); dst[1 * 296] = (bf16)(w.x >> 16); dst[2 * 296] = (bf16)(w.y & 0xffff); dst[3 * 296] = (bf16)(w.y >> 16);
                    dst[4 * 296] = (bf16)(w.z & 0xffff); dst[5 * 296] = (bf16)(w.z >> 16); dst[6 * 296] = (bf16)(w.w & 0xffff); dst[7 * 296] = (bf16)(w.w >> 16); } } }
            for (int q = tidu; q < 64 * 32; q += NTHR) Vt_l[(q >> 5) * 296 + 256 + (q & 31)] = 0;
            __syncthreads();
            const int row = rb + q0 + 16 * wave + fr;
#pragma unroll
            for (int hg = 0; hg < 2; ++hg) { const int h = kvh * 4 + 2 * hg;
                attn_wave<2>(K_l, Vt_l, 296, wave, Bq + 2 * hg, 128 + 16 * wave + fr, qb == 0 ? 128 : 0, sinkp + h, CAT + (size_t)row * DM + h * 64, true, fr, fq); }
            __syncthreads();
        } else {
            const int us = u - 512, s = us >> 1, kvp = us & 1;
            bf16x8 Bq1[2];
            { const bf16* qp = Z + (size_t)(RP + 8 * s + (fr & 7)) * QKVW + (8 * kvp + wave) * 64 + 8 * fq; Bq1[0] = *(const bf16x8*)qp; Bq1[1] = *(const bf16x8*)(qp + 32); }
            bf16* K_l = (bf16*)smem;
            bf16* Vt_l = K_l + 2 * 144 * 72;
            { f32x4 va[9], vb[9];
              const float* ck = p.in[8] + ((size_t)(jl * 128 + s) * 128) * 256; const float* cv = p.in[9] + ((size_t)(jl * 128 + s) * 128) * 256;
#pragma unroll
              for (int it = 0; it < 9; ++it) { const int q = tidu + it * NTHR, which = q / 2304, r = q - which * 2304, kvl = r / 1152, r2 = r - kvl * 1152, kidx = which ? (r2 % 144) : (r2 >> 3), ch = which ? (r2 / 144) : (r2 & 7); const int kvh = 2 * kvp + kvl;
                va[it] = (f32x4){0.f, 0.f, 0.f, 0.f}; vb[it] = va[it];
                if (kidx < 128) { const float* src = (which ? cv : ck) + (size_t)kidx * 256 + kvh * 64 + ch * 8; va[it] = *(const f32x4*)src; vb[it] = *(const f32x4*)(src + 4); }
                else if (kidx < 136) { const u32x4 w = *(const u32x4*)(Z + (size_t)(RP + 8 * s + kidx - 128) * QKVW + (which ? 1280 : 1024) + kvh * 64 + ch * 8);
                    va[it] = (f32x4){bflo(w.x), bfhi(w.x), bflo(w.y), bfhi(w.y)}; vb[it] = (f32x4){bflo(w.z), bfhi(w.z), bflo(w.w), bfhi(w.w)}; } }
#pragma unroll
              for (int it = 0; it < 9; ++it) { const int q = tidu + it * NTHR, which = q / 2304, r = q - which * 2304, kvl = r / 1152, r2 = r - kvl * 1152, kidx = which ? (r2 % 144) : (r2 >> 3), ch = which ? (r2 / 144) : (r2 & 7);
                const f32x4 a = va[it], c = vb[it];
                if (!which) *(u32x4*)(K_l + (kvl * 144 + kidx) * 72 + ch * 8) = (u32x4){pk2(a[0], a[1]), pk2(a[2], a[3]), pk2(c[0], c[1]), pk2(c[2], c[3])};
                else { bf16* dst = Vt_l + (kvl * 64 + ch * 8) * 168 + kidx; const unsigned p0 = pk2(a[0], a[1]), p1 = pk2(a[2], a[3]), p2 = pk2(c[0], c[1]), p3 = pk2(c[2], c[3]);
                    dst[0 * 168] = (bf16)(p0 & 0xffff); dst[1 * 168] = (bf16)(p0 >> 16); dst[2 * 168] = (bf16)(p1 & 0xffff); dst[3 * 168] = (bf16)(p1 >> 16);
                    dst[4 * 168] = (bf16)(p2 & 0xffff); dst[5 * 168] = (bf16)(p2 >> 16); dst[6 * 168] = (bf16)(p3 & 0xffff); dst[7 * 168] = (bf16)(p3 >> 16); } } }
            for (int q = tidu; q < 2 * 64 * 16; q += NTHR) Vt_l[(q >> 4) * 168 + 144 + (q & 15)] = 0;
            __syncthreads();
            const int kvl = wave >> 2, h = 8 * kvp + wave, row = RP + 8 * s + (fr & 7);
            attn_wave<1>(K_l + kvl * 144 * 72, Vt_l + kvl * 64 * 168, 168, 0, &Bq1, 128 + (fr & 7), 0, sinkp + h, CAT + (size_t)row * DM + h * 64, fr < 8, fr, fq);
            __syncthreads();
        }
    }
}

__device__ __forceinline__ void ffnfix_phase(const Params& p, int l) {
    const bf16* UB = (const bf16*)(p.ws + WS_UB); bf16* ACT = (bf16*)(p.ws + WS_ACT);
    const float* cw = p.in[26] + (size_t)l * 3 * FF2;
    for (int idx = obid() * NTHR + otid(); idx < 256 * 352; idx += gridDim.x * NTHR) {
        const int hr = idx / 352, cc = idx - hr * 352, col = cc * 8, hh = hr >> 1, rr = hr & 1;
        const bool seqstart = (hh & 63) == 0;
        const bf16* own0 = UB + (size_t)(hh * 4 + 0) * FF2; const bf16* own1 = UB + (size_t)(hh * 4 + 1) * FF2;
        const bf16* pm2 = UB + (size_t)((hh - 1) * 4 + 2) * FF2; const bf16* pm1 = UB + (size_t)((hh - 1) * 4 + 3) * FF2;
        float g2[8], g1[8], g0[8], a2[8], a1[8], a0[8];
        if (rr == 0) {
            if (seqstart) {
#pragma unroll
                for (int e = 0; e < 8; ++e) { g2[e] = 0.f; g1[e] = 0.f; a2[e] = 0.f; a1[e] = 0.f; } }
            else { unpack8(*(const u32x4*)(pm2 + col), g2); unpack8(*(const u32x4*)(pm2 + FF + col), a2); unpack8(*(const u32x4*)(pm1 + col), g1); unpack8(*(const u32x4*)(pm1 + FF + col), a1); }
            unpack8(*(const u32x4*)(own0 + col), g0); unpack8(*(const u32x4*)(own0 + FF + col), a0);
        } else {
            if (seqstart) {
#pragma unroll
                for (int e = 0; e < 8; ++e) { g2[e] = 0.f; a2[e] = 0.f; } }
            else { unpack8(*(const u32x4*)(pm1 + col), g2); unpack8(*(const u32x4*)(pm1 + FF + col), a2); }
            unpack8(*(const u32x4*)(own0 + col), g1); unpack8(*(const u32x4*)(own0 + FF + col), a1);
            unpack8(*(const u32x4*)(own1 + col), g0); unpack8(*(const u32x4*)(own1 + FF + col), a0);
        }
        float wg[3][8], wa[3][8];
#pragma unroll
        for (int j = 0; j < 3; ++j) { ld8f(cw + j * FF2 + col, wg[j]); ld8f(cw + j * FF2 + FF + col, wa[j]); }
        float o[8];
#pragma unroll
        for (int e = 0; e < 8; ++e) { const float cgv = wg[0][e] * g2[e] + wg[1][e] * g1[e] + wg[2][e] * g0[e], cav = wa[0][e] * a2[e] + wa[1][e] * a1[e] + wa[2][e] * a0[e]; o[e] = cgv * sigmoidf_(cgv) * cav; }
        *(u32x4*)(ACT + (size_t)(hh * 128 + rr) * FF + col) = (u32x4){pk2(o[0], o[1]), pk2(o[2], o[3]), pk2(o[4], o[5]), pk2(o[6], o[7])};
    }
    for (int idx = obid() * NTHR + otid(); idx < 4 * (FF2 / 8); idx += gridDim.x * NTHR) { const int br = idx / (FF2 / 8), c = (idx - br * (FF2 / 8)) * 8, b = br >> 1, r = br & 1;
        float v[8]; unpack8(*(const u32x4*)(UB + (size_t)((64 * b + 63) * 4 + 2 + r) * FF2 + c), v);
        st8f(p.out + O_PFFN + ((size_t)(l * 2 + b) * 2 + r) * FF2 + c, v); }
}

#define XB_TMO      128
#define XB_XCNT(j)  (256  + 64 * (j))
#define XB_XSUB(j)  (1280 + 64 * (j))
#define XB_XGEN(j)  (2304 + 64 * (j))
#define XB_TOP      3328
#define XB_TOPGEN   3392
#define XCD_BAR_WORDS 3456
#define XB_SPIN_CAP (1u << 18)

__device__ __forceinline__ unsigned xb_ld(unsigned* p)              { return __hip_atomic_load(p, __ATOMIC_RELAXED, __HIP_MEMORY_SCOPE_AGENT); }
__device__ __forceinline__ unsigned xb_add(unsigned* p, unsigned v) { return __hip_atomic_fetch_add(p, v, __ATOMIC_RELAXED, __HIP_MEMORY_SCOPE_AGENT); }
__device__ __forceinline__ unsigned xb_xcc_id() { return (unsigned)__builtin_amdgcn_s_getreg((3 << 11) | 20) & 0xFu; }
#define XB_SPIN(cond, bar) do { unsigned _sp = 0; while (cond) { __builtin_amdgcn_s_sleep(1); \
    if ((++_sp & 255u) == 0u) { if (xb_ld(&(bar)[XB_TMO])) break; if (_sp > XB_SPIN_CAP) { atomicAdd(&(bar)[XB_TMO], 1u); break; } } } } while (0)

struct XcdBarrier {
    unsigned* bar; unsigned x;
    volatile LAS unsigned* st;
};

__device__ __forceinline__ XcdBarrier xcd_barrier_post(unsigned* bar, volatile LAS unsigned* st) {
    XcdBarrier b; b.bar = bar; b.x = xb_xcc_id(); b.st = st;
    if (threadIdx.x == 0) (void)xb_add(&bar[XB_XCNT(b.x)], 1u);
    return b;
}
__device__ __forceinline__ void xcd_barrier_complete(unsigned* bar, unsigned x, unsigned& nloc, unsigned& nx) {
    const unsigned G = gridDim.x * gridDim.y * gridDim.z;
    unsigned sum, cnt, mine, sp = 0u;
    for (;;) {
        sum = 0u; cnt = 0u; mine = 0u;
#pragma unroll
        for (unsigned j = 0; j < 16; ++j) { const unsigned c = xb_ld(&bar[XB_XCNT(j)]); sum += c; cnt += (c > 0u) ? 1u : 0u; mine = (j == x) ? c : mine; }
        if (sum == G) break;
        __builtin_amdgcn_s_sleep(1);
        if ((++sp & 255u) == 0u) { if (xb_ld(&bar[XB_TMO])) break; if (sp > XB_SPIN_CAP) { atomicAdd(&bar[XB_TMO], 1u); break; } }
    }
    nloc = mine > 0u ? mine : 1u; nx = cnt > 0u ? cnt : 1u;
}

__device__ __forceinline__ void xcd_barrier(const XcdBarrier& b) {
    asm volatile("s_waitcnt vmcnt(0)" ::: "memory");
    __syncthreads();
    if (threadIdx.x == 0) {
        unsigned* bar = b.bar;
        __builtin_amdgcn_s_waitcnt(0);
        unsigned nloc = b.st[0], nx = b.st[1];
        if (nloc == 0u) { xcd_barrier_complete(bar, b.x, nloc, nx); b.st[0] = nloc; b.st[1] = nx; }
        const unsigned old = xb_add(&bar[XB_XSUB(b.x)], 1u);
        const unsigned gen = old / nloc;
        if (old + 1u == (gen + 1u) * nloc) {
            __builtin_amdgcn_fence(__ATOMIC_RELEASE, "agent");
            asm volatile("s_waitcnt vmcnt(0)" ::: "memory");
            const unsigned og = xb_add(&bar[XB_TOP], 1u);
            const unsigned tg = og / nx;
            if (og + 1u == (tg + 1u) * nx) xb_add(&bar[XB_TOPGEN], 1u);
            else XB_SPIN(xb_ld(&bar[XB_TOPGEN]) == tg, bar);
            __builtin_amdgcn_fence(__ATOMIC_ACQUIRE, "agent");
            xb_add(&bar[XB_XGEN(b.x)], 1u);
            asm volatile("s_waitcnt vmcnt(0)" ::: "memory");
        } else {
            XB_SPIN(xb_ld(&bar[XB_XGEN(b.x)]) == gen, bar);
            __builtin_amdgcn_fence(__ATOMIC_ACQUIRE, "agent");
            asm volatile("s_waitcnt vmcnt(0)" ::: "memory");
        }
    }
    __syncthreads();
}

__global__ void __launch_bounds__(NTHR, 2) mega(Params p) {
    extern __shared__ __attribute__((aligned(16))) unsigned char lds[];
    cg::grid_group grid = cg::this_grid();
    unsigned char* ws = p.ws;
    volatile LAS unsigned* bst = (volatile LAS unsigned*)((LAS unsigned char*)lds + 147392);
    if (threadIdx.x < 2) bst[threadIdx.x] = 0u;
    __syncthreads();
    XcdBarrier bar; bar.bar = (unsigned*)ws; bar.x = 0; bar.st = bst;
    if (p.hi - p.lo > 1) bar = xcd_barrier_post((unsigned*)ws, bst);
    for (int step = p.lo; step < p.hi; ++step) {
        int nrep = 1; bool skip = false;
        if (step == 0) nrep += (PROBE_PRE & 1); else if (step == 1) nrep += (PROBE_PRE >> 1) & 1; else { const int l_ = (step - 2) / 10, st_ = (step - 2) % 10; nrep += (((l_ & 1) ? PROBE_ODD : PROBE_EVEN) >> st_) & 1; }
        for (int rep = 0; rep < nrep; ++rep) {
            if (PROBE_BAR == 2 && rep > 0) xcd_barrier(bar);
        if (step == 0) prologue(p, lds);
        else if (step == 1) {
            pg8::Gemm g{(const pg8::bf16_t*)(ws + WS_AC), (const pg8::bf16_t*)(ws + WS_ZU), 256, MODW, DM}; pg8::StaticOrder S; S.init(256, MODW, gridDim.x, obid());
            EpiMod E{(float*)(ws + WS_MOD), p.in[14]};
            pg8::gemm_phase<EpiMod, pg8::StaticOrder, true, true>((PG8_LAS unsigned char*)lds, g, S, E);
        } else {
            const int l = (step - 2) / 10, st = (step - 2) % 10; const bool even = !(l & 1); const int i = l >> 1;
            if (st == 0) norm_phase(p, l, 1, lds);
            else if (st == 6) norm_phase(p, l, 2, lds);
            else if (st == 1 || st == 5 || st == 7 || st == 9) {
                pg8::Gemm g; EpiMain E; E.X = p.out; E.O = (bf16*)(ws + WS_ZU); E.gate = nullptr; E.ldc = 0; E.mode = 0; E.cw = nullptr; E.stp = nullptr; E.sout = nullptr; E.qn = nullptr; E.kn = nullptr; E.lyr = i; E.wsb = ws;
                if (st == 1) { g.A = (const pg8::bf16_t*)(ws + WS_H); g.M = R; g.K = DM;
                    if (even) { g.Bt = (const pg8::bf16_t*)(ws + WS_WIN) + (size_t)i * ZW * DM; g.N = ZW; E.ldc = ZW; } else { g.Bt = (const pg8::bf16_t*)(ws + WS_WQKV) + (size_t)i * QKVW * DM; g.N = QKVW; E.ldc = QKVW; E.mode = 3;
                        E.qn = p.in[21] + i * 64; E.kn = p.in[22] + i * 64; } }
                else if (st == 5) { g.A = (const pg8::bf16_t*)(ws + WS_CAT); g.M = RP; g.K = DM; g.N = DM; g.Bt = (const pg8::bf16_t*)(ws + (even ? WS_WAO : WS_WCO)) + (size_t)i * DM * DM;
                    E.mode = 1; E.gate = (const float*)(ws + WS_MOD) + l * 6144 + 2048; }
                else if (st == 7) { g.A = (const pg8::bf16_t*)(ws + WS_H); g.M = R; g.K = DM; g.N = FF2; g.Bt = (const pg8::bf16_t*)(ws + WS_WUP) + (size_t)l * FF2 * DM; E.mode = 2;
                    E.cw = p.in[26] + (size_t)l * 3 * FF2; E.stp = p.in[10] + (size_t)l * 128 * 2 * FF2; E.sout = p.out + O_SFFN + (size_t)l * 128 * 2 * FF2; }
                else { g.A = (const pg8::bf16_t*)(ws + WS_ACT); g.M = RP; g.K = FF; g.N = DM; g.Bt = (const pg8::bf16_t*)(ws + WS_WDN) + (size_t)l * DM * FF; E.mode = 1; E.gate = (const float*)(ws + WS_MOD) + l * 6144 + 5120; }
                if (rep > 0 && E.mode == 1) { E.mode = 0; E.O = (bf16*)(ws + WS_H); E.ldc = DM; }
                if (rep > 0 && E.mode == 1) { E.mode = 0; E.O = (bf16*)(ws + WS_H); E.ldc = DM; }
                pg8::StaticOrder S; S.init(g.M, g.N, gridDim.x, obid());
                pg8::gemm_phase<EpiMain, pg8::StaticOrder, true, true>((PG8_LAS unsigned char*)lds, g, S, E);
                if (E.mode == 3 && rep == 0) { const int G_ = gridDim.x, n2 = S.nwg - G_;
                    if (n2 > 0 && n2 < G_) { if (obid() >= n2) cache_shift(p, i, obid() - n2, G_ - n2); } else cache_shift(p, i, obid(), G_); }
                if (E.mode == 1) mini_gemm((const bf16*)g.A, (const bf16*)g.Bt, g.K, p.out, E.gate, lds);
            }
            else if (st == 2) {
                if (even) { const int G_ = gridDim.x; int il = obid(), is = obid();
                    for (int k = 0; il < 1024 || is < 512; ++k) { const bool do_s = (is < 512) && ((k & 1) || il >= 1024);
                        if (do_s) { mlstm_sample(p, i, is, lds); is += G_; } else { mlstm_local(p, i, il, lds); il += G_; } }
                    shortconv(p, i); }
                else { skip = true; continue; }
            }
            else if (st == 3) { if (even) mlstm_scan(p, i); else attn_phase(p, i, lds); }
            else if (st == 4) { if (!even) { skip = true; continue; } for (int it = obid(); it < 1024; it += gridDim.x) mlstm_out(p, i, it, lds); }
            else if (st == 8) ffnfix_phase(p, l);
        }
        }
        if (skip) continue;
        if (step + 1 < p.hi) { if (step == 0) grid.sync(); else { xcd_barrier(bar); if (PROBE_BAR == 1) xcd_barrier(bar); } }
    }
}

#ifndef NLAUNCH_MODE
#define NLAUNCH_MODE 1
#endif
extern "C" void kernel_launch(void* const* d_in, const int* in_sizes, int n_in, void* d_out, int out_size, void* d_ws, size_t ws_size, hipStream_t stream) {
    static int grid = 0;
    if (grid == 0) {
        if (n_in != 28 || (size_t)out_size != O_END || ws_size < WS_END) { fprintf(stderr, "kernel_launch: unexpected shapes: n_in %d out %d ws %zu\n", n_in, out_size, ws_size); grid = -1; return; }
        int dev = 0, cus = 0, per_cu = 0;
        hipGetDevice(&dev); hipDeviceGetAttribute(&cus, hipDeviceAttributeMultiprocessorCount, dev);
        if (hipFuncSetAttribute((const void*)mega, hipFuncAttributeMaxDynamicSharedMemorySize, LDS_BYTES) != hipSuccess) { fprintf(stderr, "kernel_launch: hipFuncSetAttribute failed\n"); grid = -1; return; }
        if (hipOccupancyMaxActiveBlocksPerMultiprocessor(&per_cu, (const void*)mega, NTHR, LDS_BYTES) != hipSuccess || per_cu < 1) { fprintf(stderr, "kernel_launch: occupancy query says %d\n", per_cu); per_cu = 1; }
        (void)hipGetLastError();
        grid = cus * 1;
    }
    if (grid < 0) return;
    Params p{};
    for (int k = 0; k < 28; ++k) p.in[k] = (const float*)d_in[k];
    p.out = (float*)d_out; p.ws = (unsigned char*)d_ws;
    const int NSTEPS = 42;
    if (hipMemsetAsync(d_ws, 0, 16384, stream) != hipSuccess) { fprintf(stderr, "memset failed\n"); return; }
#if NLAUNCH_MODE == 1
    p.lo = 0; p.hi = NSTEPS;
    void* args[] = {&p};
    hipError_t e = hipLaunchCooperativeKernel((const void*)mega, dim3(grid), dim3(NTHR), args, LDS_BYTES, stream);
    if (e != hipSuccess) fprintf(stderr, "cooperative launch failed: %s (grid %d)\n", hipGetErrorString(e), grid);
#else
    for (int s = 0; s < NSTEPS; ++s) { if (s >= 2 && ((s - 2) % 10) == 4 && (((s - 2) / 10) & 1)) continue; p.lo = s; p.hi = s + 1; hipLaunchKernelGGL(mega, dim3(grid), dim3(NTHR), LDS_BYTES, stream, p); }
#endif
}
```

```cpp
#include <hip/hip_runtime.h>
#include <hip/hip_cooperative_groups.h>
#include <cstdio>
#include <cstdint>
namespace cg = cooperative_groups;
__device__ __forceinline__ int otid() { int t = threadIdx.x; asm volatile("" : "+v"(t)); return t; }
__device__ __forceinline__ int obid() { int b = blockIdx.x; asm volatile("" : "+s"(b)); return b; }
__device__ __forceinline__ float shx(float v, int o) { const int l = otid() & 63; return __builtin_bit_cast(float, __builtin_amdgcn_ds_bpermute((l ^ o) << 2, __builtin_bit_cast(int, v))); }
__device__ __forceinline__ float shi(float v, int src) { return __builtin_bit_cast(float, __builtin_amdgcn_ds_bpermute(src << 2, __builtin_bit_cast(int, v))); }
__device__ __forceinline__ float shup(float v, int o) { const int l = otid() & 63; const int src = l >= o ? l - o : l; return __builtin_bit_cast(float, __builtin_amdgcn_ds_bpermute(src << 2, __builtin_bit_cast(int, v))); }
namespace pg8 {
#define PG8_LAS __attribute__((address_space(3)))
typedef unsigned short bf16_t;
typedef short bf16x8 __attribute__((ext_vector_type(8)));
typedef float f32x4 __attribute__((ext_vector_type(4)));
typedef unsigned u32x4 __attribute__((ext_vector_type(4)));
constexpr int BM = 256, BK = 64, HALF = 128, HTB = HALF * BK * 2  , STAGE_BYTES = 8 * HTB, NXCD = 8, WGM = 8;

__host__ __device__ __forceinline__ int lds_byte(int r, int c) { const int st = (r >> 4) * 2 + (c >> 5), rr = r & 15, cc = c & 31, ob = rr * 64 + cc * 2; return st * 1024 + (ob ^ (((ob >> 9) & 1) << 5)); }
__host__ __device__ __forceinline__ void stage_rc(int b, int& R, int& C) { const int st = b / 1024, sb = b % 1024, swz = sb ^ (((sb >> 9) & 1) << 5); R = (st >> 1) * 16 + swz / 64; C = (st & 1) * 32 + (swz % 64) / 2; }
__host__ __device__ __forceinline__ int perm32(int rho) { const int n = rho >> 4, i = rho & 15; return 8 * (i >> 2) + 4 * n + (i & 3); }

struct Unit { int pm, pn; };
struct Gemm { const bf16_t* A; const bf16_t* Bt; int M, N, K; };

struct StaticOrder {
    int nM, nN, nwg, G, c;
    __host__ __device__ void init(int M, int N, int G_, int c_) { nM = M / BM; nN = N / BM; nwg = nM * nN; G = G_; c = c_; }
    __host__ __device__ bool next(int i, Unit& u) const {
        const long L = (long)i * G + c; if (L >= nwg) return false;
        int wgid = (int)L; { const int q = nwg / NXCD, r = nwg % NXCD, xcd = wgid % NXCD, off = wgid / NXCD; wgid = (xcd < r ? xcd * (q + 1) : r * (q + 1) + (xcd - r) * q) + off; }
        const int nig = WGM * nN, gid = wgid / nig, fm = gid * WGM, gsz = (nM - fm) < WGM ? (nM - fm) : WGM;
        u.pm = fm + ((wgid % nig) % gsz); u.pn = (wgid % nig) / gsz; return true;
    }
    __device__ __forceinline__ void a_ready(const Unit&) const {}
    __device__ __forceinline__ void done(const Unit&) const {}
};

__device__ __forceinline__ unsigned cvt_pk_bf16(float lo, float hi) { unsigned r; asm volatile("v_cvt_pk_bf16_f32 %0, %1, %2" : "=v"(r) : "v"(lo), "v"(hi)); return r; }
template <class Epi, class Sched, bool ALIGN_EPI = false, bool SP2 = false>
__device__ __forceinline__ void gemm_phase(PG8_LAS unsigned char* lds, const Gemm g, const Sched& S, const Epi& E) {
    const int tid = otid(), wid = __builtin_amdgcn_readfirstlane(tid >> 6), lane = tid & 63, wr = wid >> 2, wc = wid & 3, fr = lane & 15, fq = lane >> 4;
    const int K = g.K, nt = K / BK;
    unsigned voffA[2], voffB[2];
#pragma unroll
    for (int i = 0; i < 2; ++i) { int R, C; stage_rc(tid * 16 + i * 8192, R, C); const int Rb = Epi::PERM ? ((R & ~31) + perm32(R & 31)) : R;
        const int Ra = 8 * (16 * (R >> 6) + (R & 15)) + ((R >> 4) & 3);
        voffA[i] = (unsigned)(Ra * K + C) * 2u; voffB[i] = (unsigned)(Rb * K + C) * 2u; }
    const size_t kstep = (size_t)(BK * 2);
    const size_t hstep = (size_t)HALF * K * 2;
    const size_t hstepA = (size_t)4 * K * 2;
    const size_t tstep = 2 * hstep;
    const unsigned ldsw = (unsigned)wid * 1024u;
    const int aoff = lds_byte(wr * 64 + fr, fq * 8), boff = lds_byte(wc * 32 + fr, fq * 8);
#define PG8_SA(b, h) (((b) * 2 + (h)) * HTB)
#define PG8_SB(b, h) ((4 + (b) * 2 + (h)) * HTB)
#define PG8_STAGE(bufoff, gbase, voff) do { _Pragma("unroll") for (int _i = 0; _i < 2; ++_i) \
        __builtin_amdgcn_global_load_lds((const unsigned*)((const char*)(gbase) + (voff)[_i]), (PG8_LAS unsigned*)(lds + (bufoff) + ldsw + _i * 8192), 16, 0, 0); } while (0)
#define PG8_LDA(dst, b, h) do { _Pragma("unroll") for (int m = 0; m < 4; ++m) _Pragma("unroll") for (int k = 0; k < 2; ++k) dst[m][k] = *(const PG8_LAS bf16x8*)(lds + PG8_SA(b, h) + aoff + m * 2048 + k * 1024); } while (0)
#define PG8_LDB(dst, b, h) do { _Pragma("unroll") for (int n = 0; n < 2; ++n) _Pragma("unroll") for (int k = 0; k < 2; ++k) dst[n][k] = *(const PG8_LAS bf16x8*)(lds + PG8_SB(b, h) + boff + n * 2048 + k * 1024); } while (0)
#define PG8_MMA(ai, bj, At, Bt) do { __builtin_amdgcn_s_setprio(1); _Pragma("unroll") for (int m = 0; m < 4; ++m) _Pragma("unroll") for (int n = 0; n < 2; ++n) _Pragma("unroll") for (int k = 0; k < 2; ++k) \
        acc[ai][bj][m][n] = __builtin_amdgcn_mfma_f32_16x16x32_bf16(Bt[n][k], At[m][k], acc[ai][bj][m][n], 0, 0, 0); __builtin_amdgcn_s_setprio(0); } while (0)
#define PG8_WAIT_V(n) asm volatile("s_waitcnt vmcnt(" #n ")" ::: "memory")
#define PG8_WAIT_L(n) asm volatile("s_waitcnt lgkmcnt(" #n ")" ::: "memory")
#define PG8_BAR __builtin_amdgcn_s_barrier()
#define PG8_SCHED __builtin_amdgcn_sched_barrier(0)
    Unit cur, nxt; int ui = 0;
    if (!S.next(0, cur)) return;
    f32x4 acc[2][2][4][2];
#pragma unroll
    for (int a = 0; a < 2; ++a)
#pragma unroll
        for (int b = 0; b < 2; ++b)
#pragma unroll
            for (int m = 0; m < 4; ++m)
#pragma unroll
                for (int n = 0; n < 2; ++n) acc[a][b][m][n] = (f32x4){0.f, 0.f, 0.f, 0.f};
    bf16x8 At[4][2], B0[2][2], B1[2][2];
    const char* cA = (const char*)g.A + (size_t)cur.pm * tstep; const char* cB = (const char*)g.Bt + (size_t)cur.pn * tstep;
    S.a_ready(cur);
    if constexpr (SP2) {
        PG8_STAGE(PG8_SB(0, 0), cB, voffB); PG8_STAGE(PG8_SB(0, 1), cB + hstep, voffB); PG8_STAGE(PG8_SA(0, 0), cA, voffA); PG8_STAGE(PG8_SA(0, 1), cA + hstepA, voffA);
        if (wr == 1) PG8_BAR;
        PG8_WAIT_V(2); PG8_BAR;
        PG8_STAGE(PG8_SB(1, 0), cB + kstep, voffB); PG8_STAGE(PG8_SA(1, 0), cA + kstep, voffA); PG8_STAGE(PG8_SB(1, 1), cB + hstep + kstep, voffB);
        PG8_WAIT_V(6); PG8_BAR;
    } else {
        PG8_STAGE(PG8_SB(0, 0), cB, voffB); PG8_STAGE(PG8_SA(0, 0), cA, voffA); PG8_STAGE(PG8_SB(0, 1), cB + hstep, voffB); PG8_STAGE(PG8_SA(0, 1), cA + hstepA, voffA);
        if (wr == 1) PG8_BAR;
        PG8_WAIT_V(4); PG8_BAR;
        PG8_STAGE(PG8_SB(1, 0), cB + kstep, voffB); PG8_STAGE(PG8_SA(1, 0), cA + kstep, voffA); PG8_STAGE(PG8_SB(1, 1), cB + hstep + kstep, voffB);
        PG8_WAIT_V(6); PG8_BAR;
    }
    for (;;) {
        const bool has_next = S.next(ui + 1, nxt);
        const char* nA = has_next ? (const char*)g.A + (size_t)nxt.pm * tstep : cA; const char* nB = has_next ? (const char*)g.Bt + (size_t)nxt.pn * tstep : cB;
        for (int t = 0; t < nt; t += 2) {
            const bool last = (t == nt - 2);
            const char* a1 = cA + (size_t)(t + 1) * kstep;
            const char* a2 = last ? nA : cA + (size_t)(t + 2) * kstep; const char* b2 = last ? nB : cB + (size_t)(t + 2) * kstep;
            const char* a3 = a2 + kstep; const char* b3 = b2 + kstep;
            if (last && has_next) S.a_ready(nxt);
            if constexpr (SP2) {
            PG8_LDB(B0, 0, 0); PG8_LDB(B1, 0, 1); PG8_SCHED; PG8_LDA(At, 0, 0); PG8_STAGE(PG8_SA(1, 1), a1 + hstepA, voffA);
            PG8_WAIT_V(8); PG8_WAIT_L(0); PG8_BAR; PG8_MMA(0, 0, At, B0); PG8_MMA(0, 1, At, B1); PG8_BAR; PG8_SCHED;
            PG8_LDA(At, 0, 1); PG8_STAGE(PG8_SB(0, 0), b2, voffB); PG8_STAGE(PG8_SB(0, 1), b2 + hstep, voffB); PG8_STAGE(PG8_SA(0, 0), a2, voffA);
            PG8_WAIT_V(8); PG8_WAIT_L(0); PG8_BAR; PG8_MMA(1, 0, At, B0); PG8_MMA(1, 1, At, B1); PG8_BAR; PG8_SCHED;
            PG8_LDB(B0, 1, 0); PG8_LDB(B1, 1, 1); PG8_SCHED; PG8_LDA(At, 1, 0); PG8_STAGE(PG8_SA(0, 1), a2 + hstepA, voffA);
            PG8_WAIT_V(8); PG8_WAIT_L(0); PG8_BAR; PG8_MMA(0, 0, At, B0); PG8_MMA(0, 1, At, B1); PG8_BAR; PG8_SCHED;
            PG8_LDA(At, 1, 1); PG8_STAGE(PG8_SB(1, 0), b3, voffB); PG8_STAGE(PG8_SB(1, 1), b3 + hstep, voffB); PG8_STAGE(PG8_SA(1, 0), a3, voffA);
            PG8_WAIT_V(8); PG8_WAIT_L(0); PG8_BAR; PG8_MMA(1, 0, At, B0); PG8_MMA(1, 1, At, B1); PG8_BAR; PG8_SCHED;
            } else {
            PG8_LDB(B0, 0, 0); PG8_SCHED; PG8_LDA(At, 0, 0); PG8_STAGE(PG8_SA(1, 1), a1 + hstepA, voffA);
            PG8_WAIT_L(8); PG8_BAR; PG8_WAIT_L(0); PG8_MMA(0, 0, At, B0); PG8_BAR; PG8_SCHED;
            PG8_LDB(B1, 0, 1); PG8_STAGE(PG8_SB(0, 0), b2, voffB);
            PG8_BAR; PG8_WAIT_L(0); PG8_MMA(0, 1, At, B1); PG8_BAR;
            PG8_LDA(At, 0, 1); PG8_STAGE(PG8_SA(0, 0), a2, voffA);
            PG8_BAR; PG8_WAIT_L(0); PG8_MMA(1, 0, At, B0); PG8_BAR; PG8_SCHED;
            PG8_STAGE(PG8_SB(0, 1), b2 + hstep, voffB);
            PG8_WAIT_V(6); PG8_BAR; PG8_MMA(1, 1, At, B1); PG8_BAR;
            PG8_LDB(B0, 1, 0); PG8_SCHED; PG8_LDA(At, 1, 0); PG8_STAGE(PG8_SA(0, 1), a2 + hstepA, voffA);
            PG8_WAIT_L(8); PG8_BAR; PG8_WAIT_L(0); PG8_MMA(0, 0, At, B0); PG8_BAR; PG8_SCHED;
            PG8_LDB(B1, 1, 1); PG8_STAGE(PG8_SB(1, 0), b3, voffB);
            PG8_BAR; PG8_WAIT_L(0); PG8_MMA(0, 1, At, B1); PG8_BAR;
            PG8_LDA(At, 1, 1); PG8_STAGE(PG8_SA(1, 0), a3, voffA);
            PG8_BAR; PG8_WAIT_L(0); PG8_MMA(1, 0, At, B0); PG8_BAR; PG8_SCHED;
            PG8_STAGE(PG8_SB(1, 1), b3 + hstep, voffB);
            PG8_WAIT_V(6); PG8_BAR; PG8_MMA(1, 1, At, B1); PG8_BAR;
            }
        }
        if constexpr (ALIGN_EPI) { if (wr == 0) PG8_BAR; }
        if constexpr (!Epi::AFTER_DRAIN) { E(acc, cur, wr, wc, fr, fq); S.done(cur); }
        if (!has_next) break;
#pragma unroll
        for (int a = 0; a < 2; ++a)
#pragma unroll
            for (int b = 0; b < 2; ++b)
#pragma unroll
                for (int m = 0; m < 4; ++m)
#pragma unroll
                    for (int n = 0; n < 2; ++n) acc[a][b][m][n] = (f32x4){0.f, 0.f, 0.f, 0.f};
        cur = nxt; cA = nA; cB = nB; ++ui;
        if constexpr (ALIGN_EPI) { if (wr == 1) PG8_BAR; }
    }
    PG8_WAIT_V(0);
    if constexpr (!ALIGN_EPI) { if (wr == 0) PG8_BAR; }
    PG8_BAR;
    if constexpr (Epi::AFTER_DRAIN) { E.fused(acc, cur, wr, wc, fr, fq, lds, wid, lane); S.done(cur); }
#undef PG8_SA
#undef PG8_SB
#undef PG8_STAGE
#undef PG8_LDA
#undef PG8_LDB
#undef PG8_MMA
#undef PG8_WAIT_V
#undef PG8_WAIT_L
#undef PG8_BAR
#undef PG8_SCHED
}
}

typedef unsigned short bf16;
typedef float f32x4 __attribute__((ext_vector_type(4)));
typedef float f32x2 __attribute__((ext_vector_type(2)));
typedef unsigned u32x4 __attribute__((ext_vector_type(4)));
typedef unsigned u32x2 __attribute__((ext_vector_type(2)));
typedef short bf16x8 __attribute__((ext_vector_type(8)));

constexpr int R = 17408, RP = 16384, NSEQ = 130, SEQL = 8192;
constexpr int DM = 1024, INA = 3592, ZW = 3584, QKVW = 1536, FF = 2816, FF2 = 5632, MODW = 24576;
constexpr float EPS = 1e-6f;
constexpr int NWAVES = 8, NTHR = 512;
constexpr int LDS_BYTES = 147456;

constexpr size_t O_Y = 0;
constexpr size_t O_PC = (size_t)R * 1024;
constexpr size_t O_PN = O_PC + 262144;
constexpr size_t O_PM = O_PN + 2048;
constexpr size_t O_PSC = O_PM + 16;
constexpr size_t O_PWK = O_PSC + 4096;
constexpr size_t O_PWV = O_PWK + 131072;
constexpr size_t O_PFFN = O_PWV + 131072;
constexpr size_t O_SC = O_PFFN + 90112;
constexpr size_t O_SN = O_SC + 16777216;
constexpr size_t O_SM = O_SN + 131072;
constexpr size_t O_SSC = O_SM + 1024;
constexpr size_t O_SWK = O_SSC + 262144;
constexpr size_t O_SWV = O_SWK + 8388608;
constexpr size_t O_SFFN = O_SWV + 8388608;
constexpr size_t O_END = O_SFFN + 5767168;

constexpr size_t MiB = 1u << 20;
constexpr size_t WS_WIN = 1 * MiB, WS_WAO = 15 * MiB, WS_WQKV = 19 * MiB, WS_WCO = 25 * MiB, WS_WUP = 29 * MiB, WS_WDN = 73 * MiB;
constexpr size_t WS_AC = 95 * MiB, WS_MOD = 96 * MiB, WS_TAB = 109 * MiB, WS_H = 112 * MiB, WS_CAT = 146 * MiB, WS_GATES = 180 * MiB;
constexpr size_t WS_ZU = 181 * MiB;
constexpr size_t WS_ACT = 368 * MiB;
constexpr size_t WS_DCT = WS_ACT, WS_CST = WS_ACT + 64 * MiB, WS_NS = WS_ACT + 96 * MiB, WS_DN = WS_NS + MiB / 2, WS_CS = WS_NS + MiB, WS_MS = WS_CS + 65536;
constexpr size_t WS_UB = 466 * MiB;
constexpr size_t WS_END = 472 * MiB;

__constant__ double ROPE_INV[32] = {1.0, 0.7498942093324559, 0.5623413251903491, 0.4216965034285822, 0.31622776601683794, 0.23713737056616552, 0.1778279410038923, 0.1333521432163324, 0.1, 0.07498942093324558, 0.05623413251903491, 0.042169650342858224, 0.03162277660168379, 0.023713737056616554, 0.01778279410038923, 0.01333521432163324, 0.01, 0.007498942093324558, 0.005623413251903491, 0.004216965034285823, 0.0031622776601683794, 0.0023713737056616554, 0.0017782794100389228, 0.001333521432163324, 0.001, 0.0007498942093324559, 0.0005623413251903491, 0.00042169650342858224, 0.00031622776601683794, 0.00023713737056616554, 0.00017782794100389227, 0.0001333521432163324};
#ifndef PROBE_PRE
#define PROBE_PRE 0
#define PROBE_EVEN 0
#define PROBE_ODD 0
#endif
#ifndef PROBE_BAR
#define PROBE_BAR 0
#endif
struct Params { const float* in[28]; float* out; unsigned char* ws; int lo, hi; };

__device__ __forceinline__ unsigned f2bf(float f) { unsigned u = __builtin_bit_cast(unsigned, f); return (u + 0x7fffu + ((u >> 16) & 1u)) >> 16; }
__device__ __forceinline__ unsigned pk2(float lo, float hi) { unsigned r; asm("v_cvt_pk_bf16_f32 %0, %1, %2" : "=v"(r) : "v"(lo), "v"(hi)); return r; }
__device__ __forceinline__ unsigned pk2_sw(float lo, float hi) { return f2bf(lo) | (f2bf(hi) << 16); }
__device__ __forceinline__ float bf2f(unsigned h) { return __builtin_bit_cast(float, h << 16); }
__device__ __forceinline__ float bflo(unsigned w) { return __builtin_bit_cast(float, w << 16); }
__device__ __forceinline__ float bfhi(unsigned w) { return __builtin_bit_cast(float, w & 0xffff0000u); }
template <int CTRL> __device__ __forceinline__ float dppf(float x) { return __builtin_bit_cast(float, __builtin_amdgcn_mov_dpp(__builtin_bit_cast(int, x), CTRL, 0xF, 0xF, true)); }
__device__ __forceinline__ float rdl(float x, int l) { return __builtin_bit_cast(float, __builtin_amdgcn_readlane(__builtin_bit_cast(int, x), l)); }
__device__ __forceinline__ float wave_sum(float v) {
    v += dppf<0xB1>(v); v += dppf<0x4E>(v); v += dppf<0x141>(v); v += dppf<0x140>(v);
    return (rdl(v, 0) + rdl(v, 16)) + (rdl(v, 32) + rdl(v, 48));
}
__device__ __forceinline__ float wave_max(float v) {
    v = fmaxf(v, dppf<0xB1>(v)); v = fmaxf(v, dppf<0x4E>(v)); v = fmaxf(v, dppf<0x141>(v)); v = fmaxf(v, dppf<0x140>(v));
    return fmaxf(fmaxf(rdl(v, 0), rdl(v, 16)), fmaxf(rdl(v, 32), rdl(v, 48)));
}
__device__ __forceinline__ float logsigmoidf(float f) { return fminf(f, 0.f) - log1pf(__expf(-fabsf(f))); }
__device__ __forceinline__ float sigmoidf_(float x) { return __builtin_amdgcn_rcpf(1.f + __builtin_amdgcn_exp2f(x * -1.4426950408889634f)); }
__device__ __forceinline__ int seq_of(int row) { return row < RP ? (row >> 13) : 2 + ((row - RP) >> 3); }
#define LAS __attribute__((address_space(3)))
#define LDS_WAIT() asm volatile("s_waitcnt lgkmcnt(0)" ::: "memory")

__device__ __forceinline__ float dpp_shr1f(float x) { return __builtin_bit_cast(float, __builtin_amdgcn_mov_dpp(__builtin_bit_cast(int, x), 0x111, 0xF, 0xF, false)); }
__device__ __forceinline__ f32x4 dpp_shr1(const f32x4 v) { f32x4 r; r.x = dpp_shr1f(v.x); r.y = dpp_shr1f(v.y); r.z = dpp_shr1f(v.z); r.w = dpp_shr1f(v.w); return r; }
struct EpiMain {
    static constexpr bool PERM = true, AFTER_DRAIN = false;
    int mode;
    bf16* O; int ldc; float* X; const float* gate;
    const float* qn; const float* kn; int lyr; unsigned char* wsb;
    const float* cw; const float* stp; float* sout;
    __device__ __forceinline__ void operator()(const pg8::f32x4 (&acc)[2][2][4][2], const pg8::Unit& u, int wr, int wc, int fr, int fq) const {
        const int rowb = u.pm * 256 + 8 * (16 * wr + fr), col0 = u.pn * 256 + wc * 32 + 8 * fq;
        if (mode == 0) {
#pragma unroll
            for (int ai = 0; ai < 2; ++ai)
#pragma unroll
                for (int m = 0; m < 4; ++m) { bf16* rowp = O + (size_t)(rowb + 4 * ai + m) * ldc + col0;
#pragma unroll
                    for (int bj = 0; bj < 2; ++bj) { const pg8::f32x4 v0 = acc[ai][bj][m][0], v1 = acc[ai][bj][m][1]; u32x4 w;
                        w.x = pg8::cvt_pk_bf16(v0[0], v0[1]); w.y = pg8::cvt_pk_bf16(v0[2], v0[3]); w.z = pg8::cvt_pk_bf16(v1[0], v1[1]); w.w = pg8::cvt_pk_bf16(v1[2], v1[3]);
                        *(u32x4*)(rowp + bj * 128) = w; } }
        } else if (mode == 1) {
            f32x4 gv[2][2];
            { const float* gp = gate + (size_t)(u.pm >> 5) * MODW + col0;
#pragma unroll
              for (int bj = 0; bj < 2; ++bj)
#pragma unroll
                  for (int n = 0; n < 2; ++n) gv[bj][n] = *(const f32x4*)(gp + bj * 128 + 4 * n); }
#pragma unroll
            for (int am = 0; am < 4; ++am) { const int ai = am >> 1, m0 = (am & 1) * 2;
                f32x4 xv[2][2][2];
#pragma unroll
                for (int mm = 0; mm < 2; ++mm) { const float* xp = X + (size_t)(rowb + 4 * ai + m0 + mm) * DM + col0;
#pragma unroll
                    for (int bj = 0; bj < 2; ++bj)
#pragma unroll
                        for (int n = 0; n < 2; ++n) xv[mm][bj][n] = *(const f32x4*)(xp + bj * 128 + 4 * n); }
#pragma unroll
                for (int mm = 0; mm < 2; ++mm) { float* xp = X + (size_t)(rowb + 4 * ai + m0 + mm) * DM + col0;
#pragma unroll
                    for (int bj = 0; bj < 2; ++bj)
#pragma unroll
                        for (int n = 0; n < 2; ++n) *(f32x4*)(xp + bj * 128 + 4 * n) = xv[mm][bj][n] + gv[bj][n] * acc[ai][bj][m0 + mm][n]; }
            }
        } else if (mode == 3) {
            int fq3 = fq; asm volatile("" : "+v"(fq3));
            const int head = 4 * u.pn + wc; const bool prm = u.pm < 64;
            const f32x2* TAB = (const f32x2*)(wsb + WS_TAB);
            const int sq = prm ? (u.pm >> 5) : ((rowb - RP) >> 3);
            const float* nwp = (head < 16 ? qn : kn) + 8 * fq3;
            f32x4 ca, sa, cb, sb;
            { const int pos0 = prm ? (rowb & (SEQL - 1)) : SEQL; const f32x4* tp = (const f32x4*)(TAB + pos0 * 32 + 8 * fq3); const f32x4 c0 = tp[0], c1 = tp[1], c2 = tp[2], c3 = tp[3];
              ca = (f32x4){c0[0], c0[2], c1[0], c1[2]}; sa = (f32x4){c0[1], c0[3], c1[1], c1[3]}; cb = (f32x4){c2[0], c2[2], c3[0], c3[2]}; sb = (f32x4){c2[1], c2[3], c3[1], c3[3]};
            }
#pragma unroll
            for (int j = 0; j < 8; ++j) { const int row = rowb + j, t = prm ? (row & (SEQL - 1)) : j;
                f32x4 x1a = acc[j >> 2][0][j & 3][0], x1b = acc[j >> 2][0][j & 3][1], x2a = acc[j >> 2][1][j & 3][0], x2b = acc[j >> 2][1][j & 3][1];
                if (head < 20) {
                    float ss = (x1a[0] * x1a[0] + x1a[1] * x1a[1]) + (x1a[2] * x1a[2] + x1a[3] * x1a[3]) + (x1b[0] * x1b[0] + x1b[1] * x1b[1]) + (x1b[2] * x1b[2] + x1b[3] * x1b[3])
                             + (x2a[0] * x2a[0] + x2a[1] * x2a[1]) + (x2a[2] * x2a[2] + x2a[3] * x2a[3]) + (x2b[0] * x2b[0] + x2b[1] * x2b[1]) + (x2b[2] * x2b[2] + x2b[3] * x2b[3]);
                    ss += shx(ss, 16); ss += shx(ss, 32);
                    const float rstd = rsqrtf(ss * (1.f / 64.f) + EPS);
                    const f32x4 y1a = x1a * rstd * *(const f32x4*)nwp, y1b = x1b * rstd * *(const f32x4*)(nwp + 4), y2a = x2a * rstd * *(const f32x4*)(nwp + 32), y2b = x2b * rstd * *(const f32x4*)(nwp + 36);
                    x1a = y1a * ca - y2a * sa; x1b = y1b * cb - y2b * sb; x2a = y2a * ca + y1a * sa; x2b = y2b * cb + y1b * sb;
                }
                bf16* zp = O + (size_t)row * QKVW + head * 64 + 8 * fq3;
                *(u32x4*)zp = (u32x4){pk2(x1a[0], x1a[1]), pk2(x1a[2], x1a[3]), pk2(x1b[0], x1b[1]), pk2(x1b[2], x1b[3])};
                *(u32x4*)(zp + 32) = (u32x4){pk2(x2a[0], x2a[1]), pk2(x2a[2], x2a[3]), pk2(x2b[0], x2b[1]), pk2(x2b[2], x2b[3])};
                if (head >= 16 && (!prm || t >= SEQL - 128)) {
                    float* dst = X + (head < 20 ? (prm ? O_PWK : O_SWK) : (prm ? O_PWV : O_SWV)) + (prm ? ((size_t)(lyr * 2 + sq) * 128 + (t - (SEQL - 128))) * 256 : ((size_t)(lyr * 128 + sq) * 128 + 120 + j) * 256) + ((head - 16) & 3) * 64 + 8 * fq3;
                    *(f32x4*)dst = x1a; *(f32x4*)(dst + 4) = x1b; *(f32x4*)(dst + 32) = x2a; *(f32x4*)(dst + 36) = x2b; }
                if (head < 20) { const f32x4* t1 = (const f32x4*)(TAB + 32 + 8 * fq3); const f32x4 e0 = t1[0], e1 = t1[1], e2 = t1[2], e3 = t1[3];
                    const f32x4 dca = (f32x4){e0[0], e0[2], e1[0], e1[2]}, dsa = (f32x4){e0[1], e0[3], e1[1], e1[3]}, dcb = (f32x4){e2[0], e2[2], e3[0], e3[2]}, dsb = (f32x4){e2[1], e2[3], e3[1], e3[3]};
                    const f32x4 na = ca * dca - sa * dsa, nb = cb * dcb - sb * dsb; sa = sa * dca + ca * dsa; sb = sb * dcb + cb * dsb; ca = na; cb = nb; }
                asm volatile("" ::: "memory");
            }
        } else {
            const bool smp = u.pm >= 64; const int sq = (rowb - RP) >> 3;
            bf16* UB = (bf16*)(wsb + WS_UB); bf16* ACT = (bf16*)(wsb + WS_ACT);
#pragma unroll
            for (int n = 0; n < 2; ++n) {
                const int cf = u.pn * 128 + wc * 32 + 8 * fq + 4 * n;
                const f32x4 wg0 = *(const f32x4*)(cw + cf), wg1 = *(const f32x4*)(cw + FF2 + cf), wg2 = *(const f32x4*)(cw + 2 * FF2 + cf);
                const f32x4 wa0 = *(const f32x4*)(cw + FF + cf), wa1 = *(const f32x4*)(cw + FF2 + FF + cf), wa2 = *(const f32x4*)(cw + 2 * FF2 + FF + cf);
                f32x4 g2, g1, a2, a1;
                if (smp) { const float* st = stp + (size_t)sq * 2 * FF2; g2 = *(const f32x4*)(st + cf); a2 = *(const f32x4*)(st + FF + cf); g1 = *(const f32x4*)(st + FF2 + cf); a1 = *(const f32x4*)(st + FF2 + FF + cf); }
                else { g2 = dpp_shr1(acc[1][0][2][n]); g1 = dpp_shr1(acc[1][0][3][n]); a2 = dpp_shr1(acc[1][1][2][n]); a1 = dpp_shr1(acc[1][1][3][n]); }
#pragma unroll
                for (int j = 0; j < 8; ++j) { const f32x4 G = acc[j >> 2][0][j & 3][n], A = acc[j >> 2][1][j & 3][n];
                    const f32x4 cg = wg0 * g2 + wg1 * g1 + wg2 * G, ca = wa0 * a2 + wa1 * a1 + wa2 * A;
                    if (smp || fr != 0 || j >= 2)
                        *(u32x2*)(ACT + (size_t)(rowb + j) * FF + cf) = (u32x2){pg8::cvt_pk_bf16(cg[0] * sigmoidf_(cg[0]) * ca[0], cg[1] * sigmoidf_(cg[1]) * ca[1]), pg8::cvt_pk_bf16(cg[2] * sigmoidf_(cg[2]) * ca[2], cg[3] * sigmoidf_(cg[3]) * ca[3])};
                    if (smp) { if (j >= 6) { float* d = sout + ((size_t)sq * 2 + (j - 6)) * FF2; *(f32x4*)(d + cf) = G; *(f32x4*)(d + FF + cf) = A; } }
                    else if ((fr == 0 && j < 2) || (fr == 15 && j >= 6)) { bf16* d = UB + ((size_t)(u.pm * 2 + wr) * 4 + (j < 2 ? j : j - 4)) * FF2;
                        *(u32x2*)(d + cf) = (u32x2){pk2(G[0], G[1]), pk2(G[2], G[3])}; *(u32x2*)(d + FF + cf) = (u32x2){pk2(A[0], A[1]), pk2(A[2], A[3])}; }
                    g2 = g1; g1 = G; a2 = a1; a1 = A; }
            }
        }
    }
};
struct EpiMod {
    static constexpr bool PERM = true, AFTER_DRAIN = false;
    float* O; const float* bias;
    __device__ __forceinline__ void operator()(const pg8::f32x4 (&acc)[2][2][4][2], const pg8::Unit& u, int wr, int wc, int fr, int fq) const {
        const int rowb = u.pm * 256 + 8 * (16 * wr + fr), col0 = u.pn * 256 + wc * 32 + 8 * fq;
#pragma unroll
        for (int ai = 0; ai < 2; ++ai)
#pragma unroll
            for (int m = 0; m < 4; ++m) { const int row = rowb + 4 * ai + m;
                if (row < NSEQ) {
#pragma unroll
                    for (int bj = 0; bj < 2; ++bj)
#pragma unroll
                        for (int n = 0; n < 2; ++n) { const f32x4 b = *(const f32x4*)(bias + col0 + bj * 128 + 4 * n);
                            *(f32x4*)(O + (size_t)row * MODW + col0 + bj * 128 + 4 * n) = acc[ai][bj][m][n] + b; } } }
    }
};


__device__ __forceinline__ void mini_gemm(const bf16* A, const bf16* Bt, int K, float* X, const float* gate, unsigned char* smem) {
    const int tid = otid(), lane = tid & 63, wave = tid >> 6, fr = lane & 15, fq = lane >> 4;
    float* part = (float*)smem;
    const int nks = K / 256;
    for (int u = obid(); u < 256; u += gridDim.x) {
        const int rm = u >> 4, cn = u & 15;
        const bf16* Ap = A + (size_t)(RP + 64 * rm + fr) * K + wave * (K / 8) + 8 * fq;
        const bf16* Bp = Bt + (size_t)(64 * cn + fr) * K + wave * (K / 8) + 8 * fq;
        f32x4 acc[4][4];
#pragma unroll
        for (int i = 0; i < 4; ++i)
#pragma unroll
            for (int j = 0; j < 4; ++j) acc[i][j] = (f32x4){0.f, 0.f, 0.f, 0.f};
        bf16x8 a0[4], b0[4], a1[4], b1[4];
#define MG_LD(a, b, ks) do { _Pragma("unroll") for (int i_ = 0; i_ < 4; ++i_) { a[i_] = *(const bf16x8*)(Ap + (size_t)(16 * i_) * K + 32 * (ks)); b[i_] = *(const bf16x8*)(Bp + (size_t)(16 * i_) * K + 32 * (ks)); } } while (0)
#define MG_MMA(a, b) do { _Pragma("unroll") for (int i_ = 0; i_ < 4; ++i_) _Pragma("unroll") for (int j_ = 0; j_ < 4; ++j_) acc[i_][j_] = __builtin_amdgcn_mfma_f32_16x16x32_bf16(b[j_], a[i_], acc[i_][j_], 0, 0, 0); } while (0)
        MG_LD(a0, b0, 0);
        for (int ks = 0; ks < nks; ks += 2) {
            if (ks + 1 < nks) MG_LD(a1, b1, ks + 1);
            MG_MMA(a0, b0);
            if (ks + 2 < nks) MG_LD(a0, b0, ks + 2);
            if (ks + 1 < nks) MG_MMA(a1, b1);
        }
#undef MG_LD
#undef MG_MMA
#pragma unroll
        for (int i = 0; i < 4; ++i)
#pragma unroll
            for (int j = 0; j < 4; ++j) *(f32x4*)(part + (wave * 64 + 16 * i + fr) * 68 + 16 * j + 4 * fq) = acc[i][j];
        __syncthreads();
        {
            const int row = tid >> 3, c0 = (tid & 7) * 8;
            f32x4 s0 = (f32x4){0.f, 0.f, 0.f, 0.f}, s1 = s0;
#pragma unroll
            for (int w = 0; w < 8; ++w) { s0 = s0 + *(const f32x4*)(part + (w * 64 + row) * 68 + c0); s1 = s1 + *(const f32x4*)(part + (w * 64 + row) * 68 + c0 + 4); }
            const int grow = RP + 64 * rm + row, col = 64 * cn + c0; const int sq = 2 + ((grow - RP) >> 3);
            const float* gp = gate + (size_t)sq * MODW + col; float* xp = X + (size_t)grow * DM + col;
            const f32x4 g0 = *(const f32x4*)gp, g1 = *(const f32x4*)(gp + 4);
            *(f32x4*)xp = *(const f32x4*)xp + g0 * s0; *(f32x4*)(xp + 4) = *(const f32x4*)(xp + 4) + g1 * s1;
        }
        __syncthreads();
    }
}
struct TDesc { const float* W; bf16* WT; int ldw, K; };
constexpr int I_IN = 1792, I_AO = 512, I_QKV = 768, I_CO = 512, I_UP = 2816, I_DN = 1408, I_ADA = 3072;
constexpr int TN1 = 2 * I_IN, TN2 = TN1 + 2 * I_AO, TN3 = TN2 + 2 * I_QKV, TN4 = TN3 + 2 * I_CO, TN5 = TN4 + 4 * I_UP, TN6 = TN5 + 4 * I_DN, TN7 = TN6 + 4 * I_ADA;
__device__ __forceinline__ void tdecode(const Params& p, int it, TDesc& d) {
    unsigned char* ws = p.ws; int r = it, ncols; const float* W; bf16* WT; int ldw, K = DM; bool wup = false, wqkv = false;
    if (r < TN1) { const int i = r / I_IN; r -= i * I_IN; W = p.in[15] + (size_t)i * DM * INA; WT = (bf16*)(ws + WS_WIN) + (size_t)i * ZW * DM; ldw = INA;
        if (r < 1024) ncols = 2048; else { W += 2056; WT += (size_t)2048 * DM; r -= 1024; ncols = 1536; } }
    else if (r < TN2) { r -= TN1; const int i = r / I_AO; r -= i * I_AO; W = p.in[19] + (size_t)i * DM * DM; WT = (bf16*)(ws + WS_WAO) + (size_t)i * DM * DM; ldw = DM; ncols = DM; }
    else if (r < TN3) { r -= TN2; const int i = r / I_QKV; r -= i * I_QKV; W = p.in[20] + (size_t)i * DM * QKVW; WT = (bf16*)(ws + WS_WQKV) + (size_t)i * QKVW * DM; ldw = QKVW; ncols = QKVW; wqkv = true; }
    else if (r < TN4) { r -= TN3; const int i = r / I_CO; r -= i * I_CO; W = p.in[24] + (size_t)i * DM * DM; WT = (bf16*)(ws + WS_WCO) + (size_t)i * DM * DM; ldw = DM; ncols = DM; }
    else if (r < TN5) { r -= TN4; const int i = r / I_UP; r -= i * I_UP; W = p.in[25] + (size_t)i * DM * FF2; WT = (bf16*)(ws + WS_WUP) + (size_t)i * FF2 * DM; ldw = FF2; ncols = FF2; wup = true; }
    else if (r < TN6) { r -= TN5; const int i = r / I_DN; r -= i * I_DN; W = p.in[27] + (size_t)i * FF * DM; WT = (bf16*)(ws + WS_WDN) + (size_t)i * DM * FF; ldw = DM; ncols = DM; K = FF; }
    else { r -= TN6; const int i = r / I_ADA; r -= i * I_ADA; W = p.in[13] + (size_t)i * DM * 6144; WT = (bf16*)(ws + WS_ZU) + (size_t)i * 6144 * DM; ldw = 6144; ncols = 6144; }
    const int nblk = ncols / 32, kb = r / nblk, nb = r - kb * nblk;
    int drow = 32 * nb;
    if (wup) drow = (nb < 88) ? 256 * (nb >> 2) + 32 * (nb & 3) : 256 * ((nb - 88) >> 2) + 128 + 32 * ((nb - 88) & 3);
    if (wqkv) { const int head = nb >> 1; drow = 256 * (head >> 2) + 128 * (nb & 1) + 32 * (head & 3); }
    d.W = W + (size_t)(64 * kb) * ldw + 32 * nb; d.WT = WT + (size_t)drow * K + 64 * kb; d.ldw = ldw; d.K = K;
}
__device__ __forceinline__ void tload(const TDesc& d, int lane, float (&v)[32]) {
#pragma unroll
    for (int i = 0; i < 32; ++i) v[i] = d.W[(size_t)(2 * i + (lane >> 5)) * d.ldw + (lane & 31)];
}
__device__ __forceinline__ void tstore(const TDesc& d, int lane, const float (&v)[32], float* scr) {
#pragma unroll
    for (int i = 0; i < 32; ++i) scr[(2 * i + (lane >> 5)) * 33 + (lane & 31)] = v[i];
    LDS_WAIT();
    const int c = lane & 7;
#pragma unroll
    for (int j = 0; j < 4; ++j) { const int n = (lane >> 3) + 8 * j; const float* s = scr + (8 * c) * 33 + n;
        u32x4 o; o.x = pk2(s[0 * 33], s[1 * 33]); o.y = pk2(s[2 * 33], s[3 * 33]); o.z = pk2(s[4 * 33], s[5 * 33]); o.w = pk2(s[6 * 33], s[7 * 33]);
        *(u32x4*)(d.WT + (size_t)n * d.K + 8 * c) = o; }
    LDS_WAIT();
}

__device__ __forceinline__ void prologue(const Params& p, unsigned char* smem) {
    const int tid = otid(), lane = tid & 63, wave = tid >> 6;
    const int gw = obid() * NWAVES + wave, NGW = gridDim.x * NWAVES;
    float* scr = (float*)(smem + wave * 16384);
    unsigned char* ws = p.ws;
    {
        float va[32], vb[32]; TDesc da, db;
        int it = gw;
        if (it < TN7) { tdecode(p, it, da); tload(da, lane, va); }
        while (it < TN7) {
            int nx = it + NGW;
            if (nx < TN7) { tdecode(p, nx, db); tload(db, lane, vb); }
            tstore(da, lane, va, scr);
            it = nx; nx = it + NGW;
            if (it >= TN7) break;
            if (nx < TN7) { tdecode(p, nx, da); tload(da, lane, va); }
            tstore(db, lane, vb, scr);
            it = nx;
        }
    }
    const int gt = obid() * NTHR + tid, NT = gridDim.x * NTHR;
    bf16* Ac = (bf16*)(ws + WS_AC);
    for (int idx = gt; idx < 256 * DM; idx += NT) { const int row = idx >> 10, col = idx & 1023; float v = 0.f;
        if (row < 2) v = p.in[2][row * DM + col]; else if (row < NSEQ) v = p.in[3][(row - 2) * DM + col];
        Ac[idx] = (bf16)f2bf(v * sigmoidf_(v)); }
    f32x2* TAB = (f32x2*)(ws + WS_TAB);
    for (int idx = gt; idx < 8200 * 32; idx += NT) { const int pos = idx >> 5, i = idx & 31;
        const double ang = (double)pos * ROPE_INV[i];
        const double n = rint(ang * 0.6366197723675814); double r = fma(-n, 1.5707963267948966, ang); r = fma(-n, 6.123233995736766e-17, r); const double r2 = r * r;
        const double sn = r * (1.0 + r2 * (-1.0 / 6 + r2 * (1.0 / 120 + r2 * (-1.0 / 5040 + r2 * (1.0 / 362880 + r2 * (-1.0 / 39916800 + r2 * (1.0 / 6227020800.0)))))));
        const double cn = 1.0 + r2 * (-0.5 + r2 * (1.0 / 24 + r2 * (-1.0 / 720 + r2 * (1.0 / 40320 + r2 * (-1.0 / 3628800 + r2 * (1.0 / 479001600.0 + r2 * (-1.0 / 87178291200.0)))))));
        const int qd = ((int)n) & 3; const double c = (qd == 0) ? cn : (qd == 1) ? -sn : (qd == 2) ? -cn : sn, s = (qd == 0) ? sn : (qd == 1) ? cn : (qd == 2) ? -sn : -cn;
        TAB[idx] = (f32x2){(float)c, (float)s}; }
}

__device__ __forceinline__ void norm_phase(const Params& p, int l, int which, unsigned char* smem) {
    const int tid = otid(), lane = tid & 63, wave = tid >> 6;
    const int gw = obid() * NWAVES + wave, NGW = gridDim.x * NWAVES;
    const bool do_gates = (which == 1) && !(l & 1);
    const bool first = (which == 1) && (l == 0);
    float* X = p.out;
    const float* MOD = (const float*)(p.ws + WS_MOD);
    bf16* H = (bf16*)(p.ws + WS_H);
    float* gwl = (float*)smem;
    if (do_gates) {
        const float* W = p.in[15] + (size_t)(l >> 1) * DM * INA + 2048;
        for (int idx = tid; idx < 8192; idx += NTHR) gwl[idx] = W[(size_t)(idx >> 3) * INA + (idx & 7)];
        __syncthreads();
    }
    const float* nw = (which == 1 ? p.in[11] : p.in[12]) + l * DM;
    const int off_sh = l * 6144 + (which == 1 ? 0 : 3072), off_sc = off_sh + 1024;
    f32x4 nwv[4];
#pragma unroll
    for (int j = 0; j < 4; ++j) nwv[j] = *(const f32x4*)(nw + 4 * lane + 256 * j);
    f32x4 vn[4], vn2[4];
#define NORM_SRC(r_) (first ? ((r_) < RP ? p.in[0] + (size_t)(r_) * DM : p.in[1] + (size_t)((r_) - RP) * DM) : X + (size_t)(r_) * DM)
    { const int row = gw; if (row < R) { const float* src = NORM_SRC(row);
#pragma unroll
        for (int j = 0; j < 4; ++j) vn[j] = *(const f32x4*)(src + 4 * lane + 256 * j); }
      const int row2 = gw + NGW; if (row2 < R) { const float* src = NORM_SRC(row2);
#pragma unroll
        for (int j = 0; j < 4; ++j) vn2[j] = *(const f32x4*)(src + 4 * lane + 256 * j); } }
    for (int row = gw; row < R; row += NGW) {
        const int sq = seq_of(row);
        f32x4 v[4]; float ss = 0.f;
#pragma unroll
        for (int j = 0; j < 4; ++j) { v[j] = vn[j]; vn[j] = vn2[j]; }
        { const int nrow = row + 2 * NGW; if (nrow < R) { const float* src = NORM_SRC(nrow);
#pragma unroll
            for (int j = 0; j < 4; ++j) vn2[j] = *(const f32x4*)(src + 4 * lane + 256 * j); } }
#pragma unroll
        for (int j = 0; j < 4; ++j) ss += (v[j].x * v[j].x + v[j].y * v[j].y) + (v[j].z * v[j].z + v[j].w * v[j].w);
        if (first) {
#pragma unroll
            for (int j = 0; j < 4; ++j) *(f32x4*)(X + (size_t)row * DM + 4 * lane + 256 * j) = v[j];
        }
        const float rstd = rsqrtf(wave_sum(ss) * (1.f / DM) + EPS);
        const float* mrow = MOD + (size_t)sq * MODW;
        float ga[8];
#pragma unroll
        for (int g = 0; g < 8; ++g) ga[g] = 0.f;
#pragma unroll
        for (int j = 0; j < 4; ++j) {
            const f32x4 sc = *(const f32x4*)(mrow + off_sc + 4 * lane + 256 * j), sh = *(const f32x4*)(mrow + off_sh + 4 * lane + 256 * j);
            f32x4 h = v[j] * rstd * nwv[j] * (sc + 1.f) + sh;
            *(u32x2*)(H + (size_t)row * DM + 4 * lane + 256 * j) = (u32x2){pk2(h.x, h.y), pk2(h.z, h.w)};
            if (do_gates) {
#pragma unroll
                for (int e = 0; e < 4; ++e) { const float* wp = gwl + (4 * lane + 256 * j + e) * 8; const f32x4 w0 = *(const f32x4*)wp, w1 = *(const f32x4*)(wp + 4); const float hv = h[e];
                    ga[0] += hv * w0.x; ga[1] += hv * w0.y; ga[2] += hv * w0.z; ga[3] += hv * w0.w; ga[4] += hv * w1.x; ga[5] += hv * w1.y; ga[6] += hv * w1.z; ga[7] += hv * w1.w; }
            }
        }
        if (do_gates) {
            const float* bif = p.in[16] + (l >> 1) * 8;
#pragma unroll
            for (int g = 0; g < 8; ++g) ga[g] = wave_sum(ga[g]);
            if (lane == 0) { float* G = (float*)(p.ws + WS_GATES) + (size_t)row * 8;
                *(f32x4*)G = (f32x4){ga[0] + bif[0], ga[1] + bif[1], ga[2] + bif[2], ga[3] + bif[3]}; *(f32x4*)(G + 4) = (f32x4){ga[4] + bif[4], ga[5] + bif[5], ga[6] + bif[6], ga[7] + bif[7]}; }
        }
    }
    __syncthreads();
}

__device__ __forceinline__ float scan_add(float v, int lane) {
#pragma unroll
    for (int o = 1; o < 64; o <<= 1) { const float t = shup(v, o); if (lane >= o) v += t; }
    return v;
}
__device__ __forceinline__ float scan_max(float v, int lane) {
#pragma unroll
    for (int o = 1; o < 64; o <<= 1) { const float t = shup(v, o); if (lane >= o) v = fmaxf(v, t); }
    return v;
}
constexpr float KSCALE = 0.08838834764831845f;

__device__ __forceinline__ void head_out(const Params& p, int i, int h, int row, int lane, float hv0, float hv1, unsigned zo, f32x2 on) {
    const float ss = wave_sum(hv0 * hv0 + hv1 * hv1);
    const float rstd = rsqrtf(ss * (1.f / 128.f) + EPS);
    unsigned* CAT = (unsigned*)((bf16*)(p.ws + WS_CAT) + (size_t)row * DM + h * 128);
    CAT[lane] = pk2(hv0 * rstd * on.x * sigmoidf_(bflo(zo)), hv1 * rstd * on.y * sigmoidf_(bfhi(zo)));
}
__device__ __forceinline__ void mlstm_local(const Params& p, int i, int item, unsigned char* smem) {
    const int tid = otid(), lane = tid & 63, wave = tid >> 6, fr = lane & 15, fq = lane >> 4;
    const int b = item >> 9, h = (item >> 7) & 3, c = item & 127, r0 = b * SEQL + c * 64;
    float* ws_l = (float*)smem;
    bf16* kT = (bf16*)(smem + 1024);
    bf16* vT = kT + 128 * 72;
    const float* G = (const float*)(p.ws + WS_GATES);
    const bf16* Z = (const bf16*)(p.ws + WS_ZU);
    if (wave == 0) {
        const float ig = G[(size_t)(r0 + lane) * 8 + h], lf = logsigmoidf(G[(size_t)(r0 + lane) * 8 + 4 + h]);
        const float bs = scan_add(lf, lane), bL = shi(bs, 63);
        const float a = bL - bs + ig, amax = wave_max(a);
        ws_l[lane] = __expf(a - amax);
        if (lane == 0) { float* CS = (float*)(p.ws + WS_CS); CS[item * 2] = bL; CS[item * 2 + 1] = amax; }
    }
    __syncthreads();
    { u32x4 wv[4];
#pragma unroll
      for (int it = 0; it < 4; ++it) { const int q = tid + it * NTHR, which = q >> 10, idx = q & 1023, s = idx & 63, ch = idx >> 6; wv[it] = *(const u32x4*)(Z + (size_t)(r0 + s) * ZW + (which ? 1024 : 512) + h * 128 + ch * 8); }
#pragma unroll
      for (int it = 0; it < 4; ++it) { const int q = tid + it * NTHR, which = q >> 10, idx = q & 1023, s = idx & 63, ch = idx >> 6; const u32x4 w = wv[it];
        bf16* dst = (which ? vT : kT) + (ch * 8) * 72 + s;
        if (which) {
            dst[0 * 72] = (bf16)(w.x & 0xffff); dst[1 * 72] = (bf16)(w.x >> 16); dst[2 * 72] = (bf16)(w.y & 0xffff); dst[3 * 72] = (bf16)(w.y >> 16);
            dst[4 * 72] = (bf16)(w.z & 0xffff); dst[5 * 72] = (bf16)(w.z >> 16); dst[6 * 72] = (bf16)(w.w & 0xffff); dst[7 * 72] = (bf16)(w.w >> 16);
        } else { const float sc = ws_l[s] * KSCALE;
            dst[0 * 72] = (bf16)f2bf(bflo(w.x) * sc); dst[1 * 72] = (bf16)f2bf(bfhi(w.x) * sc); dst[2 * 72] = (bf16)f2bf(bflo(w.y) * sc); dst[3 * 72] = (bf16)f2bf(bfhi(w.y) * sc);
            dst[4 * 72] = (bf16)f2bf(bflo(w.z) * sc); dst[5 * 72] = (bf16)f2bf(bfhi(w.z) * sc); dst[6 * 72] = (bf16)f2bf(bflo(w.w) * sc); dst[7 * 72] = (bf16)f2bf(bfhi(w.w) * sc); } } }
    __syncthreads();
    f32x4 acc[8];
#pragma unroll
    for (int mt = 0; mt < 8; ++mt) acc[mt] = (f32x4){0.f, 0.f, 0.f, 0.f};
#pragma unroll
    for (int ks = 0; ks < 2; ++ks) { const bf16x8 B = *(const bf16x8*)(vT + (16 * wave + fr) * 72 + 32 * ks + 8 * fq);
#pragma unroll
        for (int mt = 0; mt < 8; ++mt) { const bf16x8 A = *(const bf16x8*)(kT + (16 * mt + fr) * 72 + 32 * ks + 8 * fq); acc[mt] = __builtin_amdgcn_mfma_f32_16x16x32_bf16(A, B, acc[mt], 0, 0, 0); } }
    bf16* dCt = (bf16*)(p.ws + WS_DCT) + (size_t)item * 16384;
#pragma unroll
    for (int mt = 0; mt < 8; ++mt) *(u32x2*)(dCt + (16 * wave + fr) * 128 + 16 * mt + 4 * fq) = (u32x2){pk2_sw(acc[mt][0], acc[mt][1]), pk2_sw(acc[mt][2], acc[mt][3])};
    if (tid < 128) { float s = 0.f;
        for (int t = 0; t < 64; ++t) s += bf2f(kT[tid * 72 + t]);
        ((float*)(p.ws + WS_DN))[item * 128 + tid] = s; }
    __syncthreads();
}

__device__ __forceinline__ void mlstm_scan(const Params& p, int i) {
    const float* CS = (const float*)(p.ws + WS_CS); const bf16* dCt = (const bf16*)(p.ws + WS_DCT); const float* DN = (const float*)(p.ws + WS_DN);
    bf16* CSt = (bf16*)(p.ws + WS_CST); float* NS = (float*)(p.ws + WS_NS); float* MS = (float*)(p.ws + WS_MS);
    for (int idx = obid() * NTHR + otid(); idx < 8 * 16384; idx += gridDim.x * NTHR) {
        const int bh = idx >> 14, e = idx & 16383;
        float C = 0.f, m = 0.f, nacc = 0.f;
        float dv[16], dnv[16], dv2[16], dnv2[16];
#define SC_LD(D, DNV, c0_) do { _Pragma("unroll") for (int k_ = 0; k_ < 16; ++k_) { D[k_] = bf2f(dCt[(size_t)(bh * 128 + (c0_) + k_) * 16384 + e]); DNV[k_] = (e < 128) ? DN[(bh * 128 + (c0_) + k_) * 128 + e] : 0.f; } } while (0)
#define SC_RUN(D, DNV, c0_) do { _Pragma("unroll") for (int k_ = 0; k_ < 16; ++k_) { const int item = bh * 128 + (c0_) + k_; const float bL = CS[item * 2], amax = CS[item * 2 + 1]; \
                CSt[(size_t)item * 16384 + e] = (bf16)f2bf(C); if (e < 128) NS[item * 128 + e] = nacc; if (e == 0) MS[item] = m; \
                const float mn = fmaxf(bL + m, amax), f1 = __expf(bL + m - mn), f2 = __expf(amax - mn); C = f1 * C + f2 * D[k_]; nacc = f1 * nacc + f2 * DNV[k_]; m = mn; } } while (0)
        SC_LD(dv, dnv, 0);
        for (int c0 = 0; c0 < 128; c0 += 32) {
            SC_LD(dv2, dnv2, c0 + 16);
            SC_RUN(dv, dnv, c0);
            if (c0 + 32 < 128) SC_LD(dv, dnv, c0 + 32);
            SC_RUN(dv2, dnv2, c0 + 16);
        }
#undef SC_LD
#undef SC_RUN
        const int b = bh >> 2, h = bh & 3; const size_t sidx = (size_t)((i * 2 + b) * 4 + h);
        p.out[O_PC + sidx * 16384 + (size_t)(e & 127) * 128 + (e >> 7)] = C;
        if (e < 128) p.out[O_PN + sidx * 128 + e] = nacc;
        if (e == 0) p.out[O_PM + sidx] = m;
    }
}

__device__ __forceinline__ void mlstm_out(const Params& p, int i, int item, unsigned char* smem) {
    const int tid = otid(), lane = tid & 63, wave = tid >> 6, fr = lane & 15, fq = lane >> 4;
    const int b = item >> 9, h = (item >> 7) & 3, c = item & 127, r0 = b * SEQL + c * 64;
    float* d_l = (float*)smem;
    float* M_l = d_l + 64;
    float* wg_l = d_l + 128;
    float* mt_l = d_l + 192;
    float* den_l = d_l + 256;
    float* rs_l = d_l + 320;
    float* qn_l = d_l + 448;
    bf16* q_l = (bf16*)(smem + 2048);
    bf16* k_l = q_l + 64 * 136;
    bf16* vT = k_l + 64 * 136;
    bf16* Sw = vT + 128 * 72;
    float* hbuf = (float*)(Sw + 64 * 72);
    const float* G = (const float*)(p.ws + WS_GATES);
    const bf16* Z = (const bf16*)(p.ws + WS_ZU);
    bf16x8 Bc[4];
    { const bf16* cp = (const bf16*)(p.ws + WS_CST) + (size_t)item * 16384 + (16 * wave + fr) * 128 + 8 * fq;
#pragma unroll
      for (int ks = 0; ks < 4; ++ks) Bc[ks] = *(const bf16x8*)(cp + 32 * ks); }
    if (wave == 0) {
        const float ig = G[(size_t)(r0 + lane) * 8 + h], lf = logsigmoidf(G[(size_t)(r0 + lane) * 8 + 4 + h]);
        const float bs = scan_add(lf, lane), d = ig - bs, gmax = scan_max(d, lane);
        const float mc = ((const float*)(p.ws + WS_MS))[item];
        const float Mt = fmaxf(mc, gmax);
        d_l[lane] = d; M_l[lane] = Mt; wg_l[lane] = __expf(mc - Mt); mt_l[lane] = bs + Mt;
    }
    { u32x4 wv[6];
#pragma unroll
      for (int it = 0; it < 6; ++it) { const int q = tid + it * NTHR, which = q >> 10, idx = q & 1023, s = (which == 2) ? (idx & 63) : (idx >> 4), ch = (which == 2) ? (idx >> 6) : (idx & 15); wv[it] = *(const u32x4*)(Z + (size_t)(r0 + s) * ZW + which * 512 + h * 128 + ch * 8); }
#pragma unroll
      for (int it = 0; it < 6; ++it) { const int q = tid + it * NTHR, which = q >> 10, idx = q & 1023, s = (which == 2) ? (idx & 63) : (idx >> 4), ch = (which == 2) ? (idx >> 6) : (idx & 15); const u32x4 w = wv[it];
        if (which == 0) *(u32x4*)(q_l + s * 136 + ch * 8) = w;
        else if (which == 1) { u32x4 o; o.x = pk2(bflo(w.x) * KSCALE, bfhi(w.x) * KSCALE); o.y = pk2(bflo(w.y) * KSCALE, bfhi(w.y) * KSCALE);
            o.z = pk2(bflo(w.z) * KSCALE, bfhi(w.z) * KSCALE); o.w = pk2(bflo(w.w) * KSCALE, bfhi(w.w) * KSCALE); *(u32x4*)(k_l + s * 136 + ch * 8) = o; }
        else { bf16* dst = vT + (ch * 8) * 72 + s;
            dst[0 * 72] = (bf16)(w.x & 0xffff); dst[1 * 72] = (bf16)(w.x >> 16); dst[2 * 72] = (bf16)(w.y & 0xffff); dst[3 * 72] = (bf16)(w.y >> 16);
            dst[4 * 72] = (bf16)(w.z & 0xffff); dst[5 * 72] = (bf16)(w.z >> 16); dst[6 * 72] = (bf16)(w.w & 0xffff); dst[7 * 72] = (bf16)(w.w >> 16); } } }
    __syncthreads();
    {
        const int mt = wave >> 1, nt0 = 2 * (wave & 1);
        f32x4 a2[2] = {(f32x4){0.f, 0.f, 0.f, 0.f}, (f32x4){0.f, 0.f, 0.f, 0.f}};
#pragma unroll
        for (int ks = 0; ks < 4; ++ks) { const bf16x8 A = *(const bf16x8*)(q_l + (16 * mt + fr) * 136 + 32 * ks + 8 * fq);
#pragma unroll
            for (int n = 0; n < 2; ++n) { const bf16x8 B = *(const bf16x8*)(k_l + (16 * (nt0 + n) + fr) * 136 + 32 * ks + 8 * fq); a2[n] = __builtin_amdgcn_mfma_f32_16x16x32_bf16(A, B, a2[n], 0, 0, 0); } }
        float rsum[4] = {0.f, 0.f, 0.f, 0.f};
#pragma unroll
        for (int n = 0; n < 2; ++n) { const int s = 16 * (nt0 + n) + fr; const float ds = d_l[s];
#pragma unroll
            for (int j = 0; j < 4; ++j) { const int t = 16 * mt + 4 * fq + j; const float wv = (s <= t) ? __expf(ds - M_l[t]) : 0.f; const float val = a2[n][j] * wv; rsum[j] += val; Sw[t * 72 + s] = (bf16)f2bf(val); } }
#pragma unroll
        for (int j = 0; j < 4; ++j) { float v = rsum[j]; v += shx(v, 1); v += shx(v, 2); v += shx(v, 4); v += shx(v, 8); if (fr == 0) rs_l[(wave & 1) * 64 + 16 * mt + 4 * fq + j] = v; }
        { const int t = tid >> 3, part = tid & 7; const float* NS = (const float*)(p.ws + WS_NS) + item * 128 + part * 16;
          const u32x4 qa = *(const u32x4*)(q_l + t * 136 + part * 16), qb = *(const u32x4*)(q_l + t * 136 + part * 16 + 8);
          const f32x4 n0 = *(const f32x4*)NS, n1 = *(const f32x4*)(NS + 4), n2 = *(const f32x4*)(NS + 8), n3 = *(const f32x4*)(NS + 12);
          float v = bflo(qa.x) * n0.x + bfhi(qa.x) * n0.y + bflo(qa.y) * n0.z + bfhi(qa.y) * n0.w + bflo(qa.z) * n1.x + bfhi(qa.z) * n1.y + bflo(qa.w) * n1.z + bfhi(qa.w) * n1.w
                  + bflo(qb.x) * n2.x + bfhi(qb.x) * n2.y + bflo(qb.y) * n2.z + bfhi(qb.y) * n2.w + bflo(qb.z) * n3.x + bfhi(qb.z) * n3.y + bflo(qb.w) * n3.z + bfhi(qb.w) * n3.w;
          v += shx(v, 1); v += shx(v, 2); v += shx(v, 4); if (part == 0) qn_l[t] = v; }
    }
    __syncthreads();
    if (tid < 64) { const int t = tid; const float den = wg_l[t] * qn_l[t] + (rs_l[t] + rs_l[64 + t]); den_l[t] = __builtin_amdgcn_rcpf(fmaxf(fabsf(den), __expf(-mt_l[t]))); }
    f32x4 acc[4];
#pragma unroll
    for (int mt = 0; mt < 4; ++mt) acc[mt] = (f32x4){0.f, 0.f, 0.f, 0.f};
#pragma unroll
    for (int ks = 0; ks < 4; ++ks) { const bf16x8 B = Bc[ks];
#pragma unroll
        for (int mt = 0; mt < 4; ++mt) { const bf16x8 A = *(const bf16x8*)(q_l + (16 * mt + fr) * 136 + 32 * ks + 8 * fq); acc[mt] = __builtin_amdgcn_mfma_f32_16x16x32_bf16(A, B, acc[mt], 0, 0, 0); } }
#pragma unroll
    for (int mt = 0; mt < 4; ++mt)
#pragma unroll
        for (int j = 0; j < 4; ++j) acc[mt][j] *= wg_l[16 * mt + 4 * fq + j];
#pragma unroll
    for (int ks = 0; ks < 2; ++ks) { const bf16x8 B = *(const bf16x8*)(vT + (16 * wave + fr) * 72 + 32 * ks + 8 * fq);
#pragma unroll
        for (int mt = 0; mt < 4; ++mt) { const bf16x8 A = *(const bf16x8*)(Sw + (16 * mt + fr) * 72 + 32 * ks + 8 * fq); acc[mt] = __builtin_amdgcn_mfma_f32_16x16x32_bf16(A, B, acc[mt], 0, 0, 0); } }
    __syncthreads();
#pragma unroll
    for (int mt = 0; mt < 4; ++mt)
#pragma unroll
        for (int j = 0; j < 4; ++j) { const int t = 16 * mt + 4 * fq + j; hbuf[t * 132 + 16 * wave + fr] = acc[mt][j] * den_l[t]; }
    __syncthreads();
    { unsigned zo[8]; const f32x2 on = *(const f32x2*)(p.in[17] + i * 512 + h * 128 + 2 * lane);
#pragma unroll
      for (int tt = 0; tt < 8; ++tt) zo[tt] = *(const unsigned*)(Z + (size_t)(r0 + 8 * wave + tt) * ZW + 1536 + h * 128 + 2 * lane);
#pragma unroll
      for (int tt = 0; tt < 8; ++tt) { const int t = 8 * wave + tt; const f32x2 hv = *(const f32x2*)(hbuf + t * 132 + 2 * lane); head_out(p, i, h, r0 + t, lane, hv.x, hv.y, zo[tt], on); } }
    __syncthreads();
}

__device__ __forceinline__ void mlstm_out2(const Params& p, int i, int itA, int itB, unsigned char* smem) {
    const int tid = otid(), lane = tid & 63, wave = tid >> 6, fr = lane & 15, fq = lane >> 4, hh = wave >> 2, wl = wave & 3, tl = tid & 255;
    const int item_ = hh ? itB : itA; const bool active = item_ < 1024; const int item = active ? item_ : 0;
    const int b = item >> 9, h = (item >> 7) & 3, c = item & 127, r0 = b * SEQL + c * 64;
    unsigned char* sb = smem + hh * 65536;
    float* d_l = (float*)sb;
    float* M_l = d_l + 64;
    float* wg_l = d_l + 128;
    float* mt_l = d_l + 192;
    float* den_l = d_l + 256;
    float* rs_l = d_l + 320;
    float* qn_l = d_l + 384;
    bf16* q_l = (bf16*)(sb + 2048);
    bf16* k_l = q_l + 64 * 136;
    float* hbuf = (float*)(sb + 2048);
    bf16* vT = k_l + 64 * 136;
    bf16* Sw = vT + 128 * 72;
    const float* G = (const float*)(p.ws + WS_GATES);
    const bf16* Z = (const bf16*)(p.ws + WS_ZU);
    bf16x8 Bc[2][4];
#pragma unroll
    for (int n = 0; n < 2; ++n) { const bf16* cp = (const bf16*)(p.ws + WS_CST) + (size_t)item * 16384 + (16 * (2 * wl + n) + fr) * 128 + 8 * fq;
#pragma unroll
        for (int ks = 0; ks < 4; ++ks) Bc[n][ks] = *(const bf16x8*)(cp + 32 * ks); }
    if (wl == 0) {
        const float ig = G[(size_t)(r0 + lane) * 8 + h], lf = logsigmoidf(G[(size_t)(r0 + lane) * 8 + 4 + h]);
        const float bs = scan_add(lf, lane), d = ig - bs, gmax = scan_max(d, lane);
        const float mc = ((const float*)(p.ws + WS_MS))[item];
        const float Mt = fmaxf(mc, gmax);
        d_l[lane] = d; M_l[lane] = Mt; wg_l[lane] = __expf(mc - Mt); mt_l[lane] = bs + Mt;
    }
    { u32x4 wv[12];
#pragma unroll
      for (int it = 0; it < 12; ++it) { const int q = tl + it * 256, which = q >> 10, idx = q & 1023, s = (which == 2) ? (idx & 63) : (idx >> 4), ch = (which == 2) ? (idx >> 6) : (idx & 15); wv[it] = *(const u32x4*)(Z + (size_t)(r0 + s) * ZW + which * 512 + h * 128 + ch * 8); }
#pragma unroll
      for (int it = 0; it < 12; ++it) { const int q = tl + it * 256, which = q >> 10, idx = q & 1023, s = (which == 2) ? (idx & 63) : (idx >> 4), ch = (which == 2) ? (idx >> 6) : (idx & 15); const u32x4 w = wv[it];
        if (which == 0) *(u32x4*)(q_l + s * 136 + ch * 8) = w;
        else if (which == 1) { u32x4 o; o.x = pk2(bflo(w.x) * KSCALE, bfhi(w.x) * KSCALE); o.y = pk2(bflo(w.y) * KSCALE, bfhi(w.y) * KSCALE);
            o.z = pk2(bflo(w.z) * KSCALE, bfhi(w.z) * KSCALE); o.w = pk2(bflo(w.w) * KSCALE, bfhi(w.w) * KSCALE); *(u32x4*)(k_l + s * 136 + ch * 8) = o; }
        else { bf16* dst = vT + (ch * 8) * 72 + s;
            dst[0 * 72] = (bf16)(w.x & 0xffff); dst[1 * 72] = (bf16)(w.x >> 16); dst[2 * 72] = (bf16)(w.y & 0xffff); dst[3 * 72] = (bf16)(w.y >> 16);
            dst[4 * 72] = (bf16)(w.z & 0xffff); dst[5 * 72] = (bf16)(w.z >> 16); dst[6 * 72] = (bf16)(w.w & 0xffff); dst[7 * 72] = (bf16)(w.w >> 16); } } }
    __syncthreads();
    {
        const int mt = wl;
        f32x4 a4[4];
#pragma unroll
        for (int n = 0; n < 4; ++n) a4[n] = (f32x4){0.f, 0.f, 0.f, 0.f};
#pragma unroll
        for (int ks = 0; ks < 4; ++ks) { const bf16x8 A = *(const bf16x8*)(q_l + (16 * mt + fr) * 136 + 32 * ks + 8 * fq);
#pragma unroll
            for (int n = 0; n < 4; ++n) if (n <= mt) { const bf16x8 B = *(const bf16x8*)(k_l + (16 * n + fr) * 136 + 32 * ks + 8 * fq); a4[n] = __builtin_amdgcn_mfma_f32_16x16x32_bf16(A, B, a4[n], 0, 0, 0); } }
        float rsum[4] = {0.f, 0.f, 0.f, 0.f};
#pragma unroll
        for (int n = 0; n < 4; ++n) { const int s = 16 * n + fr; const float ds = d_l[s];
#pragma unroll
            for (int j = 0; j < 4; ++j) { const int t = 16 * mt + 4 * fq + j; const float wv = (s <= t) ? __expf(ds - M_l[t]) : 0.f; const float val = a4[n][j] * wv; rsum[j] += val; Sw[t * 72 + s] = (bf16)f2bf(val); } }
#pragma unroll
        for (int j = 0; j < 4; ++j) { float v = rsum[j]; v += shx(v, 1); v += shx(v, 2); v += shx(v, 4); v += shx(v, 8); if (fr == 0) rs_l[16 * mt + 4 * fq + j] = v; }
        { const int t = tl >> 2, part = tl & 3; const float* NS = (const float*)(p.ws + WS_NS) + item * 128 + part * 32; float v = 0.f;
#pragma unroll
          for (int g = 0; g < 4; ++g) { const u32x4 qa = *(const u32x4*)(q_l + t * 136 + part * 32 + 8 * g); const f32x4 n0 = *(const f32x4*)(NS + 8 * g), n1 = *(const f32x4*)(NS + 8 * g + 4);
              v += bflo(qa.x) * n0.x + bfhi(qa.x) * n0.y + bflo(qa.y) * n0.z + bfhi(qa.y) * n0.w + bflo(qa.z) * n1.x + bfhi(qa.z) * n1.y + bflo(qa.w) * n1.z + bfhi(qa.w) * n1.w; }
          v += shx(v, 1); v += shx(v, 2); if (part == 0) qn_l[t] = v; }
    }
    __syncthreads();
    if (tl < 64) { const int t = tl; const float den = wg_l[t] * qn_l[t] + rs_l[t]; den_l[t] = __builtin_amdgcn_rcpf(fmaxf(fabsf(den), __expf(-mt_l[t]))); }
    f32x4 acc[2][4];
#pragma unroll
    for (int n = 0; n < 2; ++n)
#pragma unroll
        for (int mt = 0; mt < 4; ++mt) acc[n][mt] = (f32x4){0.f, 0.f, 0.f, 0.f};
#pragma unroll
    for (int ks = 0; ks < 4; ++ks)
#pragma unroll
        for (int mt = 0; mt < 4; ++mt) { const bf16x8 A = *(const bf16x8*)(q_l + (16 * mt + fr) * 136 + 32 * ks + 8 * fq);
#pragma unroll
            for (int n = 0; n < 2; ++n) acc[n][mt] = __builtin_amdgcn_mfma_f32_16x16x32_bf16(A, Bc[n][ks], acc[n][mt], 0, 0, 0); }
#pragma unroll
    for (int mt = 0; mt < 4; ++mt)
#pragma unroll
        for (int j = 0; j < 4; ++j) { const float wgv = wg_l[16 * mt + 4 * fq + j]; acc[0][mt][j] *= wgv; acc[1][mt][j] *= wgv; }
#pragma unroll
    for (int ks = 0; ks < 2; ++ks)
#pragma unroll
        for (int mt = 0; mt < 4; ++mt) { const bf16x8 A = *(const bf16x8*)(Sw + (16 * mt + fr) * 72 + 32 * ks + 8 * fq);
#pragma unroll
            for (int n = 0; n < 2; ++n) { const bf16x8 B = *(const bf16x8*)(vT + (16 * (2 * wl + n) + fr) * 72 + 32 * ks + 8 * fq); acc[n][mt] = __builtin_amdgcn_mfma_f32_16x16x32_bf16(A, B, acc[n][mt], 0, 0, 0); } }
    __syncthreads();
#pragma unroll
    for (int n = 0; n < 2; ++n)
#pragma unroll
        for (int mt = 0; mt < 4; ++mt)
#pragma unroll
            for (int j = 0; j < 4; ++j) { const int t = 16 * mt + 4 * fq + j; hbuf[t * 132 + 16 * (2 * wl + n) + fr] = acc[n][mt][j] * den_l[t]; }
    __syncthreads();
    { unsigned zo[16]; const f32x2 on = *(const f32x2*)(p.in[17] + i * 512 + h * 128 + 2 * lane);
#pragma unroll
      for (int tt = 0; tt < 16; ++tt) zo[tt] = *(const unsigned*)(Z + (size_t)(r0 + 16 * wl + tt) * ZW + 1536 + h * 128 + 2 * lane);
#pragma unroll
      for (int tt = 0; tt < 16; ++tt) { const int t = 16 * wl + tt; const f32x2 hv = *(const f32x2*)(hbuf + t * 132 + 2 * lane);
          const float ss = wave_sum(hv.x * hv.x + hv.y * hv.y); const float rstd = rsqrtf(ss * (1.f / 128.f) + EPS);
          if (active) { unsigned* CAT = (unsigned*)((bf16*)(p.ws + WS_CAT) + (size_t)(r0 + t) * DM + h * 128);
              CAT[lane] = pk2(hv.x * rstd * on.x * sigmoidf_(bflo(zo[tt])), hv.y * rstd * on.y * sigmoidf_(bfhi(zo[tt]))); } } }
    __syncthreads();
}

__device__ __forceinline__ void mlstm_sample(const Params& p, int i, int item, unsigned char* smem) {
    const int tid = otid(), lane = tid & 63, wave = tid >> 6;
    const int s = item >> 2, h = item & 3, r0 = RP + 8 * s;
    float* qq = (float*)smem;
    float* kk = qq + 1024;
    float* vv = kk + 1024;
    float* qT = vv + 1024;
    float* kwT = qT + 1024;
    float* part = kwT + 1024;
    float* S_l = part + 4096;
    float* sc = S_l + 64;
    const bf16* Z = (const bf16*)(p.ws + WS_ZU);
    const float* G = (const float*)(p.ws + WS_GATES);
    const size_t sidx = (size_t)((i * 128 + s) * 4 + h);
    const float* n0 = p.in[5] + sidx * 128;
    { bf16 zv[6];
#pragma unroll
      for (int it = 0; it < 6; ++it) { const int q = tid + it * NTHR, which = q >> 10, t = (q >> 7) & 7, d = q & 127; zv[it] = Z[(size_t)(r0 + t) * ZW + which * 512 + h * 128 + d]; }
#pragma unroll
      for (int it = 0; it < 6; ++it) { const int q = tid + it * NTHR, which = q >> 10; float v = bf2f(zv[it]); if (which == 1) v *= KSCALE; qq[q] = v; } }
    if (wave == 0) {
        const int t = lane & 7;
        const float ig = G[(size_t)(r0 + t) * 8 + h], lf = logsigmoidf(G[(size_t)(r0 + t) * 8 + 4 + h]);
        float bs = 0.f;
        for (int u = 0; u < 8; ++u) { const float x = shi(lf, u); if (u <= t) bs += x; }
        const float d = ig - bs; float gmax = -INFINITY;
        for (int u = 0; u < 8; ++u) { const float x = shi(d, u); if (u <= t) gmax = fmaxf(gmax, x); }
        const float m0 = p.in[6][sidx];
        const float Mt = fmaxf(m0, gmax), bL = shi(bs, 7), a = bL - bs + ig;
        float amax = -INFINITY;
        for (int u = 0; u < 8; ++u) amax = fmaxf(amax, shi(a, u));
        const float mnew = fmaxf(bL + m0, amax);
        if (lane < 8) { sc[t] = d; sc[8 + t] = Mt; sc[16 + t] = __expf(m0 - Mt); sc[24 + t] = bs + Mt; sc[32 + t] = __expf(a - mnew); }
        if (lane == 0) { sc[56] = __expf(bL + m0 - mnew); sc[57] = mnew; }
    }
    __syncthreads();
    { const int pr = tid >> 3, part = tid & 7, t = pr >> 3, u = pr & 7; float dot = 0.f;
#pragma unroll
        for (int d = 0; d < 16; ++d) dot += qq[t * 128 + part * 16 + d] * kk[u * 128 + part * 16 + d];
        dot += shx(dot, 1); dot += shx(dot, 2); dot += shx(dot, 4);
        if (part == 0) S_l[pr] = (u <= t) ? dot * __expf(sc[u] - sc[8 + t]) : 0.f; }
    if (tid < 64) { const int t = tid >> 3, part = tid & 7; float dot = 0.f;
#pragma unroll
        for (int d = 0; d < 16; ++d) dot += qq[t * 128 + part * 16 + d] * n0[part * 16 + d];
        dot += shx(dot, 1); dot += shx(dot, 2); dot += shx(dot, 4);
        if (part == 0) sc[40 + t] = dot; }
    for (int idx = tid; idx < 1024; idx += NTHR) { const int dk = idx >> 3, t = idx & 7; qT[idx] = qq[t * 128 + dk]; kwT[idx] = kk[t * 128 + dk] * sc[32 + t]; }
    __syncthreads();
    if (tid < 8) { float rs = 0.f; for (int u = 0; u < 8; ++u) rs += S_l[tid * 8 + u];
        const float den = sc[16 + tid] * sc[40 + tid] + rs; sc[48 + tid] = fmaxf(fabsf(den), __expf(-sc[24 + tid])); }
    {
        const int e = tid & 127, g = tid >> 7; const float wc = sc[56];
        float vr[8], acc[8];
#pragma unroll
        for (int u = 0; u < 8; ++u) { vr[u] = vv[u * 128 + e]; acc[u] = 0.f; }
        const float* Cin = p.in[4] + sidx * 16384; float* Cout = p.out + O_SC + sidx * 16384;
        float cin[32];
#pragma unroll
        for (int k = 0; k < 32; ++k) cin[k] = Cin[(g * 32 + k) * 128 + e];
#pragma unroll
        for (int k = 0; k < 32; ++k) { const int dk = g * 32 + k; const float cv = cin[k];
            const f32x4 q0 = *(const f32x4*)(qT + dk * 8), q1 = *(const f32x4*)(qT + dk * 8 + 4), k0 = *(const f32x4*)(kwT + dk * 8), k1 = *(const f32x4*)(kwT + dk * 8 + 4);
            acc[0] += q0.x * cv; acc[1] += q0.y * cv; acc[2] += q0.z * cv; acc[3] += q0.w * cv; acc[4] += q1.x * cv; acc[5] += q1.y * cv; acc[6] += q1.z * cv; acc[7] += q1.w * cv;
            float cn = wc * cv;
            cn += k0.x * vr[0] + k0.y * vr[1] + k0.z * vr[2] + k0.w * vr[3] + k1.x * vr[4] + k1.y * vr[5] + k1.z * vr[6] + k1.w * vr[7];
            Cout[dk * 128 + e] = cn; }
#pragma unroll
        for (int u = 0; u < 8; ++u) part[(g * 8 + u) * 128 + e] = acc[u];
        if (tid < 128) { float nn = wc * n0[tid];
#pragma unroll
            for (int u = 0; u < 8; ++u) nn += kwT[tid * 8 + u];
            p.out[O_SN + sidx * 128 + tid] = nn; }
        if (tid == 0) p.out[O_SM + sidx] = sc[57];
    }
    __syncthreads();
    {
        const int t = wave; float hv[2];
        const unsigned zo = *(const unsigned*)(Z + (size_t)(r0 + t) * ZW + 1536 + h * 128 + 2 * lane); const f32x2 on = *(const f32x2*)(p.in[17] + i * 512 + h * 128 + 2 * lane);
#pragma unroll
        for (int k = 0; k < 2; ++k) { const int e = 2 * lane + k;
            float num = (part[(0 * 8 + t) * 128 + e] + part[(1 * 8 + t) * 128 + e]) + (part[(2 * 8 + t) * 128 + e] + part[(3 * 8 + t) * 128 + e]);
            num *= sc[16 + t];
#pragma unroll
            for (int u = 0; u < 8; ++u) num += S_l[t * 8 + u] * vv[u * 128 + e];
            hv[k] = num / sc[48 + t]; }
        head_out(p, i, h, r0 + t, lane, hv[0], hv[1], zo, on);
    }
    __syncthreads();
}

__device__ __forceinline__ void shortconv(const Params& p, int i) {
    const bf16* Z = (const bf16*)(p.ws + WS_ZU); bf16* CAT = (bf16*)(p.ws + WS_CAT);
    const float* cw = p.in[18] + i * 3 * 512;
    for (int idx = obid() * NTHR + otid(); idx < R * 64; idx += gridDim.x * NTHR) {
        const int row = idx >> 6, ch = (idx & 63) * 8;
        const bool prm = row < RP; const int t = prm ? (row & (SEQL - 1)) : ((row - RP) & 7), S = prm ? SEQL : 8, sq = prm ? (row >> 13) : ((row - RP) >> 3);
        float pr[3][8];
#pragma unroll
        for (int j = 0; j < 3; ++j) { const int tt = t - 2 + j;
            if (tt >= 0) { const bf16* zr = Z + (size_t)(row - 2 + j) * ZW; const u32x4 a = *(const u32x4*)(zr + 2560 + ch), b = *(const u32x4*)(zr + 3072 + ch);
                pr[j][0] = bflo(a.x) * bflo(b.x); pr[j][1] = bfhi(a.x) * bfhi(b.x); pr[j][2] = bflo(a.y) * bflo(b.y); pr[j][3] = bfhi(a.y) * bfhi(b.y);
                pr[j][4] = bflo(a.z) * bflo(b.z); pr[j][5] = bfhi(a.z) * bfhi(b.z); pr[j][6] = bflo(a.w) * bflo(b.w); pr[j][7] = bfhi(a.w) * bfhi(b.w); }
            else if (!prm) { const float* st = p.in[7] + ((size_t)(i * 128 + sq) * 2 + (2 + tt)) * 512 + ch; const f32x4 a = *(const f32x4*)st, b = *(const f32x4*)(st + 4);
                pr[j][0] = a.x; pr[j][1] = a.y; pr[j][2] = a.z; pr[j][3] = a.w; pr[j][4] = b.x; pr[j][5] = b.y; pr[j][6] = b.z; pr[j][7] = b.w; }
            else {
#pragma unroll
                for (int e = 0; e < 8; ++e) pr[j][e] = 0.f; } }
        const u32x4 zb = *(const u32x4*)(Z + (size_t)row * ZW + 2048 + ch);
        float zbf[8] = {bflo(zb.x), bfhi(zb.x), bflo(zb.y), bfhi(zb.y), bflo(zb.z), bfhi(zb.z), bflo(zb.w), bfhi(zb.w)};
        float o[8];
#pragma unroll
        for (int e = 0; e < 8; ++e) o[e] = zbf[e] * (cw[ch + e] * pr[0][e] + cw[512 + ch + e] * pr[1][e] + cw[1024 + ch + e] * pr[2][e]);
        *(u32x4*)(CAT + (size_t)row * DM + 512 + ch) = (u32x4){pk2(o[0], o[1]), pk2(o[2], o[3]), pk2(o[4], o[5]), pk2(o[6], o[7])};
        if (t >= S - 2) { float* dst = p.out + (prm ? O_PSC + ((size_t)(i * 2 + sq) * 2 + (t - (S - 2))) * 512 : O_SSC + ((size_t)(i * 128 + sq) * 2 + (t - (S - 2))) * 512) + ch;
            *(f32x4*)dst = (f32x4){pr[2][0], pr[2][1], pr[2][2], pr[2][3]}; *(f32x4*)(dst + 4) = (f32x4){pr[2][4], pr[2][5], pr[2][6], pr[2][7]}; }
    }
}

__device__ __forceinline__ void unpack8(const u32x4 w, float (&v)[8]) { v[0] = bflo(w.x); v[1] = bfhi(w.x); v[2] = bflo(w.y); v[3] = bfhi(w.y); v[4] = bflo(w.z); v[5] = bfhi(w.z); v[6] = bflo(w.w); v[7] = bfhi(w.w); }
__device__ __forceinline__ void ld8f(const float* s, float (&v)[8]) { const f32x4 a = *(const f32x4*)s, b = *(const f32x4*)(s + 4); v[0] = a.x; v[1] = a.y; v[2] = a.z; v[3] = a.w; v[4] = b.x; v[5] = b.y; v[6] = b.z; v[7] = b.w; }
__device__ __forceinline__ void st8f(float* d, const float (&v)[8]) { *(f32x4*)d = (f32x4){v[0], v[1], v[2], v[3]}; *(f32x4*)(d + 4) = (f32x4){v[4], v[5], v[6], v[7]}; }

__device__ __forceinline__ void cache_shift(const Params& p, int jl, int bsel, int nsel) {
    const int tid = otid();
    for (int idx = bsel * NTHR + tid; idx < 2 * 128 * 7680; idx += nsel * NTHR) { const int kv = idx / (128 * 7680), r = idx - kv * (128 * 7680), s = r / 7680, q = r - s * 7680;
        const float* src = (kv ? p.in[9] : p.in[8]) + ((size_t)(jl * 128 + s) * 128 + 8) * 256 + 4 * q; float* dst = p.out + (kv ? O_SWV : O_SWK) + ((size_t)(jl * 128 + s) * 128) * 256 + 4 * q;
        *(f32x4*)dst = *(const f32x4*)src; }
}

template <int NH>
__device__ __forceinline__ void attn_wave(const bf16* K_l, const bf16* Vt_l, int ldvt, int kt0, const bf16x8 (*Bq)[2], int qidx, int kmin, const float* sinkp, bf16* orow, bool store, int fr, int fq) {
    f32x4 s[NH][9];
    float sk[NH], mx[NH];
#pragma unroll
    for (int h = 0; h < NH; ++h) { sk[h] = sinkp[h] * 1.4426950408889634f; mx[h] = sk[h]; }
#pragma unroll
    for (int kt = 0; kt < 9; ++kt) {
        const bf16x8 A0 = *(const bf16x8*)(K_l + (16 * (kt0 + kt) + fr) * 72 + 8 * fq), A1 = *(const bf16x8*)(K_l + (16 * (kt0 + kt) + fr) * 72 + 32 + 8 * fq);
#pragma unroll
        for (int h = 0; h < NH; ++h) { f32x4 a = (f32x4){0.f, 0.f, 0.f, 0.f};
            a = __builtin_amdgcn_mfma_f32_16x16x32_bf16(A0, Bq[h][0], a, 0, 0, 0); a = __builtin_amdgcn_mfma_f32_16x16x32_bf16(A1, Bq[h][1], a, 0, 0, 0);
#pragma unroll
            for (int j = 0; j < 4; ++j) { const int kidx = 16 * (kt0 + kt) + 4 * fq + j;
                const bool valid = (kt == 0) ? ((kidx > qidx - 128) && (kidx >= kmin)) : (kt == 8) ? (kidx <= qidx) : (kidx >= kmin);
                a[j] = valid ? a[j] * 0.18033688011112042f : -INFINITY; mx[h] = fmaxf(mx[h], a[j]); }
            s[h][kt] = a; } }
    float inv[NH];
#pragma unroll
    for (int h = 0; h < NH; ++h) { mx[h] = fmaxf(mx[h], shx(mx[h], 16)); mx[h] = fmaxf(mx[h], shx(mx[h], 32)); }
#pragma unroll
    for (int h = 0; h < NH; ++h) { float sum = 0.f;
#pragma unroll
        for (int kt = 0; kt < 9; ++kt)
#pragma unroll
            for (int j = 0; j < 4; ++j) { const float e = __builtin_amdgcn_exp2f(s[h][kt][j] - mx[h]); s[h][kt][j] = e; sum += e; }
        inv[h] = sum; }
#pragma unroll
    for (int h = 0; h < NH; ++h) { float sum = inv[h]; sum += shx(sum, 16); sum += shx(sum, 32); inv[h] = __builtin_amdgcn_rcpf(sum + __builtin_amdgcn_exp2f(sk[h] - mx[h])); }
    bf16x8 Bp[NH][5];
#pragma unroll
    for (int h = 0; h < NH; ++h)
#pragma unroll
        for (int pp = 0; pp < 5; ++pp) { u32x4 w; w.x = pk2(s[h][2 * pp][0], s[h][2 * pp][1]); w.y = pk2(s[h][2 * pp][2], s[h][2 * pp][3]);
            if (pp < 4) { w.z = pk2(s[h][2 * pp + 1][0], s[h][2 * pp + 1][1]); w.w = pk2(s[h][2 * pp + 1][2], s[h][2 * pp + 1][3]); } else { w.z = 0u; w.w = 0u; }
            Bp[h][pp] = __builtin_bit_cast(bf16x8, w); }
#pragma unroll
    for (int dt = 0; dt < 4; ++dt) { f32x4 a[NH];
#pragma unroll
        for (int h = 0; h < NH; ++h) a[h] = (f32x4){0.f, 0.f, 0.f, 0.f};
#pragma unroll
        for (int pp = 0; pp < 5; ++pp) { const bf16* vp = Vt_l + (16 * dt + fr) * ldvt + 16 * (kt0 + 2 * pp) + 4 * fq;
            const u32x2 lo = *(const u32x2*)vp, hi = *(const u32x2*)(vp + 16); const bf16x8 V = __builtin_bit_cast(bf16x8, (u32x4){lo.x, lo.y, hi.x, hi.y});
#pragma unroll
            for (int h = 0; h < NH; ++h) a[h] = __builtin_amdgcn_mfma_f32_16x16x32_bf16(V, Bp[h][pp], a[h], 0, 0, 0); }
        if (store) {
#pragma unroll
            for (int h = 0; h < NH; ++h) *(u32x2*)(orow + 64 * h + 16 * dt + 4 * fq) = (u32x2){pk2(a[h][0] * inv[h], a[h][1] * inv[h]), pk2(a[h][2] * inv[h], a[h][3] * inv[h])}; } }
}

__device__ __forceinline__ void attn_phase(const Params& p, int jl, unsigned char* smem) {
    const bf16* Z = (const bf16*)(p.ws + WS_ZU); bf16* CAT = (bf16*)(p.ws + WS_CAT);
    const float* sinkp = p.in[23] + jl * 16;
    for (int u = obid(); u < 768; u += gridDim.x) { const int tidu = otid(), lane = tidu & 63, wave = tidu >> 6, fr = lane & 15, fq = lane >> 4;
        if (u < 512) {
            const int b = u >> 8, kvh = (u >> 6) & 3, qb = u & 63, q0 = qb * 128, rb = b * SEQL;
            bf16x8 Bq[4][2];
            { const bf16* qp = Z + (size_t)(rb + q0 + 16 * wave + fr) * QKVW + kvh * 256 + 8 * fq;
#pragma unroll
              for (int hq = 0; hq < 4; ++hq) { Bq[hq][0] = *(const bf16x8*)(qp + hq * 64); Bq[hq][1] = *(const bf16x8*)(qp + hq * 64 + 32); } }
            bf16* K_l = (bf16*)smem;
            bf16* Vt_l = K_l + 256 * 72;
            { u32x4 wv[8];
#pragma unroll
              for (int it = 0; it < 8; ++it) { const int q = tidu + it * NTHR, which = q >> 11, idx = q & 2047, kidx = which ? (idx & 255) : (idx >> 3), ch = which ? (idx >> 8) : (idx & 7); const int pos = q0 - 128 + kidx;
                wv[it] = (u32x4){0u, 0u, 0u, 0u};
                if (pos >= 0) wv[it] = *(const u32x4*)(Z + (size_t)(rb + pos) * QKVW + (which ? 1280 : 1024) + kvh * 64 + ch * 8); }
#pragma unroll
              for (int it = 0; it < 8; ++it) { const int q = tidu + it * NTHR, which = q >> 11, idx = q & 2047, kidx = which ? (idx & 255) : (idx >> 3), ch = which ? (idx >> 8) : (idx & 7); const u32x4 w = wv[it];
                if (!which) *(u32x4*)(K_l + kidx * 72 + ch * 8) = w;
                else { bf16* dst = Vt_l + (ch * 8) * 296 + kidx;
                    dst[0 * 296] = (bf16)(w.x & 0xffff); dst[1 * 296] = (bf16)(w.x >> 16); dst[2 * 296] = (bf16)(w.y & 0xffff); dst[3 * 296] = (bf16)(w.y >> 16);
                    dst[4 * 296] = (bf16)(w.z & 0xffff); dst[5 * 296] = (bf16)(w.z >> 16); dst[6 * 296] = (bf16)(w.w & 0xffff); dst[7 * 296] = (bf16)(w.w >> 16); } } }
            for (int q = tidu; q < 64 * 32; q += NTHR) Vt_l[(q >> 5) * 296 + 256 + (q & 31)] = 0;
            __syncthreads();
            const int row = rb + q0 + 16 * wave + fr;
#pragma unroll
            for (int hg = 0; hg < 2; ++hg) { const int h = kvh * 4 + 2 * hg;
                attn_wave<2>(K_l, Vt_l, 296, wave, Bq + 2 * hg, 128 + 16 * wave + fr, qb == 0 ? 128 : 0, sinkp + h, CAT + (size_t)row * DM + h * 64, true, fr, fq); }
            __syncthreads();
        } else {
            const int us = u - 512, s = us >> 1, kvp = us & 1;
            bf16x8 Bq1[2];
            { const bf16* qp = Z + (size_t)(RP + 8 * s + (fr & 7)) * QKVW + (8 * kvp + wave) * 64 + 8 * fq; Bq1[0] = *(const bf16x8*)qp; Bq1[1] = *(const bf16x8*)(qp + 32); }
            bf16* K_l = (bf16*)smem;
            bf16* Vt_l = K_l + 2 * 144 * 72;
            { f32x4 va[9], vb[9];
              const float* ck = p.in[8] + ((size_t)(jl * 128 + s) * 128) * 256; const float* cv = p.in[9] + ((size_t)(jl * 128 + s) * 128) * 256;
#pragma unroll
              for (int it = 0; it < 9; ++it) { const int q = tidu + it * NTHR, which = q / 2304, r = q - which * 2304, kvl = r / 1152, r2 = r - kvl * 1152, kidx = which ? (r2 % 144) : (r2 >> 3), ch = which ? (r2 / 144) : (r2 & 7); const int kvh = 2 * kvp + kvl;
                va[it] = (f32x4){0.f, 0.f, 0.f, 0.f}; vb[it] = va[it];
                if (kidx < 128) { const float* src = (which ? cv : ck) + (size_t)kidx * 256 + kvh * 64 + ch * 8; va[it] = *(const f32x4*)src; vb[it] = *(const f32x4*)(src + 4); }
                else if (kidx < 136) { const u32x4 w = *(const u32x4*)(Z + (size_t)(RP + 8 * s + kidx - 128) * QKVW + (which ? 1280 : 1024) + kvh * 64 + ch * 8);
                    va[it] = (f32x4){bflo(w.x), bfhi(w.x), bflo(w.y), bfhi(w.y)}; vb[it] = (f32x4){bflo(w.z), bfhi(w.z), bflo(w.w), bfhi(w.w)}; } }
#pragma unroll
              for (int it = 0; it < 9; ++it) { const int q = tidu + it * NTHR, which = q / 2304, r = q - which * 2304, kvl = r / 1152, r2 = r - kvl * 1152, kidx = which ? (r2 % 144) : (r2 >> 3), ch = which ? (r2 / 144) : (r2 & 7);
                const f32x4 a = va[it], c = vb[it];
                if (!which) *(u32x4*)(K_l + (kvl * 144 + kidx) * 72 + ch * 8) = (u32x4){pk2(a[0], a[1]), pk2(a[2], a[3]), pk2(c[0], c[1]), pk2(c[2], c[3])};
                else { bf16* dst = Vt_l + (kvl * 64 + ch * 8) * 168 + kidx; const unsigned p0 = pk2(a[0], a[1]), p1 = pk2(a[2], a[3]), p2 = pk2(c[0], c[1]), p3 = pk2(c[2], c[3]);
                    dst[0 * 168] = (bf16)(p0 & 0xffff); dst[1 * 168] = (bf16)(p0 >> 16); dst[2 * 168] = (bf16)(p1 & 0xffff); dst[3 * 168] = (bf16)(p1 >> 16);
                    dst[4 * 168] = (bf16)(p2 & 0xffff); dst[5 * 168] = (bf16)(p2 >> 16); dst[6 * 168] = (bf16)(p3 & 0xffff); dst[7 * 168] = (bf16)(p3 >> 16); } } }
            for (int q = tidu; q < 2 * 64 * 16; q += NTHR) Vt_l[(q >> 4) * 168 + 144 + (q & 15)] = 0;
            __syncthreads();
            const int kvl = wave >> 2, h = 8 * kvp + wave, row = RP + 8 * s + (fr & 7);
            attn_wave<1>(K_l + kvl * 144 * 72, Vt_l + kvl * 64 * 168, 168, 0, &Bq1, 128 + (fr & 7), 0, sinkp + h, CAT + (size_t)row * DM + h * 64, fr < 8, fr, fq);
            __syncthreads();
        }
    }
}

__device__ __forceinline__ void ffnfix_phase(const Params& p, int l) {
    const bf16* UB = (const bf16*)(p.ws + WS_UB); bf16* ACT = (bf16*)(p.ws + WS_ACT);
    const float* cw = p.in[26] + (size_t)l * 3 * FF2;
    for (int idx = obid() * NTHR + otid(); idx < 256 * 352; idx += gridDim.x * NTHR) {
        const int hr = idx / 352, cc = idx - hr * 352, col = cc * 8, hh = hr >> 1, rr = hr & 1;
        const bool seqstart = (hh & 63) == 0;
        const bf16* own0 = UB + (size_t)(hh * 4 + 0) * FF2; const bf16* own1 = UB + (size_t)(hh * 4 + 1) * FF2;
        const bf16* pm2 = UB + (size_t)((hh - 1) * 4 + 2) * FF2; const bf16* pm1 = UB + (size_t)((hh - 1) * 4 + 3) * FF2;
        float g2[8], g1[8], g0[8], a2[8], a1[8], a0[8];
        if (rr == 0) {
            if (seqstart) {
#pragma unroll
                for (int e = 0; e < 8; ++e) { g2[e] = 0.f; g1[e] = 0.f; a2[e] = 0.f; a1[e] = 0.f; } }
            else { unpack8(*(const u32x4*)(pm2 + col), g2); unpack8(*(const u32x4*)(pm2 + FF + col), a2); unpack8(*(const u32x4*)(pm1 + col), g1); unpack8(*(const u32x4*)(pm1 + FF + col), a1); }
            unpack8(*(const u32x4*)(own0 + col), g0); unpack8(*(const u32x4*)(own0 + FF + col), a0);
        } else {
            if (seqstart) {
#pragma unroll
                for (int e = 0; e < 8; ++e) { g2[e] = 0.f; a2[e] = 0.f; } }
            else { unpack8(*(const u32x4*)(pm1 + col), g2); unpack8(*(const u32x4*)(pm1 + FF + col), a2); }
            unpack8(*(const u32x4*)(own0 + col), g1); unpack8(*(const u32x4*)(own0 + FF + col), a1);
            unpack8(*(const u32x4*)(own1 + col), g0); unpack8(*(const u32x4*)(own1 + FF + col), a0);
        }
        float wg[3][8], wa[3][8];
#pragma unroll
        for (int j = 0; j < 3; ++j) { ld8f(cw + j * FF2 + col, wg[j]); ld8f(cw + j * FF2 + FF + col, wa[j]); }
        float o[8];
#pragma unroll
        for (int e = 0; e < 8; ++e) { const float cgv = wg[0][e] * g2[e] + wg[1][e] * g1[e] + wg[2][e] * g0[e], cav = wa[0][e] * a2[e] + wa[1][e] * a1[e] + wa[2][e] * a0[e]; o[e] = cgv * sigmoidf_(cgv) * cav; }
        *(u32x4*)(ACT + (size_t)(hh * 128 + rr) * FF + col) = (u32x4){pk2(o[0], o[1]), pk2(o[2], o[3]), pk2(o[4], o[5]), pk2(o[6], o[7])};
    }
    for (int idx = obid() * NTHR + otid(); idx < 4 * (FF2 / 8); idx += gridDim.x * NTHR) { const int br = idx / (FF2 / 8), c = (idx - br * (FF2 / 8)) * 8, b = br >> 1, r = br & 1;
        float v[8]; unpack8(*(const u32x4*)(UB + (size_t)((64 * b + 63) * 4 + 2 + r) * FF2 + c), v);
        st8f(p.out + O_PFFN + ((size_t)(l * 2 + b) * 2 + r) * FF2 + c, v); }
}

#define XB_TMO      128
#define XB_XCNT(j)  (256  + 64 * (j))
#define XB_XSUB(j)  (1280 + 64 * (j))
#define XB_XGEN(j)  (2304 + 64 * (j))
#define XB_TOP      3328
#define XB_TOPGEN   3392
#define XCD_BAR_WORDS 3456
#define XB_SPIN_CAP (1u << 18)

__device__ __forceinline__ unsigned xb_ld(unsigned* p)              { return __hip_atomic_load(p, __ATOMIC_RELAXED, __HIP_MEMORY_SCOPE_AGENT); }
__device__ __forceinline__ unsigned xb_add(unsigned* p, unsigned v) { return __hip_atomic_fetch_add(p, v, __ATOMIC_RELAXED, __HIP_MEMORY_SCOPE_AGENT); }
__device__ __forceinline__ unsigned xb_xcc_id() { return (unsigned)__builtin_amdgcn_s_getreg((3 << 11) | 20) & 0xFu; }
#define XB_SPIN(cond, bar) do { unsigned _sp = 0; while (cond) { __builtin_amdgcn_s_sleep(1); \
    if ((++_sp & 255u) == 0u) { if (xb_ld(&(bar)[XB_TMO])) break; if (_sp > XB_SPIN_CAP) { atomicAdd(&(bar)[XB_TMO], 1u); break; } } } } while (0)

struct XcdBarrier {
    unsigned* bar; unsigned x;
    volatile LAS unsigned* st;
};

__device__ __forceinline__ XcdBarrier xcd_barrier_post(unsigned* bar, volatile LAS unsigned* st) {
    XcdBarrier b; b.bar = bar; b.x = xb_xcc_id(); b.st = st;
    if (threadIdx.x == 0) (void)xb_add(&bar[XB_XCNT(b.x)], 1u);
    return b;
}
__device__ __forceinline__ void xcd_barrier_complete(unsigned* bar, unsigned x, unsigned& nloc, unsigned& nx) {
    const unsigned G = gridDim.x * gridDim.y * gridDim.z;
    unsigned sum, cnt, mine, sp = 0u;
    for (;;) {
        sum = 0u; cnt = 0u; mine = 0u;
#pragma unroll
        for (unsigned j = 0; j < 16; ++j) { const unsigned c = xb_ld(&bar[XB_XCNT(j)]); sum += c; cnt += (c > 0u) ? 1u : 0u; mine = (j == x) ? c : mine; }
        if (sum == G) break;
        __builtin_amdgcn_s_sleep(1);
        if ((++sp & 255u) == 0u) { if (xb_ld(&bar[XB_TMO])) break; if (sp > XB_SPIN_CAP) { atomicAdd(&bar[XB_TMO], 1u); break; } }
    }
    nloc = mine > 0u ? mine : 1u; nx = cnt > 0u ? cnt : 1u;
}

__device__ __forceinline__ void xcd_barrier(const XcdBarrier& b) {
    asm volatile("s_waitcnt vmcnt(0)" ::: "memory");
    __syncthreads();
    if (threadIdx.x == 0) {
        unsigned* bar = b.bar;
        __builtin_amdgcn_s_waitcnt(0);
        unsigned nloc = b.st[0], nx = b.st[1];
        if (nloc == 0u) { xcd_barrier_complete(bar, b.x, nloc, nx); b.st[0] = nloc; b.st[1] = nx; }
        const unsigned old = xb_add(&bar[XB_XSUB(b.x)], 1u);
        const unsigned gen = old / nloc;
        if (old + 1u == (gen + 1u) * nloc) {
            __builtin_amdgcn_fence(__ATOMIC_RELEASE, "agent");
            asm volatile("s_waitcnt vmcnt(0)" ::: "memory");
            const unsigned og = xb_add(&bar[XB_TOP], 1u);
            const unsigned tg = og / nx;
            if (og + 1u == (tg + 1u) * nx) xb_add(&bar[XB_TOPGEN], 1u);
            else XB_SPIN(xb_ld(&bar[XB_TOPGEN]) == tg, bar);
            __builtin_amdgcn_fence(__ATOMIC_ACQUIRE, "agent");
            xb_add(&bar[XB_XGEN(b.x)], 1u);
            asm volatile("s_waitcnt vmcnt(0)" ::: "memory");
        } else {
            XB_SPIN(xb_ld(&bar[XB_XGEN(b.x)]) == gen, bar);
            __builtin_amdgcn_fence(__ATOMIC_ACQUIRE, "agent");
            asm volatile("s_waitcnt vmcnt(0)" ::: "memory");
        }
    }
    __syncthreads();
}

__global__ void __launch_bounds__(NTHR, 2) mega(Params p) {
    extern __shared__ __attribute__((aligned(16))) unsigned char lds[];
    cg::grid_group grid = cg::this_grid();
    unsigned char* ws = p.ws;
    volatile LAS unsigned* bst = (volatile LAS unsigned*)((LAS unsigned char*)lds + 147392);
    if (threadIdx.x < 2) bst[threadIdx.x] = 0u;
    __syncthreads();
    XcdBarrier bar; bar.bar = (unsigned*)ws; bar.x = 0; bar.st = bst;
    if (p.hi - p.lo > 1) bar = xcd_barrier_post((unsigned*)ws, bst);
    for (int step = p.lo; step < p.hi; ++step) {
        int nrep = 1; bool skip = false;
        if (step == 0) nrep += (PROBE_PRE & 1); else if (step == 1) nrep += (PROBE_PRE >> 1) & 1; else { const int l_ = (step - 2) / 10, st_ = (step - 2) % 10; nrep += (((l_ & 1) ? PROBE_ODD : PROBE_EVEN) >> st_) & 1; }
        for (int rep = 0; rep < nrep; ++rep) {
            if (PROBE_BAR == 2 && rep > 0) xcd_barrier(bar);
        if (step == 0) prologue(p, lds);
        else if (step == 1) {
            pg8::Gemm g{(const pg8::bf16_t*)(ws + WS_AC), (const pg8::bf16_t*)(ws + WS_ZU), 256, MODW, DM}; pg8::StaticOrder S; S.init(256, MODW, gridDim.x, obid());
            EpiMod E{(float*)(ws + WS_MOD), p.in[14]};
            pg8::gemm_phase<EpiMod, pg8::StaticOrder, true, true>((PG8_LAS unsigned char*)lds, g, S, E);
        } else {
            const int l = (step - 2) / 10, st = (step - 2) % 10; const bool even = !(l & 1); const int i = l >> 1;
            if (st == 0) norm_phase(p, l, 1, lds);
            else if (st == 6) norm_phase(p, l, 2, lds);
            else if (st == 1 || st == 5 || st == 7 || st == 9) {
                pg8::Gemm g; EpiMain E; E.X = p.out; E.O = (bf16*)(ws + WS_ZU); E.gate = nullptr; E.ldc = 0; E.mode = 0; E.cw = nullptr; E.stp = nullptr; E.sout = nullptr; E.qn = nullptr; E.kn = nullptr; E.lyr = i; E.wsb = ws;
                if (st == 1) { g.A = (const pg8::bf16_t*)(ws + WS_H); g.M = R; g.K = DM;
                    if (even) { g.Bt = (const pg8::bf16_t*)(ws + WS_WIN) + (size_t)i * ZW * DM; g.N = ZW; E.ldc = ZW; } else { g.Bt = (const pg8::bf16_t*)(ws + WS_WQKV) + (size_t)i * QKVW * DM; g.N = QKVW; E.ldc = QKVW; E.mode = 3;
                        E.qn = p.in[21] + i * 64; E.kn = p.in[22] + i * 64; } }
                else if (st == 5) { g.A = (const pg8::bf16_t*)(ws + WS_CAT); g.M = RP; g.K = DM; g.N = DM; g.Bt = (const pg8::bf16_t*)(ws + (even ? WS_WAO : WS_WCO)) + (size_t)i * DM * DM;
                    E.mode = 1; E.gate = (const float*)(ws + WS_MOD) + l * 6144 + 2048; }
                else if (st == 7) { g.A = (const pg8::bf16_t*)(ws + WS_H); g.M = R; g.K = DM; g.N = FF2; g.Bt = (const pg8::bf16_t*)(ws + WS_WUP) + (size_t)l * FF2 * DM; E.mode = 2;
                    E.cw = p.in[26] + (size_t)l * 3 * FF2; E.stp = p.in[10] + (size_t)l * 128 * 2 * FF2; E.sout = p.out + O_SFFN + (size_t)l * 128 * 2 * FF2; }
                else { g.A = (const pg8::bf16_t*)(ws + WS_ACT); g.M = RP; g.K = FF; g.N = DM; g.Bt = (const pg8::bf16_t*)(ws + WS_WDN) + (size_t)l * DM * FF; E.mode = 1; E.gate = (const float*)(ws + WS_MOD) + l * 6144 + 5120; }
                if (rep > 0 && E.mode == 1) { E.mode = 0; E.O = (bf16*)(ws + WS_H); E.ldc = DM; }
                if (rep > 0 && E.mode == 1) { E.mode = 0; E.O = (bf16*)(ws + WS_H); E.ldc = DM; }
                pg8::StaticOrder S; S.init(g.M, g.N, gridDim.x, obid());
                pg8::gemm_phase<EpiMain, pg8::StaticOrder, true, true>((PG8_LAS unsigned char*)lds, g, S, E);
                if (E.mode == 3 && rep == 0) { const int G_ = gridDim.x, n2 = S.nwg - G_;
                    if (n2 > 0 && n2 < G_) { if (obid() >= n2) cache_shift(p, i, obid() - n2, G_ - n2); } else cache_shift(p, i, obid(), G_); }
                if (E.mode == 1) mini_gemm((const bf16*)g.A, (const bf16*)g.Bt, g.K, p.out, E.gate, lds);
            }
            else if (st == 2) {
                if (even) { const int G_ = gridDim.x; int il = obid(), is = obid();
                    for (int k = 0; il < 1024 || is < 512; ++k) { const bool do_s = (is < 512) && ((k & 1) || il >= 1024);
                        if (do_s) { mlstm_sample(p, i, is, lds); is += G_; } else { mlstm_local(p, i, il, lds); il += G_; } }
                    shortconv(p, i); }
                else { skip = true; continue; }
            }
            else if (st == 3) { if (even) mlstm_scan(p, i); else attn_phase(p, i, lds); }
            else if (st == 4) { if (!even) { skip = true; continue; } for (int it = obid(); it < 1024; it += 2 * gridDim.x) mlstm_out2(p, i, it, it + gridDim.x, lds); }
            else if (st == 8) ffnfix_phase(p, l);
        }
        }
        if (skip) continue;
        if (step + 1 < p.hi) { if (step == 0) grid.sync(); else { xcd_barrier(bar); if (PROBE_BAR == 1) xcd_barrier(bar); } }
    }
}

#ifndef NLAUNCH_MODE
#define NLAUNCH_MODE 1
#endif
extern "C" void kernel_launch(void* const* d_in, const int* in_sizes, int n_in, void* d_out, int out_size, void* d_ws, size_t ws_size, hipStream_t stream) {
    static int grid = 0;
    if (grid == 0) {
        if (n_in != 28 || (size_t)out_size != O_END || ws_size < WS_END) { fprintf(stderr, "kernel_launch: unexpected shapes: n_in %d out %d ws %zu\n", n_in, out_size, ws_size); grid = -1; return; }
        int dev = 0, cus = 0, per_cu = 0;
        hipGetDevice(&dev); hipDeviceGetAttribute(&cus, hipDeviceAttributeMultiprocessorCount, dev);
        if (hipFuncSetAttribute((const void*)mega, hipFuncAttributeMaxDynamicSharedMemorySize, LDS_BYTES) != hipSuccess) { fprintf(stderr, "kernel_launch: hipFuncSetAttribute failed\n"); grid = -1; return; }
        if (hipOccupancyMaxActiveBlocksPerMultiprocessor(&per_cu, (const void*)mega, NTHR, LDS_BYTES) != hipSuccess || per_cu < 1) { fprintf(stderr, "kernel_launch: occupancy query says %d\n", per_cu); per_cu = 1; }
        (void)hipGetLastError();
        grid = cus * 1;
    }
    if (grid < 0) return;
    Params p{};
    for (int k = 0; k < 28; ++k) p.in[k] = (const float*)d_in[k];
    p.out = (float*)d_out; p.ws = (unsigned char*)d_ws;
    const int NSTEPS = 42;
    if (hipMemsetAsync(d_ws, 0, 16384, stream) != hipSuccess) { fprintf(stderr, "memset failed\n"); return; }
#if NLAUNCH_MODE == 1
    p.lo = 0; p.hi = NSTEPS;
    void* args[] = {&p};
    hipError_t e = hipLaunchCooperativeKernel((const void*)mega, dim3(grid), dim3(NTHR), args, LDS_BYTES, stream);
    if (e != hipSuccess) fprintf(stderr, "cooperative launch failed: %s (grid %d)\n", hipGetErrorString(e), grid);
#else
    for (int s = 0; s < NSTEPS; ++s) { if (s >= 2 && ((s - 2) % 10) == 4 && (((s - 2) / 10) & 1)) continue; p.lo = s; p.hi = s + 1; hipLaunchKernelGGL(mega, dim3(grid), dim3(NTHR), LDS_BYTES, stream, p); }
#endif
}
```

```cpp
#include <hip/hip_runtime.h>
#include <hip/hip_cooperative_groups.h>
#include <cstdio>
#include <cstdint>
namespace cg = cooperative_groups;
__device__ __forceinline__ int otid() { int t = threadIdx.x; asm volatile("" : "+v"(t)); return t; }
__device__ __forceinline__ int obid() { int b = blockIdx.x; asm volatile("" : "+s"(b)); return b; }
__device__ __forceinline__ float shx(float v, int o) { const int l = otid() & 63; return __builtin_bit_cast(float, __builtin_amdgcn_ds_bpermute((l ^ o) << 2, __builtin_bit_cast(int, v))); }
__device__ __forceinline__ float shi(float v, int src) { return __builtin_bit_cast(float, __builtin_amdgcn_ds_bpermute(src << 2, __builtin_bit_cast(int, v))); }
__device__ __forceinline__ float shup(float v, int o) { const int l = otid() & 63; const int src = l >= o ? l - o : l; return __builtin_bit_cast(float, __builtin_amdgcn_ds_bpermute(src << 2, __builtin_bit_cast(int, v))); }
namespace pg8 {
#define PG8_LAS __attribute__((address_space(3)))
typedef unsigned short bf16_t;
typedef short bf16x8 __attribute__((ext_vector_type(8)));
typedef float f32x4 __attribute__((ext_vector_type(4)));
typedef unsigned u32x4 __attribute__((ext_vector_type(4)));
constexpr int BM = 256, BK = 64, HALF = 128, HTB = HALF * BK * 2  , STAGE_BYTES = 8 * HTB, NXCD = 8, WGM = 8;

__host__ __device__ __forceinline__ int lds_byte(int r, int c) { const int st = (r >> 4) * 2 + (c >> 5), rr = r & 15, cc = c & 31, ob = rr * 64 + cc * 2; return st * 1024 + (ob ^ (((ob >> 9) & 1) << 5)); }
__host__ __device__ __forceinline__ void stage_rc(int b, int& R, int& C) { const int st = b / 1024, sb = b % 1024, swz = sb ^ (((sb >> 9) & 1) << 5); R = (st >> 1) * 16 + swz / 64; C = (st & 1) * 32 + (swz % 64) / 2; }
__host__ __device__ __forceinline__ int perm32(int rho) { const int n = rho >> 4, i = rho & 15; return 8 * (i >> 2) + 4 * n + (i & 3); }

struct Unit { int pm, pn; };
struct Gemm { const bf16_t* A; const bf16_t* Bt; int M, N, K; };

struct StaticOrder {
    int nM, nN, nwg, G, c;
    __host__ __device__ void init(int M, int N, int G_, int c_) { nM = M / BM; nN = N / BM; nwg = nM * nN; G = G_; c = c_; }
    __host__ __device__ bool next(int i, Unit& u) const {
        const long L = (long)i * G + c; if (L >= nwg) return false;
        int wgid = (int)L; { const int q = nwg / NXCD, r = nwg % NXCD, xcd = wgid % NXCD, off = wgid / NXCD; wgid = (xcd < r ? xcd * (q + 1) : r * (q + 1) + (xcd - r) * q) + off; }
        const int nig = WGM * nN, gid = wgid / nig, fm = gid * WGM, gsz = (nM - fm) < WGM ? (nM - fm) : WGM;
        u.pm = fm + ((wgid % nig) % gsz); u.pn = (wgid % nig) / gsz; return true;
    }
    __device__ __forceinline__ void a_ready(const Unit&) const {}
    __device__ __forceinline__ void done(const Unit&) const {}
};

__device__ __forceinline__ unsigned cvt_pk_bf16(float lo, float hi) { unsigned r; asm volatile("v_cvt_pk_bf16_f32 %0, %1, %2" : "=v"(r) : "v"(lo), "v"(hi)); return r; }
template <class Epi, class Sched, bool ALIGN_EPI = false, bool SP2 = false>
__device__ __forceinline__ void gemm_phase(PG8_LAS unsigned char* lds, const Gemm g, const Sched& S, const Epi& E) {
    const int tid = otid(), wid = __builtin_amdgcn_readfirstlane(tid >> 6), lane = tid & 63, wr = wid >> 2, wc = wid & 3, fr = lane & 15, fq = lane >> 4;
    const int K = g.K, nt = K / BK;
    unsigned voffA[2], voffB[2];
#pragma unroll
    for (int i = 0; i < 2; ++i) { int R, C; stage_rc(tid * 16 + i * 8192, R, C); const int Rb = Epi::PERM ? ((R & ~31) + perm32(R & 31)) : R;
        const int Ra = 8 * (16 * (R >> 6) + (R & 15)) + ((R >> 4) & 3);
        voffA[i] = (unsigned)(Ra * K + C) * 2u; voffB[i] = (unsigned)(Rb * K + C) * 2u; }
    const size_t kstep = (size_t)(BK * 2);
    const size_t hstep = (size_t)HALF * K * 2;
    const size_t hstepA = (size_t)4 * K * 2;
    const size_t tstep = 2 * hstep;
    const unsigned ldsw = (unsigned)wid * 1024u;
    const int aoff = lds_byte(wr * 64 + fr, fq * 8), boff = lds_byte(wc * 32 + fr, fq * 8);
#define PG8_SA(b, h) (((b) * 2 + (h)) * HTB)
#define PG8_SB(b, h) ((4 + (b) * 2 + (h)) * HTB)
#define PG8_STAGE(bufoff, gbase, voff) do { _Pragma("unroll") for (int _i = 0; _i < 2; ++_i) \
        __builtin_amdgcn_global_load_lds((const unsigned*)((const char*)(gbase) + (voff)[_i]), (PG8_LAS unsigned*)(lds + (bufoff) + ldsw + _i * 8192), 16, 0, 0); } while (0)
#define PG8_LDA(dst, b, h) do { _Pragma("unroll") for (int m = 0; m < 4; ++m) _Pragma("unroll") for (int k = 0; k < 2; ++k) dst[m][k] = *(const PG8_LAS bf16x8*)(lds + PG8_SA(b, h) + aoff + m * 2048 + k * 1024); } while (0)
#define PG8_LDB(dst, b, h) do { _Pragma("unroll") for (int n = 0; n < 2; ++n) _Pragma("unroll") for (int k = 0; k < 2; ++k) dst[n][k] = *(const PG8_LAS bf16x8*)(lds + PG8_SB(b, h) + boff + n * 2048 + k * 1024); } while (0)
#define PG8_MMA(ai, bj, At, Bt) do { __builtin_amdgcn_s_setprio(1); _Pragma("unroll") for (int m = 0; m < 4; ++m) _Pragma("unroll") for (int n = 0; n < 2; ++n) _Pragma("unroll") for (int k = 0; k < 2; ++k) \
        acc[ai][bj][m][n] = __builtin_amdgcn_mfma_f32_16x16x32_bf16(Bt[n][k], At[m][k], acc[ai][bj][m][n], 0, 0, 0); __builtin_amdgcn_s_setprio(0); } while (0)
#define PG8_WAIT_V(n) asm volatile("s_waitcnt vmcnt(" #n ")" ::: "memory")
#define PG8_WAIT_L(n) asm volatile("s_waitcnt lgkmcnt(" #n ")" ::: "memory")
#define PG8_BAR __builtin_amdgcn_s_barrier()
#define PG8_SCHED __builtin_amdgcn_sched_barrier(0)
    Unit cur, nxt; int ui = 0;
    if (!S.next(0, cur)) return;
    f32x4 acc[2][2][4][2];
#pragma unroll
    for (int a = 0; a < 2; ++a)
#pragma unroll
        for (int b = 0; b < 2; ++b)
#pragma unroll
            for (int m = 0; m < 4; ++m)
#pragma unroll
                for (int n = 0; n < 2; ++n) acc[a][b][m][n] = (f32x4){0.f, 0.f, 0.f, 0.f};
    bf16x8 At[4][2], B0[2][2], B1[2][2];
    const char* cA = (const char*)g.A + (size_t)cur.pm * tstep; const char* cB = (const char*)g.Bt + (size_t)cur.pn * tstep;
    S.a_ready(cur);
    if constexpr (SP2) {
        PG8_STAGE(PG8_SB(0, 0), cB, voffB); PG8_STAGE(PG8_SB(0, 1), cB + hstep, voffB); PG8_STAGE(PG8_SA(0, 0), cA, voffA); PG8_STAGE(PG8_SA(0, 1), cA + hstepA, voffA);
        if (wr == 1) PG8_BAR;
        PG8_WAIT_V(2); PG8_BAR;
        PG8_STAGE(PG8_SB(1, 0), cB + kstep, voffB); PG8_STAGE(PG8_SA(1, 0), cA + kstep, voffA); PG8_STAGE(PG8_SB(1, 1), cB + hstep + kstep, voffB);
        PG8_WAIT_V(6); PG8_BAR;
    } else {
        PG8_STAGE(PG8_SB(0, 0), cB, voffB); PG8_STAGE(PG8_SA(0, 0), cA, voffA); PG8_STAGE(PG8_SB(0, 1), cB + hstep, voffB); PG8_STAGE(PG8_SA(0, 1), cA + hstepA, voffA);
        if (wr == 1) PG8_BAR;
        PG8_WAIT_V(4); PG8_BAR;
        PG8_STAGE(PG8_SB(1, 0), cB + kstep, voffB); PG8_STAGE(PG8_SA(1, 0), cA + kstep, voffA); PG8_STAGE(PG8_SB(1, 1), cB + hstep + kstep, voffB);
        PG8_WAIT_V(6); PG8_BAR;
    }
    for (;;) {
        const bool has_next = S.next(ui + 1, nxt);
        const char* nA = has_next ? (const char*)g.A + (size_t)nxt.pm * tstep : cA; const char* nB = has_next ? (const char*)g.Bt + (size_t)nxt.pn * tstep : cB;
        for (int t = 0; t < nt; t += 2) {
            const bool last = (t == nt - 2);
            const char* a1 = cA + (size_t)(t + 1) * kstep;
            const char* a2 = last ? nA : cA + (size_t)(t + 2) * kstep; const char* b2 = last ? nB : cB + (size_t)(t + 2) * kstep;
            const char* a3 = a2 + kstep; const char* b3 = b2 + kstep;
            if (last && has_next) S.a_ready(nxt);
            if constexpr (SP2) {
            PG8_LDB(B0, 0, 0); PG8_LDB(B1, 0, 1); PG8_SCHED; PG8_LDA(At, 0, 0); PG8_STAGE(PG8_SA(1, 1), a1 + hstepA, voffA);
            PG8_WAIT_V(8); PG8_WAIT_L(0); PG8_BAR; PG8_MMA(0, 0, At, B0); PG8_MMA(0, 1, At, B1); PG8_BAR; PG8_SCHED;
            PG8_LDA(At, 0, 1); PG8_STAGE(PG8_SB(0, 0), b2, voffB); PG8_STAGE(PG8_SB(0, 1), b2 + hstep, voffB); PG8_STAGE(PG8_SA(0, 0), a2, voffA);
            PG8_WAIT_V(8); PG8_WAIT_L(0); PG8_BAR; PG8_MMA(1, 0, At, B0); PG8_MMA(1, 1, At, B1); PG8_BAR; PG8_SCHED;
            PG8_LDB(B0, 1, 0); PG8_LDB(B1, 1, 1); PG8_SCHED; PG8_LDA(At, 1, 0); PG8_STAGE(PG8_SA(0, 1), a2 + hstepA, voffA);
            PG8_WAIT_V(8); PG8_WAIT_L(0); PG8_BAR; PG8_MMA(0, 0, At, B0); PG8_MMA(0, 1, At, B1); PG8_BAR; PG8_SCHED;
            PG8_LDA(At, 1, 1); PG8_STAGE(PG8_SB(1, 0), b3, voffB); PG8_STAGE(PG8_SB(1, 1), b3 + hstep, voffB); PG8_STAGE(PG8_SA(1, 0), a3, voffA);
            PG8_WAIT_V(8); PG8_WAIT_L(0); PG8_BAR; PG8_MMA(1, 0, At, B0); PG8_MMA(1, 1, At, B1); PG8_BAR; PG8_SCHED;
            } else {
            PG8_LDB(B0, 0, 0); PG8_SCHED; PG8_LDA(At, 0, 0); PG8_STAGE(PG8_SA(1, 1), a1 + hstepA, voffA);
            PG8_WAIT_L(8); PG8_BAR; PG8_WAIT_L(0); PG8_MMA(0, 0, At, B0); PG8_BAR; PG8_SCHED;
            PG8_LDB(B1, 0, 1); PG8_STAGE(PG8_SB(0, 0), b2, voffB);
            PG8_BAR; PG8_WAIT_L(0); PG8_MMA(0, 1, At, B1); PG8_BAR;
            PG8_LDA(At, 0, 1); PG8_STAGE(PG8_SA(0, 0), a2, voffA);
            PG8_BAR; PG8_WAIT_L(0); PG8_MMA(1, 0, At, B0); PG8_BAR; PG8_SCHED;
            PG8_STAGE(PG8_SB(0, 1), b2 + hstep, voffB);
            PG8_WAIT_V(6); PG8_BAR; PG8_MMA(1, 1, At, B1); PG8_BAR;
            PG8_LDB(B0, 1, 0); PG8_SCHED; PG8_LDA(At, 1, 0); PG8_STAGE(PG8_SA(0, 1), a2 + hstepA, voffA);
            PG8_WAIT_L(8); PG8_BAR; PG8_WAIT_L(0); PG8_MMA(0, 0, At, B0); PG8_BAR; PG8_SCHED;
            PG8_LDB(B1, 1, 1); PG8_STAGE(PG8_SB(1, 0), b3, voffB);
            PG8_BAR; PG8_WAIT_L(0); PG8_MMA(0, 1, At, B1); PG8_BAR;
            PG8_LDA(At, 1, 1); PG8_STAGE(PG8_SA(1, 0), a3, voffA);
            PG8_BAR; PG8_WAIT_L(0); PG8_MMA(1, 0, At, B0); PG8_BAR; PG8_SCHED;
            PG8_STAGE(PG8_SB(1, 1), b3 + hstep, voffB);
            PG8_WAIT_V(6); PG8_BAR; PG8_MMA(1, 1, At, B1); PG8_BAR;
            }
        }
        if constexpr (ALIGN_EPI) { if (wr == 0) PG8_BAR; }
        if constexpr (!Epi::AFTER_DRAIN) { E(acc, cur, wr, wc, fr, fq); S.done(cur); }
        if (!has_next) break;
#pragma unroll
        for (int a = 0; a < 2; ++a)
#pragma unroll
            for (int b = 0; b < 2; ++b)
#pragma unroll
                for (int m = 0; m < 4; ++m)
#pragma unroll
                    for (int n = 0; n < 2; ++n) acc[a][b][m][n] = (f32x4){0.f, 0.f, 0.f, 0.f};
        cur = nxt; cA = nA; cB = nB; ++ui;
        if constexpr (ALIGN_EPI) { if (wr == 1) PG8_BAR; }
    }
    PG8_WAIT_V(0);
    if constexpr (!ALIGN_EPI) { if (wr == 0) PG8_BAR; }
    PG8_BAR;
    if constexpr (Epi::AFTER_DRAIN) { E.fused(acc, cur, wr, wc, fr, fq, lds, wid, lane); S.done(cur); }
#undef PG8_SA
#undef PG8_SB
#undef PG8_STAGE
#undef PG8_LDA
#undef PG8_LDB
#undef PG8_MMA
#undef PG8_WAIT_V
#undef PG8_WAIT_L
#undef PG8_BAR
#undef PG8_SCHED
}
}

typedef unsigned short bf16;
typedef float f32x4 __attribute__((ext_vector_type(4)));
typedef float f32x2 __attribute__((ext_vector_type(2)));
typedef unsigned u32x4 __attribute__((ext_vector_type(4)));
typedef unsigned u32x2 __attribute__((ext_vector_type(2)));
typedef short bf16x8 __attribute__((ext_vector_type(8)));

constexpr int R = 17408, RP = 16384, NSEQ = 130, SEQL = 8192;
constexpr int DM = 1024, INA = 3592, ZW = 3584, QKVW = 1536, FF = 2816, FF2 = 5632, MODW = 24576;
constexpr float EPS = 1e-6f;
constexpr int NWAVES = 8, NTHR = 512;
constexpr int LDS_BYTES = 147456;

constexpr size_t O_Y = 0;
constexpr size_t O_PC = (size_t)R * 1024;
constexpr size_t O_PN = O_PC + 262144;
constexpr size_t O_PM = O_PN + 2048;
constexpr size_t O_PSC = O_PM + 16;
constexpr size_t O_PWK = O_PSC + 4096;
constexpr size_t O_PWV = O_PWK + 131072;
constexpr size_t O_PFFN = O_PWV + 131072;
constexpr size_t O_SC = O_PFFN + 90112;
constexpr size_t O_SN = O_SC + 16777216;
constexpr size_t O_SM = O_SN + 131072;
constexpr size_t O_SSC = O_SM + 1024;
constexpr size_t O_SWK = O_SSC + 262144;
constexpr size_t O_SWV = O_SWK + 8388608;
constexpr size_t O_SFFN = O_SWV + 8388608;
constexpr size_t O_END = O_SFFN + 5767168;

constexpr size_t MiB = 1u << 20;
constexpr size_t WS_WIN = 1 * MiB, WS_WAO = 15 * MiB, WS_WQKV = 19 * MiB, WS_WCO = 25 * MiB, WS_WUP = 29 * MiB, WS_WDN = 73 * MiB;
constexpr size_t WS_AC = 95 * MiB, WS_MOD = 96 * MiB, WS_TAB = 109 * MiB, WS_H = 112 * MiB, WS_CAT = 146 * MiB, WS_GATES = 180 * MiB;
constexpr size_t WS_ZU = 181 * MiB;
constexpr size_t WS_ACT = 368 * MiB;
constexpr size_t WS_DCT = WS_ACT, WS_CST = WS_ACT + 64 * MiB, WS_NS = WS_ACT + 96 * MiB, WS_DN = WS_NS + MiB / 2, WS_CS = WS_NS + MiB, WS_MS = WS_CS + 65536;
constexpr size_t WS_UB = 466 * MiB;
constexpr size_t WS_END = 472 * MiB;

__constant__ double ROPE_INV[32] = {1.0, 0.7498942093324559, 0.5623413251903491, 0.4216965034285822, 0.31622776601683794, 0.23713737056616552, 0.1778279410038923, 0.1333521432163324, 0.1, 0.07498942093324558, 0.05623413251903491, 0.042169650342858224, 0.03162277660168379, 0.023713737056616554, 0.01778279410038923, 0.01333521432163324, 0.01, 0.007498942093324558, 0.005623413251903491, 0.004216965034285823, 0.0031622776601683794, 0.0023713737056616554, 0.0017782794100389228, 0.001333521432163324, 0.001, 0.0007498942093324559, 0.0005623413251903491, 0.00042169650342858224, 0.00031622776601683794, 0.00023713737056616554, 0.00017782794100389227, 0.0001333521432163324};
#ifndef PROBE_PRE
#define PROBE_PRE 0
#define PROBE_EVEN 0
#define PROBE_ODD 0
#endif
#ifndef PROBE_BAR
#define PROBE_BAR 0
#endif
struct Params { const float* in[28]; float* out; unsigned char* ws; int lo, hi; };

__device__ __forceinline__ unsigned f2bf(float f) { unsigned u = __builtin_bit_cast(unsigned, f); return (u + 0x7fffu + ((u >> 16) & 1u)) >> 16; }
__device__ __forceinline__ unsigned pk2(float lo, float hi) { unsigned r; asm("v_cvt_pk_bf16_f32 %0, %1, %2" : "=v"(r) : "v"(lo), "v"(hi)); return r; }
__device__ __forceinline__ unsigned pk2_sw(float lo, float hi) { return f2bf(lo) | (f2bf(hi) << 16); }
__device__ __forceinline__ float bf2f(unsigned h) { return __builtin_bit_cast(float, h << 16); }
__device__ __forceinline__ float bflo(unsigned w) { return __builtin_bit_cast(float, w << 16); }
__device__ __forceinline__ float bfhi(unsigned w) { return __builtin_bit_cast(float, w & 0xffff0000u); }
template <int CTRL> __device__ __forceinline__ float dppf(float x) { return __builtin_bit_cast(float, __builtin_amdgcn_mov_dpp(__builtin_bit_cast(int, x), CTRL, 0xF, 0xF, true)); }
__device__ __forceinline__ float rdl(float x, int l) { return __builtin_bit_cast(float, __builtin_amdgcn_readlane(__builtin_bit_cast(int, x), l)); }
__device__ __forceinline__ float wave_sum(float v) {
    v += dppf<0xB1>(v); v += dppf<0x4E>(v); v += dppf<0x141>(v); v += dppf<0x140>(v);
    return (rdl(v, 0) + rdl(v, 16)) + (rdl(v, 32) + rdl(v, 48));
}
__device__ __forceinline__ float wave_max(float v) {
    v = fmaxf(v, dppf<0xB1>(v)); v = fmaxf(v, dppf<0x4E>(v)); v = fmaxf(v, dppf<0x141>(v)); v = fmaxf(v, dppf<0x140>(v));
    return fmaxf(fmaxf(rdl(v, 0), rdl(v, 16)), fmaxf(rdl(v, 32), rdl(v, 48)));
}
__device__ __forceinline__ float logsigmoidf(float f) { return fminf(f, 0.f) - log1pf(__expf(-fabsf(f))); }
__device__ __forceinline__ float sigmoidf_(float x) { return __builtin_amdgcn_rcpf(1.f + __builtin_amdgcn_exp2f(x * -1.4426950408889634f)); }
__device__ __forceinline__ int seq_of(int row) { return row < RP ? (row >> 13) : 2 + ((row - RP) >> 3); }
#define LAS __attribute__((address_space(3)))
#define LDS_WAIT() asm volatile("s_waitcnt lgkmcnt(0)" ::: "memory")

__device__ __forceinline__ float dpp_shr1f(float x) { return __builtin_bit_cast(float, __builtin_amdgcn_mov_dpp(__builtin_bit_cast(int, x), 0x111, 0xF, 0xF, false)); }
__device__ __forceinline__ f32x4 dpp_shr1(const f32x4 v) { f32x4 r; r.x = dpp_shr1f(v.x); r.y = dpp_shr1f(v.y); r.z = dpp_shr1f(v.z); r.w = dpp_shr1f(v.w); return r; }
struct EpiMain {
    static constexpr bool PERM = true, AFTER_DRAIN = false;
    int mode;
    bf16* O; int ldc; float* X; const float* gate;
    const float* qn; const float* kn; int lyr; unsigned char* wsb;
    const float* cw; const float* stp; float* sout;
    __device__ __forceinline__ void operator()(const pg8::f32x4 (&acc)[2][2][4][2], const pg8::Unit& u, int wr, int wc, int fr, int fq) const {
        const int rowb = u.pm * 256 + 8 * (16 * wr + fr), col0 = u.pn * 256 + wc * 32 + 8 * fq;
        if (mode == 0) {
#pragma unroll
            for (int ai = 0; ai < 2; ++ai)
#pragma unroll
                for (int m = 0; m < 4; ++m) { bf16* rowp = O + (size_t)(rowb + 4 * ai + m) * ldc + col0;
#pragma unroll
                    for (int bj = 0; bj < 2; ++bj) { const pg8::f32x4 v0 = acc[ai][bj][m][0], v1 = acc[ai][bj][m][1]; u32x4 w;
                        w.x = pg8::cvt_pk_bf16(v0[0], v0[1]); w.y = pg8::cvt_pk_bf16(v0[2], v0[3]); w.z = pg8::cvt_pk_bf16(v1[0], v1[1]); w.w = pg8::cvt_pk_bf16(v1[2], v1[3]);
                        *(u32x4*)(rowp + bj * 128) = w; } }
        } else if (mode == 1) {
            f32x4 gv[2][2];
            { const float* gp = gate + (size_t)(u.pm >> 5) * MODW + col0;
#pragma unroll
              for (int bj = 0; bj < 2; ++bj)
#pragma unroll
                  for (int n = 0; n < 2; ++n) gv[bj][n] = *(const f32x4*)(gp + bj * 128 + 4 * n); }
#pragma unroll
            for (int am = 0; am < 4; ++am) { const int ai = am >> 1, m0 = (am & 1) * 2;
                f32x4 xv[2][2][2];
#pragma unroll
                for (int mm = 0; mm < 2; ++mm) { const float* xp = X + (size_t)(rowb + 4 * ai + m0 + mm) * DM + col0;
#pragma unroll
                    for (int bj = 0; bj < 2; ++bj)
#pragma unroll
                        for (int n = 0; n < 2; ++n) xv[mm][bj][n] = *(const f32x4*)(xp + bj * 128 + 4 * n); }
#pragma unroll
                for (int mm = 0; mm < 2; ++mm) { float* xp = X + (size_t)(rowb + 4 * ai + m0 + mm) * DM + col0;
#pragma unroll
                    for (int bj = 0; bj < 2; ++bj)
#pragma unroll
                        for (int n = 0; n < 2; ++n) *(f32x4*)(xp + bj * 128 + 4 * n) = xv[mm][bj][n] + gv[bj][n] * acc[ai][bj][m0 + mm][n]; }
            }
        } else if (mode == 3) {
            int fq3 = fq; asm volatile("" : "+v"(fq3));
            const int head = 4 * u.pn + wc; const bool prm = u.pm < 64;
            const f32x2* TAB = (const f32x2*)(wsb + WS_TAB);
            const int sq = prm ? (u.pm >> 5) : ((rowb - RP) >> 3);
            const float* nwp = (head < 16 ? qn : kn) + 8 * fq3;
            f32x4 ca, sa, cb, sb;
            { const int pos0 = prm ? (rowb & (SEQL - 1)) : SEQL; const f32x4* tp = (const f32x4*)(TAB + pos0 * 32 + 8 * fq3); const f32x4 c0 = tp[0], c1 = tp[1], c2 = tp[2], c3 = tp[3];
              ca = (f32x4){c0[0], c0[2], c1[0], c1[2]}; sa = (f32x4){c0[1], c0[3], c1[1], c1[3]}; cb = (f32x4){c2[0], c2[2], c3[0], c3[2]}; sb = (f32x4){c2[1], c2[3], c3[1], c3[3]};
            }
#pragma unroll
            for (int j = 0; j < 8; ++j) { const int row = rowb + j, t = prm ? (row & (SEQL - 1)) : j;
                f32x4 x1a = acc[j >> 2][0][j & 3][0], x1b = acc[j >> 2][0][j & 3][1], x2a = acc[j >> 2][1][j & 3][0], x2b = acc[j >> 2][1][j & 3][1];
                if (head < 20) {
                    float ss = (x1a[0] * x1a[0] + x1a[1] * x1a[1]) + (x1a[2] * x1a[2] + x1a[3] * x1a[3]) + (x1b[0] * x1b[0] + x1b[1] * x1b[1]) + (x1b[2] * x1b[2] + x1b[3] * x1b[3])
                             + (x2a[0] * x2a[0] + x2a[1] * x2a[1]) + (x2a[2] * x2a[2] + x2a[3] * x2a[3]) + (x2b[0] * x2b[0] + x2b[1] * x2b[1]) + (x2b[2] * x2b[2] + x2b[3] * x2b[3]);
                    ss += shx(ss, 16); ss += shx(ss, 32);
                    const float rstd = rsqrtf(ss * (1.f / 64.f) + EPS);
                    const f32x4 y1a = x1a * rstd * *(const f32x4*)nwp, y1b = x1b * rstd * *(const f32x4*)(nwp + 4), y2a = x2a * rstd * *(const f32x4*)(nwp + 32), y2b = x2b * rstd * *(const f32x4*)(nwp + 36);
                    x1a = y1a * ca - y2a * sa; x1b = y1b * cb - y2b * sb; x2a = y2a * ca + y1a * sa; x2b = y2b * cb + y1b * sb;
                }
                bf16* zp = O + (size_t)row * QKVW + head * 64 + 8 * fq3;
                *(u32x4*)zp = (u32x4){pk2(x1a[0], x1a[1]), pk2(x1a[2], x1a[3]), pk2(x1b[0], x1b[1]), pk2(x1b[2], x1b[3])};
                *(u32x4*)(zp + 32) = (u32x4){pk2(x2a[0], x2a[1]), pk2(x2a[2], x2a[3]), pk2(x2b[0], x2b[1]), pk2(x2b[2], x2b[3])};
                if (head >= 16 && (!prm || t >= SEQL - 128)) {
                    float* dst = X + (head < 20 ? (prm ? O_PWK : O_SWK) : (prm ? O_PWV : O_SWV)) + (prm ? ((size_t)(lyr * 2 + sq) * 128 + (t - (SEQL - 128))) * 256 : ((size_t)(lyr * 128 + sq) * 128 + 120 + j) * 256) + ((head - 16) & 3) * 64 + 8 * fq3;
                    *(f32x4*)dst = x1a; *(f32x4*)(dst + 4) = x1b; *(f32x4*)(dst + 32) = x2a; *(f32x4*)(dst + 36) = x2b; }
                if (head < 20) { const f32x4* t1 = (const f32x4*)(TAB + 32 + 8 * fq3); const f32x4 e0 = t1[0], e1 = t1[1], e2 = t1[2], e3 = t1[3];
                    const f32x4 dca = (f32x4){e0[0], e0[2], e1[0], e1[2]}, dsa = (f32x4){e0[1], e0[3], e1[1], e1[3]}, dcb = (f32x4){e2[0], e2[2], e3[0], e3[2]}, dsb = (f32x4){e2[1], e2[3], e3[1], e3[3]};
                    const f32x4 na = ca * dca - sa * dsa, nb = cb * dcb - sb * dsb; sa = sa * dca + ca * dsa; sb = sb * dcb + cb * dsb; ca = na; cb = nb; }
                asm volatile("" ::: "memory");
            }
        } else {
            const bool smp = u.pm >= 64; const int sq = (rowb - RP) >> 3;
            bf16* UB = (bf16*)(wsb + WS_UB); bf16* ACT = (bf16*)(wsb + WS_ACT);
#pragma unroll
            for (int n = 0; n < 2; ++n) {
                const int cf = u.pn * 128 + wc * 32 + 8 * fq + 4 * n;
                const f32x4 wg0 = *(const f32x4*)(cw + cf), wg1 = *(const f32x4*)(cw + FF2 + cf), wg2 = *(const f32x4*)(cw + 2 * FF2 + cf);
                const f32x4 wa0 = *(const f32x4*)(cw + FF + cf), wa1 = *(const f32x4*)(cw + FF2 + FF + cf), wa2 = *(const f32x4*)(cw + 2 * FF2 + FF + cf);
                f32x4 g2, g1, a2, a1;
                if (smp) { const float* st = stp + (size_t)sq * 2 * FF2; g2 = *(const f32x4*)(st + cf); a2 = *(const f32x4*)(st + FF + cf); g1 = *(const f32x4*)(st + FF2 + cf); a1 = *(const f32x4*)(st + FF2 + FF + cf); }
                else { g2 = dpp_shr1(acc[1][0][2][n]); g1 = dpp_shr1(acc[1][0][3][n]); a2 = dpp_shr1(acc[1][1][2][n]); a1 = dpp_shr1(acc[1][1][3][n]); }
#pragma unroll
                for (int j = 0; j < 8; ++j) { const f32x4 G = acc[j >> 2][0][j & 3][n], A = acc[j >> 2][1][j & 3][n];
                    const f32x4 cg = wg0 * g2 + wg1 * g1 + wg2 * G, ca = wa0 * a2 + wa1 * a1 + wa2 * A;
                    if (smp || fr != 0 || j >= 2)
                        *(u32x2*)(ACT + (size_t)(rowb + j) * FF + cf) = (u32x2){pg8::cvt_pk_bf16(cg[0] * sigmoidf_(cg[0]) * ca[0], cg[1] * sigmoidf_(cg[1]) * ca[1]), pg8::cvt_pk_bf16(cg[2] * sigmoidf_(cg[2]) * ca[2], cg[3] * sigmoidf_(cg[3]) * ca[3])};
                    if (smp) { if (j >= 6) { float* d = sout + ((size_t)sq * 2 + (j - 6)) * FF2; *(f32x4*)(d + cf) = G; *(f32x4*)(d + FF + cf) = A; } }
                    else if ((fr == 0 && j < 2) || (fr == 15 && j >= 6)) { bf16* d = UB + ((size_t)(u.pm * 2 + wr) * 4 + (j < 2 ? j : j - 4)) * FF2;
                        *(u32x2*)(d + cf) = (u32x2){pk2(G[0], G[1]), pk2(G[2], G[3])}; *(u32x2*)(d + FF + cf) = (u32x2){pk2(A[0], A[1]), pk2(A[2], A[3])}; }
                    g2 = g1; g1 = G; a2 = a1; a1 = A; }
            }
        }
    }
};
struct EpiMod {
    static constexpr bool PERM = true, AFTER_DRAIN = false;
    float* O; const float* bias;
    __device__ __forceinline__ void operator()(const pg8::f32x4 (&acc)[2][2][4][2], const pg8::Unit& u, int wr, int wc, int fr, int fq) const {
        const int rowb = u.pm * 256 + 8 * (16 * wr + fr), col0 = u.pn * 256 + wc * 32 + 8 * fq;
#pragma unroll
        for (int ai = 0; ai < 2; ++ai)
#pragma unroll
            for (int m = 0; m < 4; ++m) { const int row = rowb + 4 * ai + m;
                if (row < NSEQ) {
#pragma unroll
                    for (int bj = 0; bj < 2; ++bj)
#pragma unroll
                        for (int n = 0; n < 2; ++n) { const f32x4 b = *(const f32x4*)(bias + col0 + bj * 128 + 4 * n);
                            *(f32x4*)(O + (size_t)row * MODW + col0 + bj * 128 + 4 * n) = acc[ai][bj][m][n] + b; } } }
    }
};


__device__ __forceinline__ void mini_gemm(const bf16* A, const bf16* Bt, int K, float* X, const float* gate, unsigned char* smem) {
    const int tid = otid(), lane = tid & 63, wave = tid >> 6, fr = lane & 15, fq = lane >> 4;
    float* part = (float*)smem;
    const int nks = K / 256;
    for (int u = obid(); u < 256; u += gridDim.x) {
        const int rm = u >> 4, cn = u & 15;
        const bf16* Ap = A + (size_t)(RP + 64 * rm + fr) * K + wave * (K / 8) + 8 * fq;
        const bf16* Bp = Bt + (size_t)(64 * cn + fr) * K + wave * (K / 8) + 8 * fq;
        f32x4 acc[4][4];
#pragma unroll
        for (int i = 0; i < 4; ++i)
#pragma unroll
            for (int j = 0; j < 4; ++j) acc[i][j] = (f32x4){0.f, 0.f, 0.f, 0.f};
        bf16x8 a0[4], b0[4], a1[4], b1[4];
#define MG_LD(a, b, ks) do { _Pragma("unroll") for (int i_ = 0; i_ < 4; ++i_) { a[i_] = *(const bf16x8*)(Ap + (size_t)(16 * i_) * K + 32 * (ks)); b[i_] = *(const bf16x8*)(Bp + (size_t)(16 * i_) * K + 32 * (ks)); } } while (0)
#define MG_MMA(a, b) do { _Pragma("unroll") for (int i_ = 0; i_ < 4; ++i_) _Pragma("unroll") for (int j_ = 0; j_ < 4; ++j_) acc[i_][j_] = __builtin_amdgcn_mfma_f32_16x16x32_bf16(b[j_], a[i_], acc[i_][j_], 0, 0, 0); } while (0)
        MG_LD(a0, b0, 0);
        for (int ks = 0; ks < nks; ks += 2) {
            if (ks + 1 < nks) MG_LD(a1, b1, ks + 1);
            MG_MMA(a0, b0);
            if (ks + 2 < nks) MG_LD(a0, b0, ks + 2);
            if (ks + 1 < nks) MG_MMA(a1, b1);
        }
#undef MG_LD
#undef MG_MMA
#pragma unroll
        for (int i = 0; i < 4; ++i)
#pragma unroll
            for (int j = 0; j < 4; ++j) *(f32x4*)(part + (wave * 64 + 16 * i + fr) * 68 + 16 * j + 4 * fq) = acc[i][j];
        __syncthreads();
        {
            const int row = tid >> 3, c0 = (tid & 7) * 8;
            f32x4 s0 = (f32x4){0.f, 0.f, 0.f, 0.f}, s1 = s0;
#pragma unroll
            for (int w = 0; w < 8; ++w) { s0 = s0 + *(const f32x4*)(part + (w * 64 + row) * 68 + c0); s1 = s1 + *(const f32x4*)(part + (w * 64 + row) * 68 + c0 + 4); }
            const int grow = RP + 64 * rm + row, col = 64 * cn + c0; const int sq = 2 + ((grow - RP) >> 3);
            const float* gp = gate + (size_t)sq * MODW + col; float* xp = X + (size_t)grow * DM + col;
            const f32x4 g0 = *(const f32x4*)gp, g1 = *(const f32x4*)(gp + 4);
            *(f32x4*)xp = *(const f32x4*)xp + g0 * s0; *(f32x4*)(xp + 4) = *(const f32x4*)(xp + 4) + g1 * s1;
        }
        __syncthreads();
    }
}
struct TDesc { const float* W; bf16* WT; int ldw, K; };
constexpr int I_IN = 1792, I_AO = 512, I_QKV = 768, I_CO = 512, I_UP = 2816, I_DN = 1408, I_ADA = 3072;
constexpr int TN1 = 2 * I_IN, TN2 = TN1 + 2 * I_AO, TN3 = TN2 + 2 * I_QKV, TN4 = TN3 + 2 * I_CO, TN5 = TN4 + 4 * I_UP, TN6 = TN5 + 4 * I_DN, TN7 = TN6 + 4 * I_ADA;
__device__ __forceinline__ void tdecode(const Params& p, int it, TDesc& d) {
    unsigned char* ws = p.ws; int r = it, ncols; const float* W; bf16* WT; int ldw, K = DM; bool wup = false, wqkv = false;
    if (r < TN1) { const int i = r / I_IN; r -= i * I_IN; W = p.in[15] + (size_t)i * DM * INA; WT = (bf16*)(ws + WS_WIN) + (size_t)i * ZW * DM; ldw = INA;
        if (r < 1024) ncols = 2048; else { W += 2056; WT += (size_t)2048 * DM; r -= 1024; ncols = 1536; } }
    else if (r < TN2) { r -= TN1; const int i = r / I_AO; r -= i * I_AO; W = p.in[19] + (size_t)i * DM * DM; WT = (bf16*)(ws + WS_WAO) + (size_t)i * DM * DM; ldw = DM; ncols = DM; }
    else if (r < TN3) { r -= TN2; const int i = r / I_QKV; r -= i * I_QKV; W = p.in[20] + (size_t)i * DM * QKVW; WT = (bf16*)(ws + WS_WQKV) + (size_t)i * QKVW * DM; ldw = QKVW; ncols = QKVW; wqkv = true; }
    else if (r < TN4) { r -= TN3; const int i = r / I_CO; r -= i * I_CO; W = p.in[24] + (size_t)i * DM * DM; WT = (bf16*)(ws + WS_WCO) + (size_t)i * DM * DM; ldw = DM; ncols = DM; }
    else if (r < TN5) { r -= TN4; const int i = r / I_UP; r -= i * I_UP; W = p.in[25] + (size_t)i * DM * FF2; WT = (bf16*)(ws + WS_WUP) + (size_t)i * FF2 * DM; ldw = FF2; ncols = FF2; wup = true; }
    else if (r < TN6) { r -= TN5; const int i = r / I_DN; r -= i * I_DN; W = p.in[27] + (size_t)i * FF * DM; WT = (bf16*)(ws + WS_WDN) + (size_t)i * DM * FF; ldw = DM; ncols = DM; K = FF; }
    else { r -= TN6; const int i = r / I_ADA; r -= i * I_ADA; W = p.in[13] + (size_t)i * DM * 6144; WT = (bf16*)(ws + WS_ZU) + (size_t)i * 6144 * DM; ldw = 6144; ncols = 6144; }
    const int nblk = ncols / 32, kb = r / nblk, nb = r - kb * nblk;
    int drow = 32 * nb;
    if (wup) drow = (nb < 88) ? 256 * (nb >> 2) + 32 * (nb & 3) : 256 * ((nb - 88) >> 2) + 128 + 32 * ((nb - 88) & 3);
    if (wqkv) { const int head = nb >> 1; drow = 256 * (head >> 2) + 128 * (nb & 1) + 32 * (head & 3); }
    d.W = W + (size_t)(64 * kb) * ldw + 32 * nb; d.WT = WT + (size_t)drow * K + 64 * kb; d.ldw = ldw; d.K = K;
}
__device__ __forceinline__ void tload(const TDesc& d, int lane, float (&v)[32]) {
#pragma unroll
    for (int i = 0; i < 32; ++i) v[i] = d.W[(size_t)(2 * i + (lane >> 5)) * d.ldw + (lane & 31)];
}
__device__ __forceinline__ void tstore(const TDesc& d, int lane, const float (&v)[32], float* scr) {
#pragma unroll
    for (int i = 0; i < 32; ++i) scr[(2 * i + (lane >> 5)) * 33 + (lane & 31)] = v[i];
    LDS_WAIT();
    const int c = lane & 7;
#pragma unroll
    for (int j = 0; j < 4; ++j) { const int n = (lane >> 3) + 8 * j; const float* s = scr + (8 * c) * 33 + n;
        u32x4 o; o.x = pk2(s[0 * 33], s[1 * 33]); o.y = pk2(s[2 * 33], s[3 * 33]); o.z = pk2(s[4 * 33], s[5 * 33]); o.w = pk2(s[6 * 33], s[7 * 33]);
        *(u32x4*)(d.WT + (size_t)n * d.K + 8 * c) = o; }
    LDS_WAIT();
}

__device__ __forceinline__ void prologue(const Params& p, unsigned char* smem) {
    const int tid = otid(), lane = tid & 63, wave = tid >> 6;
    const int gw = obid() * NWAVES + wave, NGW = gridDim.x * NWAVES;
    float* scr = (float*)(smem + wave * 16384);
    unsigned char* ws = p.ws;
    {
        float va[32], vb[32]; TDesc da, db;
        int it = gw;
        if (it < TN7) { tdecode(p, it, da); tload(da, lane, va); }
        while (it < TN7) {
            int nx = it + NGW;
            if (nx < TN7) { tdecode(p, nx, db); tload(db, lane, vb); }
            tstore(da, lane, va, scr);
            it = nx; nx = it + NGW;
            if (it >= TN7) break;
            if (nx < TN7) { tdecode(p, nx, da); tload(da, lane, va); }
            tstore(db, lane, vb, scr);
            it = nx;
        }
    }
    const int gt = obid() * NTHR + tid, NT = gridDim.x * NTHR;
    bf16* Ac = (bf16*)(ws + WS_AC);
    for (int idx = gt; idx < 256 * DM; idx += NT) { const int row = idx >> 10, col = idx & 1023; float v = 0.f;
        if (row < 2) v = p.in[2][row * DM + col]; else if (row < NSEQ) v = p.in[3][(row - 2) * DM + col];
        Ac[idx] = (bf16)f2bf(v * sigmoidf_(v)); }
    f32x2* TAB = (f32x2*)(ws + WS_TAB);
    for (int idx = gt; idx < 8200 * 32; idx += NT) { const int pos = idx >> 5, i = idx & 31;
        const double ang = (double)pos * ROPE_INV[i];
        const double n = rint(ang * 0.6366197723675814); double r = fma(-n, 1.5707963267948966, ang); r = fma(-n, 6.123233995736766e-17, r); const double r2 = r * r;
        const double sn = r * (1.0 + r2 * (-1.0 / 6 + r2 * (1.0 / 120 + r2 * (-1.0 / 5040 + r2 * (1.0 / 362880 + r2 * (-1.0 / 39916800 + r2 * (1.0 / 6227020800.0)))))));
        const double cn = 1.0 + r2 * (-0.5 + r2 * (1.0 / 24 + r2 * (-1.0 / 720 + r2 * (1.0 / 40320 + r2 * (-1.0 / 3628800 + r2 * (1.0 / 479001600.0 + r2 * (-1.0 / 87178291200.0)))))));
        const int qd = ((int)n) & 3; const double c = (qd == 0) ? cn : (qd == 1) ? -sn : (qd == 2) ? -cn : sn, s = (qd == 0) ? sn : (qd == 1) ? cn : (qd == 2) ? -sn : -cn;
        TAB[idx] = (f32x2){(float)c, (float)s}; }
}

__device__ __forceinline__ void norm_phase(const Params& p, int l, int which, unsigned char* smem) {
    const int tid = otid(), lane = tid & 63, wave = tid >> 6;
    const int gw = obid() * NWAVES + wave, NGW = gridDim.x * NWAVES;
    const bool do_gates = (which == 1) && !(l & 1);
    const bool first = (which == 1) && (l == 0);
    float* X = p.out;
    const float* MOD = (const float*)(p.ws + WS_MOD);
    bf16* H = (bf16*)(p.ws + WS_H);
    float* gwl = (float*)smem;
    if (do_gates) {
        const float* W = p.in[15] + (size_t)(l >> 1) * DM * INA + 2048;
        for (int idx = tid; idx < 8192; idx += NTHR) gwl[idx] = W[(size_t)(idx >> 3) * INA + (idx & 7)];
        __syncthreads();
    }
    const float* nw = (which == 1 ? p.in[11] : p.in[12]) + l * DM;
    const int off_sh = l * 6144 + (which == 1 ? 0 : 3072), off_sc = off_sh + 1024;
    f32x4 nwv[4];
#pragma unroll
    for (int j = 0; j < 4; ++j) nwv[j] = *(const f32x4*)(nw + 4 * lane + 256 * j);
    f32x4 vn[4], vn2[4];
#define NORM_SRC(r_) (first ? ((r_) < RP ? p.in[0] + (size_t)(r_) * DM : p.in[1] + (size_t)((r_) - RP) * DM) : X + (size_t)(r_) * DM)
    { const int row = gw; if (row < R) { const float* src = NORM_SRC(row);
#pragma unroll
        for (int j = 0; j < 4; ++j) vn[j] = *(const f32x4*)(src + 4 * lane + 256 * j); }
      const int row2 = gw + NGW; if (row2 < R) { const float* src = NORM_SRC(row2);
#pragma unroll
        for (int j = 0; j < 4; ++j) vn2[j] = *(const f32x4*)(src + 4 * lane + 256 * j); } }
    int cur_sq = -1; f32x4 mulv[4], shv[4];
    for (int row = gw; row < R; row += NGW) {
        const int sq = seq_of(row);
        if (sq != cur_sq) { cur_sq = sq; const float* mrow_ = MOD + (size_t)sq * MODW;
#pragma unroll
            for (int j = 0; j < 4; ++j) { const f32x4 sc = *(const f32x4*)(mrow_ + off_sc + 4 * lane + 256 * j); shv[j] = *(const f32x4*)(mrow_ + off_sh + 4 * lane + 256 * j); mulv[j] = nwv[j] * (sc + 1.f); } }
        f32x4 v[4]; float ss = 0.f;
#pragma unroll
        for (int j = 0; j < 4; ++j) { v[j] = vn[j]; vn[j] = vn2[j]; }
        { const int nrow = row + 2 * NGW; if (nrow < R) { const float* src = NORM_SRC(nrow);
#pragma unroll
            for (int j = 0; j < 4; ++j) vn2[j] = *(const f32x4*)(src + 4 * lane + 256 * j); } }
#pragma unroll
        for (int j = 0; j < 4; ++j) ss += (v[j].x * v[j].x + v[j].y * v[j].y) + (v[j].z * v[j].z + v[j].w * v[j].w);
        if (first) {
#pragma unroll
            for (int j = 0; j < 4; ++j) *(f32x4*)(X + (size_t)row * DM + 4 * lane + 256 * j) = v[j];
        }
        const float rstd = rsqrtf(wave_sum(ss) * (1.f / DM) + EPS);
        float ga[8];
#pragma unroll
        for (int g = 0; g < 8; ++g) ga[g] = 0.f;
#pragma unroll
        for (int j = 0; j < 4; ++j) {
            f32x4 h = v[j] * rstd * mulv[j] + shv[j];
            *(u32x2*)(H + (size_t)row * DM + 4 * lane + 256 * j) = (u32x2){pk2(h.x, h.y), pk2(h.z, h.w)};
            if (do_gates) {
#pragma unroll
                for (int e = 0; e < 4; ++e) { const float* wp = gwl + (4 * lane + 256 * j + e) * 8; const f32x4 w0 = *(const f32x4*)wp, w1 = *(const f32x4*)(wp + 4); const float hv = h[e];
                    ga[0] += hv * w0.x; ga[1] += hv * w0.y; ga[2] += hv * w0.z; ga[3] += hv * w0.w; ga[4] += hv * w1.x; ga[5] += hv * w1.y; ga[6] += hv * w1.z; ga[7] += hv * w1.w; }
            }
        }
        if (do_gates) {
            const float* bif = p.in[16] + (l >> 1) * 8;
#pragma unroll
            for (int g = 0; g < 8; ++g) ga[g] = wave_sum(ga[g]);
            if (lane == 0) { float* G = (float*)(p.ws + WS_GATES) + (size_t)row * 8;
                *(f32x4*)G = (f32x4){ga[0] + bif[0], ga[1] + bif[1], ga[2] + bif[2], ga[3] + bif[3]}; *(f32x4*)(G + 4) = (f32x4){ga[4] + bif[4], ga[5] + bif[5], ga[6] + bif[6], ga[7] + bif[7]}; }
        }
    }
    __syncthreads();
}

__device__ __forceinline__ float scan_add(float v, int lane) {
#pragma unroll
    for (int o = 1; o < 64; o <<= 1) { const float t = shup(v, o); if (lane >= o) v += t; }
    return v;
}
__device__ __forceinline__ float scan_max(float v, int lane) {
#pragma unroll
    for (int o = 1; o < 64; o <<= 1) { const float t = shup(v, o); if (lane >= o) v = fmaxf(v, t); }
    return v;
}
constexpr float KSCALE = 0.08838834764831845f;

__device__ __forceinline__ void head_out(const Params& p, int i, int h, int row, int lane, float hv0, float hv1, unsigned zo, f32x2 on) {
    const float ss = wave_sum(hv0 * hv0 + hv1 * hv1);
    const float rstd = rsqrtf(ss * (1.f / 128.f) + EPS);
    unsigned* CAT = (unsigned*)((bf16*)(p.ws + WS_CAT) + (size_t)row * DM + h * 128);
    CAT[lane] = pk2(hv0 * rstd * on.x * sigmoidf_(bflo(zo)), hv1 * rstd * on.y * sigmoidf_(bfhi(zo)));
}
__device__ __forceinline__ void mlstm_local(const Params& p, int i, int item, unsigned char* smem) {
    const int tid = otid(), lane = tid & 63, wave = tid >> 6, fr = lane & 15, fq = lane >> 4;
    const int b = item >> 9, h = (item >> 7) & 3, c = item & 127, r0 = b * SEQL + c * 64;
    float* ws_l = (float*)smem;
    bf16* kT = (bf16*)(smem + 1024);
    bf16* vT = kT + 128 * 72;
    const float* G = (const float*)(p.ws + WS_GATES);
    const bf16* Z = (const bf16*)(p.ws + WS_ZU);
    if (wave == 0) {
        const float ig = G[(size_t)(r0 + lane) * 8 + h], lf = logsigmoidf(G[(size_t)(r0 + lane) * 8 + 4 + h]);
        const float bs = scan_add(lf, lane), bL = shi(bs, 63);
        const float a = bL - bs + ig, amax = wave_max(a);
        ws_l[lane] = __expf(a - amax);
        if (lane == 0) { float* CS = (float*)(p.ws + WS_CS); CS[item * 2] = bL; CS[item * 2 + 1] = amax; }
    }
    __syncthreads();
    { u32x4 wv[4];
#pragma unroll
      for (int it = 0; it < 4; ++it) { const int q = tid + it * NTHR, which = q >> 10, idx = q & 1023, s = idx & 63, ch = idx >> 6; wv[it] = *(const u32x4*)(Z + (size_t)(r0 + s) * ZW + (which ? 1024 : 512) + h * 128 + ch * 8); }
#pragma unroll
      for (int it = 0; it < 4; ++it) { const int q = tid + it * NTHR, which = q >> 10, idx = q & 1023, s = idx & 63, ch = idx >> 6; const u32x4 w = wv[it];
        bf16* dst = (which ? vT : kT) + (ch * 8) * 72 + s;
        if (which) {
            dst[0 * 72] = (bf16)(w.x & 0xffff); dst[1 * 72] = (bf16)(w.x >> 16); dst[2 * 72] = (bf16)(w.y & 0xffff); dst[3 * 72] = (bf16)(w.y >> 16);
            dst[4 * 72] = (bf16)(w.z & 0xffff); dst[5 * 72] = (bf16)(w.z >> 16); dst[6 * 72] = (bf16)(w.w & 0xffff); dst[7 * 72] = (bf16)(w.w >> 16);
        } else { const float sc = ws_l[s] * KSCALE;
            dst[0 * 72] = (bf16)f2bf(bflo(w.x) * sc); dst[1 * 72] = (bf16)f2bf(bfhi(w.x) * sc); dst[2 * 72] = (bf16)f2bf(bflo(w.y) * sc); dst[3 * 72] = (bf16)f2bf(bfhi(w.y) * sc);
            dst[4 * 72] = (bf16)f2bf(bflo(w.z) * sc); dst[5 * 72] = (bf16)f2bf(bfhi(w.z) * sc); dst[6 * 72] = (bf16)f2bf(bflo(w.w) * sc); dst[7 * 72] = (bf16)f2bf(bfhi(w.w) * sc); } } }
    __syncthreads();
    f32x4 acc[8];
#pragma unroll
    for (int mt = 0; mt < 8; ++mt) acc[mt] = (f32x4){0.f, 0.f, 0.f, 0.f};
#pragma unroll
    for (int ks = 0; ks < 2; ++ks) { const bf16x8 B = *(const bf16x8*)(vT + (16 * wave + fr) * 72 + 32 * ks + 8 * fq);
#pragma unroll
        for (int mt = 0; mt < 8; ++mt) { const bf16x8 A = *(const bf16x8*)(kT + (16 * mt + fr) * 72 + 32 * ks + 8 * fq); acc[mt] = __builtin_amdgcn_mfma_f32_16x16x32_bf16(A, B, acc[mt], 0, 0, 0); } }
    bf16* dCt = (bf16*)(p.ws + WS_DCT) + (size_t)item * 16384;
#pragma unroll
    for (int mt = 0; mt < 8; ++mt) *(u32x2*)(dCt + (16 * wave + fr) * 128 + 16 * mt + 4 * fq) = (u32x2){pk2_sw(acc[mt][0], acc[mt][1]), pk2_sw(acc[mt][2], acc[mt][3])};
    if (tid < 128) { float s = 0.f;
        for (int t = 0; t < 64; ++t) s += bf2f(kT[tid * 72 + t]);
        ((float*)(p.ws + WS_DN))[item * 128 + tid] = s; }
    __syncthreads();
}

__device__ __forceinline__ void mlstm_scan(const Params& p, int i) {
    const float* CS = (const float*)(p.ws + WS_CS); const bf16* dCt = (const bf16*)(p.ws + WS_DCT); const float* DN = (const float*)(p.ws + WS_DN);
    bf16* CSt = (bf16*)(p.ws + WS_CST); float* NS = (float*)(p.ws + WS_NS); float* MS = (float*)(p.ws + WS_MS);
    for (int idx = obid() * NTHR + otid(); idx < 8 * 16384; idx += gridDim.x * NTHR) {
        const int bh = idx >> 14, e = idx & 16383;
        float C = 0.f, m = 0.f, nacc = 0.f;
        float dv[16], dnv[16], dv2[16], dnv2[16];
#define SC_LD(D, DNV, c0_) do { _Pragma("unroll") for (int k_ = 0; k_ < 16; ++k_) { D[k_] = bf2f(dCt[(size_t)(bh * 128 + (c0_) + k_) * 16384 + e]); DNV[k_] = (e < 128) ? DN[(bh * 128 + (c0_) + k_) * 128 + e] : 0.f; } } while (0)
#define SC_RUN(D, DNV, c0_) do { _Pragma("unroll") for (int k_ = 0; k_ < 16; ++k_) { const int item = bh * 128 + (c0_) + k_; const float bL = CS[item * 2], amax = CS[item * 2 + 1]; \
                CSt[(size_t)item * 16384 + e] = (bf16)f2bf(C); if (e < 128) NS[item * 128 + e] = nacc; if (e == 0) MS[item] = m; \
                const float mn = fmaxf(bL + m, amax), f1 = __expf(bL + m - mn), f2 = __expf(amax - mn); C = f1 * C + f2 * D[k_]; nacc = f1 * nacc + f2 * DNV[k_]; m = mn; } } while (0)
        SC_LD(dv, dnv, 0);
        for (int c0 = 0; c0 < 128; c0 += 32) {
            SC_LD(dv2, dnv2, c0 + 16);
            SC_RUN(dv, dnv, c0);
            if (c0 + 32 < 128) SC_LD(dv, dnv, c0 + 32);
            SC_RUN(dv2, dnv2, c0 + 16);
        }
#undef SC_LD
#undef SC_RUN
        const int b = bh >> 2, h = bh & 3; const size_t sidx = (size_t)((i * 2 + b) * 4 + h);
        p.out[O_PC + sidx * 16384 + (size_t)(e & 127) * 128 + (e >> 7)] = C;
        if (e < 128) p.out[O_PN + sidx * 128 + e] = nacc;
        if (e == 0) p.out[O_PM + sidx] = m;
    }
}

__device__ __forceinline__ void mlstm_out(const Params& p, int i, int item, unsigned char* smem) {
    const int tid = otid(), lane = tid & 63, wave = tid >> 6, fr = lane & 15, fq = lane >> 4;
    const int b = item >> 9, h = (item >> 7) & 3, c = item & 127, r0 = b * SEQL + c * 64;
    float* d_l = (float*)smem;
    float* M_l = d_l + 64;
    float* wg_l = d_l + 128;
    float* mt_l = d_l + 192;
    float* den_l = d_l + 256;
    float* rs_l = d_l + 320;
    float* qn_l = d_l + 448;
    bf16* q_l = (bf16*)(smem + 2048);
    bf16* k_l = q_l + 64 * 136;
    bf16* vT = k_l + 64 * 136;
    bf16* Sw = vT + 128 * 72;
    float* hbuf = (float*)(Sw + 64 * 72);
    const float* G = (const float*)(p.ws + WS_GATES);
    const bf16* Z = (const bf16*)(p.ws + WS_ZU);
    bf16x8 Bc[4];
    { const bf16* cp = (const bf16*)(p.ws + WS_CST) + (size_t)item * 16384 + (16 * wave + fr) * 128 + 8 * fq;
#pragma unroll
      for (int ks = 0; ks < 4; ++ks) Bc[ks] = *(const bf16x8*)(cp + 32 * ks); }
    if (wave == 0) {
        const float ig = G[(size_t)(r0 + lane) * 8 + h], lf = logsigmoidf(G[(size_t)(r0 + lane) * 8 + 4 + h]);
        const float bs = scan_add(lf, lane), d = ig - bs, gmax = scan_max(d, lane);
        const float mc = ((const float*)(p.ws + WS_MS))[item];
        const float Mt = fmaxf(mc, gmax);
        d_l[lane] = d; M_l[lane] = Mt; wg_l[lane] = __expf(mc - Mt); mt_l[lane] = bs + Mt;
    }
    { u32x4 wv[6];
#pragma unroll
      for (int it = 0; it < 6; ++it) { const int q = tid + it * NTHR, which = q >> 10, idx = q & 1023, s = (which == 2) ? (idx & 63) : (idx >> 4), ch = (which == 2) ? (idx >> 6) : (idx & 15); wv[it] = *(const u32x4*)(Z + (size_t)(r0 + s) * ZW + which * 512 + h * 128 + ch * 8); }
#pragma unroll
      for (int it = 0; it < 6; ++it) { const int q = tid + it * NTHR, which = q >> 10, idx = q & 1023, s = (which == 2) ? (idx & 63) : (idx >> 4), ch = (which == 2) ? (idx >> 6) : (idx & 15); const u32x4 w = wv[it];
        if (which == 0) *(u32x4*)(q_l + s * 136 + ch * 8) = w;
        else if (which == 1) { u32x4 o; o.x = pk2(bflo(w.x) * KSCALE, bfhi(w.x) * KSCALE); o.y = pk2(bflo(w.y) * KSCALE, bfhi(w.y) * KSCALE);
            o.z = pk2(bflo(w.z) * KSCALE, bfhi(w.z) * KSCALE); o.w = pk2(bflo(w.w) * KSCALE, bfhi(w.w) * KSCALE); *(u32x4*)(k_l + s * 136 + ch * 8) = o; }
        else { bf16* dst = vT + (ch * 8) * 72 + s;
            dst[0 * 72] = (bf16)(w.x & 0xffff); dst[1 * 72] = (bf16)(w.x >> 16); dst[2 * 72] = (bf16)(w.y & 0xffff); dst[3 * 72] = (bf16)(w.y >> 16);
            dst[4 * 72] = (bf16)(w.z & 0xffff); dst[5 * 72] = (bf16)(w.z >> 16); dst[6 * 72] = (bf16)(w.w & 0xffff); dst[7 * 72] = (bf16)(w.w >> 16); } } }
    __syncthreads();
    {
        const int mt = wave >> 1, nt0 = 2 * (wave & 1);
        f32x4 a2[2] = {(f32x4){0.f, 0.f, 0.f, 0.f}, (f32x4){0.f, 0.f, 0.f, 0.f}};
#pragma unroll
        for (int ks = 0; ks < 4; ++ks) { const bf16x8 A = *(const bf16x8*)(q_l + (16 * mt + fr) * 136 + 32 * ks + 8 * fq);
#pragma unroll
            for (int n = 0; n < 2; ++n) { const bf16x8 B = *(const bf16x8*)(k_l + (16 * (nt0 + n) + fr) * 136 + 32 * ks + 8 * fq); a2[n] = __builtin_amdgcn_mfma_f32_16x16x32_bf16(A, B, a2[n], 0, 0, 0); } }
        float rsum[4] = {0.f, 0.f, 0.f, 0.f};
#pragma unroll
        for (int n = 0; n < 2; ++n) { const int s = 16 * (nt0 + n) + fr; const float ds = d_l[s];
#pragma unroll
            for (int j = 0; j < 4; ++j) { const int t = 16 * mt + 4 * fq + j; const float wv = (s <= t) ? __expf(ds - M_l[t]) : 0.f; const float val = a2[n][j] * wv; rsum[j] += val; Sw[t * 72 + s] = (bf16)f2bf(val); } }
#pragma unroll
        for (int j = 0; j < 4; ++j) { float v = rsum[j]; v += shx(v, 1); v += shx(v, 2); v += shx(v, 4); v += shx(v, 8); if (fr == 0) rs_l[(wave & 1) * 64 + 16 * mt + 4 * fq + j] = v; }
        { const int t = tid >> 3, part = tid & 7; const float* NS = (const float*)(p.ws + WS_NS) + item * 128 + part * 16;
          const u32x4 qa = *(const u32x4*)(q_l + t * 136 + part * 16), qb = *(const u32x4*)(q_l + t * 136 + part * 16 + 8);
          const f32x4 n0 = *(const f32x4*)NS, n1 = *(const f32x4*)(NS + 4), n2 = *(const f32x4*)(NS + 8), n3 = *(const f32x4*)(NS + 12);
          float v = bflo(qa.x) * n0.x + bfhi(qa.x) * n0.y + bflo(qa.y) * n0.z + bfhi(qa.y) * n0.w + bflo(qa.z) * n1.x + bfhi(qa.z) * n1.y + bflo(qa.w) * n1.z + bfhi(qa.w) * n1.w
                  + bflo(qb.x) * n2.x + bfhi(qb.x) * n2.y + bflo(qb.y) * n2.z + bfhi(qb.y) * n2.w + bflo(qb.z) * n3.x + bfhi(qb.z) * n3.y + bflo(qb.w) * n3.z + bfhi(qb.w) * n3.w;
          v += shx(v, 1); v += shx(v, 2); v += shx(v, 4); if (part == 0) qn_l[t] = v; }
    }
    __syncthreads();
    if (tid < 64) { const int t = tid; const float den = wg_l[t] * qn_l[t] + (rs_l[t] + rs_l[64 + t]); den_l[t] = __builtin_amdgcn_rcpf(fmaxf(fabsf(den), __expf(-mt_l[t]))); }
    f32x4 acc[4];
#pragma unroll
    for (int mt = 0; mt < 4; ++mt) acc[mt] = (f32x4){0.f, 0.f, 0.f, 0.f};
#pragma unroll
    for (int ks = 0; ks < 4; ++ks) { const bf16x8 B = Bc[ks];
#pragma unroll
        for (int mt = 0; mt < 4; ++mt) { const bf16x8 A = *(const bf16x8*)(q_l + (16 * mt + fr) * 136 + 32 * ks + 8 * fq); acc[mt] = __builtin_amdgcn_mfma_f32_16x16x32_bf16(A, B, acc[mt], 0, 0, 0); } }
#pragma unroll
    for (int mt = 0; mt < 4; ++mt)
#pragma unroll
        for (int j = 0; j < 4; ++j) acc[mt][j] *= wg_l[16 * mt + 4 * fq + j];
#pragma unroll
    for (int ks = 0; ks < 2; ++ks) { const bf16x8 B = *(const bf16x8*)(vT + (16 * wave + fr) * 72 + 32 * ks + 8 * fq);
#pragma unroll
        for (int mt = 0; mt < 4; ++mt) { const bf16x8 A = *(const bf16x8*)(Sw + (16 * mt + fr) * 72 + 32 * ks + 8 * fq); acc[mt] = __builtin_amdgcn_mfma_f32_16x16x32_bf16(A, B, acc[mt], 0, 0, 0); } }
    __syncthreads();
#pragma unroll
    for (int mt = 0; mt < 4; ++mt)
#pragma unroll
        for (int j = 0; j < 4; ++j) { const int t = 16 * mt + 4 * fq + j; hbuf[t * 132 + 16 * wave + fr] = acc[mt][j] * den_l[t]; }
    __syncthreads();
    { unsigned zo[8]; const f32x2 on = *(const f32x2*)(p.in[17] + i * 512 + h * 128 + 2 * lane);
#pragma unroll
      for (int tt = 0; tt < 8; ++tt) zo[tt] = *(const unsigned*)(Z + (size_t)(r0 + 8 * wave + tt) * ZW + 1536 + h * 128 + 2 * lane);
#pragma unroll
      for (int tt = 0; tt < 8; ++tt) { const int t = 8 * wave + tt; const f32x2 hv = *(const f32x2*)(hbuf + t * 132 + 2 * lane); head_out(p, i, h, r0 + t, lane, hv.x, hv.y, zo[tt], on); } }
    __syncthreads();
}

__device__ __forceinline__ void mlstm_out2(const Params& p, int i, int itA, int itB, unsigned char* smem) {
    const int tid = otid(), lane = tid & 63, wave = tid >> 6, fr = lane & 15, fq = lane >> 4, hh = wave >> 2, wl = wave & 3, tl = tid & 255;
    const int item_ = hh ? itB : itA; const bool active = item_ < 1024; const int item = active ? item_ : 0;
    const int b = item >> 9, h = (item >> 7) & 3, c = item & 127, r0 = b * SEQL + c * 64;
    unsigned char* sb = smem + hh * 65536;
    float* d_l = (float*)sb;
    float* M_l = d_l + 64;
    float* wg_l = d_l + 128;
    float* mt_l = d_l + 192;
    float* den_l = d_l + 256;
    float* rs_l = d_l + 320;
    float* qn_l = d_l + 384;
    bf16* q_l = (bf16*)(sb + 2048);
    bf16* k_l = q_l + 64 * 136;
    float* hbuf = (float*)(sb + 2048);
    bf16* vT = k_l + 64 * 136;
    bf16* Sw = vT + 128 * 72;
    const float* G = (const float*)(p.ws + WS_GATES);
    const bf16* Z = (const bf16*)(p.ws + WS_ZU);
    bf16x8 Bc[2][4];
#pragma unroll
    for (int n = 0; n < 2; ++n) { const bf16* cp = (const bf16*)(p.ws + WS_CST) + (size_t)item * 16384 + (16 * (2 * wl + n) + fr) * 128 + 8 * fq;
#pragma unroll
        for (int ks = 0; ks < 4; ++ks) Bc[n][ks] = *(const bf16x8*)(cp + 32 * ks); }
    if (wl == 0) {
        const float ig = G[(size_t)(r0 + lane) * 8 + h], lf = logsigmoidf(G[(size_t)(r0 + lane) * 8 + 4 + h]);
        const float bs = scan_add(lf, lane), d = ig - bs, gmax = scan_max(d, lane);
        const float mc = ((const float*)(p.ws + WS_MS))[item];
        const float Mt = fmaxf(mc, gmax);
        d_l[lane] = d; M_l[lane] = Mt; wg_l[lane] = __expf(mc - Mt); mt_l[lane] = bs + Mt;
    }
    { u32x4 wv[12];
#pragma unroll
      for (int it = 0; it < 12; ++it) { const int q = tl + it * 256, which = q >> 10, idx = q & 1023, s = (which == 2) ? (idx & 63) : (idx >> 4), ch = (which == 2) ? (idx >> 6) : (idx & 15); wv[it] = *(const u32x4*)(Z + (size_t)(r0 + s) * ZW + which * 512 + h * 128 + ch * 8); }
#pragma unroll
      for (int it = 0; it < 12; ++it) { const int q = tl + it * 256, which = q >> 10, idx = q & 1023, s = (which == 2) ? (idx & 63) : (idx >> 4), ch = (which == 2) ? (idx >> 6) : (idx & 15); const u32x4 w = wv[it];
        if (which == 0) *(u32x4*)(q_l + s * 136 + ch * 8) = w;
        else if (which == 1) { u32x4 o; o.x = pk2(bflo(w.x) * KSCALE, bfhi(w.x) * KSCALE); o.y = pk2(bflo(w.y) * KSCALE, bfhi(w.y) * KSCALE);
            o.z = pk2(bflo(w.z) * KSCALE, bfhi(w.z) * KSCALE); o.w = pk2(bflo(w.w) * KSCALE, bfhi(w.w) * KSCALE); *(u32x4*)(k_l + s * 136 + ch * 8) = o; }
        else { bf16* dst = vT + (ch * 8) * 72 + s;
            dst[0 * 72] = (bf16)(w.x & 0xffff); dst[1 * 72] = (bf16)(w.x >> 16); dst[2 * 72] = (bf16)(w.y & 0xffff); dst[3 * 72] = (bf16)(w.y >> 16);
            dst[4 * 72] = (bf16)(w.z & 0xffff); dst[5 * 72] = (bf16)(w.z >> 16); dst[6 * 72] = (bf16)(w.w & 0xffff); dst[7 * 72] = (bf16)(w.w >> 16); } } }
    __syncthreads();
    {
        const int mt = wl;
        f32x4 a4[4];
#pragma unroll
        for (int n = 0; n < 4; ++n) a4[n] = (f32x4){0.f, 0.f, 0.f, 0.f};
#pragma unroll
        for (int ks = 0; ks < 4; ++ks) { const bf16x8 A = *(const bf16x8*)(q_l + (16 * mt + fr) * 136 + 32 * ks + 8 * fq);
#pragma unroll
            for (int n = 0; n < 4; ++n) if (n <= mt) { const bf16x8 B = *(const bf16x8*)(k_l + (16 * n + fr) * 136 + 32 * ks + 8 * fq); a4[n] = __builtin_amdgcn_mfma_f32_16x16x32_bf16(A, B, a4[n], 0, 0, 0); } }
        float rsum[4] = {0.f, 0.f, 0.f, 0.f};
#pragma unroll
        for (int n = 0; n < 4; ++n) { const int s = 16 * n + fr; const float ds = d_l[s];
#pragma unroll
            for (int j = 0; j < 4; ++j) { const int t = 16 * mt + 4 * fq + j; const float wv = (s <= t) ? __expf(ds - M_l[t]) : 0.f; const float val = a4[n][j] * wv; rsum[j] += val; Sw[t * 72 + s] = (bf16)f2bf(val); } }
#pragma unroll
        for (int j = 0; j < 4; ++j) { float v = rsum[j]; v += shx(v, 1); v += shx(v, 2); v += shx(v, 4); v += shx(v, 8); if (fr == 0) rs_l[16 * mt + 4 * fq + j] = v; }
        { const int t = tl >> 2, part = tl & 3; const float* NS = (const float*)(p.ws + WS_NS) + item * 128 + part * 32; float v = 0.f;
#pragma unroll
          for (int g = 0; g < 4; ++g) { const u32x4 qa = *(const u32x4*)(q_l + t * 136 + part * 32 + 8 * g); const f32x4 n0 = *(const f32x4*)(NS + 8 * g), n1 = *(const f32x4*)(NS + 8 * g + 4);
              v += bflo(qa.x) * n0.x + bfhi(qa.x) * n0.y + bflo(qa.y) * n0.z + bfhi(qa.y) * n0.w + bflo(qa.z) * n1.x + bfhi(qa.z) * n1.y + bflo(qa.w) * n1.z + bfhi(qa.w) * n1.w; }
          v += shx(v, 1); v += shx(v, 2); if (part == 0) qn_l[t] = v; }
    }
    __syncthreads();
    if (tl < 64) { const int t = tl; const float den = wg_l[t] * qn_l[t] + rs_l[t]; den_l[t] = __builtin_amdgcn_rcpf(fmaxf(fabsf(den), __expf(-mt_l[t]))); }
    f32x4 acc[2][4];
#pragma unroll
    for (int n = 0; n < 2; ++n)
#pragma unroll
        for (int mt = 0; mt < 4; ++mt) acc[n][mt] = (f32x4){0.f, 0.f, 0.f, 0.f};
#pragma unroll
    for (int ks = 0; ks < 4; ++ks)
#pragma unroll
        for (int mt = 0; mt < 4; ++mt) { const bf16x8 A = *(const bf16x8*)(q_l + (16 * mt + fr) * 136 + 32 * ks + 8 * fq);
#pragma unroll
            for (int n = 0; n < 2; ++n) acc[n][mt] = __builtin_amdgcn_mfma_f32_16x16x32_bf16(A, Bc[n][ks], acc[n][mt], 0, 0, 0); }
#pragma unroll
    for (int mt = 0; mt < 4; ++mt)
#pragma unroll
        for (int j = 0; j < 4; ++j) { const float wgv = wg_l[16 * mt + 4 * fq + j]; acc[0][mt][j] *= wgv; acc[1][mt][j] *= wgv; }
#pragma unroll
    for (int ks = 0; ks < 2; ++ks)
#pragma unroll
        for (int mt = 0; mt < 4; ++mt) { const bf16x8 A = *(const bf16x8*)(Sw + (16 * mt + fr) * 72 + 32 * ks + 8 * fq);
#pragma unroll
            for (int n = 0; n < 2; ++n) { const bf16x8 B = *(const bf16x8*)(vT + (16 * (2 * wl + n) + fr) * 72 + 32 * ks + 8 * fq); acc[n][mt] = __builtin_amdgcn_mfma_f32_16x16x32_bf16(A, B, acc[n][mt], 0, 0, 0); } }
    __syncthreads();
#pragma unroll
    for (int n = 0; n < 2; ++n)
#pragma unroll
        for (int mt = 0; mt < 4; ++mt)
#pragma unroll
            for (int j = 0; j < 4; ++j) { const int t = 16 * mt + 4 * fq + j; hbuf[t * 132 + 16 * (2 * wl + n) + fr] = acc[n][mt][j] * den_l[t]; }
    __syncthreads();
    { unsigned zo[16]; const f32x2 on = *(const f32x2*)(p.in[17] + i * 512 + h * 128 + 2 * lane);
#pragma unroll
      for (int tt = 0; tt < 16; ++tt) zo[tt] = *(const unsigned*)(Z + (size_t)(r0 + 16 * wl + tt) * ZW + 1536 + h * 128 + 2 * lane);
#pragma unroll
      for (int tt = 0; tt < 16; ++tt) { const int t = 16 * wl + tt; const f32x2 hv = *(const f32x2*)(hbuf + t * 132 + 2 * lane);
          const float ss = wave_sum(hv.x * hv.x + hv.y * hv.y); const float rstd = rsqrtf(ss * (1.f / 128.f) + EPS);
          if (active) { unsigned* CAT = (unsigned*)((bf16*)(p.ws + WS_CAT) + (size_t)(r0 + t) * DM + h * 128);
              CAT[lane] = pk2(hv.x * rstd * on.x * sigmoidf_(bflo(zo[tt])), hv.y * rstd * on.y * sigmoidf_(bfhi(zo[tt]))); } } }
    __syncthreads();
}

__device__ __forceinline__ void mlstm_sample(const Params& p, int i, int item, unsigned char* smem) {
    const int tid = otid(), lane = tid & 63, wave = tid >> 6;
    const int s = item >> 2, h = item & 3, r0 = RP + 8 * s;
    float* qq = (float*)smem;
    float* kk = qq + 1024;
    float* vv = kk + 1024;
    float* qT = vv + 1024;
    float* kwT = qT + 1024;
    float* part = kwT + 1024;
    float* S_l = part + 4096;
    float* sc = S_l + 64;
    const bf16* Z = (const bf16*)(p.ws + WS_ZU);
    const float* G = (const float*)(p.ws + WS_GATES);
    const size_t sidx = (size_t)((i * 128 + s) * 4 + h);
    const float* n0 = p.in[5] + sidx * 128;
    { bf16 zv[6];
#pragma unroll
      for (int it = 0; it < 6; ++it) { const int q = tid + it * NTHR, which = q >> 10, t = (q >> 7) & 7, d = q & 127; zv[it] = Z[(size_t)(r0 + t) * ZW + which * 512 + h * 128 + d]; }
#pragma unroll
      for (int it = 0; it < 6; ++it) { const int q = tid + it * NTHR, which = q >> 10; float v = bf2f(zv[it]); if (which == 1) v *= KSCALE; qq[q] = v; } }
    if (wave == 0) {
        const int t = lane & 7;
        const float ig = G[(size_t)(r0 + t) * 8 + h], lf = logsigmoidf(G[(size_t)(r0 + t) * 8 + 4 + h]);
        float bs = 0.f;
        for (int u = 0; u < 8; ++u) { const float x = shi(lf, u); if (u <= t) bs += x; }
        const float d = ig - bs; float gmax = -INFINITY;
        for (int u = 0; u < 8; ++u) { const float x = shi(d, u); if (u <= t) gmax = fmaxf(gmax, x); }
        const float m0 = p.in[6][sidx];
        const float Mt = fmaxf(m0, gmax), bL = shi(bs, 7), a = bL - bs + ig;
        float amax = -INFINITY;
        for (int u = 0; u < 8; ++u) amax = fmaxf(amax, shi(a, u));
        const float mnew = fmaxf(bL + m0, amax);
        if (lane < 8) { sc[t] = d; sc[8 + t] = Mt; sc[16 + t] = __expf(m0 - Mt); sc[24 + t] = bs + Mt; sc[32 + t] = __expf(a - mnew); }
        if (lane == 0) { sc[56] = __expf(bL + m0 - mnew); sc[57] = mnew; }
    }
    __syncthreads();
    { const int pr = tid >> 3, part = tid & 7, t = pr >> 3, u = pr & 7; float dot = 0.f;
#pragma unroll
        for (int d = 0; d < 16; ++d) dot += qq[t * 128 + part * 16 + d] * kk[u * 128 + part * 16 + d];
        dot += shx(dot, 1); dot += shx(dot, 2); dot += shx(dot, 4);
        if (part == 0) S_l[pr] = (u <= t) ? dot * __expf(sc[u] - sc[8 + t]) : 0.f; }
    if (tid < 64) { const int t = tid >> 3, part = tid & 7; float dot = 0.f;
#pragma unroll
        for (int d = 0; d < 16; ++d) dot += qq[t * 128 + part * 16 + d] * n0[part * 16 + d];
        dot += shx(dot, 1); dot += shx(dot, 2); dot += shx(dot, 4);
        if (part == 0) sc[40 + t] = dot; }
    for (int idx = tid; idx < 1024; idx += NTHR) { const int dk = idx >> 3, t = idx & 7; qT[idx] = qq[t * 128 + dk]; kwT[idx] = kk[t * 128 + dk] * sc[32 + t]; }
    __syncthreads();
    if (tid < 8) { float rs = 0.f; for (int u = 0; u < 8; ++u) rs += S_l[tid * 8 + u];
        const float den = sc[16 + tid] * sc[40 + tid] + rs; sc[48 + tid] = fmaxf(fabsf(den), __expf(-sc[24 + tid])); }
    {
        const int e = tid & 127, g = tid >> 7; const float wc = sc[56];
        float vr[8], acc[8];
#pragma unroll
        for (int u = 0; u < 8; ++u) { vr[u] = vv[u * 128 + e]; acc[u] = 0.f; }
        const float* Cin = p.in[4] + sidx * 16384; float* Cout = p.out + O_SC + sidx * 16384;
        float cin[32];
#pragma unroll
        for (int k = 0; k < 32; ++k) cin[k] = Cin[(g * 32 + k) * 128 + e];
#pragma unroll
        for (int k = 0; k < 32; ++k) { const int dk = g * 32 + k; const float cv = cin[k];
            const f32x4 q0 = *(const f32x4*)(qT + dk * 8), q1 = *(const f32x4*)(qT + dk * 8 + 4), k0 = *(const f32x4*)(kwT + dk * 8), k1 = *(const f32x4*)(kwT + dk * 8 + 4);
            acc[0] += q0.x * cv; acc[1] += q0.y * cv; acc[2] += q0.z * cv; acc[3] += q0.w * cv; acc[4] += q1.x * cv; acc[5] += q1.y * cv; acc[6] += q1.z * cv; acc[7] += q1.w * cv;
            float cn = wc * cv;
            cn += k0.x * vr[0] + k0.y * vr[1] + k0.z * vr[2] + k0.w * vr[3] + k1.x * vr[4] + k1.y * vr[5] + k1.z * vr[6] + k1.w * vr[7];
            Cout[dk * 128 + e] = cn; }
#pragma unroll
        for (int u = 0; u < 8; ++u) part[(g * 8 + u) * 128 + e] = acc[u];
        if (tid < 128) { float nn = wc * n0[tid];
#pragma unroll
            for (int u = 0; u < 8; ++u) nn += kwT[tid * 8 + u];
            p.out[O_SN + sidx * 128 + tid] = nn; }
        if (tid == 0) p.out[O_SM + sidx] = sc[57];
    }
    __syncthreads();
    {
        const int t = wave; float hv[2];
        const unsigned zo = *(const unsigned*)(Z + (size_t)(r0 + t) * ZW + 1536 + h * 128 + 2 * lane); const f32x2 on = *(const f32x2*)(p.in[17] + i * 512 + h * 128 + 2 * lane);
#pragma unroll
        for (int k = 0; k < 2; ++k) { const int e = 2 * lane + k;
            float num = (part[(0 * 8 + t) * 128 + e] + part[(1 * 8 + t) * 128 + e]) + (part[(2 * 8 + t) * 128 + e] + part[(3 * 8 + t) * 128 + e]);
            num *= sc[16 + t];
#pragma unroll
            for (int u = 0; u < 8; ++u) num += S_l[t * 8 + u] * vv[u * 128 + e];
            hv[k] = num / sc[48 + t]; }
        head_out(p, i, h, r0 + t, lane, hv[0], hv[1], zo, on);
    }
    __syncthreads();
}

__device__ __forceinline__ void shortconv(const Params& p, int i) {
    const bf16* Z = (const bf16*)(p.ws + WS_ZU); bf16* CAT = (bf16*)(p.ws + WS_CAT);
    const float* cw = p.in[18] + i * 3 * 512;
    for (int idx = obid() * NTHR + otid(); idx < R * 64; idx += gridDim.x * NTHR) {
        const int row = idx >> 6, ch = (idx & 63) * 8;
        const bool prm = row < RP; const int t = prm ? (row & (SEQL - 1)) : ((row - RP) & 7), S = prm ? SEQL : 8, sq = prm ? (row >> 13) : ((row - RP) >> 3);
        float pr[3][8];
#pragma unroll
        for (int j = 0; j < 3; ++j) { const int tt = t - 2 + j;
            if (tt >= 0) { const bf16* zr = Z + (size_t)(row - 2 + j) * ZW; const u32x4 a = *(const u32x4*)(zr + 2560 + ch), b = *(const u32x4*)(zr + 3072 + ch);
                pr[j][0] = bflo(a.x) * bflo(b.x); pr[j][1] = bfhi(a.x) * bfhi(b.x); pr[j][2] = bflo(a.y) * bflo(b.y); pr[j][3] = bfhi(a.y) * bfhi(b.y);
                pr[j][4] = bflo(a.z) * bflo(b.z); pr[j][5] = bfhi(a.z) * bfhi(b.z); pr[j][6] = bflo(a.w) * bflo(b.w); pr[j][7] = bfhi(a.w) * bfhi(b.w); }
            else if (!prm) { const float* st = p.in[7] + ((size_t)(i * 128 + sq) * 2 + (2 + tt)) * 512 + ch; const f32x4 a = *(const f32x4*)st, b = *(const f32x4*)(st + 4);
                pr[j][0] = a.x; pr[j][1] = a.y; pr[j][2] = a.z; pr[j][3] = a.w; pr[j][4] = b.x; pr[j][5] = b.y; pr[j][6] = b.z; pr[j][7] = b.w; }
            else {
#pragma unroll
                for (int e = 0; e < 8; ++e) pr[j][e] = 0.f; } }
        const u32x4 zb = *(const u32x4*)(Z + (size_t)row * ZW + 2048 + ch);
        float zbf[8] = {bflo(zb.x), bfhi(zb.x), bflo(zb.y), bfhi(zb.y), bflo(zb.z), bfhi(zb.z), bflo(zb.w), bfhi(zb.w)};
        float o[8];
#pragma unroll
        for (int e = 0; e < 8; ++e) o[e] = zbf[e] * (cw[ch + e] * pr[0][e] + cw[512 + ch + e] * pr[1][e] + cw[1024 + ch + e] * pr[2][e]);
        *(u32x4*)(CAT + (size_t)row * DM + 512 + ch) = (u32x4){pk2(o[0], o[1]), pk2(o[2], o[3]), pk2(o[4], o[5]), pk2(o[6], o[7])};
        if (t >= S - 2) { float* dst = p.out + (prm ? O_PSC + ((size_t)(i * 2 + sq) * 2 + (t - (S - 2))) * 512 : O_SSC + ((size_t)(i * 128 + sq) * 2 + (t - (S - 2))) * 512) + ch;
            *(f32x4*)dst = (f32x4){pr[2][0], pr[2][1], pr[2][2], pr[2][3]}; *(f32x4*)(dst + 4) = (f32x4){pr[2][4], pr[2][5], pr[2][6], pr[2][7]}; }
    }
}

__device__ __forceinline__ void unpack8(const u32x4 w, float (&v)[8]) { v[0] = bflo(w.x); v[1] = bfhi(w.x); v[2] = bflo(w.y); v[3] = bfhi(w.y); v[4] = bflo(w.z); v[5] = bfhi(w.z); v[6] = bflo(w.w); v[7] = bfhi(w.w); }
__device__ __forceinline__ void ld8f(const float* s, float (&v)[8]) { const f32x4 a = *(const f32x4*)s, b = *(const f32x4*)(s + 4); v[0] = a.x; v[1] = a.y; v[2] = a.z; v[3] = a.w; v[4] = b.x; v[5] = b.y; v[6] = b.z; v[7] = b.w; }
__device__ __forceinline__ void st8f(float* d, const float (&v)[8]) { *(f32x4*)d = (f32x4){v[0], v[1], v[2], v[3]}; *(f32x4*)(d + 4) = (f32x4){v[4], v[5], v[6], v[7]}; }

__device__ __forceinline__ void cache_shift(const Params& p, int jl, int bsel, int nsel) {
    const int tid = otid();
    for (int idx = bsel * NTHR + tid; idx < 2 * 128 * 7680; idx += nsel * NTHR) { const int kv = idx / (128 * 7680), r = idx - kv * (128 * 7680), s = r / 7680, q = r - s * 7680;
        const float* src = (kv ? p.in[9] : p.in[8]) + ((size_t)(jl * 128 + s) * 128 + 8) * 256 + 4 * q; float* dst = p.out + (kv ? O_SWV : O_SWK) + ((size_t)(jl * 128 + s) * 128) * 256 + 4 * q;
        *(f32x4*)dst = *(const f32x4*)src; }
}

template <int NH>
__device__ __forceinline__ void attn_wave(const bf16* K_l, const bf16* Vt_l, int ldvt, int kt0, const bf16x8 (*Bq)[2], int qidx, int kmin, const float* sinkp, bf16* orow, bool store, int fr, int fq) {
    f32x4 s[NH][9];
    float sk[NH], mx[NH];
#pragma unroll
    for (int h = 0; h < NH; ++h) { sk[h] = sinkp[h] * 1.4426950408889634f; mx[h] = sk[h]; }
#pragma unroll
    for (int kt = 0; kt < 9; ++kt) {
        const bf16x8 A0 = *(const bf16x8*)(K_l + (16 * (kt0 + kt) + fr) * 72 + 8 * fq), A1 = *(const bf16x8*)(K_l + (16 * (kt0 + kt) + fr) * 72 + 32 + 8 * fq);
#pragma unroll
        for (int h = 0; h < NH; ++h) { f32x4 a = (f32x4){0.f, 0.f, 0.f, 0.f};
            a = __builtin_amdgcn_mfma_f32_16x16x32_bf16(A0, Bq[h][0], a, 0, 0, 0); a = __builtin_amdgcn_mfma_f32_16x16x32_bf16(A1, Bq[h][1], a, 0, 0, 0);
#pragma unroll
            for (int j = 0; j < 4; ++j) { const int kidx = 16 * (kt0 + kt) + 4 * fq + j;
                const bool valid = (kt == 0) ? ((kidx > qidx - 128) && (kidx >= kmin)) : (kt == 8) ? (kidx <= qidx) : (kidx >= kmin);
                a[j] = valid ? a[j] * 0.18033688011112042f : -INFINITY; mx[h] = fmaxf(mx[h], a[j]); }
            s[h][kt] = a; } }
    float inv[NH];
#pragma unroll
    for (int h = 0; h < NH; ++h) { mx[h] = fmaxf(mx[h], shx(mx[h], 16)); mx[h] = fmaxf(mx[h], shx(mx[h], 32)); }
#pragma unroll
    for (int h = 0; h < NH; ++h) { float sum = 0.f;
#pragma unroll
        for (int kt = 0; kt < 9; ++kt)
#pragma unroll
            for (int j = 0; j < 4; ++j) { const float e = __builtin_amdgcn_exp2f(s[h][kt][j] - mx[h]); s[h][kt][j] = e; sum += e; }
        inv[h] = sum; }
#pragma unroll
    for (int h = 0; h < NH; ++h) { float sum = inv[h]; sum += shx(sum, 16); sum += shx(sum, 32); inv[h] = __builtin_amdgcn_rcpf(sum + __builtin_amdgcn_exp2f(sk[h] - mx[h])); }
    bf16x8 Bp[NH][5];
#pragma unroll
    for (int h = 0; h < NH; ++h)
#pragma unroll
        for (int pp = 0; pp < 5; ++pp) { u32x4 w; w.x = pk2(s[h][2 * pp][0], s[h][2 * pp][1]); w.y = pk2(s[h][2 * pp][2], s[h][2 * pp][3]);
            if (pp < 4) { w.z = pk2(s[h][2 * pp + 1][0], s[h][2 * pp + 1][1]); w.w = pk2(s[h][2 * pp + 1][2], s[h][2 * pp + 1][3]); } else { w.z = 0u; w.w = 0u; }
            Bp[h][pp] = __builtin_bit_cast(bf16x8, w); }
#pragma unroll
    for (int dt = 0; dt < 4; ++dt) { f32x4 a[NH];
#pragma unroll
        for (int h = 0; h < NH; ++h) a[h] = (f32x4){0.f, 0.f, 0.f, 0.f};
#pragma unroll
        for (int pp = 0; pp < 5; ++pp) { const bf16* vp = Vt_l + (16 * dt + fr) * ldvt + 16 * (kt0 + 2 * pp) + 4 * fq;
            const u32x2 lo = *(const u32x2*)vp, hi = *(const u32x2*)(vp + 16); const bf16x8 V = __builtin_bit_cast(bf16x8, (u32x4){lo.x, lo.y, hi.x, hi.y});
#pragma unroll
            for (int h = 0; h < NH; ++h) a[h] = __builtin_amdgcn_mfma_f32_16x16x32_bf16(V, Bp[h][pp], a[h], 0, 0, 0); }
        if (store) {
#pragma unroll
            for (int h = 0; h < NH; ++h) *(u32x2*)(orow + 64 * h + 16 * dt + 4 * fq) = (u32x2){pk2(a[h][0] * inv[h], a[h][1] * inv[h]), pk2(a[h][2] * inv[h], a[h][3] * inv[h])}; } }
}

__device__ __forceinline__ void attn_phase(const Params& p, int jl, unsigned char* smem) {
    const bf16* Z = (const bf16*)(p.ws + WS_ZU); bf16* CAT = (bf16*)(p.ws + WS_CAT);
    const float* sinkp = p.in[23] + jl * 16;
    for (int u = obid(); u < 768; u += gridDim.x) { const int tidu = otid(), lane = tidu & 63, wave = tidu >> 6, fr = lane & 15, fq = lane >> 4;
        if (u < 512) {
            const int b = u >> 8, kvh = (u >> 6) & 3, qb = u & 63, q0 = qb * 128, rb = b * SEQL;
            bf16x8 Bq[4][2];
            { const bf16* qp = Z + (size_t)(rb + q0 + 16 * wave + fr) * QKVW + kvh * 256 + 8 * fq;
#pragma unroll
              for (int hq = 0; hq < 4; ++hq) { Bq[hq][0] = *(const bf16x8*)(qp + hq * 64); Bq[hq][1] = *(const bf16x8*)(qp + hq * 64 + 32); } }
            bf16* K_l = (bf16*)smem;
            bf16* Vt_l = K_l + 256 * 72;
            { u32x4 wv[8];
#pragma unroll
              for (int it = 0; it < 8; ++it) { const int q = tidu + it * NTHR, which = q >> 11, idx = q & 2047, kidx = which ? (idx & 255) : (idx >> 3), ch = which ? (idx >> 8) : (idx & 7); const int pos = q0 - 128 + kidx;
                wv[it] = (u32x4){0u, 0u, 0u, 0u};
                if (pos >= 0) wv[it] = *(const u32x4*)(Z + (size_t)(rb + pos) * QKVW + (which ? 1280 : 1024) + kvh * 64 + ch * 8); }
#pragma unroll
              for (int it = 0; it < 8; ++it) { const int q = tidu + it * NTHR, which = q >> 11, idx = q & 2047, kidx = which ? (idx & 255) : (idx >> 3), ch = which ? (idx >> 8) : (idx & 7); const u32x4 w = wv[it];
                if (!which) *(u32x4*)(K_l + kidx * 72 + ch * 8) = w;
                else { bf16* dst = Vt_l + (ch * 8) * 296 + kidx;
                    dst[0 * 296] = (bf16)(w.x & 0xffff); dst[1 * 296] = (bf16)(w.x >> 16); dst[2 * 296] = (bf16)(w.y & 0xffff); dst[3 * 296] = (bf16)(w.y >> 16);
                    dst[4 * 296] = (bf16)(w.z & 0xffff); dst[5 * 296] = (bf16)(w.z >> 16); dst[6 * 296] = (bf16)(w.w & 0xffff); dst[7 * 296] = (bf16)(w.w >> 16); } } }
            for (int q = tidu; q < 64 * 32; q += NTHR) Vt_l[(q >> 5) * 296 + 256 + (q & 31)] = 0;
            __syncthreads();
            const int row = rb + q0 + 16 * wave + fr;
#pragma unroll
            for (int hg = 0; hg < 2; ++hg) { const int h = kvh * 4 + 2 * hg;
                attn_wave<2>(K_l, Vt_l, 296, wave, Bq + 2 * hg, 128 + 16 * wave + fr, qb == 0 ? 128 : 0, sinkp + h, CAT + (size_t)row * DM + h * 64, true, fr, fq); }
            __syncthreads();
        } else {
            const int us = u - 512, s = us >> 1, kvp = us & 1;
            bf16x8 Bq1[2];
            { const bf16* qp = Z + (size_t)(RP + 8 * s + (fr & 7)) * QKVW + (8 * kvp + wave) * 64 + 8 * fq; Bq1[0] = *(const bf16x8*)qp; Bq1[1] = *(const bf16x8*)(qp + 32); }
            bf16* K_l = (bf16*)smem;
            bf16* Vt_l = K_l + 2 * 144 * 72;
            { f32x4 va[9], vb[9];
              const float* ck = p.in[8] + ((size_t)(jl * 128 + s) * 128) * 256; const float* cv = p.in[9] + ((size_t)(jl * 128 + s) * 128) * 256;
#pragma unroll
              for (int it = 0; it < 9; ++it) { const int q = tidu + it * NTHR, which = q / 2304, r = q - which * 2304, kvl = r / 1152, r2 = r - kvl * 1152, kidx = which ? (r2 % 144) : (r2 >> 3), ch = which ? (r2 / 144) : (r2 & 7); const int kvh = 2 * kvp + kvl;
                va[it] = (f32x4){0.f, 0.f, 0.f, 0.f}; vb[it] = va[it];
                if (kidx < 128) { const float* src = (which ? cv : ck) + (size_t)kidx * 256 + kvh * 64 + ch * 8; va[it] = *(const f32x4*)src; vb[it] = *(const f32x4*)(src + 4); }
                else if (kidx < 136) { const u32x4 w = *(const u32x4*)(Z + (size_t)(RP + 8 * s + kidx - 128) * QKVW + (which ? 1280 : 1024) + kvh * 64 + ch * 8);
                    va[it] = (f32x4){bflo(w.x), bfhi(w.x), bflo(w.y), bfhi(w.y)}; vb[it] = (f32x4){bflo(w.z), bfhi(w.z), bflo(w.w), bfhi(w.w)}; } }
#pragma unroll
              for (int it = 0; it < 9; ++it) { const int q = tidu + it * NTHR, which = q / 2304, r = q - which * 2304, kvl = r / 1152, r2 = r - kvl * 1152, kidx = which ? (r2 % 144) : (r2 >> 3), ch = which ? (r2 / 144) : (r2 & 7);
                const f32x4 a = va[it], c = vb[it];
                if (!which) *(u32x4*)(K_l + (kvl * 144 + kidx) * 72 + ch * 8) = (u32x4){pk2(a[0], a[1]), pk2(a[2], a[3]), pk2(c[0], c[1]), pk2(c[2], c[3])};
                else { bf16* dst = Vt_l + (kvl * 64 + ch * 8) * 168 + kidx; const unsigned p0 = pk2(a[0], a[1]), p1 = pk2(a[2], a[3]), p2 = pk2(c[0], c[1]), p3 = pk2(c[2], c[3]);
                    dst[0 * 168] = (bf16)(p0 & 0xffff); dst[1 * 168] = (bf16)(p0 >> 16); dst[2 * 168] = (bf16)(p1 & 0xffff); dst[3 * 168] = (bf16)(p1 >> 16);
                    dst[4 * 168] = (bf16)(p2 & 0xffff); dst[5 * 168] = (bf16)(p2 >> 16); dst[6 * 168] = (bf16)(p3 & 0xffff); dst[7 * 168] = (bf16)(p3 >> 16); } } }
            for (int q = tidu; q < 2 * 64 * 16; q += NTHR) Vt_l[(q >> 4) * 168 + 144 + (q & 15)] = 0;
            __syncthreads();
            const int kvl = wave >> 2, h = 8 * kvp + wave, row = RP + 8 * s + (fr & 7);
            attn_wave<1>(K_l + kvl * 144 * 72, Vt_l + kvl * 64 * 168, 168, 0, &Bq1, 128 + (fr & 7), 0, sinkp + h, CAT + (size_t)row * DM + h * 64, fr < 8, fr, fq);
            __syncthreads();
        }
    }
}

__device__ __forceinline__ void ffnfix_phase(const Params& p, int l) {
    const bf16* UB = (const bf16*)(p.ws + WS_UB); bf16* ACT = (bf16*)(p.ws + WS_ACT);
    const float* cw = p.in[26] + (size_t)l * 3 * FF2;
    for (int idx = obid() * NTHR + otid(); idx < 256 * 352; idx += gridDim.x * NTHR) {
        const int hr = idx / 352, cc = idx - hr * 352, col = cc * 8, hh = hr >> 1, rr = hr & 1;
        const bool seqstart = (hh & 63) == 0;
        const bf16* own0 = UB + (size_t)(hh * 4 + 0) * FF2; const bf16* own1 = UB + (size_t)(hh * 4 + 1) * FF2;
        const bf16* pm2 = UB + (size_t)((hh - 1) * 4 + 2) * FF2; const bf16* pm1 = UB + (size_t)((hh - 1) * 4 + 3) * FF2;
        float g2[8], g1[8], g0[8], a2[8], a1[8], a0[8];
        if (rr == 0) {
            if (seqstart) {
#pragma unroll
                for (int e = 0; e < 8; ++e) { g2[e] = 0.f; g1[e] = 0.f; a2[e] = 0.f; a1[e] = 0.f; } }
            else { unpack8(*(const u32x4*)(pm2 + col), g2); unpack8(*(const u32x4*)(pm2 + FF + col), a2); unpack8(*(const u32x4*)(pm1 + col), g1); unpack8(*(const u32x4*)(pm1 + FF + col), a1); }
            unpack8(*(const u32x4*)(own0 + col), g0); unpack8(*(const u32x4*)(own0 + FF + col), a0);
        } else {
            if (seqstart) {
#pragma unroll
                for (int e = 0; e < 8; ++e) { g2[e] = 0.f; a2[e] = 0.f; } }
            else { unpack8(*(const u32x4*)(pm1 + col), g2); unpack8(*(const u32x4*)(pm1 + FF + col), a2); }
            unpack8(*(const u32x4*)(own0 + col), g1); unpack8(*(const u32x4*)(own0 + FF + col), a1);
            unpack8(*(const u32x4*)(own1 + col), g0); unpack8(*(const u32x4*)(own1 + FF + col), a0);
        }
        float wg[3][8], wa[3][8];
#pragma unroll
        for (int j = 0; j < 3; ++j) { ld8f(cw + j * FF2 + col, wg[j]); ld8f(cw + j * FF2 + FF + col, wa[j]); }
        float o[8];
#pragma unroll
        for (int e = 0; e < 8; ++e) { const float cgv = wg[0][e] * g2[e] + wg[1][e] * g1[e] + wg[2][e] * g0[e], cav = wa[0][e] * a2[e] + wa[1][e] * a1[e] + wa[2][e] * a0[e]; o[e] = cgv * sigmoidf_(cgv) * cav; }
        *(u32x4*)(ACT + (size_t)(hh * 128 + rr) * FF + col) = (u32x4){pk2(o[0], o[1]), pk2(o[2], o[3]), pk2(o[4], o[5]), pk2(o[6], o[7])};
    }
    for (int idx = obid() * NTHR + otid(); idx < 4 * (FF2 / 8); idx += gridDim.x * NTHR) { const int br = idx / (FF2 / 8), c = (idx - br * (FF2 / 8)) * 8, b = br >> 1, r = br & 1;
        float v[8]; unpack8(*(const u32x4*)(UB + (size_t)((64 * b + 63) * 4 + 2 + r) * FF2 + c), v);
        st8f(p.out + O_PFFN + ((size_t)(l * 2 + b) * 2 + r) * FF2 + c, v); }
}

#define XB_TMO      128
#define XB_XCNT(j)  (256  + 64 * (j))
#define XB_XSUB(j)  (1280 + 64 * (j))
#define XB_XGEN(j)  (2304 + 64 * (j))
#define XB_TOP      3328
#define XB_TOPGEN   3392
#define XCD_BAR_WORDS 3456
#define XB_SPIN_CAP (1u << 18)

__device__ __forceinline__ unsigned xb_ld(unsigned* p)              { return __hip_atomic_load(p, __ATOMIC_RELAXED, __HIP_MEMORY_SCOPE_AGENT); }
__device__ __forceinline__ unsigned xb_add(unsigned* p, unsigned v) { return __hip_atomic_fetch_add(p, v, __ATOMIC_RELAXED, __HIP_MEMORY_SCOPE_AGENT); }
__device__ __forceinline__ unsigned xb_xcc_id() { return (unsigned)__builtin_amdgcn_s_getreg((3 << 11) | 20) & 0xFu; }
#define XB_SPIN(cond, bar) do { unsigned _sp = 0; while (cond) { __builtin_amdgcn_s_sleep(1); \
    if ((++_sp & 255u) == 0u) { if (xb_ld(&(bar)[XB_TMO])) break; if (_sp > XB_SPIN_CAP) { atomicAdd(&(bar)[XB_TMO], 1u); break; } } } } while (0)

struct XcdBarrier {
    unsigned* bar; unsigned x;
    volatile LAS unsigned* st;
};

__device__ __forceinline__ XcdBarrier xcd_barrier_post(unsigned* bar, volatile LAS unsigned* st) {
    XcdBarrier b; b.bar = bar; b.x = xb_xcc_id(); b.st = st;
    if (threadIdx.x == 0) (void)xb_add(&bar[XB_XCNT(b.x)], 1u);
    return b;
}
__device__ __forceinline__ void xcd_barrier_complete(unsigned* bar, unsigned x, unsigned& nloc, unsigned& nx) {
    const unsigned G = gridDim.x * gridDim.y * gridDim.z;
    unsigned sum, cnt, mine, sp = 0u;
    for (;;) {
        sum = 0u; cnt = 0u; mine = 0u;
#pragma unroll
        for (unsigned j = 0; j < 16; ++j) { const unsigned c = xb_ld(&bar[XB_XCNT(j)]); sum += c; cnt += (c > 0u) ? 1u : 0u; mine = (j == x) ? c : mine; }
        if (sum == G) break;
        __builtin_amdgcn_s_sleep(1);
        if ((++sp & 255u) == 0u) { if (xb_ld(&bar[XB_TMO])) break; if (sp > XB_SPIN_CAP) { atomicAdd(&bar[XB_TMO], 1u); break; } }
    }
    nloc = mine > 0u ? mine : 1u; nx = cnt > 0u ? cnt : 1u;
}

__device__ __forceinline__ void xcd_barrier(const XcdBarrier& b) {
    asm volatile("s_waitcnt vmcnt(0)" ::: "memory");
    __syncthreads();
    if (threadIdx.x == 0) {
        unsigned* bar = b.bar;
        __builtin_amdgcn_s_waitcnt(0);
        unsigned nloc = b.st[0], nx = b.st[1];
        if (nloc == 0u) { xcd_barrier_complete(bar, b.x, nloc, nx); b.st[0] = nloc; b.st[1] = nx; }
        const unsigned old = xb_add(&bar[XB_XSUB(b.x)], 1u);
        const unsigned gen = old / nloc;
        if (old + 1u == (gen + 1u) * nloc) {
            __builtin_amdgcn_fence(__ATOMIC_RELEASE, "agent");
            asm volatile("s_waitcnt vmcnt(0)" ::: "memory");
            const unsigned og = xb_add(&bar[XB_TOP], 1u);
            const unsigned tg = og / nx;
            if (og + 1u == (tg + 1u) * nx) xb_add(&bar[XB_TOPGEN], 1u);
            else XB_SPIN(xb_ld(&bar[XB_TOPGEN]) == tg, bar);
            __builtin_amdgcn_fence(__ATOMIC_ACQUIRE, "agent");
            xb_add(&bar[XB_XGEN(b.x)], 1u);
            asm volatile("s_waitcnt vmcnt(0)" ::: "memory");
        } else {
            XB_SPIN(xb_ld(&bar[XB_XGEN(b.x)]) == gen, bar);
            __builtin_amdgcn_fence(__ATOMIC_ACQUIRE, "agent");
            asm volatile("s_waitcnt vmcnt(0)" ::: "memory");
        }
    }
    __syncthreads();
}

__global__ void __launch_bounds__(NTHR, 2) mega(Params p) {
    extern __shared__ __attribute__((aligned(16))) unsigned char lds[];
    cg::grid_group grid = cg::this_grid();
    unsigned char* ws = p.ws;
    volatile LAS unsigned* bst = (volatile LAS unsigned*)((LAS unsigned char*)lds + 147392);
    if (threadIdx.x < 2) bst[threadIdx.x] = 0u;
    __syncthreads();
    XcdBarrier bar; bar.bar = (unsigned*)ws; bar.x = 0; bar.st = bst;
    if (p.hi - p.lo > 1) bar = xcd_barrier_post((unsigned*)ws, bst);
    for (int step = p.lo; step < p.hi; ++step) {
        int nrep = 1; bool skip = false;
        if (step == 0) nrep += (PROBE_PRE & 1); else if (step == 1) nrep += (PROBE_PRE >> 1) & 1; else { const int l_ = (step - 2) / 10, st_ = (step - 2) % 10; nrep += (((l_ & 1) ? PROBE_ODD : PROBE_EVEN) >> st_) & 1; }
        for (int rep = 0; rep < nrep; ++rep) {
            if (PROBE_BAR == 2 && rep > 0) xcd_barrier(bar);
        if (step == 0) prologue(p, lds);
        else if (step == 1) {
            pg8::Gemm g{(const pg8::bf16_t*)(ws + WS_AC), (const pg8::bf16_t*)(ws + WS_ZU), 256, MODW, DM}; pg8::StaticOrder S; S.init(256, MODW, gridDim.x, obid());
            EpiMod E{(float*)(ws + WS_MOD), p.in[14]};
            pg8::gemm_phase<EpiMod, pg8::StaticOrder, true, true>((PG8_LAS unsigned char*)lds, g, S, E);
        } else {
            const int l = (step - 2) / 10, st = (step - 2) % 10; const bool even = !(l & 1); const int i = l >> 1;
            if (st == 0) norm_phase(p, l, 1, lds);
            else if (st == 6) norm_phase(p, l, 2, lds);
            else if (st == 1 || st == 5 || st == 7 || st == 9) {
                pg8::Gemm g; EpiMain E; E.X = p.out; E.O = (bf16*)(ws + WS_ZU); E.gate = nullptr; E.ldc = 0; E.mode = 0; E.cw = nullptr; E.stp = nullptr; E.sout = nullptr; E.qn = nullptr; E.kn = nullptr; E.lyr = i; E.wsb = ws;
                if (st == 1) { g.A = (const pg8::bf16_t*)(ws + WS_H); g.M = R; g.K = DM;
                    if (even) { g.Bt = (const pg8::bf16_t*)(ws + WS_WIN) + (size_t)i * ZW * DM; g.N = ZW; E.ldc = ZW; } else { g.Bt = (const pg8::bf16_t*)(ws + WS_WQKV) + (size_t)i * QKVW * DM; g.N = QKVW; E.ldc = QKVW; E.mode = 3;
                        E.qn = p.in[21] + i * 64; E.kn = p.in[22] + i * 64; } }
                else if (st == 5) { g.A = (const pg8::bf16_t*)(ws + WS_CAT); g.M = RP; g.K = DM; g.N = DM; g.Bt = (const pg8::bf16_t*)(ws + (even ? WS_WAO : WS_WCO)) + (size_t)i * DM * DM;
                    E.mode = 1; E.gate = (const float*)(ws + WS_MOD) + l * 6144 + 2048; }
                else if (st == 7) { g.A = (const pg8::bf16_t*)(ws + WS_H); g.M = R; g.K = DM; g.N = FF2; g.Bt = (const pg8::bf16_t*)(ws + WS_WUP) + (size_t)l * FF2 * DM; E.mode = 2;
                    E.cw = p.in[26] + (size_t)l * 3 * FF2; E.stp = p.in[10] + (size_t)l * 128 * 2 * FF2; E.sout = p.out + O_SFFN + (size_t)l * 128 * 2 * FF2; }
                else { g.A = (const pg8::bf16_t*)(ws + WS_ACT); g.M = RP; g.K = FF; g.N = DM; g.Bt = (const pg8::bf16_t*)(ws + WS_WDN) + (size_t)l * DM * FF; E.mode = 1; E.gate = (const float*)(ws + WS_MOD) + l * 6144 + 5120; }
                if (rep > 0 && E.mode == 1) { E.mode = 0; E.O = (bf16*)(ws + WS_H); E.ldc = DM; }
                if (rep > 0 && E.mode == 1) { E.mode = 0; E.O = (bf16*)(ws + WS_H); E.ldc = DM; }
                pg8::StaticOrder S; S.init(g.M, g.N, gridDim.x, obid());
                pg8::gemm_phase<EpiMain, pg8::StaticOrder, true, true>((PG8_LAS unsigned char*)lds, g, S, E);
                if (E.mode == 3 && rep == 0) { const int G_ = gridDim.x, n2 = S.nwg - G_;
                    if (n2 > 0 && n2 < G_) { if (obid() >= n2) cache_shift(p, i, obid() - n2, G_ - n2); } else cache_shift(p, i, obid(), G_); }
                if (E.mode == 1) mini_gemm((const bf16*)g.A, (const bf16*)g.Bt, g.K, p.out, E.gate, lds);
            }
            else if (st == 2) {
                if (even) { const int G_ = gridDim.x; int il = obid(), is = obid();
                    for (int k = 0; il < 1024 || is < 512; ++k) { const bool do_s = (is < 512) && ((k & 1) || il >= 1024);
                        if (do_s) { mlstm_sample(p, i, is, lds); is += G_; } else { mlstm_local(p, i, il, lds); il += G_; } }
                    shortconv(p, i); }
                else { skip = true; continue; }
            }
            else if (st == 3) { if (even) mlstm_scan(p, i); else attn_phase(p, i, lds); }
            else if (st == 4) { if (!even) { skip = true; continue; } for (int it = obid(); it < 1024; it += 2 * gridDim.x) mlstm_out2(p, i, it, it + gridDim.x, lds); }
            else if (st == 8) ffnfix_phase(p, l);
        }
        }
        if (skip) continue;
        if (step + 1 < p.hi) { if (step == 0) grid.sync(); else { xcd_barrier(bar); if (PROBE_BAR == 1) xcd_barrier(bar); } }
    }
}

#ifndef NLAUNCH_MODE
#define NLAUNCH_MODE 1
#endif
extern "C" void kernel_launch(void* const* d_in, const int* in_sizes, int n_in, void* d_out, int out_size, void* d_ws, size_t ws_size, hipStream_t stream) {
    static int grid = 0;
    if (grid == 0) {
        if (n_in != 28 || (size_t)out_size != O_END || ws_size < WS_END) { fprintf(stderr, "kernel_launch: unexpected shapes: n_in %d out %d ws %zu\n", n_in, out_size, ws_size); grid = -1; return; }
        int dev = 0, cus = 0, per_cu = 0;
        hipGetDevice(&dev); hipDeviceGetAttribute(&cus, hipDeviceAttributeMultiprocessorCount, dev);
        if (hipFuncSetAttribute((const void*)mega, hipFuncAttributeMaxDynamicSharedMemorySize, LDS_BYTES) != hipSuccess) { fprintf(stderr, "kernel_launch: hipFuncSetAttribute failed\n"); grid = -1; return; }
        if (hipOccupancyMaxActiveBlocksPerMultiprocessor(&per_cu, (const void*)mega, NTHR, LDS_BYTES) != hipSuccess || per_cu < 1) { fprintf(stderr, "kernel_launch: occupancy query says %d\n", per_cu); per_cu = 1; }
        (void)hipGetLastError();
        grid = cus * 1;
    }
    if (grid < 0) return;
    Params p{};
    for (int k = 0; k < 28; ++k) p.in[k] = (const float*)d_in[k];
    p.out = (float*)d_out; p.ws = (unsigned char*)d_ws;
    const int NSTEPS = 42;
    if (hipMemsetAsync(d_ws, 0, 16384, stream) != hipSuccess) { fprintf(stderr, "memset failed\n"); return; }
#if NLAUNCH_MODE == 1
    p.lo = 0; p.hi = NSTEPS;
    void* args[] = {&p};
    hipError_t e = hipLaunchCooperativeKernel((const void*)mega, dim3(grid), dim3(NTHR), args, LDS_BYTES, stream);
    if (e != hipSuccess) fprintf(stderr, "cooperative launch failed: %s (grid %d)\n", hipGetErrorString(e), grid);
#else
    for (int s = 0; s < NSTEPS; ++s) { if (s >= 2 && ((s - 2) % 10) == 4 && (((s - 2) / 10) & 1)) continue; p.lo = s; p.hi = s + 1; hipLaunchKernelGGL(mega, dim3(grid), dim3(NTHR), LDS_BYTES, stream, p); }
#endif
}
```

```cpp
#include <hip/hip_runtime.h>
#include <hip/hip_cooperative_groups.h>
#include <cstdio>
#include <cstdint>
namespace cg = cooperative_groups;
__device__ __forceinline__ int otid() { int t = threadIdx.x; asm volatile("" : "+v"(t)); return t; }
__device__ __forceinline__ int obid() { int b = blockIdx.x; asm volatile("" : "+s"(b)); return b; }
__device__ __forceinline__ float shx(float v, int o) { const int l = otid() & 63; return __builtin_bit_cast(float, __builtin_amdgcn_ds_bpermute((l ^ o) << 2, __builtin_bit_cast(int, v))); }
__device__ __forceinline__ float shi(float v, int src) { return __builtin_bit_cast(float, __builtin_amdgcn_ds_bpermute(src << 2, __builtin_bit_cast(int, v))); }
__device__ __forceinline__ float shup(float v, int o) { const int l = otid() & 63; const int src = l >= o ? l - o : l; return __builtin_bit_cast(float, __builtin_amdgcn_ds_bpermute(src << 2, __builtin_bit_cast(int, v))); }
namespace pg8 {
#define PG8_LAS __attribute__((address_space(3)))
typedef unsigned short bf16_t;
typedef short bf16x8 __attribute__((ext_vector_type(8)));
typedef float f32x4 __attribute__((ext_vector_type(4)));
typedef unsigned u32x4 __attribute__((ext_vector_type(4)));
constexpr int BM = 256, BK = 64, HALF = 128, HTB = HALF * BK * 2  , STAGE_BYTES = 8 * HTB, NXCD = 8, WGM = 8;

__host__ __device__ __forceinline__ int lds_byte(int r, int c) { const int st = (r >> 4) * 2 + (c >> 5), rr = r & 15, cc = c & 31, ob = rr * 64 + cc * 2; return st * 1024 + (ob ^ (((ob >> 9) & 1) << 5)); }
__host__ __device__ __forceinline__ void stage_rc(int b, int& R, int& C) { const int st = b / 1024, sb = b % 1024, swz = sb ^ (((sb >> 9) & 1) << 5); R = (st >> 1) * 16 + swz / 64; C = (st & 1) * 32 + (swz % 64) / 2; }
__host__ __device__ __forceinline__ int perm32(int rho) { const int n = rho >> 4, i = rho & 15; return 8 * (i >> 2) + 4 * n + (i & 3); }

struct Unit { int pm, pn; };
struct Gemm { const bf16_t* A; const bf16_t* Bt; int M, N, K; };

struct StaticOrder {
    int nM, nN, nwg, G, c;
    __host__ __device__ void init(int M, int N, int G_, int c_) { nM = M / BM; nN = N / BM; nwg = nM * nN; G = G_; c = c_; }
    __host__ __device__ bool next(int i, Unit& u) const {
        const long L = (long)i * G + c; if (L >= nwg) return false;
        int wgid = (int)L; { const int q = nwg / NXCD, r = nwg % NXCD, xcd = wgid % NXCD, off = wgid / NXCD; wgid = (xcd < r ? xcd * (q + 1) : r * (q + 1) + (xcd - r) * q) + off; }
        const int nig = WGM * nN, gid = wgid / nig, fm = gid * WGM, gsz = (nM - fm) < WGM ? (nM - fm) : WGM;
        u.pm = fm + ((wgid % nig) % gsz); u.pn = (wgid % nig) / gsz; return true;
    }
    __device__ __forceinline__ void a_ready(const Unit&) const {}
    __device__ __forceinline__ void done(const Unit&) const {}
};

__device__ __forceinline__ unsigned cvt_pk_bf16(float lo, float hi) { unsigned r; asm volatile("v_cvt_pk_bf16_f32 %0, %1, %2" : "=v"(r) : "v"(lo), "v"(hi)); return r; }
template <class Epi, class Sched, bool ALIGN_EPI = false, bool SP2 = false>
__device__ __forceinline__ void gemm_phase(PG8_LAS unsigned char* lds, const Gemm g, const Sched& S, const Epi& E) {
    const int tid = otid(), wid = __builtin_amdgcn_readfirstlane(tid >> 6), lane = tid & 63, wr = wid >> 2, wc = wid & 3, fr = lane & 15, fq = lane >> 4;
    const int K = g.K, nt = K / BK;
    unsigned voffA[2], voffB[2];
#pragma unroll
    for (int i = 0; i < 2; ++i) { int R, C; stage_rc(tid * 16 + i * 8192, R, C); const int Rb = Epi::PERM ? ((R & ~31) + perm32(R & 31)) : R;
        const int Ra = 8 * (16 * (R >> 6) + (R & 15)) + ((R >> 4) & 3);
        voffA[i] = (unsigned)(Ra * K + C) * 2u; voffB[i] = (unsigned)(Rb * K + C) * 2u; }
    const size_t kstep = (size_t)(BK * 2);
    const size_t hstep = (size_t)HALF * K * 2;
    const size_t hstepA = (size_t)4 * K * 2;
    const size_t tstep = 2 * hstep;
    const unsigned ldsw = (unsigned)wid * 1024u;
    const int aoff = lds_byte(wr * 64 + fr, fq * 8), boff = lds_byte(wc * 32 + fr, fq * 8);
#define PG8_SA(b, h) (((b) * 2 + (h)) * HTB)
#define PG8_SB(b, h) ((4 + (b) * 2 + (h)) * HTB)
#define PG8_STAGE(bufoff, gbase, voff) do { _Pragma("unroll") for (int _i = 0; _i < 2; ++_i) \
        __builtin_amdgcn_global_load_lds((const unsigned*)((const char*)(gbase) + (voff)[_i]), (PG8_LAS unsigned*)(lds + (bufoff) + ldsw + _i * 8192), 16, 0, 0); } while (0)
#define PG8_LDA(dst, b, h) do { _Pragma("unroll") for (int m = 0; m < 4; ++m) _Pragma("unroll") for (int k = 0; k < 2; ++k) dst[m][k] = *(const PG8_LAS bf16x8*)(lds + PG8_SA(b, h) + aoff + m * 2048 + k * 1024); } while (0)
#define PG8_LDB(dst, b, h) do { _Pragma("unroll") for (int n = 0; n < 2; ++n) _Pragma("unroll") for (int k = 0; k < 2; ++k) dst[n][k] = *(const PG8_LAS bf16x8*)(lds + PG8_SB(b, h) + boff + n * 2048 + k * 1024); } while (0)
#define PG8_MMA(ai, bj, At, Bt) do { __builtin_amdgcn_s_setprio(1); _Pragma("unroll") for (int m = 0; m < 4; ++m) _Pragma("unroll") for (int n = 0; n < 2; ++n) _Pragma("unroll") for (int k = 0; k < 2; ++k) \
        acc[ai][bj][m][n] = __builtin_amdgcn_mfma_f32_16x16x32_bf16(Bt[n][k], At[m][k], acc[ai][bj][m][n], 0, 0, 0); __builtin_amdgcn_s_setprio(0); } while (0)
#define PG8_WAIT_V(n) asm volatile("s_waitcnt vmcnt(" #n ")" ::: "memory")
#define PG8_WAIT_L(n) asm volatile("s_waitcnt lgkmcnt(" #n ")" ::: "memory")
#define PG8_BAR __builtin_amdgcn_s_barrier()
#define PG8_SCHED __builtin_amdgcn_sched_barrier(0)
    Unit cur, nxt; int ui = 0;
    if (!S.next(0, cur)) return;
    f32x4 acc[2][2][4][2];
#pragma unroll
    for (int a = 0; a < 2; ++a)
#pragma unroll
        for (int b = 0; b < 2; ++b)
#pragma unroll
            for (int m = 0; m < 4; ++m)
#pragma unroll
                for (int n = 0; n < 2; ++n) acc[a][b][m][n] = (f32x4){0.f, 0.f, 0.f, 0.f};
    bf16x8 At[4][2], B0[2][2], B1[2][2];
    const char* cA = (const char*)g.A + (size_t)cur.pm * tstep; const char* cB = (const char*)g.Bt + (size_t)cur.pn * tstep;
    S.a_ready(cur);
    if constexpr (SP2) {
        PG8_STAGE(PG8_SB(0, 0), cB, voffB); PG8_STAGE(PG8_SB(0, 1), cB + hstep, voffB); PG8_STAGE(PG8_SA(0, 0), cA, voffA); PG8_STAGE(PG8_SA(0, 1), cA + hstepA, voffA);
        if (wr == 1) PG8_BAR;
        PG8_WAIT_V(2); PG8_BAR;
        PG8_STAGE(PG8_SB(1, 0), cB + kstep, voffB); PG8_STAGE(PG8_SA(1, 0), cA + kstep, voffA); PG8_STAGE(PG8_SB(1, 1), cB + hstep + kstep, voffB);
        PG8_WAIT_V(6); PG8_BAR;
    } else {
        PG8_STAGE(PG8_SB(0, 0), cB, voffB); PG8_STAGE(PG8_SA(0, 0), cA, voffA); PG8_STAGE(PG8_SB(0, 1), cB + hstep, voffB); PG8_STAGE(PG8_SA(0, 1), cA + hstepA, voffA);
        if (wr == 1) PG8_BAR;
        PG8_WAIT_V(4); PG8_BAR;
        PG8_STAGE(PG8_SB(1, 0), cB + kstep, voffB); PG8_STAGE(PG8_SA(1, 0), cA + kstep, voffA); PG8_STAGE(PG8_SB(1, 1), cB + hstep + kstep, voffB);
        PG8_WAIT_V(6); PG8_BAR;
    }
    for (;;) {
        const bool has_next = S.next(ui + 1, nxt);
        const char* nA = has_next ? (const char*)g.A + (size_t)nxt.pm * tstep : cA; const char* nB = has_next ? (const char*)g.Bt + (size_t)nxt.pn * tstep : cB;
        for (int t = 0; t < nt; t += 2) {
            const bool last = (t == nt - 2);
            const char* a1 = cA + (size_t)(t + 1) * kstep;
            const char* a2 = last ? nA : cA + (size_t)(t + 2) * kstep; const char* b2 = last ? nB : cB + (size_t)(t + 2) * kstep;
            const char* a3 = a2 + kstep; const char* b3 = b2 + kstep;
            if (last && has_next) S.a_ready(nxt);
            if constexpr (SP2) {
            PG8_LDB(B0, 0, 0); PG8_LDB(B1, 0, 1); PG8_SCHED; PG8_LDA(At, 0, 0); PG8_STAGE(PG8_SA(1, 1), a1 + hstepA, voffA);
            PG8_WAIT_V(8); PG8_WAIT_L(0); PG8_BAR; PG8_MMA(0, 0, At, B0); PG8_MMA(0, 1, At, B1); PG8_BAR; PG8_SCHED;
            PG8_LDA(At, 0, 1); PG8_STAGE(PG8_SB(0, 0), b2, voffB); PG8_STAGE(PG8_SB(0, 1), b2 + hstep, voffB); PG8_STAGE(PG8_SA(0, 0), a2, voffA);
            PG8_WAIT_V(8); PG8_WAIT_L(0); PG8_BAR; PG8_MMA(1, 0, At, B0); PG8_MMA(1, 1, At, B1); PG8_BAR; PG8_SCHED;
            PG8_LDB(B0, 1, 0); PG8_LDB(B1, 1, 1); PG8_SCHED; PG8_LDA(At, 1, 0); PG8_STAGE(PG8_SA(0, 1), a2 + hstepA, voffA);
            PG8_WAIT_V(8); PG8_WAIT_L(0); PG8_BAR; PG8_MMA(0, 0, At, B0); PG8_MMA(0, 1, At, B1); PG8_BAR; PG8_SCHED;
            PG8_LDA(At, 1, 1); PG8_STAGE(PG8_SB(1, 0), b3, voffB); PG8_STAGE(PG8_SB(1, 1), b3 + hstep, voffB); PG8_STAGE(PG8_SA(1, 0), a3, voffA);
            PG8_WAIT_V(8); PG8_WAIT_L(0); PG8_BAR; PG8_MMA(1, 0, At, B0); PG8_MMA(1, 1, At, B1); PG8_BAR; PG8_SCHED;
            } else {
            PG8_LDB(B0, 0, 0); PG8_SCHED; PG8_LDA(At, 0, 0); PG8_STAGE(PG8_SA(1, 1), a1 + hstepA, voffA);
            PG8_WAIT_L(8); PG8_BAR; PG8_WAIT_L(0); PG8_MMA(0, 0, At, B0); PG8_BAR; PG8_SCHED;
            PG8_LDB(B1, 0, 1); PG8_STAGE(PG8_SB(0, 0), b2, voffB);
            PG8_BAR; PG8_WAIT_L(0); PG8_MMA(0, 1, At, B1); PG8_BAR;
            PG8_LDA(At, 0, 1); PG8_STAGE(PG8_SA(0, 0), a2, voffA);
            PG8_BAR; PG8_WAIT_L(0); PG8_MMA(1, 0, At, B0); PG8_BAR; PG8_SCHED;
            PG8_STAGE(PG8_SB(0, 1), b2 + hstep, voffB);
            PG8_WAIT_V(6); PG8_BAR; PG8_MMA(1, 1, At, B1); PG8_BAR;
            PG8_LDB(B0, 1, 0); PG8_SCHED; PG8_LDA(At, 1, 0); PG8_STAGE(PG8_SA(0, 1), a2 + hstepA, voffA);
            PG8_WAIT_L(8); PG8_BAR; PG8_WAIT_L(0); PG8_MMA(0, 0, At, B0); PG8_BAR; PG8_SCHED;
            PG8_LDB(B1, 1, 1); PG8_STAGE(PG8_SB(1, 0), b3, voffB);
            PG8_BAR; PG8_WAIT_L(0); PG8_MMA(0, 1, At, B1); PG8_BAR;
            PG8_LDA(At, 1, 1); PG8_STAGE(PG8_SA(1, 0), a3, voffA);
            PG8_BAR; PG8_WAIT_L(0); PG8_MMA(1, 0, At, B0); PG8_BAR; PG8_SCHED;
            PG8_STAGE(PG8_SB(1, 1), b3 + hstep, voffB);
            PG8_WAIT_V(6); PG8_BAR; PG8_MMA(1, 1, At, B1); PG8_BAR;
            }
        }
        if constexpr (ALIGN_EPI) { if (wr == 0) PG8_BAR; }
        if constexpr (!Epi::AFTER_DRAIN) { E(acc, cur, wr, wc, fr, fq); S.done(cur); }
        if (!has_next) break;
#pragma unroll
        for (int a = 0; a < 2; ++a)
#pragma unroll
            for (int b = 0; b < 2; ++b)
#pragma unroll
                for (int m = 0; m < 4; ++m)
#pragma unroll
                    for (int n = 0; n < 2; ++n) acc[a][b][m][n] = (f32x4){0.f, 0.f, 0.f, 0.f};
        cur = nxt; cA = nA; cB = nB; ++ui;
        if constexpr (ALIGN_EPI) { if (wr == 1) PG8_BAR; }
    }
    PG8_WAIT_V(0);
    if constexpr (!ALIGN_EPI) { if (wr == 0) PG8_BAR; }
    PG8_BAR;
    if constexpr (Epi::AFTER_DRAIN) { E.fused(acc, cur, wr, wc, fr, fq, lds, wid, lane); S.done(cur); }
#undef PG8_SA
#undef PG8_SB
#undef PG8_STAGE
#undef PG8_LDA
#undef PG8_LDB
#undef PG8_MMA
#undef PG8_WAIT_V
#undef PG8_WAIT_L
#undef PG8_BAR
#undef PG8_SCHED
}
}

typedef unsigned short bf16;
typedef float f32x4 __attribute__((ext_vector_type(4)));
typedef float f32x2 __attribute__((ext_vector_type(2)));
typedef unsigned u32x4 __attribute__((ext_vector_type(4)));
typedef unsigned u32x2 __attribute__((ext_vector_type(2)));
typedef short bf16x8 __attribute__((ext_vector_type(8)));

constexpr int R = 17408, RP = 16384, NSEQ = 130, SEQL = 8192;
constexpr int DM = 1024, INA = 3592, ZW = 3584, QKVW = 1536, FF = 2816, FF2 = 5632, MODW = 24576;
constexpr float EPS = 1e-6f;
constexpr int NWAVES = 8, NTHR = 512;
constexpr int LDS_BYTES = 147456;

constexpr size_t O_Y = 0;
constexpr size_t O_PC = (size_t)R * 1024;
constexpr size_t O_PN = O_PC + 262144;
constexpr size_t O_PM = O_PN + 2048;
constexpr size_t O_PSC = O_PM + 16;
constexpr size_t O_PWK = O_PSC + 4096;
constexpr size_t O_PWV = O_PWK + 131072;
constexpr size_t O_PFFN = O_PWV + 131072;
constexpr size_t O_SC = O_PFFN + 90112;
constexpr size_t O_SN = O_SC + 16777216;
constexpr size_t O_SM = O_SN + 131072;
constexpr size_t O_SSC = O_SM + 1024;
constexpr size_t O_SWK = O_SSC + 262144;
constexpr size_t O_SWV = O_SWK + 8388608;
constexpr size_t O_SFFN = O_SWV + 8388608;
constexpr size_t O_END = O_SFFN + 5767168;

constexpr size_t MiB = 1u << 20;
constexpr size_t WS_WIN = 1 * MiB, WS_WAO = 15 * MiB, WS_WQKV = 19 * MiB, WS_WCO = 25 * MiB, WS_WUP = 29 * MiB, WS_WDN = 73 * MiB;
constexpr size_t WS_AC = 95 * MiB, WS_MOD = 96 * MiB, WS_TAB = 109 * MiB, WS_H = 112 * MiB, WS_CAT = 146 * MiB, WS_GATES = 180 * MiB;
constexpr size_t WS_ZU = 181 * MiB;
constexpr size_t WS_ACT = 368 * MiB;
constexpr size_t WS_DCT = WS_ACT, WS_CST = WS_ACT + 64 * MiB, WS_NS = WS_ACT + 96 * MiB, WS_DN = WS_NS + MiB / 2, WS_CS = WS_NS + MiB, WS_MS = WS_CS + 65536;
constexpr size_t WS_UB = 466 * MiB;
constexpr size_t WS_END = 472 * MiB;

__constant__ double ROPE_INV[32] = {1.0, 0.7498942093324559, 0.5623413251903491, 0.4216965034285822, 0.31622776601683794, 0.23713737056616552, 0.1778279410038923, 0.1333521432163324, 0.1, 0.07498942093324558, 0.05623413251903491, 0.042169650342858224, 0.03162277660168379, 0.023713737056616554, 0.01778279410038923, 0.01333521432163324, 0.01, 0.007498942093324558, 0.005623413251903491, 0.004216965034285823, 0.0031622776601683794, 0.0023713737056616554, 0.0017782794100389228, 0.001333521432163324, 0.001, 0.0007498942093324559, 0.0005623413251903491, 0.00042169650342858224, 0.00031622776601683794, 0.00023713737056616554, 0.00017782794100389227, 0.0001333521432163324};
#ifndef PROBE_PRE
#define PROBE_PRE 0
#define PROBE_EVEN 0
#define PROBE_ODD 0
#endif
#ifndef PROBE_BAR
#define PROBE_BAR 0
#endif
struct Params { const float* in[28]; float* out; unsigned char* ws; int lo, hi; };

__device__ __forceinline__ unsigned f2bf(float f) { unsigned u = __builtin_bit_cast(unsigned, f); return (u + 0x7fffu + ((u >> 16) & 1u)) >> 16; }
__device__ __forceinline__ unsigned pk2(float lo, float hi) { unsigned r; asm("v_cvt_pk_bf16_f32 %0, %1, %2" : "=v"(r) : "v"(lo), "v"(hi)); return r; }
__device__ __forceinline__ unsigned pk2_sw(float lo, float hi) { return f2bf(lo) | (f2bf(hi) << 16); }
__device__ __forceinline__ float bf2f(unsigned h) { return __builtin_bit_cast(float, h << 16); }
__device__ __forceinline__ float bflo(unsigned w) { return __builtin_bit_cast(float, w << 16); }
__device__ __forceinline__ float bfhi(unsigned w) { return __builtin_bit_cast(float, w & 0xffff0000u); }
template <int CTRL> __device__ __forceinline__ float dppf(float x) { return __builtin_bit_cast(float, __builtin_amdgcn_mov_dpp(__builtin_bit_cast(int, x), CTRL, 0xF, 0xF, true)); }
__device__ __forceinline__ float rdl(float x, int l) { return __builtin_bit_cast(float, __builtin_amdgcn_readlane(__builtin_bit_cast(int, x), l)); }
__device__ __forceinline__ float wave_sum(float v) {
    v += dppf<0xB1>(v); v += dppf<0x4E>(v); v += dppf<0x141>(v); v += dppf<0x140>(v);
    return (rdl(v, 0) + rdl(v, 16)) + (rdl(v, 32) + rdl(v, 48));
}
__device__ __forceinline__ float wave_max(float v) {
    v = fmaxf(v, dppf<0xB1>(v)); v = fmaxf(v, dppf<0x4E>(v)); v = fmaxf(v, dppf<0x141>(v)); v = fmaxf(v, dppf<0x140>(v));
    return fmaxf(fmaxf(rdl(v, 0), rdl(v, 16)), fmaxf(rdl(v, 32), rdl(v, 48)));
}
__device__ __forceinline__ float logsigmoidf(float f) { return fminf(f, 0.f) - log1pf(__expf(-fabsf(f))); }
__device__ __forceinline__ float sigmoidf_(float x) { return __builtin_amdgcn_rcpf(1.f + __builtin_amdgcn_exp2f(x * -1.4426950408889634f)); }
__device__ __forceinline__ int seq_of(int row) { return row < RP ? (row >> 13) : 2 + ((row - RP) >> 3); }
#define LAS __attribute__((address_space(3)))
#define LDS_WAIT() asm volatile("s_waitcnt lgkmcnt(0)" ::: "memory")

__device__ __forceinline__ float dpp_shr1f(float x) { return __builtin_bit_cast(float, __builtin_amdgcn_mov_dpp(__builtin_bit_cast(int, x), 0x111, 0xF, 0xF, false)); }
__device__ __forceinline__ f32x4 dpp_shr1(const f32x4 v) { f32x4 r; r.x = dpp_shr1f(v.x); r.y = dpp_shr1f(v.y); r.z = dpp_shr1f(v.z); r.w = dpp_shr1f(v.w); return r; }
struct EpiMain {
    static constexpr bool PERM = true, AFTER_DRAIN = false;
    int mode;
    bf16* O; int ldc; float* X; const float* gate;
    const float* qn; const float* kn; int lyr; unsigned char* wsb;
    const float* cw; const float* stp; float* sout;
    __device__ __forceinline__ void operator()(const pg8::f32x4 (&acc)[2][2][4][2], const pg8::Unit& u, int wr, int wc, int fr, int fq) const {
        const int rowb = u.pm * 256 + 8 * (16 * wr + fr), col0 = u.pn * 256 + wc * 32 + 8 * fq;
        if (mode == 0) {
#pragma unroll
            for (int ai = 0; ai < 2; ++ai)
#pragma unroll
                for (int m = 0; m < 4; ++m) { bf16* rowp = O + (size_t)(rowb + 4 * ai + m) * ldc + col0;
#pragma unroll
                    for (int bj = 0; bj < 2; ++bj) { const pg8::f32x4 v0 = acc[ai][bj][m][0], v1 = acc[ai][bj][m][1]; u32x4 w;
                        w.x = pg8::cvt_pk_bf16(v0[0], v0[1]); w.y = pg8::cvt_pk_bf16(v0[2], v0[3]); w.z = pg8::cvt_pk_bf16(v1[0], v1[1]); w.w = pg8::cvt_pk_bf16(v1[2], v1[3]);
                        *(u32x4*)(rowp + bj * 128) = w; } }
        } else if (mode == 1) {
            f32x4 gv[2][2];
            { const float* gp = gate + (size_t)(u.pm >> 5) * MODW + col0;
#pragma unroll
              for (int bj = 0; bj < 2; ++bj)
#pragma unroll
                  for (int n = 0; n < 2; ++n) gv[bj][n] = *(const f32x4*)(gp + bj * 128 + 4 * n); }
#pragma unroll
            for (int am = 0; am < 4; ++am) { const int ai = am >> 1, m0 = (am & 1) * 2;
                f32x4 xv[2][2][2];
#pragma unroll
                for (int mm = 0; mm < 2; ++mm) { const float* xp = X + (size_t)(rowb + 4 * ai + m0 + mm) * DM + col0;
#pragma unroll
                    for (int bj = 0; bj < 2; ++bj)
#pragma unroll
                        for (int n = 0; n < 2; ++n) xv[mm][bj][n] = *(const f32x4*)(xp + bj * 128 + 4 * n); }
#pragma unroll
                for (int mm = 0; mm < 2; ++mm) { float* xp = X + (size_t)(rowb + 4 * ai + m0 + mm) * DM + col0;
#pragma unroll
                    for (int bj = 0; bj < 2; ++bj)
#pragma unroll
                        for (int n = 0; n < 2; ++n) *(f32x4*)(xp + bj * 128 + 4 * n) = xv[mm][bj][n] + gv[bj][n] * acc[ai][bj][m0 + mm][n]; }
            }
        } else if (mode == 3) {
            int fq3 = fq; asm volatile("" : "+v"(fq3));
            const int head = 4 * u.pn + wc; const bool prm = u.pm < 64;
            const f32x2* TAB = (const f32x2*)(wsb + WS_TAB);
            const int sq = prm ? (u.pm >> 5) : ((rowb - RP) >> 3);
            const float* nwp = (head < 16 ? qn : kn) + 8 * fq3;
            f32x4 ca, sa, cb, sb;
            { const int pos0 = prm ? (rowb & (SEQL - 1)) : SEQL; const f32x4* tp = (const f32x4*)(TAB + pos0 * 32 + 8 * fq3); const f32x4 c0 = tp[0], c1 = tp[1], c2 = tp[2], c3 = tp[3];
              ca = (f32x4){c0[0], c0[2], c1[0], c1[2]}; sa = (f32x4){c0[1], c0[3], c1[1], c1[3]}; cb = (f32x4){c2[0], c2[2], c3[0], c3[2]}; sb = (f32x4){c2[1], c2[3], c3[1], c3[3]};
            }
#pragma unroll
            for (int j = 0; j < 8; ++j) { const int row = rowb + j, t = prm ? (row & (SEQL - 1)) : j;
                f32x4 x1a = acc[j >> 2][0][j & 3][0], x1b = acc[j >> 2][0][j & 3][1], x2a = acc[j >> 2][1][j & 3][0], x2b = acc[j >> 2][1][j & 3][1];
                if (head < 20) {
                    float ss = (x1a[0] * x1a[0] + x1a[1] * x1a[1]) + (x1a[2] * x1a[2] + x1a[3] * x1a[3]) + (x1b[0] * x1b[0] + x1b[1] * x1b[1]) + (x1b[2] * x1b[2] + x1b[3] * x1b[3])
                             + (x2a[0] * x2a[0] + x2a[1] * x2a[1]) + (x2a[2] * x2a[2] + x2a[3] * x2a[3]) + (x2b[0] * x2b[0] + x2b[1] * x2b[1]) + (x2b[2] * x2b[2] + x2b[3] * x2b[3]);
                    ss += shx(ss, 16); ss += shx(ss, 32);
                    const float rstd = rsqrtf(ss * (1.f / 64.f) + EPS);
                    const f32x4 y1a = x1a * rstd * *(const f32x4*)nwp, y1b = x1b * rstd * *(const f32x4*)(nwp + 4), y2a = x2a * rstd * *(const f32x4*)(nwp + 32), y2b = x2b * rstd * *(const f32x4*)(nwp + 36);
                    x1a = y1a * ca - y2a * sa; x1b = y1b * cb - y2b * sb; x2a = y2a * ca + y1a * sa; x2b = y2b * cb + y1b * sb;
                }
                bf16* zp = O + (size_t)row * QKVW + head * 64 + 8 * fq3;
                *(u32x4*)zp = (u32x4){pk2(x1a[0], x1a[1]), pk2(x1a[2], x1a[3]), pk2(x1b[0], x1b[1]), pk2(x1b[2], x1b[3])};
                *(u32x4*)(zp + 32) = (u32x4){pk2(x2a[0], x2a[1]), pk2(x2a[2], x2a[3]), pk2(x2b[0], x2b[1]), pk2(x2b[2], x2b[3])};
                if (head >= 16 && (!prm || t >= SEQL - 128)) {
                    float* dst = X + (head < 20 ? (prm ? O_PWK : O_SWK) : (prm ? O_PWV : O_SWV)) + (prm ? ((size_t)(lyr * 2 + sq) * 128 + (t - (SEQL - 128))) * 256 : ((size_t)(lyr * 128 + sq) * 128 + 120 + j) * 256) + ((head - 16) & 3) * 64 + 8 * fq3;
                    *(f32x4*)dst = x1a; *(f32x4*)(dst + 4) = x1b; *(f32x4*)(dst + 32) = x2a; *(f32x4*)(dst + 36) = x2b; }
                if (head < 20) { const f32x4* t1 = (const f32x4*)(TAB + 32 + 8 * fq3); const f32x4 e0 = t1[0], e1 = t1[1], e2 = t1[2], e3 = t1[3];
                    const f32x4 dca = (f32x4){e0[0], e0[2], e1[0], e1[2]}, dsa = (f32x4){e0[1], e0[3], e1[1], e1[3]}, dcb = (f32x4){e2[0], e2[2], e3[0], e3[2]}, dsb = (f32x4){e2[1], e2[3], e3[1], e3[3]};
                    const f32x4 na = ca * dca - sa * dsa, nb = cb * dcb - sb * dsb; sa = sa * dca + ca * dsa; sb = sb * dcb + cb * dsb; ca = na; cb = nb; }
                asm volatile("" ::: "memory");
            }
        } else {
            const bool smp = u.pm >= 64; const int sq = (rowb - RP) >> 3;
            bf16* UB = (bf16*)(wsb + WS_UB); bf16* ACT = (bf16*)(wsb + WS_ACT);
#pragma unroll
            for (int n = 0; n < 2; ++n) {
                const int cf = u.pn * 128 + wc * 32 + 8 * fq + 4 * n;
                const f32x4 wg0 = *(const f32x4*)(cw + cf), wg1 = *(const f32x4*)(cw + FF2 + cf), wg2 = *(const f32x4*)(cw + 2 * FF2 + cf);
                const f32x4 wa0 = *(const f32x4*)(cw + FF + cf), wa1 = *(const f32x4*)(cw + FF2 + FF + cf), wa2 = *(const f32x4*)(cw + 2 * FF2 + FF + cf);
                f32x4 g2, g1, a2, a1;
                if (smp) { const float* st = stp + (size_t)sq * 2 * FF2; g2 = *(const f32x4*)(st + cf); a2 = *(const f32x4*)(st + FF + cf); g1 = *(const f32x4*)(st + FF2 + cf); a1 = *(const f32x4*)(st + FF2 + FF + cf); }
                else { g2 = dpp_shr1(acc[1][0][2][n]); g1 = dpp_shr1(acc[1][0][3][n]); a2 = dpp_shr1(acc[1][1][2][n]); a1 = dpp_shr1(acc[1][1][3][n]); }
#pragma unroll
                for (int j = 0; j < 8; ++j) { const f32x4 G = acc[j >> 2][0][j & 3][n], A = acc[j >> 2][1][j & 3][n];
                    const f32x4 cg = wg0 * g2 + wg1 * g1 + wg2 * G, ca = wa0 * a2 + wa1 * a1 + wa2 * A;
                    if (smp || fr != 0 || j >= 2)
                        *(u32x2*)(ACT + (size_t)(rowb + j) * FF + cf) = (u32x2){pg8::cvt_pk_bf16(cg[0] * sigmoidf_(cg[0]) * ca[0], cg[1] * sigmoidf_(cg[1]) * ca[1]), pg8::cvt_pk_bf16(cg[2] * sigmoidf_(cg[2]) * ca[2], cg[3] * sigmoidf_(cg[3]) * ca[3])};
                    if (smp) { if (j >= 6) { float* d = sout + ((size_t)sq * 2 + (j - 6)) * FF2; *(f32x4*)(d + cf) = G; *(f32x4*)(d + FF + cf) = A; } }
                    else if ((fr == 0 && j < 2) || (fr == 15 && j >= 6)) { bf16* d = UB + ((size_t)(u.pm * 2 + wr) * 4 + (j < 2 ? j : j - 4)) * FF2;
                        *(u32x2*)(d + cf) = (u32x2){pk2(G[0], G[1]), pk2(G[2], G[3])}; *(u32x2*)(d + FF + cf) = (u32x2){pk2(A[0], A[1]), pk2(A[2], A[3])}; }
                    g2 = g1; g1 = G; a2 = a1; a1 = A; }
            }
        }
    }
};
struct EpiMod {
    static constexpr bool PERM = true, AFTER_DRAIN = false;
    float* O; const float* bias;
    __device__ __forceinline__ void operator()(const pg8::f32x4 (&acc)[2][2][4][2], const pg8::Unit& u, int wr, int wc, int fr, int fq) const {
        const int rowb = u.pm * 256 + 8 * (16 * wr + fr), col0 = u.pn * 256 + wc * 32 + 8 * fq;
#pragma unroll
        for (int ai = 0; ai < 2; ++ai)
#pragma unroll
            for (int m = 0; m < 4; ++m) { const int row = rowb + 4 * ai + m;
                if (row < NSEQ) {
#pragma unroll
                    for (int bj = 0; bj < 2; ++bj)
#pragma unroll
                        for (int n = 0; n < 2; ++n) { const f32x4 b = *(const f32x4*)(bias + col0 + bj * 128 + 4 * n);
                            *(f32x4*)(O + (size_t)row * MODW + col0 + bj * 128 + 4 * n) = acc[ai][bj][m][n] + b; } } }
    }
};


__device__ __forceinline__ void mini_gemm(const bf16* A, const bf16* Bt, int K, float* X, const float* gate, unsigned char* smem) {
    const int tid = otid(), lane = tid & 63, wave = tid >> 6, fr = lane & 15, fq = lane >> 4;
    float* part = (float*)smem;
    const int nks = K / 256;
    for (int u = obid(); u < 256; u += gridDim.x) {
        const int rm = u >> 4, cn = u & 15;
        const bf16* Ap = A + (size_t)(RP + 64 * rm + fr) * K + wave * (K / 8) + 8 * fq;
        const bf16* Bp = Bt + (size_t)(64 * cn + fr) * K + wave * (K / 8) + 8 * fq;
        f32x4 acc[4][4];
#pragma unroll
        for (int i = 0; i < 4; ++i)
#pragma unroll
            for (int j = 0; j < 4; ++j) acc[i][j] = (f32x4){0.f, 0.f, 0.f, 0.f};
        bf16x8 a0[4], b0[4], a1[4], b1[4];
#define MG_LD(a, b, ks) do { _Pragma("unroll") for (int i_ = 0; i_ < 4; ++i_) { a[i_] = *(const bf16x8*)(Ap + (size_t)(16 * i_) * K + 32 * (ks)); b[i_] = *(const bf16x8*)(Bp + (size_t)(16 * i_) * K + 32 * (ks)); } } while (0)
#define MG_MMA(a, b) do { _Pragma("unroll") for (int i_ = 0; i_ < 4; ++i_) _Pragma("unroll") for (int j_ = 0; j_ < 4; ++j_) acc[i_][j_] = __builtin_amdgcn_mfma_f32_16x16x32_bf16(b[j_], a[i_], acc[i_][j_], 0, 0, 0); } while (0)
        MG_LD(a0, b0, 0);
        for (int ks = 0; ks < nks; ks += 2) {
            if (ks + 1 < nks) MG_LD(a1, b1, ks + 1);
            MG_MMA(a0, b0);
            if (ks + 2 < nks) MG_LD(a0, b0, ks + 2);
            if (ks + 1 < nks) MG_MMA(a1, b1);
        }
#undef MG_LD
#undef MG_MMA
#pragma unroll
        for (int i = 0; i < 4; ++i)
#pragma unroll
            for (int j = 0; j < 4; ++j) *(f32x4*)(part + (wave * 64 + 16 * i + fr) * 68 + 16 * j + 4 * fq) = acc[i][j];
        __syncthreads();
        {
            const int row = tid >> 3, c0 = (tid & 7) * 8;
            f32x4 s0 = (f32x4){0.f, 0.f, 0.f, 0.f}, s1 = s0;
#pragma unroll
            for (int w = 0; w < 8; ++w) { s0 = s0 + *(const f32x4*)(part + (w * 64 + row) * 68 + c0); s1 = s1 + *(const f32x4*)(part + (w * 64 + row) * 68 + c0 + 4); }
            const int grow = RP + 64 * rm + row, col = 64 * cn + c0; const int sq = 2 + ((grow - RP) >> 3);
            const float* gp = gate + (size_t)sq * MODW + col; float* xp = X + (size_t)grow * DM + col;
            const f32x4 g0 = *(const f32x4*)gp, g1 = *(const f32x4*)(gp + 4);
            *(f32x4*)xp = *(const f32x4*)xp + g0 * s0; *(f32x4*)(xp + 4) = *(const f32x4*)(xp + 4) + g1 * s1;
        }
        __syncthreads();
    }
}
struct TDesc { const float* W; bf16* WT; int ldw, K; };
constexpr int I_IN = 1792, I_AO = 512, I_QKV = 768, I_CO = 512, I_UP = 2816, I_DN = 1408, I_ADA = 3072;
constexpr int TN1 = 2 * I_IN, TN2 = TN1 + 2 * I_AO, TN3 = TN2 + 2 * I_QKV, TN4 = TN3 + 2 * I_CO, TN5 = TN4 + 4 * I_UP, TN6 = TN5 + 4 * I_DN, TN7 = TN6 + 4 * I_ADA;
__device__ __forceinline__ void tdecode(const Params& p, int it, TDesc& d) {
    unsigned char* ws = p.ws; int r = it, ncols; const float* W; bf16* WT; int ldw, K = DM; bool wup = false, wqkv = false;
    if (r < TN1) { const int i = r / I_IN; r -= i * I_IN; W = p.in[15] + (size_t)i * DM * INA; WT = (bf16*)(ws + WS_WIN) + (size_t)i * ZW * DM; ldw = INA;
        if (r < 1024) ncols = 2048; else { W += 2056; WT += (size_t)2048 * DM; r -= 1024; ncols = 1536; } }
    else if (r < TN2) { r -= TN1; const int i = r / I_AO; r -= i * I_AO; W = p.in[19] + (size_t)i * DM * DM; WT = (bf16*)(ws + WS_WAO) + (size_t)i * DM * DM; ldw = DM; ncols = DM; }
    else if (r < TN3) { r -= TN2; const int i = r / I_QKV; r -= i * I_QKV; W = p.in[20] + (size_t)i * DM * QKVW; WT = (bf16*)(ws + WS_WQKV) + (size_t)i * QKVW * DM; ldw = QKVW; ncols = QKVW; wqkv = true; }
    else if (r < TN4) { r -= TN3; const int i = r / I_CO; r -= i * I_CO; W = p.in[24] + (size_t)i * DM * DM; WT = (bf16*)(ws + WS_WCO) + (size_t)i * DM * DM; ldw = DM; ncols = DM; }
    else if (r < TN5) { r -= TN4; const int i = r / I_UP; r -= i * I_UP; W = p.in[25] + (size_t)i * DM * FF2; WT = (bf16*)(ws + WS_WUP) + (size_t)i * FF2 * DM; ldw = FF2; ncols = FF2; wup = true; }
    else if (r < TN6) { r -= TN5; const int i = r / I_DN; r -= i * I_DN; W = p.in[27] + (size_t)i * FF * DM; WT = (bf16*)(ws + WS_WDN) + (size_t)i * DM * FF; ldw = DM; ncols = DM; K = FF; }
    else { r -= TN6; const int i = r / I_ADA; r -= i * I_ADA; W = p.in[13] + (size_t)i * DM * 6144; WT = (bf16*)(ws + WS_ZU) + (size_t)i * 6144 * DM; ldw = 6144; ncols = 6144; }
    const int nblk = ncols / 32, kb = r / nblk, nb = r - kb * nblk;
    int drow = 32 * nb;
    if (wup) drow = (nb < 88) ? 256 * (nb >> 2) + 32 * (nb & 3) : 256 * ((nb - 88) >> 2) + 128 + 32 * ((nb - 88) & 3);
    if (wqkv) { const int head = nb >> 1; drow = 256 * (head >> 2) + 128 * (nb & 1) + 32 * (head & 3); }
    d.W = W + (size_t)(64 * kb) * ldw + 32 * nb; d.WT = WT + (size_t)drow * K + 64 * kb; d.ldw = ldw; d.K = K;
}
__device__ __forceinline__ void tload(const TDesc& d, int lane, float (&v)[32]) {
#pragma unroll
    for (int i = 0; i < 32; ++i) v[i] = d.W[(size_t)(2 * i + (lane >> 5)) * d.ldw + (lane & 31)];
}
__device__ __forceinline__ void tstore(const TDesc& d, int lane, const float (&v)[32], float* scr) {
#pragma unroll
    for (int i = 0; i < 32; ++i) scr[(2 * i + (lane >> 5)) * 33 + (lane & 31)] = v[i];
    LDS_WAIT();
    const int c = lane & 7;
#pragma unroll
    for (int j = 0; j < 4; ++j) { const int n = (lane >> 3) + 8 * j; const float* s = scr + (8 * c) * 33 + n;
        u32x4 o; o.x = pk2(s[0 * 33], s[1 * 33]); o.y = pk2(s[2 * 33], s[3 * 33]); o.z = pk2(s[4 * 33], s[5 * 33]); o.w = pk2(s[6 * 33], s[7 * 33]);
        *(u32x4*)(d.WT + (size_t)n * d.K + 8 * c) = o; }
    LDS_WAIT();
}

__device__ __forceinline__ void prologue(const Params& p, unsigned char* smem) {
    const int tid = otid(), lane = tid & 63, wave = tid >> 6;
    const int gw = obid() * NWAVES + wave, NGW = gridDim.x * NWAVES;
    float* scr = (float*)(smem + wave * 16384);
    unsigned char* ws = p.ws;
    {
        float va[32], vb[32]; TDesc da, db;
        int it = gw;
        if (it < TN7) { tdecode(p, it, da); tload(da, lane, va); }
        while (it < TN7) {
            int nx = it + NGW;
            if (nx < TN7) { tdecode(p, nx, db); tload(db, lane, vb); }
            tstore(da, lane, va, scr);
            it = nx; nx = it + NGW;
            if (it >= TN7) break;
            if (nx < TN7) { tdecode(p, nx, da); tload(da, lane, va); }
            tstore(db, lane, vb, scr);
            it = nx;
        }
    }
    const int gt = obid() * NTHR + tid, NT = gridDim.x * NTHR;
    bf16* Ac = (bf16*)(ws + WS_AC);
    for (int idx = gt; idx < 256 * DM; idx += NT) { const int row = idx >> 10, col = idx & 1023; float v = 0.f;
        if (row < 2) v = p.in[2][row * DM + col]; else if (row < NSEQ) v = p.in[3][(row - 2) * DM + col];
        Ac[idx] = (bf16)f2bf(v * sigmoidf_(v)); }
    f32x2* TAB = (f32x2*)(ws + WS_TAB);
    for (int idx = gt; idx < 8200 * 32; idx += NT) { const int pos = idx >> 5, i = idx & 31;
        const double ang = (double)pos * ROPE_INV[i];
        const double n = rint(ang * 0.6366197723675814); double r = fma(-n, 1.5707963267948966, ang); r = fma(-n, 6.123233995736766e-17, r); const double r2 = r * r;
        const double sn = r * (1.0 + r2 * (-1.0 / 6 + r2 * (1.0 / 120 + r2 * (-1.0 / 5040 + r2 * (1.0 / 362880 + r2 * (-1.0 / 39916800 + r2 * (1.0 / 6227020800.0)))))));
        const double cn = 1.0 + r2 * (-0.5 + r2 * (1.0 / 24 + r2 * (-1.0 / 720 + r2 * (1.0 / 40320 + r2 * (-1.0 / 3628800 + r2 * (1.0 / 479001600.0 + r2 * (-1.0 / 87178291200.0)))))));
        const int qd = ((int)n) & 3; const double c = (qd == 0) ? cn : (qd == 1) ? -sn : (qd == 2) ? -cn : sn, s = (qd == 0) ? sn : (qd == 1) ? cn : (qd == 2) ? -sn : -cn;
        TAB[idx] = (f32x2){(float)c, (float)s}; }
}

__device__ __forceinline__ void norm_phase(const Params& p, int l, int which, unsigned char* smem) {
    const int tid = otid(), lane = tid & 63, wave = tid >> 6;
    const int gw = obid() * NWAVES + wave, NGW = gridDim.x * NWAVES;
    const bool do_gates = (which == 1) && !(l & 1);
    const bool first = (which == 1) && (l == 0);
    float* X = p.out;
    const float* MOD = (const float*)(p.ws + WS_MOD);
    bf16* H = (bf16*)(p.ws + WS_H);
    float* gwl = (float*)smem;
    if (do_gates) {
        const float* W = p.in[15] + (size_t)(l >> 1) * DM * INA + 2048;
        for (int idx = tid; idx < 8192; idx += NTHR) gwl[idx] = W[(size_t)(idx >> 3) * INA + (idx & 7)];
        __syncthreads();
    }
    const float* nw = (which == 1 ? p.in[11] : p.in[12]) + l * DM;
    const int off_sh = l * 6144 + (which == 1 ? 0 : 3072), off_sc = off_sh + 1024;
    f32x4 nwv[4];
#pragma unroll
    for (int j = 0; j < 4; ++j) nwv[j] = *(const f32x4*)(nw + 4 * lane + 256 * j);
    f32x4 vn[4], vn2[4];
#define NORM_SRC(r_) (first ? ((r_) < RP ? p.in[0] + (size_t)(r_) * DM : p.in[1] + (size_t)((r_) - RP) * DM) : X + (size_t)(r_) * DM)
    { const int row = gw; if (row < R) { const float* src = NORM_SRC(row);
#pragma unroll
        for (int j = 0; j < 4; ++j) vn[j] = *(const f32x4*)(src + 4 * lane + 256 * j); }
      const int row2 = gw + NGW; if (row2 < R) { const float* src = NORM_SRC(row2);
#pragma unroll
        for (int j = 0; j < 4; ++j) vn2[j] = *(const f32x4*)(src + 4 * lane + 256 * j); } }
    int cur_sq = -1; f32x4 mulv[4], shv[4];
    for (int row = gw; row < R; row += NGW) {
        const int sq = seq_of(row);
        if (sq != cur_sq) { cur_sq = sq; const float* mrow_ = MOD + (size_t)sq * MODW;
#pragma unroll
            for (int j = 0; j < 4; ++j) { const f32x4 sc = *(const f32x4*)(mrow_ + off_sc + 4 * lane + 256 * j); shv[j] = *(const f32x4*)(mrow_ + off_sh + 4 * lane + 256 * j); mulv[j] = nwv[j] * (sc + 1.f); } }
        f32x4 v[4]; float ss = 0.f;
#pragma unroll
        for (int j = 0; j < 4; ++j) { v[j] = vn[j]; vn[j] = vn2[j]; }
        { const int nrow = row + 2 * NGW; if (nrow < R) { const float* src = NORM_SRC(nrow);
#pragma unroll
            for (int j = 0; j < 4; ++j) vn2[j] = *(const f32x4*)(src + 4 * lane + 256 * j); } }
#pragma unroll
        for (int j = 0; j < 4; ++j) ss += (v[j].x * v[j].x + v[j].y * v[j].y) + (v[j].z * v[j].z + v[j].w * v[j].w);
        if (first) {
#pragma unroll
            for (int j = 0; j < 4; ++j) *(f32x4*)(X + (size_t)row * DM + 4 * lane + 256 * j) = v[j];
        }
        const float rstd = rsqrtf(wave_sum(ss) * (1.f / DM) + EPS);
        float ga[8];
#pragma unroll
        for (int g = 0; g < 8; ++g) ga[g] = 0.f;
#pragma unroll
        for (int j = 0; j < 4; ++j) {
            f32x4 h = v[j] * rstd * mulv[j] + shv[j];
            *(u32x2*)(H + (size_t)row * DM + 4 * lane + 256 * j) = (u32x2){pk2(h.x, h.y), pk2(h.z, h.w)};
            if (do_gates) {
#pragma unroll
                for (int e = 0; e < 4; ++e) { const float* wp = gwl + (4 * lane + 256 * j + e) * 8; const f32x4 w0 = *(const f32x4*)wp, w1 = *(const f32x4*)(wp + 4); const float hv = h[e];
                    ga[0] += hv * w0.x; ga[1] += hv * w0.y; ga[2] += hv * w0.z; ga[3] += hv * w0.w; ga[4] += hv * w1.x; ga[5] += hv * w1.y; ga[6] += hv * w1.z; ga[7] += hv * w1.w; }
            }
        }
        if (do_gates) {
            const float* bif = p.in[16] + (l >> 1) * 8;
#pragma unroll
            for (int g = 0; g < 8; ++g) ga[g] = wave_sum(ga[g]);
            if (lane == 0) { float* G = (float*)(p.ws + WS_GATES) + (size_t)row * 8;
                *(f32x4*)G = (f32x4){ga[0] + bif[0], ga[1] + bif[1], ga[2] + bif[2], ga[3] + bif[3]}; *(f32x4*)(G + 4) = (f32x4){ga[4] + bif[4], ga[5] + bif[5], ga[6] + bif[6], ga[7] + bif[7]}; }
        }
    }
    __syncthreads();
}

__device__ __forceinline__ float scan_add(float v, int lane) {
#pragma unroll
    for (int o = 1; o < 64; o <<= 1) { const float t = shup(v, o); if (lane >= o) v += t; }
    return v;
}
__device__ __forceinline__ float scan_max(float v, int lane) {
#pragma unroll
    for (int o = 1; o < 64; o <<= 1) { const float t = shup(v, o); if (lane >= o) v = fmaxf(v, t); }
    return v;
}
constexpr float KSCALE = 0.08838834764831845f;

__device__ __forceinline__ void head_out(const Params& p, int i, int h, int row, int lane, float hv0, float hv1, unsigned zo, f32x2 on) {
    const float ss = wave_sum(hv0 * hv0 + hv1 * hv1);
    const float rstd = rsqrtf(ss * (1.f / 128.f) + EPS);
    unsigned* CAT = (unsigned*)((bf16*)(p.ws + WS_CAT) + (size_t)row * DM + h * 128);
    CAT[lane] = pk2(hv0 * rstd * on.x * sigmoidf_(bflo(zo)), hv1 * rstd * on.y * sigmoidf_(bfhi(zo)));
}
__device__ __forceinline__ void mlstm_local(const Params& p, int i, int item, unsigned char* smem) {
    const int tid = otid(), lane = tid & 63, wave = tid >> 6, fr = lane & 15, fq = lane >> 4;
    const int b = item >> 9, h = (item >> 7) & 3, c = item & 127, r0 = b * SEQL + c * 64;
    float* ws_l = (float*)smem;
    bf16* kT = (bf16*)(smem + 1024);
    bf16* vT = kT + 128 * 72;
    const float* G = (const float*)(p.ws + WS_GATES);
    const bf16* Z = (const bf16*)(p.ws + WS_ZU);
    if (wave == 0) {
        const float ig = G[(size_t)(r0 + lane) * 8 + h], lf = logsigmoidf(G[(size_t)(r0 + lane) * 8 + 4 + h]);
        const float bs = scan_add(lf, lane), bL = shi(bs, 63);
        const float a = bL - bs + ig, amax = wave_max(a);
        ws_l[lane] = __expf(a - amax);
        if (lane == 0) { float* CS = (float*)(p.ws + WS_CS); CS[item * 2] = bL; CS[item * 2 + 1] = amax; }
    }
    __syncthreads();
    { u32x4 wv[4];
#pragma unroll
      for (int it = 0; it < 4; ++it) { const int q = tid + it * NTHR, which = q >> 10, idx = q & 1023, s = idx & 63, ch = idx >> 6; wv[it] = *(const u32x4*)(Z + (size_t)(r0 + s) * ZW + (which ? 1024 : 512) + h * 128 + ch * 8); }
#pragma unroll
      for (int it = 0; it < 4; ++it) { const int q = tid + it * NTHR, which = q >> 10, idx = q & 1023, s = idx & 63, ch = idx >> 6; const u32x4 w = wv[it];
        bf16* dst = (which ? vT : kT) + (ch * 8) * 72 + s;
        if (which) {
            dst[0 * 72] = (bf16)(w.x & 0xffff); dst[1 * 72] = (bf16)(w.x >> 16); dst[2 * 72] = (bf16)(w.y & 0xffff); dst[3 * 72] = (bf16)(w.y >> 16);
            dst[4 * 72] = (bf16)(w.z & 0xffff); dst[5 * 72] = (bf16)(w.z >> 16); dst[6 * 72] = (bf16)(w.w & 0xffff); dst[7 * 72] = (bf16)(w.w >> 16);
        } else { const float sc = ws_l[s] * KSCALE;
            dst[0 * 72] = (bf16)f2bf(bflo(w.x) * sc); dst[1 * 72] = (bf16)f2bf(bfhi(w.x) * sc); dst[2 * 72] = (bf16)f2bf(bflo(w.y) * sc); dst[3 * 72] = (bf16)f2bf(bfhi(w.y) * sc);
            dst[4 * 72] = (bf16)f2bf(bflo(w.z) * sc); dst[5 * 72] = (bf16)f2bf(bfhi(w.z) * sc); dst[6 * 72] = (bf16)f2bf(bflo(w.w) * sc); dst[7 * 72] = (bf16)f2bf(bfhi(w.w) * sc); } } }
    __syncthreads();
    f32x4 acc[8];
#pragma unroll
    for (int mt = 0; mt < 8; ++mt) acc[mt] = (f32x4){0.f, 0.f, 0.f, 0.f};
#pragma unroll
    for (int ks = 0; ks < 2; ++ks) { const bf16x8 B = *(const bf16x8*)(vT + (16 * wave + fr) * 72 + 32 * ks + 8 * fq);
#pragma unroll
        for (int mt = 0; mt < 8; ++mt) { const bf16x8 A = *(const bf16x8*)(kT + (16 * mt + fr) * 72 + 32 * ks + 8 * fq); acc[mt] = __builtin_amdgcn_mfma_f32_16x16x32_bf16(A, B, acc[mt], 0, 0, 0); } }
    bf16* dCt = (bf16*)(p.ws + WS_DCT) + (size_t)item * 16384;
#pragma unroll
    for (int mt = 0; mt < 8; ++mt) *(u32x2*)(dCt + (16 * wave + fr) * 128 + 16 * mt + 4 * fq) = (u32x2){pk2_sw(acc[mt][0], acc[mt][1]), pk2_sw(acc[mt][2], acc[mt][3])};
    if (tid < 128) { float s = 0.f;
        for (int t = 0; t < 64; ++t) s += bf2f(kT[tid * 72 + t]);
        ((float*)(p.ws + WS_DN))[item * 128 + tid] = s; }
    __syncthreads();
}

__device__ __forceinline__ void mlstm_scan(const Params& p, int i, unsigned char* smem) {
    const float* CS = (const float*)(p.ws + WS_CS); const bf16* dCt = (const bf16*)(p.ws + WS_DCT); const float* DN = (const float*)(p.ws + WS_DN);
    bf16* CSt = (bf16*)(p.ws + WS_CST); float* NS = (float*)(p.ws + WS_NS); float* MS = (float*)(p.ws + WS_MS);
    for (int idx = obid() * NTHR + otid(); idx < 8 * 16384; idx += gridDim.x * NTHR) {
        const int bh = idx >> 14, e = idx & 16383;
        float* csl = (float*)smem;
        __syncthreads(); if (otid() < 256) csl[otid()] = CS[bh * 256 + otid()]; __syncthreads();
        float C = 0.f, m = 0.f, nacc = 0.f;
        float dv[16], dnv[16], dv2[16], dnv2[16];
#define SC_LD(D, DNV, c0_) do { _Pragma("unroll") for (int k_ = 0; k_ < 16; ++k_) { D[k_] = bf2f(dCt[(size_t)(bh * 128 + (c0_) + k_) * 16384 + e]); DNV[k_] = (e < 128) ? DN[(bh * 128 + (c0_) + k_) * 128 + e] : 0.f; } } while (0)
#define SC_RUN(D, DNV, c0_) do { _Pragma("unroll") for (int k_ = 0; k_ < 16; ++k_) { const int item = bh * 128 + (c0_) + k_; const float bL = csl[2 * ((c0_) + k_)], amax = csl[2 * ((c0_) + k_) + 1]; \
                CSt[(size_t)item * 16384 + e] = (bf16)f2bf(C); if (e < 128) NS[item * 128 + e] = nacc; if (e == 0) MS[item] = m; \
                const float mn = fmaxf(bL + m, amax), f1 = __expf(bL + m - mn), f2 = __expf(amax - mn); C = f1 * C + f2 * D[k_]; nacc = f1 * nacc + f2 * DNV[k_]; m = mn; } } while (0)
        SC_LD(dv, dnv, 0);
        for (int c0 = 0; c0 < 128; c0 += 32) {
            SC_LD(dv2, dnv2, c0 + 16);
            SC_RUN(dv, dnv, c0);
            if (c0 + 32 < 128) SC_LD(dv, dnv, c0 + 32);
            SC_RUN(dv2, dnv2, c0 + 16);
        }
#undef SC_LD
#undef SC_RUN
        const int b = bh >> 2, h = bh & 3; const size_t sidx = (size_t)((i * 2 + b) * 4 + h);
        p.out[O_PC + sidx * 16384 + (size_t)(e & 127) * 128 + (e >> 7)] = C;
        if (e < 128) p.out[O_PN + sidx * 128 + e] = nacc;
        if (e == 0) p.out[O_PM + sidx] = m;
    }
}

__device__ __forceinline__ void mlstm_out(const Params& p, int i, int item, unsigned char* smem) {
    const int tid = otid(), lane = tid & 63, wave = tid >> 6, fr = lane & 15, fq = lane >> 4;
    const int b = item >> 9, h = (item >> 7) & 3, c = item & 127, r0 = b * SEQL + c * 64;
    float* d_l = (float*)smem;
    float* M_l = d_l + 64;
    float* wg_l = d_l + 128;
    float* mt_l = d_l + 192;
    float* den_l = d_l + 256;
    float* rs_l = d_l + 320;
    float* qn_l = d_l + 448;
    bf16* q_l = (bf16*)(smem + 2048);
    bf16* k_l = q_l + 64 * 136;
    bf16* vT = k_l + 64 * 136;
    bf16* Sw = vT + 128 * 72;
    float* hbuf = (float*)(Sw + 64 * 72);
    const float* G = (const float*)(p.ws + WS_GATES);
    const bf16* Z = (const bf16*)(p.ws + WS_ZU);
    bf16x8 Bc[4];
    { const bf16* cp = (const bf16*)(p.ws + WS_CST) + (size_t)item * 16384 + (16 * wave + fr) * 128 + 8 * fq;
#pragma unroll
      for (int ks = 0; ks < 4; ++ks) Bc[ks] = *(const bf16x8*)(cp + 32 * ks); }
    if (wave == 0) {
        const float ig = G[(size_t)(r0 + lane) * 8 + h], lf = logsigmoidf(G[(size_t)(r0 + lane) * 8 + 4 + h]);
        const float bs = scan_add(lf, lane), d = ig - bs, gmax = scan_max(d, lane);
        const float mc = ((const float*)(p.ws + WS_MS))[item];
        const float Mt = fmaxf(mc, gmax);
        d_l[lane] = d; M_l[lane] = Mt; wg_l[lane] = __expf(mc - Mt); mt_l[lane] = bs + Mt;
    }
    { u32x4 wv[6];
#pragma unroll
      for (int it = 0; it < 6; ++it) { const int q = tid + it * NTHR, which = q >> 10, idx = q & 1023, s = (which == 2) ? (idx & 63) : (idx >> 4), ch = (which == 2) ? (idx >> 6) : (idx & 15); wv[it] = *(const u32x4*)(Z + (size_t)(r0 + s) * ZW + which * 512 + h * 128 + ch * 8); }
#pragma unroll
      for (int it = 0; it < 6; ++it) { const int q = tid + it * NTHR, which = q >> 10, idx = q & 1023, s = (which == 2) ? (idx & 63) : (idx >> 4), ch = (which == 2) ? (idx >> 6) : (idx & 15); const u32x4 w = wv[it];
        if (which == 0) *(u32x4*)(q_l + s * 136 + ch * 8) = w;
        else if (which == 1) { u32x4 o; o.x = pk2(bflo(w.x) * KSCALE, bfhi(w.x) * KSCALE); o.y = pk2(bflo(w.y) * KSCALE, bfhi(w.y) * KSCALE);
            o.z = pk2(bflo(w.z) * KSCALE, bfhi(w.z) * KSCALE); o.w = pk2(bflo(w.w) * KSCALE, bfhi(w.w) * KSCALE); *(u32x4*)(k_l + s * 136 + ch * 8) = o; }
        else { bf16* dst = vT + (ch * 8) * 72 + s;
            dst[0 * 72] = (bf16)(w.x & 0xffff); dst[1 * 72] = (bf16)(w.x >> 16); dst[2 * 72] = (bf16)(w.y & 0xffff); dst[3 * 72] = (bf16)(w.y >> 16);
            dst[4 * 72] = (bf16)(w.z & 0xffff); dst[5 * 72] = (bf16)(w.z >> 16); dst[6 * 72] = (bf16)(w.w & 0xffff); dst[7 * 72] = (bf16)(w.w >> 16); } } }
    __syncthreads();
    {
        const int mt = wave >> 1, nt0 = 2 * (wave & 1);
        f32x4 a2[2] = {(f32x4){0.f, 0.f, 0.f, 0.f}, (f32x4){0.f, 0.f, 0.f, 0.f}};
#pragma unroll
        for (int ks = 0; ks < 4; ++ks) { const bf16x8 A = *(const bf16x8*)(q_l + (16 * mt + fr) * 136 + 32 * ks + 8 * fq);
#pragma unroll
            for (int n = 0; n < 2; ++n) { const bf16x8 B = *(const bf16x8*)(k_l + (16 * (nt0 + n) + fr) * 136 + 32 * ks + 8 * fq); a2[n] = __builtin_amdgcn_mfma_f32_16x16x32_bf16(A, B, a2[n], 0, 0, 0); } }
        float rsum[4] = {0.f, 0.f, 0.f, 0.f};
#pragma unroll
        for (int n = 0; n < 2; ++n) { const int s = 16 * (nt0 + n) + fr; const float ds = d_l[s];
#pragma unroll
            for (int j = 0; j < 4; ++j) { const int t = 16 * mt + 4 * fq + j; const float wv = (s <= t) ? __expf(ds - M_l[t]) : 0.f; const float val = a2[n][j] * wv; rsum[j] += val; Sw[t * 72 + s] = (bf16)f2bf(val); } }
#pragma unroll
        for (int j = 0; j < 4; ++j) { float v = rsum[j]; v += shx(v, 1); v += shx(v, 2); v += shx(v, 4); v += shx(v, 8); if (fr == 0) rs_l[(wave & 1) * 64 + 16 * mt + 4 * fq + j] = v; }
        { const int t = tid >> 3, part = tid & 7; const float* NS = (const float*)(p.ws + WS_NS) + item * 128 + part * 16;
          const u32x4 qa = *(const u32x4*)(q_l + t * 136 + part * 16), qb = *(const u32x4*)(q_l + t * 136 + part * 16 + 8);
          const f32x4 n0 = *(const f32x4*)NS, n1 = *(const f32x4*)(NS + 4), n2 = *(const f32x4*)(NS + 8), n3 = *(const f32x4*)(NS + 12);
          float v = bflo(qa.x) * n0.x + bfhi(qa.x) * n0.y + bflo(qa.y) * n0.z + bfhi(qa.y) * n0.w + bflo(qa.z) * n1.x + bfhi(qa.z) * n1.y + bflo(qa.w) * n1.z + bfhi(qa.w) * n1.w
                  + bflo(qb.x) * n2.x + bfhi(qb.x) * n2.y + bflo(qb.y) * n2.z + bfhi(qb.y) * n2.w + bflo(qb.z) * n3.x + bfhi(qb.z) * n3.y + bflo(qb.w) * n3.z + bfhi(qb.w) * n3.w;
          v += shx(v, 1); v += shx(v, 2); v += shx(v, 4); if (part == 0) qn_l[t] = v; }
    }
    __syncthreads();
    if (tid < 64) { const int t = tid; const float den = wg_l[t] * qn_l[t] + (rs_l[t] + rs_l[64 + t]); den_l[t] = __builtin_amdgcn_rcpf(fmaxf(fabsf(den), __expf(-mt_l[t]))); }
    f32x4 acc[4];
#pragma unroll
    for (int mt = 0; mt < 4; ++mt) acc[mt] = (f32x4){0.f, 0.f, 0.f, 0.f};
#pragma unroll
    for (int ks = 0; ks < 4; ++ks) { const bf16x8 B = Bc[ks];
#pragma unroll
        for (int mt = 0; mt < 4; ++mt) { const bf16x8 A = *(const bf16x8*)(q_l + (16 * mt + fr) * 136 + 32 * ks + 8 * fq); acc[mt] = __builtin_amdgcn_mfma_f32_16x16x32_bf16(A, B, acc[mt], 0, 0, 0); } }
#pragma unroll
    for (int mt = 0; mt < 4; ++mt)
#pragma unroll
        for (int j = 0; j < 4; ++j) acc[mt][j] *= wg_l[16 * mt + 4 * fq + j];
#pragma unroll
    for (int ks = 0; ks < 2; ++ks) { const bf16x8 B = *(const bf16x8*)(vT + (16 * wave + fr) * 72 + 32 * ks + 8 * fq);
#pragma unroll
        for (int mt = 0; mt < 4; ++mt) { const bf16x8 A = *(const bf16x8*)(Sw + (16 * mt + fr) * 72 + 32 * ks + 8 * fq); acc[mt] = __builtin_amdgcn_mfma_f32_16x16x32_bf16(A, B, acc[mt], 0, 0, 0); } }
    __syncthreads();
#pragma unroll
    for (int mt = 0; mt < 4; ++mt)
#pragma unroll
        for (int j = 0; j < 4; ++j) { const int t = 16 * mt + 4 * fq + j; hbuf[t * 132 + 16 * wave + fr] = acc[mt][j] * den_l[t]; }
    __syncthreads();
    { unsigned zo[8]; const f32x2 on = *(const f32x2*)(p.in[17] + i * 512 + h * 128 + 2 * lane);
#pragma unroll
      for (int tt = 0; tt < 8; ++tt) zo[tt] = *(const unsigned*)(Z + (size_t)(r0 + 8 * wave + tt) * ZW + 1536 + h * 128 + 2 * lane);
#pragma unroll
      for (int tt = 0; tt < 8; ++tt) { const int t = 8 * wave + tt; const f32x2 hv = *(const f32x2*)(hbuf + t * 132 + 2 * lane); head_out(p, i, h, r0 + t, lane, hv.x, hv.y, zo[tt], on); } }
    __syncthreads();
}

__device__ __forceinline__ void mlstm_out2(const Params& p, int i, int itA, int itB, unsigned char* smem) {
    const int tid = otid(), lane = tid & 63, wave = tid >> 6, fr = lane & 15, fq = lane >> 4, hh = wave >> 2, wl = wave & 3, tl = tid & 255;
    const int item_ = hh ? itB : itA; const bool active = item_ < 1024; const int item = active ? item_ : 0;
    const int b = item >> 9, h = (item >> 7) & 3, c = item & 127, r0 = b * SEQL + c * 64;
    unsigned char* sb = smem + hh * 65536;
    float* d_l = (float*)sb;
    float* M_l = d_l + 64;
    float* wg_l = d_l + 128;
    float* mt_l = d_l + 192;
    float* den_l = d_l + 256;
    float* rs_l = d_l + 320;
    float* qn_l = d_l + 384;
    bf16* q_l = (bf16*)(sb + 2048);
    bf16* k_l = q_l + 64 * 136;
    float* hbuf = (float*)(sb + 2048);
    bf16* vT = k_l + 64 * 136;
    bf16* Sw = vT + 128 * 72;
    const float* G = (const float*)(p.ws + WS_GATES);
    const bf16* Z = (const bf16*)(p.ws + WS_ZU);
    bf16x8 Bc[2][4];
#pragma unroll
    for (int n = 0; n < 2; ++n) { const bf16* cp = (const bf16*)(p.ws + WS_CST) + (size_t)item * 16384 + (16 * (2 * wl + n) + fr) * 128 + 8 * fq;
#pragma unroll
        for (int ks = 0; ks < 4; ++ks) Bc[n][ks] = *(const bf16x8*)(cp + 32 * ks); }
    if (wl == 0) {
        const float ig = G[(size_t)(r0 + lane) * 8 + h], lf = logsigmoidf(G[(size_t)(r0 + lane) * 8 + 4 + h]);
        const float bs = scan_add(lf, lane), d = ig - bs, gmax = scan_max(d, lane);
        const float mc = ((const float*)(p.ws + WS_MS))[item];
        const float Mt = fmaxf(mc, gmax);
        d_l[lane] = d; M_l[lane] = Mt; wg_l[lane] = __expf(mc - Mt); mt_l[lane] = bs + Mt;
    }
    { u32x4 wv[12];
#pragma unroll
      for (int it = 0; it < 12; ++it) { const int q = tl + it * 256, which = q >> 10, idx = q & 1023, s = (which == 2) ? (idx & 63) : (idx >> 4), ch = (which == 2) ? (idx >> 6) : (idx & 15); wv[it] = *(const u32x4*)(Z + (size_t)(r0 + s) * ZW + which * 512 + h * 128 + ch * 8); }
#pragma unroll
      for (int it = 0; it < 12; ++it) { const int q = tl + it * 256, which = q >> 10, idx = q & 1023, s = (which == 2) ? (idx & 63) : (idx >> 4), ch = (which == 2) ? (idx >> 6) : (idx & 15); const u32x4 w = wv[it];
        if (which == 0) *(u32x4*)(q_l + s * 136 + ch * 8) = w;
        else if (which == 1) { u32x4 o; o.x = pk2(bflo(w.x) * KSCALE, bfhi(w.x) * KSCALE); o.y = pk2(bflo(w.y) * KSCALE, bfhi(w.y) * KSCALE);
            o.z = pk2(bflo(w.z) * KSCALE, bfhi(w.z) * KSCALE); o.w = pk2(bflo(w.w) * KSCALE, bfhi(w.w) * KSCALE); *(u32x4*)(k_l + s * 136 + ch * 8) = o; }
        else { bf16* dst = vT + (ch * 8) * 72 + s;
            dst[0 * 72] = (bf16)(w.x & 0xffff); dst[1 * 72] = (bf16)(w.x >> 16); dst[2 * 72] = (bf16)(w.y & 0xffff); dst[3 * 72] = (bf16)(w.y >> 16);
            dst[4 * 72] = (bf16)(w.z & 0xffff); dst[5 * 72] = (bf16)(w.z >> 16); dst[6 * 72] = (bf16)(w.w & 0xffff); dst[7 * 72] = (bf16)(w.w >> 16); } } }
    __syncthreads();
    {
        const int mt = wl;
        f32x4 a4[4];
#pragma unroll
        for (int n = 0; n < 4; ++n) a4[n] = (f32x4){0.f, 0.f, 0.f, 0.f};
#pragma unroll
        for (int ks = 0; ks < 4; ++ks) { const bf16x8 A = *(const bf16x8*)(q_l + (16 * mt + fr) * 136 + 32 * ks + 8 * fq);
#pragma unroll
            for (int n = 0; n < 4; ++n) if (n <= mt) { const bf16x8 B = *(const bf16x8*)(k_l + (16 * n + fr) * 136 + 32 * ks + 8 * fq); a4[n] = __builtin_amdgcn_mfma_f32_16x16x32_bf16(A, B, a4[n], 0, 0, 0); } }
        float rsum[4] = {0.f, 0.f, 0.f, 0.f};
#pragma unroll
        for (int n = 0; n < 4; ++n) { const int s = 16 * n + fr; const float ds = d_l[s];
#pragma unroll
            for (int j = 0; j < 4; ++j) { const int t = 16 * mt + 4 * fq + j; const float wv = (s <= t) ? __expf(ds - M_l[t]) : 0.f; const float val = a4[n][j] * wv; rsum[j] += val; Sw[t * 72 + s] = (bf16)f2bf(val); } }
#pragma unroll
        for (int j = 0; j < 4; ++j) { float v = rsum[j]; v += shx(v, 1); v += shx(v, 2); v += shx(v, 4); v += shx(v, 8); if (fr == 0) rs_l[16 * mt + 4 * fq + j] = v; }
        { const int t = tl >> 2, part = tl & 3; const float* NS = (const float*)(p.ws + WS_NS) + item * 128 + part * 32; float v = 0.f;
#pragma unroll
          for (int g = 0; g < 4; ++g) { const u32x4 qa = *(const u32x4*)(q_l + t * 136 + part * 32 + 8 * g); const f32x4 n0 = *(const f32x4*)(NS + 8 * g), n1 = *(const f32x4*)(NS + 8 * g + 4);
              v += bflo(qa.x) * n0.x + bfhi(qa.x) * n0.y + bflo(qa.y) * n0.z + bfhi(qa.y) * n0.w + bflo(qa.z) * n1.x + bfhi(qa.z) * n1.y + bflo(qa.w) * n1.z + bfhi(qa.w) * n1.w; }
          v += shx(v, 1); v += shx(v, 2); if (part == 0) qn_l[t] = v; }
    }
    __syncthreads();
    if (tl < 64) { const int t = tl; const float den = wg_l[t] * qn_l[t] + rs_l[t]; den_l[t] = __builtin_amdgcn_rcpf(fmaxf(fabsf(den), __expf(-mt_l[t]))); }
    f32x4 acc[2][4];
#pragma unroll
    for (int n = 0; n < 2; ++n)
#pragma unroll
        for (int mt = 0; mt < 4; ++mt) acc[n][mt] = (f32x4){0.f, 0.f, 0.f, 0.f};
#pragma unroll
    for (int ks = 0; ks < 4; ++ks)
#pragma unroll
        for (int mt = 0; mt < 4; ++mt) { const bf16x8 A = *(const bf16x8*)(q_l + (16 * mt + fr) * 136 + 32 * ks + 8 * fq);
#pragma unroll
            for (int n = 0; n < 2; ++n) acc[n][mt] = __builtin_amdgcn_mfma_f32_16x16x32_bf16(A, Bc[n][ks], acc[n][mt], 0, 0, 0); }
#pragma unroll
    for (int mt = 0; mt < 4; ++mt)
#pragma unroll
        for (int j = 0; j < 4; ++j) { const float wgv = wg_l[16 * mt + 4 * fq + j]; acc[0][mt][j] *= wgv; acc[1][mt][j] *= wgv; }
#pragma unroll
    for (int ks = 0; ks < 2; ++ks)
#pragma unroll
        for (int mt = 0; mt < 4; ++mt) { const bf16x8 A = *(const bf16x8*)(Sw + (16 * mt + fr) * 72 + 32 * ks + 8 * fq);
#pragma unroll
            for (int n = 0; n < 2; ++n) { const bf16x8 B = *(const bf16x8*)(vT + (16 * (2 * wl + n) + fr) * 72 + 32 * ks + 8 * fq); acc[n][mt] = __builtin_amdgcn_mfma_f32_16x16x32_bf16(A, B, acc[n][mt], 0, 0, 0); } }
    __syncthreads();
#pragma unroll
    for (int n = 0; n < 2; ++n)
#pragma unroll
        for (int mt = 0; mt < 4; ++mt)
#pragma unroll
            for (int j = 0; j < 4; ++j) { const int t = 16 * mt + 4 * fq + j; hbuf[t * 132 + 16 * (2 * wl + n) + fr] = acc[n][mt][j] * den_l[t]; }
    __syncthreads();
    { unsigned zo[16]; const f32x2 on = *(const f32x2*)(p.in[17] + i * 512 + h * 128 + 2 * lane);
#pragma unroll
      for (int tt = 0; tt < 16; ++tt) zo[tt] = *(const unsigned*)(Z + (size_t)(r0 + 16 * wl + tt) * ZW + 1536 + h * 128 + 2 * lane);
#pragma unroll
      for (int tt = 0; tt < 16; ++tt) { const int t = 16 * wl + tt; const f32x2 hv = *(const f32x2*)(hbuf + t * 132 + 2 * lane);
          const float ss = wave_sum(hv.x * hv.x + hv.y * hv.y); const float rstd = rsqrtf(ss * (1.f / 128.f) + EPS);
          if (active) { unsigned* CAT = (unsigned*)((bf16*)(p.ws + WS_CAT) + (size_t)(r0 + t) * DM + h * 128);
              CAT[lane] = pk2(hv.x * rstd * on.x * sigmoidf_(bflo(zo[tt])), hv.y * rstd * on.y * sigmoidf_(bfhi(zo[tt]))); } } }
    __syncthreads();
}

__device__ __forceinline__ void mlstm_sample(const Params& p, int i, int item, unsigned char* smem) {
    const int tid = otid(), lane = tid & 63, wave = tid >> 6;
    const int s = item >> 2, h = item & 3, r0 = RP + 8 * s;
    float* qq = (float*)smem;
    float* kk = qq + 1024;
    float* vv = kk + 1024;
    float* qT = vv + 1024;
    float* kwT = qT + 1024;
    float* part = kwT + 1024;
    float* S_l = part + 4096;
    float* sc = S_l + 64;
    const bf16* Z = (const bf16*)(p.ws + WS_ZU);
    const float* G = (const float*)(p.ws + WS_GATES);
    const size_t sidx = (size_t)((i * 128 + s) * 4 + h);
    const float* n0 = p.in[5] + sidx * 128;
    { bf16 zv[6];
#pragma unroll
      for (int it = 0; it < 6; ++it) { const int q = tid + it * NTHR, which = q >> 10, t = (q >> 7) & 7, d = q & 127; zv[it] = Z[(size_t)(r0 + t) * ZW + which * 512 + h * 128 + d]; }
#pragma unroll
      for (int it = 0; it < 6; ++it) { const int q = tid + it * NTHR, which = q >> 10; float v = bf2f(zv[it]); if (which == 1) v *= KSCALE; qq[q] = v; } }
    if (wave == 0) {
        const int t = lane & 7;
        const float ig = G[(size_t)(r0 + t) * 8 + h], lf = logsigmoidf(G[(size_t)(r0 + t) * 8 + 4 + h]);
        float bs = 0.f;
        for (int u = 0; u < 8; ++u) { const float x = shi(lf, u); if (u <= t) bs += x; }
        const float d = ig - bs; float gmax = -INFINITY;
        for (int u = 0; u < 8; ++u) { const float x = shi(d, u); if (u <= t) gmax = fmaxf(gmax, x); }
        const float m0 = p.in[6][sidx];
        const float Mt = fmaxf(m0, gmax), bL = shi(bs, 7), a = bL - bs + ig;
        float amax = -INFINITY;
        for (int u = 0; u < 8; ++u) amax = fmaxf(amax, shi(a, u));
        const float mnew = fmaxf(bL + m0, amax);
        if (lane < 8) { sc[t] = d; sc[8 + t] = Mt; sc[16 + t] = __expf(m0 - Mt); sc[24 + t] = bs + Mt; sc[32 + t] = __expf(a - mnew); }
        if (lane == 0) { sc[56] = __expf(bL + m0 - mnew); sc[57] = mnew; }
    }
    __syncthreads();
    { const int pr = tid >> 3, part = tid & 7, t = pr >> 3, u = pr & 7; float dot = 0.f;
#pragma unroll
        for (int d = 0; d < 16; ++d) dot += qq[t * 128 + part * 16 + d] * kk[u * 128 + part * 16 + d];
        dot += shx(dot, 1); dot += shx(dot, 2); dot += shx(dot, 4);
        if (part == 0) S_l[pr] = (u <= t) ? dot * __expf(sc[u] - sc[8 + t]) : 0.f; }
    if (tid < 64) { const int t = tid >> 3, part = tid & 7; float dot = 0.f;
#pragma unroll
        for (int d = 0; d < 16; ++d) dot += qq[t * 128 + part * 16 + d] * n0[part * 16 + d];
        dot += shx(dot, 1); dot += shx(dot, 2); dot += shx(dot, 4);
        if (part == 0) sc[40 + t] = dot; }
    for (int idx = tid; idx < 1024; idx += NTHR) { const int dk = idx >> 3, t = idx & 7; qT[idx] = qq[t * 128 + dk]; kwT[idx] = kk[t * 128 + dk] * sc[32 + t]; }
    __syncthreads();
    if (tid < 8) { float rs = 0.f; for (int u = 0; u < 8; ++u) rs += S_l[tid * 8 + u];
        const float den = sc[16 + tid] * sc[40 + tid] + rs; sc[48 + tid] = fmaxf(fabsf(den), __expf(-sc[24 + tid])); }
    {
        const int e = tid & 127, g = tid >> 7; const float wc = sc[56];
        float vr[8], acc[8];
#pragma unroll
        for (int u = 0; u < 8; ++u) { vr[u] = vv[u * 128 + e]; acc[u] = 0.f; }
        const float* Cin = p.in[4] + sidx * 16384; float* Cout = p.out + O_SC + sidx * 16384;
        float cin[32];
#pragma unroll
        for (int k = 0; k < 32; ++k) cin[k] = Cin[(g * 32 + k) * 128 + e];
#pragma unroll
        for (int k = 0; k < 32; ++k) { const int dk = g * 32 + k; const float cv = cin[k];
            const f32x4 q0 = *(const f32x4*)(qT + dk * 8), q1 = *(const f32x4*)(qT + dk * 8 + 4), k0 = *(const f32x4*)(kwT + dk * 8), k1 = *(const f32x4*)(kwT + dk * 8 + 4);
            acc[0] += q0.x * cv; acc[1] += q0.y * cv; acc[2] += q0.z * cv; acc[3] += q0.w * cv; acc[4] += q1.x * cv; acc[5] += q1.y * cv; acc[6] += q1.z * cv; acc[7] += q1.w * cv;
            float cn = wc * cv;
            cn += k0.x * vr[0] + k0.y * vr[1] + k0.z * vr[2] + k0.w * vr[3] + k1.x * vr[4] + k1.y * vr[5] + k1.z * vr[6] + k1.w * vr[7];
            Cout[dk * 128 + e] = cn; }
#pragma unroll
        for (int u = 0; u < 8; ++u) part[(g * 8 + u) * 128 + e] = acc[u];
        if (tid < 128) { float nn = wc * n0[tid];
#pragma unroll
            for (int u = 0; u < 8; ++u) nn += kwT[tid * 8 + u];
            p.out[O_SN + sidx * 128 + tid] = nn; }
        if (tid == 0) p.out[O_SM + sidx] = sc[57];
    }
    __syncthreads();
    {
        const int t = wave; float hv[2];
        const unsigned zo = *(const unsigned*)(Z + (size_t)(r0 + t) * ZW + 1536 + h * 128 + 2 * lane); const f32x2 on = *(const f32x2*)(p.in[17] + i * 512 + h * 128 + 2 * lane);
#pragma unroll
        for (int k = 0; k < 2; ++k) { const int e = 2 * lane + k;
            float num = (part[(0 * 8 + t) * 128 + e] + part[(1 * 8 + t) * 128 + e]) + (part[(2 * 8 + t) * 128 + e] + part[(3 * 8 + t) * 128 + e]);
            num *= sc[16 + t];
#pragma unroll
            for (int u = 0; u < 8; ++u) num += S_l[t * 8 + u] * vv[u * 128 + e];
            hv[k] = num / sc[48 + t]; }
        head_out(p, i, h, r0 + t, lane, hv[0], hv[1], zo, on);
    }
    __syncthreads();
}

__device__ __forceinline__ void shortconv(const Params& p, int i) {
    const bf16* Z = (const bf16*)(p.ws + WS_ZU); bf16* CAT = (bf16*)(p.ws + WS_CAT);
    const float* cw = p.in[18] + i * 3 * 512;
    for (int idx = obid() * NTHR + otid(); idx < R * 64; idx += gridDim.x * NTHR) {
        const int row = idx >> 6, ch = (idx & 63) * 8;
        const bool prm = row < RP; const int t = prm ? (row & (SEQL - 1)) : ((row - RP) & 7), S = prm ? SEQL : 8, sq = prm ? (row >> 13) : ((row - RP) >> 3);
        float pr[3][8];
#pragma unroll
        for (int j = 0; j < 3; ++j) { const int tt = t - 2 + j;
            if (tt >= 0) { const bf16* zr = Z + (size_t)(row - 2 + j) * ZW; const u32x4 a = *(const u32x4*)(zr + 2560 + ch), b = *(const u32x4*)(zr + 3072 + ch);
                pr[j][0] = bflo(a.x) * bflo(b.x); pr[j][1] = bfhi(a.x) * bfhi(b.x); pr[j][2] = bflo(a.y) * bflo(b.y); pr[j][3] = bfhi(a.y) * bfhi(b.y);
                pr[j][4] = bflo(a.z) * bflo(b.z); pr[j][5] = bfhi(a.z) * bfhi(b.z); pr[j][6] = bflo(a.w) * bflo(b.w); pr[j][7] = bfhi(a.w) * bfhi(b.w); }
            else if (!prm) { const float* st = p.in[7] + ((size_t)(i * 128 + sq) * 2 + (2 + tt)) * 512 + ch; const f32x4 a = *(const f32x4*)st, b = *(const f32x4*)(st + 4);
                pr[j][0] = a.x; pr[j][1] = a.y; pr[j][2] = a.z; pr[j][3] = a.w; pr[j][4] = b.x; pr[j][5] = b.y; pr[j][6] = b.z; pr[j][7] = b.w; }
            else {
#pragma unroll
                for (int e = 0; e < 8; ++e) pr[j][e] = 0.f; } }
        const u32x4 zb = *(const u32x4*)(Z + (size_t)row * ZW + 2048 + ch);
        float zbf[8] = {bflo(zb.x), bfhi(zb.x), bflo(zb.y), bfhi(zb.y), bflo(zb.z), bfhi(zb.z), bflo(zb.w), bfhi(zb.w)};
        float o[8];
#pragma unroll
        for (int e = 0; e < 8; ++e) o[e] = zbf[e] * (cw[ch + e] * pr[0][e] + cw[512 + ch + e] * pr[1][e] + cw[1024 + ch + e] * pr[2][e]);
        *(u32x4*)(CAT + (size_t)row * DM + 512 + ch) = (u32x4){pk2(o[0], o[1]), pk2(o[2], o[3]), pk2(o[4], o[5]), pk2(o[6], o[7])};
        if (t >= S - 2) { float* dst = p.out + (prm ? O_PSC + ((size_t)(i * 2 + sq) * 2 + (t - (S - 2))) * 512 : O_SSC + ((size_t)(i * 128 + sq) * 2 + (t - (S - 2))) * 512) + ch;
            *(f32x4*)dst = (f32x4){pr[2][0], pr[2][1], pr[2][2], pr[2][3]}; *(f32x4*)(dst + 4) = (f32x4){pr[2][4], pr[2][5], pr[2][6], pr[2][7]}; }
    }
}

__device__ __forceinline__ void unpack8(const u32x4 w, float (&v)[8]) { v[0] = bflo(w.x); v[1] = bfhi(w.x); v[2] = bflo(w.y); v[3] = bfhi(w.y); v[4] = bflo(w.z); v[5] = bfhi(w.z); v[6] = bflo(w.w); v[7] = bfhi(w.w); }
__device__ __forceinline__ void ld8f(const float* s, float (&v)[8]) { const f32x4 a = *(const f32x4*)s, b = *(const f32x4*)(s + 4); v[0] = a.x; v[1] = a.y; v[2] = a.z; v[3] = a.w; v[4] = b.x; v[5] = b.y; v[6] = b.z; v[7] = b.w; }
__device__ __forceinline__ void st8f(float* d, const float (&v)[8]) { *(f32x4*)d = (f32x4){v[0], v[1], v[2], v[3]}; *(f32x4*)(d + 4) = (f32x4){v[4], v[5], v[6], v[7]}; }

__device__ __forceinline__ void cache_shift(const Params& p, int jl, int bsel, int nsel) {
    const int tid = otid();
    for (int idx = bsel * NTHR + tid; idx < 2 * 128 * 7680; idx += nsel * NTHR) { const int kv = idx / (128 * 7680), r = idx - kv * (128 * 7680), s = r / 7680, q = r - s * 7680;
        const float* src = (kv ? p.in[9] : p.in[8]) + ((size_t)(jl * 128 + s) * 128 + 8) * 256 + 4 * q; float* dst = p.out + (kv ? O_SWV : O_SWK) + ((size_t)(jl * 128 + s) * 128) * 256 + 4 * q;
        *(f32x4*)dst = *(const f32x4*)src; }
}

template <int NH>
__device__ __forceinline__ void attn_wave(const bf16* K_l, const bf16* Vt_l, int ldvt, int kt0, const bf16x8 (*Bq)[2], int qidx, int kmin, const float* sinkp, bf16* orow, bool store, int fr, int fq) {
    f32x4 s[NH][9];
    float sk[NH], mx[NH];
#pragma unroll
    for (int h = 0; h < NH; ++h) { sk[h] = sinkp[h] * 1.4426950408889634f; mx[h] = sk[h]; }
#pragma unroll
    for (int kt = 0; kt < 9; ++kt) {
        const bf16x8 A0 = *(const bf16x8*)(K_l + (16 * (kt0 + kt) + fr) * 72 + 8 * fq), A1 = *(const bf16x8*)(K_l + (16 * (kt0 + kt) + fr) * 72 + 32 + 8 * fq);
#pragma unroll
        for (int h = 0; h < NH; ++h) { f32x4 a = (f32x4){0.f, 0.f, 0.f, 0.f};
            a = __builtin_amdgcn_mfma_f32_16x16x32_bf16(A0, Bq[h][0], a, 0, 0, 0); a = __builtin_amdgcn_mfma_f32_16x16x32_bf16(A1, Bq[h][1], a, 0, 0, 0);
#pragma unroll
            for (int j = 0; j < 4; ++j) { const int kidx = 16 * (kt0 + kt) + 4 * fq + j;
                const bool valid = (kt == 0) ? ((kidx > qidx - 128) && (kidx >= kmin)) : (kt == 8) ? (kidx <= qidx) : (kidx >= kmin);
                a[j] = valid ? a[j] * 0.18033688011112042f : -INFINITY; mx[h] = fmaxf(mx[h], a[j]); }
            s[h][kt] = a; } }
    float inv[NH];
#pragma unroll
    for (int h = 0; h < NH; ++h) { mx[h] = fmaxf(mx[h], shx(mx[h], 16)); mx[h] = fmaxf(mx[h], shx(mx[h], 32)); }
#pragma unroll
    for (int h = 0; h < NH; ++h) { float sum = 0.f;
#pragma unroll
        for (int kt = 0; kt < 9; ++kt)
#pragma unroll
            for (int j = 0; j < 4; ++j) { const float e = __builtin_amdgcn_exp2f(s[h][kt][j] - mx[h]); s[h][kt][j] = e; sum += e; }
        inv[h] = sum; }
#pragma unroll
    for (int h = 0; h < NH; ++h) { float sum = inv[h]; sum += shx(sum, 16); sum += shx(sum, 32); inv[h] = __builtin_amdgcn_rcpf(sum + __builtin_amdgcn_exp2f(sk[h] - mx[h])); }
    bf16x8 Bp[NH][5];
#pragma unroll
    for (int h = 0; h < NH; ++h)
#pragma unroll
        for (int pp = 0; pp < 5; ++pp) { u32x4 w; w.x = pk2(s[h][2 * pp][0], s[h][2 * pp][1]); w.y = pk2(s[h][2 * pp][2], s[h][2 * pp][3]);
            if (pp < 4) { w.z = pk2(s[h][2 * pp + 1][0], s[h][2 * pp + 1][1]); w.w = pk2(s[h][2 * pp + 1][2], s[h][2 * pp + 1][3]); } else { w.z = 0u; w.w = 0u; }
            Bp[h][pp] = __builtin_bit_cast(bf16x8, w); }
#pragma unroll
    for (int dt = 0; dt < 4; ++dt) { f32x4 a[NH];
#pragma unroll
        for (int h = 0; h < NH; ++h) a[h] = (f32x4){0.f, 0.f, 0.f, 0.f};
#pragma unroll
        for (int pp = 0; pp < 5; ++pp) { const bf16* vp = Vt_l + (16 * dt + fr) * ldvt + 16 * (kt0 + 2 * pp) + 4 * fq;
            const u32x2 lo = *(const u32x2*)vp, hi = *(const u32x2*)(vp + 16); const bf16x8 V = __builtin_bit_cast(bf16x8, (u32x4){lo.x, lo.y, hi.x, hi.y});
#pragma unroll
            for (int h = 0; h < NH; ++h) a[h] = __builtin_amdgcn_mfma_f32_16x16x32_bf16(V, Bp[h][pp], a[h], 0, 0, 0); }
        if (store) {
#pragma unroll
            for (int h = 0; h < NH; ++h) *(u32x2*)(orow + 64 * h + 16 * dt + 4 * fq) = (u32x2){pk2(a[h][0] * inv[h], a[h][1] * inv[h]), pk2(a[h][2] * inv[h], a[h][3] * inv[h])}; } }
}

__device__ __forceinline__ void attn_phase(const Params& p, int jl, unsigned char* smem) {
    const bf16* Z = (const bf16*)(p.ws + WS_ZU); bf16* CAT = (bf16*)(p.ws + WS_CAT);
    const float* sinkp = p.in[23] + jl * 16;
    for (int u = obid(); u < 768; u += gridDim.x) { const int tidu = otid(), lane = tidu & 63, wave = tidu >> 6, fr = lane & 15, fq = lane >> 4;
        if (u < 512) {
            const int b = u >> 8, kvh = (u >> 6) & 3, qb = u & 63, q0 = qb * 128, rb = b * SEQL;
            bf16x8 Bq[4][2];
            { const bf16* qp = Z + (size_t)(rb + q0 + 16 * wave + fr) * QKVW + kvh * 256 + 8 * fq;
#pragma unroll
              for (int hq = 0; hq < 4; ++hq) { Bq[hq][0] = *(const bf16x8*)(qp + hq * 64); Bq[hq][1] = *(const bf16x8*)(qp + hq * 64 + 32); } }
            bf16* K_l = (bf16*)smem;
            bf16* Vt_l = K_l + 256 * 72;
            { u32x4 wv[8];
#pragma unroll
              for (int it = 0; it < 8; ++it) { const int q = tidu + it * NTHR, which = q >> 11, idx = q & 2047, kidx = which ? (idx & 255) : (idx >> 3), ch = which ? (idx >> 8) : (idx & 7); const int pos = q0 - 128 + kidx;
                wv[it] = (u32x4){0u, 0u, 0u, 0u};
                if (pos >= 0) wv[it] = *(const u32x4*)(Z + (size_t)(rb + pos) * QKVW + (which ? 1280 : 1024) + kvh * 64 + ch * 8); }
#pragma unroll
              for (int it = 0; it < 8; ++it) { const int q = tidu + it * NTHR, which = q >> 11, idx = q & 2047, kidx = which ? (idx & 255) : (idx >> 3), ch = which ? (idx >> 8) : (idx & 7); const u32x4 w = wv[it];
                if (!which) *(u32x4*)(K_l + kidx * 72 + ch * 8) = w;
                else { bf16* dst = Vt_l + (ch * 8) * 296 + kidx;
                    dst[0 * 296] = (bf16)(w.x & 0xffff); dst[1 * 296] = (bf16)(w.x >> 16); dst[2 * 296] = (bf16)(w.y & 0xffff); dst[3 * 296] = (bf16)(w.y >> 16);
                    dst[4 * 296] = (bf16)(w.z & 0xffff); dst[5 * 296] = (bf16)(w.z >> 16); dst[6 * 296] = (bf16)(w.w & 0xffff); dst[7 * 296] = (bf16)(w.w >> 16); } } }
            for (int q = tidu; q < 64 * 32; q += NTHR) Vt_l[(q >> 5) * 296 + 256 + (q & 31)] = 0;
            __syncthreads();
            const int row = rb + q0 + 16 * wave + fr;
#pragma unroll
            for (int hg = 0; hg < 2; ++hg) { const int h = kvh * 4 + 2 * hg;
                attn_wave<2>(K_l, Vt_l, 296, wave, Bq + 2 * hg, 128 + 16 * wave + fr, qb == 0 ? 128 : 0, sinkp + h, CAT + (size_t)row * DM + h * 64, true, fr, fq); }
            __syncthreads();
        } else {
            const int us = u - 512, s = us >> 1, kvp = us & 1;
            bf16x8 Bq1[2];
            { const bf16* qp = Z + (size_t)(RP + 8 * s + (fr & 7)) * QKVW + (8 * kvp + wave) * 64 + 8 * fq; Bq1[0] = *(const bf16x8*)qp; Bq1[1] = *(const bf16x8*)(qp + 32); }
            bf16* K_l = (bf16*)smem;
            bf16* Vt_l = K_l + 2 * 144 * 72;
            { f32x4 va[9], vb[9];
              const float* ck = p.in[8] + ((size_t)(jl * 128 + s) * 128) * 256; const float* cv = p.in[9] + ((size_t)(jl * 128 + s) * 128) * 256;
#pragma unroll
              for (int it = 0; it < 9; ++it) { const int q = tidu + it * NTHR, which = q / 2304, r = q - which * 2304, kvl = r / 1152, r2 = r - kvl * 1152, kidx = which ? (r2 % 144) : (r2 >> 3), ch = which ? (r2 / 144) : (r2 & 7); const int kvh = 2 * kvp + kvl;
                va[it] = (f32x4){0.f, 0.f, 0.f, 0.f}; vb[it] = va[it];
                if (kidx < 128) { const float* src = (which ? cv : ck) + (size_t)kidx * 256 + kvh * 64 + ch * 8; va[it] = *(const f32x4*)src; vb[it] = *(const f32x4*)(src + 4); }
                else if (kidx < 136) { const u32x4 w = *(const u32x4*)(Z + (size_t)(RP + 8 * s + kidx - 128) * QKVW + (which ? 1280 : 1024) + kvh * 64 + ch * 8);
                    va[it] = (f32x4){bflo(w.x), bfhi(w.x), bflo(w.y), bfhi(w.y)}; vb[it] = (f32x4){bflo(w.z), bfhi(w.z), bflo(w.w), bfhi(w.w)}; } }
#pragma unroll
              for (int it = 0; it < 9; ++it) { const int q = tidu + it * NTHR, which = q / 2304, r = q - which * 2304, kvl = r / 1152, r2 = r - kvl * 1152, kidx = which ? (r2 % 144) : (r2 >> 3), ch = which ? (r2 / 144) : (r2 & 7);
                const f32x4 a = va[it], c = vb[it];
                if (!which) *(u32x4*)(K_l + (kvl * 144 + kidx) * 72 + ch * 8) = (u32x4){pk2(a[0], a[1]), pk2(a[2], a[3]), pk2(c[0], c[1]), pk2(c[2], c[3])};
                else { bf16* dst = Vt_l + (kvl * 64 + ch * 8) * 168 + kidx; const unsigned p0 = pk2(a[0], a[1]), p1 = pk2(a[2], a[3]), p2 = pk2(c[0], c[1]), p3 = pk2(c[2], c[3]);
                    dst[0 * 168] = (bf16)(p0 & 0xffff); dst[1 * 168] = (bf16)(p0 >> 16); dst[2 * 168] = (bf16)(p1 & 0xffff); dst[3 * 168] = (bf16)(p1 >> 16);
                    dst[4 * 168] = (bf16)(p2 & 0xffff); dst[5 * 168] = (bf16)(p2 >> 16); dst[6 * 168] = (bf16)(p3 & 0xffff); dst[7 * 168] = (bf16)(p3 >> 16); } } }
            for (int q = tidu; q < 2 * 64 * 16; q += NTHR) Vt_l[(q >> 4) * 168 + 144 + (q & 15)] = 0;
            __syncthreads();
            const int kvl = wave >> 2, h = 8 * kvp + wave, row = RP + 8 * s + (fr & 7);
            attn_wave<1>(K_l + kvl * 144 * 72, Vt_l + kvl * 64 * 168, 168, 0, &Bq1, 128 + (fr & 7), 0, sinkp + h, CAT + (size_t)row * DM + h * 64, fr < 8, fr, fq);
            __syncthreads();
        }
    }
}

__device__ __forceinline__ void ffnfix_phase(const Params& p, int l) {
    const bf16* UB = (const bf16*)(p.ws + WS_UB); bf16* ACT = (bf16*)(p.ws + WS_ACT);
    const float* cw = p.in[26] + (size_t)l * 3 * FF2;
    for (int idx = obid() * NTHR + otid(); idx < 256 * 352; idx += gridDim.x * NTHR) {
        const int hr = idx / 352, cc = idx - hr * 352, col = cc * 8, hh = hr >> 1, rr = hr & 1;
        const bool seqstart = (hh & 63) == 0;
        const bf16* own0 = UB + (size_t)(hh * 4 + 0) * FF2; const bf16* own1 = UB + (size_t)(hh * 4 + 1) * FF2;
        const bf16* pm2 = UB + (size_t)((hh - 1) * 4 + 2) * FF2; const bf16* pm1 = UB + (size_t)((hh - 1) * 4 + 3) * FF2;
        float g2[8], g1[8], g0[8], a2[8], a1[8], a0[8];
        if (rr == 0) {
            if (seqstart) {
#pragma unroll
                for (int e = 0; e < 8; ++e) { g2[e] = 0.f; g1[e] = 0.f; a2[e] = 0.f; a1[e] = 0.f; } }
            else { unpack8(*(const u32x4*)(pm2 + col), g2); unpack8(*(const u32x4*)(pm2 + FF + col), a2); unpack8(*(const u32x4*)(pm1 + col), g1); unpack8(*(const u32x4*)(pm1 + FF + col), a1); }
            unpack8(*(const u32x4*)(own0 + col), g0); unpack8(*(const u32x4*)(own0 + FF + col), a0);
        } else {
            if (seqstart) {
#pragma unroll
                for (int e = 0; e < 8; ++e) { g2[e] = 0.f; a2[e] = 0.f; } }
            else { unpack8(*(const u32x4*)(pm1 + col), g2); unpack8(*(const u32x4*)(pm1 + FF + col), a2); }
            unpack8(*(const u32x4*)(own0 + col), g1); unpack8(*(const u32x4*)(own0 + FF + col), a1);
            unpack8(*(const u32x4*)(own1 + col), g0); unpack8(*(const u32x4*)(own1 + FF + col), a0);
        }
        float wg[3][8], wa[3][8];
#pragma unroll
        for (int j = 0; j < 3; ++j) { ld8f(cw + j * FF2 + col, wg[j]); ld8f(cw + j * FF2 + FF + col, wa[j]); }
        float o[8];
#pragma unroll
        for (int e = 0; e < 8; ++e) { const float cgv = wg[0][e] * g2[e] + wg[1][e] * g1[e] + wg[2][e] * g0[e], cav = wa[0][e] * a2[e] + wa[1][e] * a1[e] + wa[2][e] * a0[e]; o[e] = cgv * sigmoidf_(cgv) * cav; }
        *(u32x4*)(ACT + (size_t)(hh * 128 + rr) * FF + col) = (u32x4){pk2(o[0], o[1]), pk2(o[2], o[3]), pk2(o[4], o[5]), pk2(o[6], o[7])};
    }
    for (int idx = obid() * NTHR + otid(); idx < 4 * (FF2 / 8); idx += gridDim.x * NTHR) { const int br = idx / (FF2 / 8), c = (idx - br * (FF2 / 8)) * 8, b = br >> 1, r = br & 1;
        float v[8]; unpack8(*(const u32x4*)(UB + (size_t)((64 * b + 63) * 4 + 2 + r) * FF2 + c), v);
        st8f(p.out + O_PFFN + ((size_t)(l * 2 + b) * 2 + r) * FF2 + c, v); }
}

#define XB_TMO      128
#define XB_XCNT(j)  (256  + 64 * (j))
#define XB_XSUB(j)  (1280 + 64 * (j))
#define XB_XGEN(j)  (2304 + 64 * (j))
#define XB_TOP      3328
#define XB_TOPGEN   3392
#define XCD_BAR_WORDS 3456
#define XB_SPIN_CAP (1u << 18)

__device__ __forceinline__ unsigned xb_ld(unsigned* p)              { return __hip_atomic_load(p, __ATOMIC_RELAXED, __HIP_MEMORY_SCOPE_AGENT); }
__device__ __forceinline__ unsigned xb_add(unsigned* p, unsigned v) { return __hip_atomic_fetch_add(p, v, __ATOMIC_RELAXED, __HIP_MEMORY_SCOPE_AGENT); }
__device__ __forceinline__ unsigned xb_xcc_id() { return (unsigned)__builtin_amdgcn_s_getreg((3 << 11) | 20) & 0xFu; }
#define XB_SPIN(cond, bar) do { unsigned _sp = 0; while (cond) { __builtin_amdgcn_s_sleep(1); \
    if ((++_sp & 255u) == 0u) { if (xb_ld(&(bar)[XB_TMO])) break; if (_sp > XB_SPIN_CAP) { atomicAdd(&(bar)[XB_TMO], 1u); break; } } } } while (0)

struct XcdBarrier {
    unsigned* bar; unsigned x;
    volatile LAS unsigned* st;
};

__device__ __forceinline__ XcdBarrier xcd_barrier_post(unsigned* bar, volatile LAS unsigned* st) {
    XcdBarrier b; b.bar = bar; b.x = xb_xcc_id(); b.st = st;
    if (threadIdx.x == 0) (void)xb_add(&bar[XB_XCNT(b.x)], 1u);
    return b;
}
__device__ __forceinline__ void xcd_barrier_complete(unsigned* bar, unsigned x, unsigned& nloc, unsigned& nx) {
    const unsigned G = gridDim.x * gridDim.y * gridDim.z;
    unsigned sum, cnt, mine, sp = 0u;
    for (;;) {
        sum = 0u; cnt = 0u; mine = 0u;
#pragma unroll
        for (unsigned j = 0; j < 16; ++j) { const unsigned c = xb_ld(&bar[XB_XCNT(j)]); sum += c; cnt += (c > 0u) ? 1u : 0u; mine = (j == x) ? c : mine; }
        if (sum == G) break;
        __builtin_amdgcn_s_sleep(1);
        if ((++sp & 255u) == 0u) { if (xb_ld(&bar[XB_TMO])) break; if (sp > XB_SPIN_CAP) { atomicAdd(&bar[XB_TMO], 1u); break; } }
    }
    nloc = mine > 0u ? mine : 1u; nx = cnt > 0u ? cnt : 1u;
}

__device__ __forceinline__ void xcd_barrier(const XcdBarrier& b) {
    asm volatile("s_waitcnt vmcnt(0)" ::: "memory");
    __syncthreads();
    if (threadIdx.x == 0) {
        unsigned* bar = b.bar;
        __builtin_amdgcn_s_waitcnt(0);
        unsigned nloc = b.st[0], nx = b.st[1];
        if (nloc == 0u) { xcd_barrier_complete(bar, b.x, nloc, nx); b.st[0] = nloc; b.st[1] = nx; }
        const unsigned old = xb_add(&bar[XB_XSUB(b.x)], 1u);
        const unsigned gen = old / nloc;
        if (old + 1u == (gen + 1u) * nloc) {
            __builtin_amdgcn_fence(__ATOMIC_RELEASE, "agent");
            asm volatile("s_waitcnt vmcnt(0)" ::: "memory");
            const unsigned og = xb_add(&bar[XB_TOP], 1u);
            const unsigned tg = og / nx;
            if (og + 1u == (tg + 1u) * nx) xb_add(&bar[XB_TOPGEN], 1u);
            else XB_SPIN(xb_ld(&bar[XB_TOPGEN]) == tg, bar);
            __builtin_amdgcn_fence(__ATOMIC_ACQUIRE, "agent");
            xb_add(&bar[XB_XGEN(b.x)], 1u);
            asm volatile("s_waitcnt vmcnt(0)" ::: "memory");
        } else {
            XB_SPIN(xb_ld(&bar[XB_XGEN(b.x)]) == gen, bar);
            __builtin_amdgcn_fence(__ATOMIC_ACQUIRE, "agent");
            asm volatile("s_waitcnt vmcnt(0)" ::: "memory");
        }
    }
    __syncthreads();
}

__global__ void __launch_bounds__(NTHR, 2) mega(Params p) {
    extern __shared__ __attribute__((aligned(16))) unsigned char lds[];
    cg::grid_group grid = cg::this_grid();
    unsigned char* ws = p.ws;
    volatile LAS unsigned* bst = (volatile LAS unsigned*)((LAS unsigned char*)lds + 147392);
    if (threadIdx.x < 2) bst[threadIdx.x] = 0u;
    __syncthreads();
    XcdBarrier bar; bar.bar = (unsigned*)ws; bar.x = 0; bar.st = bst;
    if (p.hi - p.lo > 1) bar = xcd_barrier_post((unsigned*)ws, bst);
    for (int step = p.lo; step < p.hi; ++step) {
        int nrep = 1; bool skip = false;
        if (step == 0) nrep += (PROBE_PRE & 1); else if (step == 1) nrep += (PROBE_PRE >> 1) & 1; else { const int l_ = (step - 2) / 10, st_ = (step - 2) % 10; nrep += (((l_ & 1) ? PROBE_ODD : PROBE_EVEN) >> st_) & 1; }
        for (int rep = 0; rep < nrep; ++rep) {
            if (PROBE_BAR == 2 && rep > 0) xcd_barrier(bar);
        if (step == 0) prologue(p, lds);
        else if (step == 1) {
            pg8::Gemm g{(const pg8::bf16_t*)(ws + WS_AC), (const pg8::bf16_t*)(ws + WS_ZU), 256, MODW, DM}; pg8::StaticOrder S; S.init(256, MODW, gridDim.x, obid());
            EpiMod E{(float*)(ws + WS_MOD), p.in[14]};
            pg8::gemm_phase<EpiMod, pg8::StaticOrder, true, true>((PG8_LAS unsigned char*)lds, g, S, E);
        } else {
            const int l = (step - 2) / 10, st = (step - 2) % 10; const bool even = !(l & 1); const int i = l >> 1;
            if (st == 0) norm_phase(p, l, 1, lds);
            else if (st == 6) norm_phase(p, l, 2, lds);
            else if (st == 1 || st == 5 || st == 7 || st == 9) {
                pg8::Gemm g; EpiMain E; E.X = p.out; E.O = (bf16*)(ws + WS_ZU); E.gate = nullptr; E.ldc = 0; E.mode = 0; E.cw = nullptr; E.stp = nullptr; E.sout = nullptr; E.qn = nullptr; E.kn = nullptr; E.lyr = i; E.wsb = ws;
                if (st == 1) { g.A = (const pg8::bf16_t*)(ws + WS_H); g.M = R; g.K = DM;
                    if (even) { g.Bt = (const pg8::bf16_t*)(ws + WS_WIN) + (size_t)i * ZW * DM; g.N = ZW; E.ldc = ZW; } else { g.Bt = (const pg8::bf16_t*)(ws + WS_WQKV) + (size_t)i * QKVW * DM; g.N = QKVW; E.ldc = QKVW; E.mode = 3;
                        E.qn = p.in[21] + i * 64; E.kn = p.in[22] + i * 64; } }
                else if (st == 5) { g.A = (const pg8::bf16_t*)(ws + WS_CAT); g.M = RP; g.K = DM; g.N = DM; g.Bt = (const pg8::bf16_t*)(ws + (even ? WS_WAO : WS_WCO)) + (size_t)i * DM * DM;
                    E.mode = 1; E.gate = (const float*)(ws + WS_MOD) + l * 6144 + 2048; }
                else if (st == 7) { g.A = (const pg8::bf16_t*)(ws + WS_H); g.M = R; g.K = DM; g.N = FF2; g.Bt = (const pg8::bf16_t*)(ws + WS_WUP) + (size_t)l * FF2 * DM; E.mode = 2;
                    E.cw = p.in[26] + (size_t)l * 3 * FF2; E.stp = p.in[10] + (size_t)l * 128 * 2 * FF2; E.sout = p.out + O_SFFN + (size_t)l * 128 * 2 * FF2; }
                else { g.A = (const pg8::bf16_t*)(ws + WS_ACT); g.M = RP; g.K = FF; g.N = DM; g.Bt = (const pg8::bf16_t*)(ws + WS_WDN) + (size_t)l * DM * FF; E.mode = 1; E.gate = (const float*)(ws + WS_MOD) + l * 6144 + 5120; }
                if (rep > 0 && E.mode == 1) { E.mode = 0; E.O = (bf16*)(ws + WS_H); E.ldc = DM; }
                if (rep > 0 && E.mode == 1) { E.mode = 0; E.O = (bf16*)(ws + WS_H); E.ldc = DM; }
                pg8::StaticOrder S; S.init(g.M, g.N, gridDim.x, obid());
                pg8::gemm_phase<EpiMain, pg8::StaticOrder, true, true>((PG8_LAS unsigned char*)lds, g, S, E);
                if (E.mode == 3 && rep == 0) { const int G_ = gridDim.x, n2 = S.nwg - G_;
                    if (n2 > 0 && n2 < G_) { if (obid() >= n2) cache_shift(p, i, obid() - n2, G_ - n2); } else cache_shift(p, i, obid(), G_); }
                if (E.mode == 1) mini_gemm((const bf16*)g.A, (const bf16*)g.Bt, g.K, p.out, E.gate, lds);
            }
            else if (st == 2) {
                if (even) { const int G_ = gridDim.x; int il = obid(), is = obid();
                    for (int k = 0; il < 1024 || is < 512; ++k) { const bool do_s = (is < 512) && ((k & 1) || il >= 1024);
                        if (do_s) { mlstm_sample(p, i, is, lds); is += G_; } else { mlstm_local(p, i, il, lds); il += G_; } }
                    shortconv(p, i); }
                else { skip = true; continue; }
            }
            else if (st == 3) { if (even) mlstm_scan(p, i, lds); else attn_phase(p, i, lds); }
            else if (st == 4) { if (!even) { skip = true; continue; } for (int it = obid(); it < 1024; it += 2 * gridDim.x) mlstm_out2(p, i, it, it + gridDim.x, lds); }
            else if (st == 8) ffnfix_phase(p, l);
        }
        }
        if (skip) continue;
        if (step + 1 < p.hi) { if (step == 0) grid.sync(); else { xcd_barrier(bar); if (PROBE_BAR == 1) xcd_barrier(bar); } }
    }
}

#ifndef NLAUNCH_MODE
#define NLAUNCH_MODE 1
#endif
extern "C" void kernel_launch(void* const* d_in, const int* in_sizes, int n_in, void* d_out, int out_size, void* d_ws, size_t ws_size, hipStream_t stream) {
    static int grid = 0;
    if (grid == 0) {
        if (n_in != 28 || (size_t)out_size != O_END || ws_size < WS_END) { fprintf(stderr, "kernel_launch: unexpected shapes: n_in %d out %d ws %zu\n", n_in, out_size, ws_size); grid = -1; return; }
        int dev = 0, cus = 0, per_cu = 0;
        hipGetDevice(&dev); hipDeviceGetAttribute(&cus, hipDeviceAttributeMultiprocessorCount, dev);
        if (hipFuncSetAttribute((const void*)mega, hipFuncAttributeMaxDynamicSharedMemorySize, LDS_BYTES) != hipSuccess) { fprintf(stderr, "kernel_launch: hipFuncSetAttribute failed\n"); grid = -1; return; }
        if (hipOccupancyMaxActiveBlocksPerMultiprocessor(&per_cu, (const void*)mega, NTHR, LDS_BYTES) != hipSuccess || per_cu < 1) { fprintf(stderr, "kernel_launch: occupancy query says %d\n", per_cu); per_cu = 1; }
        (void)hipGetLastError();
        grid = cus * 1;
    }
    if (grid < 0) return;
    Params p{};
    for (int k = 0; k < 28; ++k) p.in[k] = (const float*)d_in[k];
    p.out = (float*)d_out; p.ws = (unsigned char*)d_ws;
    const int NSTEPS = 42;
    if (hipMemsetAsync(d_ws, 0, 16384, stream) != hipSuccess) { fprintf(stderr, "memset failed\n"); return; }
#if NLAUNCH_MODE == 1
    p.lo = 0; p.hi = NSTEPS;
    void* args[] = {&p};
    hipError_t e = hipLaunchCooperativeKernel((const void*)mega, dim3(grid), dim3(NTHR), args, LDS_BYTES, stream);
    if (e != hipSuccess) fprintf(stderr, "cooperative launch failed: %s (grid %d)\n", hipGetErrorString(e), grid);
#else
    for (int s = 0; s < NSTEPS; ++s) { if (s >= 2 && ((s - 2) % 10) == 4 && (((s - 2) / 10) & 1)) continue; p.lo = s; p.hi = s + 1; hipLaunchKernelGGL(mega, dim3(grid), dim3(NTHR), LDS_BYTES, stream, p); }
#endif
}
```

```cpp
#include <hip/hip_runtime.h>
#include <hip/hip_cooperative_groups.h>
#include <cstdio>
#include <cstdint>
namespace cg = cooperative_groups;
__device__ __forceinline__ int otid() { int t = threadIdx.x; asm volatile("" : "+v"(t)); return t; }
__device__ __forceinline__ int obid() { int b = blockIdx.x; asm volatile("" : "+s"(b)); return b; }
__device__ __forceinline__ float shx(float v, int o) { const int l = otid() & 63; return __builtin_bit_cast(float, __builtin_amdgcn_ds_bpermute((l ^ o) << 2, __builtin_bit_cast(int, v))); }
__device__ __forceinline__ float shi(float v, int src) { return __builtin_bit_cast(float, __builtin_amdgcn_ds_bpermute(src << 2, __builtin_bit_cast(int, v))); }
__device__ __forceinline__ float shup(float v, int o) { const int l = otid() & 63; const int src = l >= o ? l - o : l; return __builtin_bit_cast(float, __builtin_amdgcn_ds_bpermute(src << 2, __builtin_bit_cast(int, v))); }
namespace pg8 {
#define PG8_LAS __attribute__((address_space(3)))
typedef unsigned short bf16_t;
typedef short bf16x8 __attribute__((ext_vector_type(8)));
typedef float f32x4 __attribute__((ext_vector_type(4)));
typedef unsigned u32x4 __attribute__((ext_vector_type(4)));
constexpr int BM = 256, BK = 64, HALF = 128, HTB = HALF * BK * 2  , STAGE_BYTES = 8 * HTB, NXCD = 8, WGM = 8;

__host__ __device__ __forceinline__ int lds_byte(int r, int c) { const int st = (r >> 4) * 2 + (c >> 5), rr = r & 15, cc = c & 31, ob = rr * 64 + cc * 2; return st * 1024 + (ob ^ (((ob >> 9) & 1) << 5)); }
__host__ __device__ __forceinline__ void stage_rc(int b, int& R, int& C) { const int st = b / 1024, sb = b % 1024, swz = sb ^ (((sb >> 9) & 1) << 5); R = (st >> 1) * 16 + swz / 64; C = (st & 1) * 32 + (swz % 64) / 2; }
__host__ __device__ __forceinline__ int perm32(int rho) { const int n = rho >> 4, i = rho & 15; return 8 * (i >> 2) + 4 * n + (i & 3); }

struct Unit { int pm, pn; };
struct Gemm { const bf16_t* A; const bf16_t* Bt; int M, N, K; };

struct StaticOrder {
    int nM, nN, nwg, G, c;
    __host__ __device__ void init(int M, int N, int G_, int c_) { nM = M / BM; nN = N / BM; nwg = nM * nN; G = G_; c = c_; }
    __host__ __device__ bool next(int i, Unit& u) const {
        const long L = (long)i * G + c; if (L >= nwg) return false;
        int wgid = (int)L; { const int q = nwg / NXCD, r = nwg % NXCD, xcd = wgid % NXCD, off = wgid / NXCD; wgid = (xcd < r ? xcd * (q + 1) : r * (q + 1) + (xcd - r) * q) + off; }
        const int nig = WGM * nN, gid = wgid / nig, fm = gid * WGM, gsz = (nM - fm) < WGM ? (nM - fm) : WGM;
        u.pm = fm + ((wgid % nig) % gsz); u.pn = (wgid % nig) / gsz; return true;
    }
    __device__ __forceinline__ void a_ready(const Unit&) const {}
    __device__ __forceinline__ void done(const Unit&) const {}
};

__device__ __forceinline__ unsigned cvt_pk_bf16(float lo, float hi) { unsigned r; asm volatile("v_cvt_pk_bf16_f32 %0, %1, %2" : "=v"(r) : "v"(lo), "v"(hi)); return r; }
template <class Epi, class Sched, bool ALIGN_EPI = false, bool SP2 = false>
__device__ __forceinline__ void gemm_phase(PG8_LAS unsigned char* lds, const Gemm g, const Sched& S, const Epi& E) {
    const int tid = otid(), wid = __builtin_amdgcn_readfirstlane(tid >> 6), lane = tid & 63, wr = wid >> 2, wc = wid & 3, fr = lane & 15, fq = lane >> 4;
    const int K = g.K, nt = K / BK;
    unsigned voffA[2], voffB[2];
#pragma unroll
    for (int i = 0; i < 2; ++i) { int R, C; stage_rc(tid * 16 + i * 8192, R, C); const int Rb = Epi::PERM ? ((R & ~31) + perm32(R & 31)) : R;
        const int Ra = 8 * (16 * (R >> 6) + (R & 15)) + ((R >> 4) & 3);
        voffA[i] = (unsigned)(Ra * K + C) * 2u; voffB[i] = (unsigned)(Rb * K + C) * 2u; }
    const size_t kstep = (size_t)(BK * 2);
    const size_t hstep = (size_t)HALF * K * 2;
    const size_t hstepA = (size_t)4 * K * 2;
    const size_t tstep = 2 * hstep;
    const unsigned ldsw = (unsigned)wid * 1024u;
    const int aoff = lds_byte(wr * 64 + fr, fq * 8), boff = lds_byte(wc * 32 + fr, fq * 8);
#define PG8_SA(b, h) (((b) * 2 + (h)) * HTB)
#define PG8_SB(b, h) ((4 + (b) * 2 + (h)) * HTB)
#define PG8_STAGE(bufoff, gbase, voff) do { _Pragma("unroll") for (int _i = 0; _i < 2; ++_i) \
        __builtin_amdgcn_global_load_lds((const unsigned*)((const char*)(gbase) + (voff)[_i]), (PG8_LAS unsigned*)(lds + (bufoff) + ldsw + _i * 8192), 16, 0, 0); } while (0)
#define PG8_LDA(dst, b, h) do { _Pragma("unroll") for (int m = 0; m < 4; ++m) _Pragma("unroll") for (int k = 0; k < 2; ++k) dst[m][k] = *(const PG8_LAS bf16x8*)(lds + PG8_SA(b, h) + aoff + m * 2048 + k * 1024); } while (0)
#define PG8_LDB(dst, b, h) do { _Pragma("unroll") for (int n = 0; n < 2; ++n) _Pragma("unroll") for (int k = 0; k < 2; ++k) dst[n][k] = *(const PG8_LAS bf16x8*)(lds + PG8_SB(b, h) + boff + n * 2048 + k * 1024); } while (0)
#define PG8_MMA(ai, bj, At, Bt) do { __builtin_amdgcn_s_setprio(1); _Pragma("unroll") for (int m = 0; m < 4; ++m) _Pragma("unroll") for (int n = 0; n < 2; ++n) _Pragma("unroll") for (int k = 0; k < 2; ++k) \
        acc[ai][bj][m][n] = __builtin_amdgcn_mfma_f32_16x16x32_bf16(Bt[n][k], At[m][k], acc[ai][bj][m][n], 0, 0, 0); __builtin_amdgcn_s_setprio(0); } while (0)
#define PG8_WAIT_V(n) asm volatile("s_waitcnt vmcnt(" #n ")" ::: "memory")
#define PG8_WAIT_L(n) asm volatile("s_waitcnt lgkmcnt(" #n ")" ::: "memory")
#define PG8_BAR __builtin_amdgcn_s_barrier()
#define PG8_SCHED __builtin_amdgcn_sched_barrier(0)
    Unit cur, nxt; int ui = 0;
    if (!S.next(0, cur)) return;
    f32x4 acc[2][2][4][2];
#pragma unroll
    for (int a = 0; a < 2; ++a)
#pragma unroll
        for (int b = 0; b < 2; ++b)
#pragma unroll
            for (int m = 0; m < 4; ++m)
#pragma unroll
                for (int n = 0; n < 2; ++n) acc[a][b][m][n] = (f32x4){0.f, 0.f, 0.f, 0.f};
    bf16x8 At[4][2], B0[2][2], B1[2][2];
    const char* cA = (const char*)g.A + (size_t)cur.pm * tstep; const char* cB = (const char*)g.Bt + (size_t)cur.pn * tstep;
    S.a_ready(cur);
    if constexpr (SP2) {
        PG8_STAGE(PG8_SB(0, 0), cB, voffB); PG8_STAGE(PG8_SB(0, 1), cB + hstep, voffB); PG8_STAGE(PG8_SA(0, 0), cA, voffA); PG8_STAGE(PG8_SA(0, 1), cA + hstepA, voffA);
        if (wr == 1) PG8_BAR;
        PG8_WAIT_V(2); PG8_BAR;
        PG8_STAGE(PG8_SB(1, 0), cB + kstep, voffB); PG8_STAGE(PG8_SA(1, 0), cA + kstep, voffA); PG8_STAGE(PG8_SB(1, 1), cB + hstep + kstep, voffB);
        PG8_WAIT_V(6); PG8_BAR;
    } else {
        PG8_STAGE(PG8_SB(0, 0), cB, voffB); PG8_STAGE(PG8_SA(0, 0), cA, voffA); PG8_STAGE(PG8_SB(0, 1), cB + hstep, voffB); PG8_STAGE(PG8_SA(0, 1), cA + hstepA, voffA);
        if (wr == 1) PG8_BAR;
        PG8_WAIT_V(4); PG8_BAR;
        PG8_STAGE(PG8_SB(1, 0), cB + kstep, voffB); PG8_STAGE(PG8_SA(1, 0), cA + kstep, voffA); PG8_STAGE(PG8_SB(1, 1), cB + hstep + kstep, voffB);
        PG8_WAIT_V(6); PG8_BAR;
    }
    for (;;) {
        const bool has_next = S.next(ui + 1, nxt);
        const char* nA = has_next ? (const char*)g.A + (size_t)nxt.pm * tstep : cA; const char* nB = has_next ? (const char*)g.Bt + (size_t)nxt.pn * tstep : cB;
        for (int t = 0; t < nt; t += 2) {
            const bool last = (t == nt - 2);
            const char* a1 = cA + (size_t)(t + 1) * kstep;
            const char* a2 = last ? nA : cA + (size_t)(t + 2) * kstep; const char* b2 = last ? nB : cB + (size_t)(t + 2) * kstep;
            const char* a3 = a2 + kstep; const char* b3 = b2 + kstep;
            if (last && has_next) S.a_ready(nxt);
            if constexpr (SP2) {
            PG8_LDB(B0, 0, 0); PG8_LDB(B1, 0, 1); PG8_SCHED; PG8_LDA(At, 0, 0); PG8_STAGE(PG8_SA(1, 1), a1 + hstepA, voffA);
            PG8_WAIT_V(8); PG8_WAIT_L(0); PG8_BAR; PG8_MMA(0, 0, At, B0); PG8_MMA(0, 1, At, B1); PG8_BAR; PG8_SCHED;
            PG8_LDA(At, 0, 1); PG8_STAGE(PG8_SB(0, 0), b2, voffB); PG8_STAGE(PG8_SB(0, 1), b2 + hstep, voffB); PG8_STAGE(PG8_SA(0, 0), a2, voffA);
            PG8_WAIT_V(8); PG8_WAIT_L(0); PG8_BAR; PG8_MMA(1, 0, At, B0); PG8_MMA(1, 1, At, B1); PG8_BAR; PG8_SCHED;
            PG8_LDB(B0, 1, 0); PG8_LDB(B1, 1, 1); PG8_SCHED; PG8_LDA(At, 1, 0); PG8_STAGE(PG8_SA(0, 1), a2 + hstepA, voffA);
            PG8_WAIT_V(8); PG8_WAIT_L(0); PG8_BAR; PG8_MMA(0, 0, At, B0); PG8_MMA(0, 1, At, B1); PG8_BAR; PG8_SCHED;
            PG8_LDA(At, 1, 1); PG8_STAGE(PG8_SB(1, 0), b3, voffB); PG8_STAGE(PG8_SB(1, 1), b3 + hstep, voffB); PG8_STAGE(PG8_SA(1, 0), a3, voffA);
            PG8_WAIT_V(8); PG8_WAIT_L(0); PG8_BAR; PG8_MMA(1, 0, At, B0); PG8_MMA(1, 1, At, B1); PG8_BAR; PG8_SCHED;
            } else {
            PG8_LDB(B0, 0, 0); PG8_SCHED; PG8_LDA(At, 0, 0); PG8_STAGE(PG8_SA(1, 1), a1 + hstepA, voffA);
            PG8_WAIT_L(8); PG8_BAR; PG8_WAIT_L(0); PG8_MMA(0, 0, At, B0); PG8_BAR; PG8_SCHED;
            PG8_LDB(B1, 0, 1); PG8_STAGE(PG8_SB(0, 0), b2, voffB);
            PG8_BAR; PG8_WAIT_L(0); PG8_MMA(0, 1, At, B1); PG8_BAR;
            PG8_LDA(At, 0, 1); PG8_STAGE(PG8_SA(0, 0), a2, voffA);
            PG8_BAR; PG8_WAIT_L(0); PG8_MMA(1, 0, At, B0); PG8_BAR; PG8_SCHED;
            PG8_STAGE(PG8_SB(0, 1), b2 + hstep, voffB);
            PG8_WAIT_V(6); PG8_BAR; PG8_MMA(1, 1, At, B1); PG8_BAR;
            PG8_LDB(B0, 1, 0); PG8_SCHED; PG8_LDA(At, 1, 0); PG8_STAGE(PG8_SA(0, 1), a2 + hstepA, voffA);
            PG8_WAIT_L(8); PG8_BAR; PG8_WAIT_L(0); PG8_MMA(0, 0, At, B0); PG8_BAR; PG8_SCHED;
            PG8_LDB(B1, 1, 1); PG8_STAGE(PG8_SB(1, 0), b3, voffB);
            PG8_BAR; PG8_WAIT_L(0); PG8_MMA(0, 1, At, B1); PG8_BAR;
            PG8_LDA(At, 1, 1); PG8_STAGE(PG8_SA(1, 0), a3, voffA);
            PG8_BAR; PG8_WAIT_L(0); PG8_MMA(1, 0, At, B0); PG8_BAR; PG8_SCHED;
            PG8_STAGE(PG8_SB(1, 1), b3 + hstep, voffB);
            PG8_WAIT_V(6); PG8_BAR; PG8_MMA(1, 1, At, B1); PG8_BAR;
            }
        }
        if constexpr (ALIGN_EPI) { if (wr == 0) PG8_BAR; }
        if constexpr (!Epi::AFTER_DRAIN) { E(acc, cur, wr, wc, fr, fq); S.done(cur); }
        if (!has_next) break;
#pragma unroll
        for (int a = 0; a < 2; ++a)
#pragma unroll
            for (int b = 0; b < 2; ++b)
#pragma unroll
                for (int m = 0; m < 4; ++m)
#pragma unroll
                    for (int n = 0; n < 2; ++n) acc[a][b][m][n] = (f32x4){0.f, 0.f, 0.f, 0.f};
        cur = nxt; cA = nA; cB = nB; ++ui;
        if constexpr (ALIGN_EPI) { if (wr == 1) PG8_BAR; }
    }
    PG8_WAIT_V(0);
    if constexpr (!ALIGN_EPI) { if (wr == 0) PG8_BAR; }
    PG8_BAR;
    if constexpr (Epi::AFTER_DRAIN) { E.fused(acc, cur, wr, wc, fr, fq, lds, wid, lane); S.done(cur); }
#undef PG8_SA
#undef PG8_SB
#undef PG8_STAGE
#undef PG8_LDA
#undef PG8_LDB
#undef PG8_MMA
#undef PG8_WAIT_V
#undef PG8_WAIT_L
#undef PG8_BAR
#undef PG8_SCHED
}
}

typedef unsigned short bf16;
typedef float f32x4 __attribute__((ext_vector_type(4)));
typedef float f32x2 __attribute__((ext_vector_type(2)));
typedef unsigned u32x4 __attribute__((ext_vector_type(4)));
typedef unsigned u32x2 __attribute__((ext_vector_type(2)));
typedef short bf16x8 __attribute__((ext_vector_type(8)));

constexpr int R = 17408, RP = 16384, NSEQ = 130, SEQL = 8192;
constexpr int DM = 1024, INA = 3592, ZW = 3584, QKVW = 1536, FF = 2816, FF2 = 5632, MODW = 24576;
constexpr float EPS = 1e-6f;
constexpr int NWAVES = 8, NTHR = 512;
constexpr int LDS_BYTES = 147456;

constexpr size_t O_Y = 0;
constexpr size_t O_PC = (size_t)R * 1024;
constexpr size_t O_PN = O_PC + 262144;
constexpr size_t O_PM = O_PN + 2048;
constexpr size_t O_PSC = O_PM + 16;
constexpr size_t O_PWK = O_PSC + 4096;
constexpr size_t O_PWV = O_PWK + 131072;
constexpr size_t O_PFFN = O_PWV + 131072;
constexpr size_t O_SC = O_PFFN + 90112;
constexpr size_t O_SN = O_SC + 16777216;
constexpr size_t O_SM = O_SN + 131072;
constexpr size_t O_SSC = O_SM + 1024;
constexpr size_t O_SWK = O_SSC + 262144;
constexpr size_t O_SWV = O_SWK + 8388608;
constexpr size_t O_SFFN = O_SWV + 8388608;
constexpr size_t O_END = O_SFFN + 5767168;

constexpr size_t MiB = 1u << 20;
constexpr size_t WS_WIN = 1 * MiB, WS_WAO = 15 * MiB, WS_WQKV = 19 * MiB, WS_WCO = 25 * MiB, WS_WUP = 29 * MiB, WS_WDN = 73 * MiB;
constexpr size_t WS_AC = 95 * MiB, WS_MOD = 96 * MiB, WS_TAB = 109 * MiB, WS_H = 112 * MiB, WS_CAT = 146 * MiB, WS_GATES = 180 * MiB;
constexpr size_t WS_ZU = 181 * MiB;
constexpr size_t WS_ACT = 368 * MiB;
constexpr size_t WS_DCT = WS_ACT, WS_CST = WS_ACT + 64 * MiB, WS_NS = WS_ACT + 96 * MiB, WS_DN = WS_NS + MiB / 2, WS_CS = WS_NS + MiB, WS_MS = WS_CS + 65536;
constexpr size_t WS_UB = 466 * MiB;
constexpr size_t WS_END = 472 * MiB;

__constant__ double ROPE_INV[32] = {1.0, 0.7498942093324559, 0.5623413251903491, 0.4216965034285822, 0.31622776601683794, 0.23713737056616552, 0.1778279410038923, 0.1333521432163324, 0.1, 0.07498942093324558, 0.05623413251903491, 0.042169650342858224, 0.03162277660168379, 0.023713737056616554, 0.01778279410038923, 0.01333521432163324, 0.01, 0.007498942093324558, 0.005623413251903491, 0.004216965034285823, 0.0031622776601683794, 0.0023713737056616554, 0.0017782794100389228, 0.001333521432163324, 0.001, 0.0007498942093324559, 0.0005623413251903491, 0.00042169650342858224, 0.00031622776601683794, 0.00023713737056616554, 0.00017782794100389227, 0.0001333521432163324};
#ifndef PROBE_PRE
#define PROBE_PRE 0
#define PROBE_EVEN 0
#define PROBE_ODD 0
#endif
#ifndef PROBE_BAR
#define PROBE_BAR 0
#endif
struct Params { const float* in[28]; float* out; unsigned char* ws; int lo, hi; };

__device__ __forceinline__ unsigned f2bf(float f) { unsigned u = __builtin_bit_cast(unsigned, f); return (u + 0x7fffu + ((u >> 16) & 1u)) >> 16; }
__device__ __forceinline__ unsigned pk2(float lo, float hi) { unsigned r; asm("v_cvt_pk_bf16_f32 %0, %1, %2" : "=v"(r) : "v"(lo), "v"(hi)); return r; }
__device__ __forceinline__ unsigned pk2_sw(float lo, float hi) { return f2bf(lo) | (f2bf(hi) << 16); }
__device__ __forceinline__ float bf2f(unsigned h) { return __builtin_bit_cast(float, h << 16); }
__device__ __forceinline__ float bflo(unsigned w) { return __builtin_bit_cast(float, w << 16); }
__device__ __forceinline__ float bfhi(unsigned w) { return __builtin_bit_cast(float, w & 0xffff0000u); }
template <int CTRL> __device__ __forceinline__ float dppf(float x) { return __builtin_bit_cast(float, __builtin_amdgcn_mov_dpp(__builtin_bit_cast(int, x), CTRL, 0xF, 0xF, true)); }
__device__ __forceinline__ float rdl(float x, int l) { return __builtin_bit_cast(float, __builtin_amdgcn_readlane(__builtin_bit_cast(int, x), l)); }
__device__ __forceinline__ float wave_sum(float v) {
    v += dppf<0xB1>(v); v += dppf<0x4E>(v); v += dppf<0x141>(v); v += dppf<0x140>(v);
    return (rdl(v, 0) + rdl(v, 16)) + (rdl(v, 32) + rdl(v, 48));
}
__device__ __forceinline__ float wave_max(float v) {
    v = fmaxf(v, dppf<0xB1>(v)); v = fmaxf(v, dppf<0x4E>(v)); v = fmaxf(v, dppf<0x141>(v)); v = fmaxf(v, dppf<0x140>(v));
    return fmaxf(fmaxf(rdl(v, 0), rdl(v, 16)), fmaxf(rdl(v, 32), rdl(v, 48)));
}
__device__ __forceinline__ float logsigmoidf(float f) { return fminf(f, 0.f) - log1pf(__expf(-fabsf(f))); }
__device__ __forceinline__ float sigmoidf_(float x) { return __builtin_amdgcn_rcpf(1.f + __builtin_amdgcn_exp2f(x * -1.4426950408889634f)); }
__device__ __forceinline__ int seq_of(int row) { return row < RP ? (row >> 13) : 2 + ((row - RP) >> 3); }
#define LAS __attribute__((address_space(3)))
#define LDS_WAIT() asm volatile("s_waitcnt lgkmcnt(0)" ::: "memory")

__device__ __forceinline__ float dpp_shr1f(float x) { return __builtin_bit_cast(float, __builtin_amdgcn_mov_dpp(__builtin_bit_cast(int, x), 0x111, 0xF, 0xF, false)); }
__device__ __forceinline__ f32x4 dpp_shr1(const f32x4 v) { f32x4 r; r.x = dpp_shr1f(v.x); r.y = dpp_shr1f(v.y); r.z = dpp_shr1f(v.z); r.w = dpp_shr1f(v.w); return r; }
struct EpiMain {
    static constexpr bool PERM = true, AFTER_DRAIN = false;
    int mode;
    bf16* O; int ldc; float* X; const float* gate;
    const float* qn; const float* kn; int lyr; unsigned char* wsb;
    const float* cw; const float* stp; float* sout;
    __device__ __forceinline__ void operator()(const pg8::f32x4 (&acc)[2][2][4][2], const pg8::Unit& u, int wr, int wc, int fr, int fq) const {
        const int rowb = u.pm * 256 + 8 * (16 * wr + fr), col0 = u.pn * 256 + wc * 32 + 8 * fq;
        if (mode == 0) {
#pragma unroll
            for (int ai = 0; ai < 2; ++ai)
#pragma unroll
                for (int m = 0; m < 4; ++m) { bf16* rowp = O + (size_t)(rowb + 4 * ai + m) * ldc + col0;
#pragma unroll
                    for (int bj = 0; bj < 2; ++bj) { const pg8::f32x4 v0 = acc[ai][bj][m][0], v1 = acc[ai][bj][m][1]; u32x4 w;
                        w.x = pg8::cvt_pk_bf16(v0[0], v0[1]); w.y = pg8::cvt_pk_bf16(v0[2], v0[3]); w.z = pg8::cvt_pk_bf16(v1[0], v1[1]); w.w = pg8::cvt_pk_bf16(v1[2], v1[3]);
                        *(u32x4*)(rowp + bj * 128) = w; } }
        } else if (mode == 1) {
            f32x4 gv[2][2];
            { const float* gp = gate + (size_t)(u.pm >> 5) * MODW + col0;
#pragma unroll
              for (int bj = 0; bj < 2; ++bj)
#pragma unroll
                  for (int n = 0; n < 2; ++n) gv[bj][n] = *(const f32x4*)(gp + bj * 128 + 4 * n); }
#pragma unroll
            for (int am = 0; am < 4; ++am) { const int ai = am >> 1, m0 = (am & 1) * 2;
                f32x4 xv[2][2][2];
#pragma unroll
                for (int mm = 0; mm < 2; ++mm) { const float* xp = X + (size_t)(rowb + 4 * ai + m0 + mm) * DM + col0;
#pragma unroll
                    for (int bj = 0; bj < 2; ++bj)
#pragma unroll
                        for (int n = 0; n < 2; ++n) xv[mm][bj][n] = *(const f32x4*)(xp + bj * 128 + 4 * n); }
#pragma unroll
                for (int mm = 0; mm < 2; ++mm) { float* xp = X + (size_t)(rowb + 4 * ai + m0 + mm) * DM + col0;
#pragma unroll
                    for (int bj = 0; bj < 2; ++bj)
#pragma unroll
                        for (int n = 0; n < 2; ++n) *(f32x4*)(xp + bj * 128 + 4 * n) = xv[mm][bj][n] + gv[bj][n] * acc[ai][bj][m0 + mm][n]; }
            }
        } else if (mode == 3) {
            int fq3 = fq; asm volatile("" : "+v"(fq3));
            const int head = 4 * u.pn + wc; const bool prm = u.pm < 64;
            const f32x2* TAB = (const f32x2*)(wsb + WS_TAB);
            const int sq = prm ? (u.pm >> 5) : ((rowb - RP) >> 3);
            const float* nwp = (head < 16 ? qn : kn) + 8 * fq3;
            f32x4 ca, sa, cb, sb;
            { const int pos0 = prm ? (rowb & (SEQL - 1)) : SEQL; const f32x4* tp = (const f32x4*)(TAB + pos0 * 32 + 8 * fq3); const f32x4 c0 = tp[0], c1 = tp[1], c2 = tp[2], c3 = tp[3];
              ca = (f32x4){c0[0], c0[2], c1[0], c1[2]}; sa = (f32x4){c0[1], c0[3], c1[1], c1[3]}; cb = (f32x4){c2[0], c2[2], c3[0], c3[2]}; sb = (f32x4){c2[1], c2[3], c3[1], c3[3]};
            }
#pragma unroll
            for (int j = 0; j < 8; ++j) { const int row = rowb + j, t = prm ? (row & (SEQL - 1)) : j;
                f32x4 x1a = acc[j >> 2][0][j & 3][0], x1b = acc[j >> 2][0][j & 3][1], x2a = acc[j >> 2][1][j & 3][0], x2b = acc[j >> 2][1][j & 3][1];
                if (head < 20) {
                    float ss = (x1a[0] * x1a[0] + x1a[1] * x1a[1]) + (x1a[2] * x1a[2] + x1a[3] * x1a[3]) + (x1b[0] * x1b[0] + x1b[1] * x1b[1]) + (x1b[2] * x1b[2] + x1b[3] * x1b[3])
                             + (x2a[0] * x2a[0] + x2a[1] * x2a[1]) + (x2a[2] * x2a[2] + x2a[3] * x2a[3]) + (x2b[0] * x2b[0] + x2b[1] * x2b[1]) + (x2b[2] * x2b[2] + x2b[3] * x2b[3]);
                    ss += shx(ss, 16); ss += shx(ss, 32);
                    const float rstd = rsqrtf(ss * (1.f / 64.f) + EPS);
                    const f32x4 y1a = x1a * rstd * *(const f32x4*)nwp, y1b = x1b * rstd * *(const f32x4*)(nwp + 4), y2a = x2a * rstd * *(const f32x4*)(nwp + 32), y2b = x2b * rstd * *(const f32x4*)(nwp + 36);
                    x1a = y1a * ca - y2a * sa; x1b = y1b * cb - y2b * sb; x2a = y2a * ca + y1a * sa; x2b = y2b * cb + y1b * sb;
                }
                bf16* zp = O + (size_t)row * QKVW + head * 64 + 8 * fq3;
                *(u32x4*)zp = (u32x4){pk2(x1a[0], x1a[1]), pk2(x1a[2], x1a[3]), pk2(x1b[0], x1b[1]), pk2(x1b[2], x1b[3])};
                *(u32x4*)(zp + 32) = (u32x4){pk2(x2a[0], x2a[1]), pk2(x2a[2], x2a[3]), pk2(x2b[0], x2b[1]), pk2(x2b[2], x2b[3])};
                if (head >= 16 && (!prm || t >= SEQL - 128)) {
                    float* dst = X + (head < 20 ? (prm ? O_PWK : O_SWK) : (prm ? O_PWV : O_SWV)) + (prm ? ((size_t)(lyr * 2 + sq) * 128 + (t - (SEQL - 128))) * 256 : ((size_t)(lyr * 128 + sq) * 128 + 120 + j) * 256) + ((head - 16) & 3) * 64 + 8 * fq3;
                    *(f32x4*)dst = x1a; *(f32x4*)(dst + 4) = x1b; *(f32x4*)(dst + 32) = x2a; *(f32x4*)(dst + 36) = x2b; }
                if (head < 20) { const f32x4* t1 = (const f32x4*)(TAB + 32 + 8 * fq3); const f32x4 e0 = t1[0], e1 = t1[1], e2 = t1[2], e3 = t1[3];
                    const f32x4 dca = (f32x4){e0[0], e0[2], e1[0], e1[2]}, dsa = (f32x4){e0[1], e0[3], e1[1], e1[3]}, dcb = (f32x4){e2[0], e2[2], e3[0], e3[2]}, dsb = (f32x4){e2[1], e2[3], e3[1], e3[3]};
                    const f32x4 na = ca * dca - sa * dsa, nb = cb * dcb - sb * dsb; sa = sa * dca + ca * dsa; sb = sb * dcb + cb * dsb; ca = na; cb = nb; }
                asm volatile("" ::: "memory");
            }
        } else {
            const bool smp = u.pm >= 64; const int sq = (rowb - RP) >> 3;
            bf16* UB = (bf16*)(wsb + WS_UB); bf16* ACT = (bf16*)(wsb + WS_ACT);
#pragma unroll
            for (int n = 0; n < 2; ++n) {
                const int cf = u.pn * 128 + wc * 32 + 8 * fq + 4 * n;
                const f32x4 wg0 = *(const f32x4*)(cw + cf), wg1 = *(const f32x4*)(cw + FF2 + cf), wg2 = *(const f32x4*)(cw + 2 * FF2 + cf);
                const f32x4 wa0 = *(const f32x4*)(cw + FF + cf), wa1 = *(const f32x4*)(cw + FF2 + FF + cf), wa2 = *(const f32x4*)(cw + 2 * FF2 + FF + cf);
                f32x4 g2, g1, a2, a1;
                if (smp) { const float* st = stp + (size_t)sq * 2 * FF2; g2 = *(const f32x4*)(st + cf); a2 = *(const f32x4*)(st + FF + cf); g1 = *(const f32x4*)(st + FF2 + cf); a1 = *(const f32x4*)(st + FF2 + FF + cf); }
                else { g2 = dpp_shr1(acc[1][0][2][n]); g1 = dpp_shr1(acc[1][0][3][n]); a2 = dpp_shr1(acc[1][1][2][n]); a1 = dpp_shr1(acc[1][1][3][n]); }
#pragma unroll
                for (int j = 0; j < 8; ++j) { const f32x4 G = acc[j >> 2][0][j & 3][n], A = acc[j >> 2][1][j & 3][n];
                    const f32x4 cg = wg0 * g2 + wg1 * g1 + wg2 * G, ca = wa0 * a2 + wa1 * a1 + wa2 * A;
                    if (smp || fr != 0 || j >= 2)
                        *(u32x2*)(ACT + (size_t)(rowb + j) * FF + cf) = (u32x2){pg8::cvt_pk_bf16(cg[0] * sigmoidf_(cg[0]) * ca[0], cg[1] * sigmoidf_(cg[1]) * ca[1]), pg8::cvt_pk_bf16(cg[2] * sigmoidf_(cg[2]) * ca[2], cg[3] * sigmoidf_(cg[3]) * ca[3])};
                    if (smp) { if (j >= 6) { float* d = sout + ((size_t)sq * 2 + (j - 6)) * FF2; *(f32x4*)(d + cf) = G; *(f32x4*)(d + FF + cf) = A; } }
                    else if ((fr == 0 && j < 2) || (fr == 15 && j >= 6)) { bf16* d = UB + ((size_t)(u.pm * 2 + wr) * 4 + (j < 2 ? j : j - 4)) * FF2;
                        *(u32x2*)(d + cf) = (u32x2){pk2(G[0], G[1]), pk2(G[2], G[3])}; *(u32x2*)(d + FF + cf) = (u32x2){pk2(A[0], A[1]), pk2(A[2], A[3])}; }
                    g2 = g1; g1 = G; a2 = a1; a1 = A; }
            }
        }
    }
};
struct EpiMod {
    static constexpr bool PERM = true, AFTER_DRAIN = false;
    float* O; const float* bias;
    __device__ __forceinline__ void operator()(const pg8::f32x4 (&acc)[2][2][4][2], const pg8::Unit& u, int wr, int wc, int fr, int fq) const {
        const int rowb = u.pm * 256 + 8 * (16 * wr + fr), col0 = u.pn * 256 + wc * 32 + 8 * fq;
#pragma unroll
        for (int ai = 0; ai < 2; ++ai)
#pragma unroll
            for (int m = 0; m < 4; ++m) { const int row = rowb + 4 * ai + m;
                if (row < NSEQ) {
#pragma unroll
                    for (int bj = 0; bj < 2; ++bj)
#pragma unroll
                        for (int n = 0; n < 2; ++n) { const f32x4 b = *(const f32x4*)(bias + col0 + bj * 128 + 4 * n);
                            *(f32x4*)(O + (size_t)row * MODW + col0 + bj * 128 + 4 * n) = acc[ai][bj][m][n] + b; } } }
    }
};


__device__ __forceinline__ void mini_gemm(const bf16* A, const bf16* Bt, int K, float* X, const float* gate, unsigned char* smem) {
    const int tid = otid(), lane = tid & 63, wave = tid >> 6, fr = lane & 15, fq = lane >> 4;
    float* part = (float*)smem;
    const int nks = K / 256;
    for (int u = obid(); u < 256; u += gridDim.x) {
        const int rm = u >> 4, cn = u & 15;
        const bf16* Ap = A + (size_t)(RP + 64 * rm + fr) * K + wave * (K / 8) + 8 * fq;
        const bf16* Bp = Bt + (size_t)(64 * cn + fr) * K + wave * (K / 8) + 8 * fq;
        f32x4 acc[4][4];
#pragma unroll
        for (int i = 0; i < 4; ++i)
#pragma unroll
            for (int j = 0; j < 4; ++j) acc[i][j] = (f32x4){0.f, 0.f, 0.f, 0.f};
        bf16x8 a0[4], b0[4], a1[4], b1[4];
#define MG_LD(a, b, ks) do { _Pragma("unroll") for (int i_ = 0; i_ < 4; ++i_) { a[i_] = *(const bf16x8*)(Ap + (size_t)(16 * i_) * K + 32 * (ks)); b[i_] = *(const bf16x8*)(Bp + (size_t)(16 * i_) * K + 32 * (ks)); } } while (0)
#define MG_MMA(a, b) do { _Pragma("unroll") for (int i_ = 0; i_ < 4; ++i_) _Pragma("unroll") for (int j_ = 0; j_ < 4; ++j_) acc[i_][j_] = __builtin_amdgcn_mfma_f32_16x16x32_bf16(b[j_], a[i_], acc[i_][j_], 0, 0, 0); } while (0)
        MG_LD(a0, b0, 0);
        for (int ks = 0; ks < nks; ks += 2) {
            if (ks + 1 < nks) MG_LD(a1, b1, ks + 1);
            MG_MMA(a0, b0);
            if (ks + 2 < nks) MG_LD(a0, b0, ks + 2);
            if (ks + 1 < nks) MG_MMA(a1, b1);
        }
#undef MG_LD
#undef MG_MMA
#pragma unroll
        for (int i = 0; i < 4; ++i)
#pragma unroll
            for (int j = 0; j < 4; ++j) *(f32x4*)(part + (wave * 64 + 16 * i + fr) * 68 + 16 * j + 4 * fq) = acc[i][j];
        __syncthreads();
        {
            const int row = tid >> 3, c0 = (tid & 7) * 8;
            f32x4 s0 = (f32x4){0.f, 0.f, 0.f, 0.f}, s1 = s0;
#pragma unroll
            for (int w = 0; w < 8; ++w) { s0 = s0 + *(const f32x4*)(part + (w * 64 + row) * 68 + c0); s1 = s1 + *(const f32x4*)(part + (w * 64 + row) * 68 + c0 + 4); }
            const int grow = RP + 64 * rm + row, col = 64 * cn + c0; const int sq = 2 + ((grow - RP) >> 3);
            const float* gp = gate + (size_t)sq * MODW + col; float* xp = X + (size_t)grow * DM + col;
            const f32x4 g0 = *(const f32x4*)gp, g1 = *(const f32x4*)(gp + 4);
            *(f32x4*)xp = *(const f32x4*)xp + g0 * s0; *(f32x4*)(xp + 4) = *(const f32x4*)(xp + 4) + g1 * s1;
        }
        __syncthreads();
    }
}
struct TDesc { const float* W; bf16* WT; int ldw, K; };
constexpr int I_IN = 1792, I_AO = 512, I_QKV = 768, I_CO = 512, I_UP = 2816, I_DN = 1408, I_ADA = 3072;
constexpr int TN1 = 2 * I_IN, TN2 = TN1 + 2 * I_AO, TN3 = TN2 + 2 * I_QKV, TN4 = TN3 + 2 * I_CO, TN5 = TN4 + 4 * I_UP, TN6 = TN5 + 4 * I_DN, TN7 = TN6 + 4 * I_ADA;
__device__ __forceinline__ void tdecode(const Params& p, int it, TDesc& d) {
    unsigned char* ws = p.ws; int r = it, ncols; const float* W; bf16* WT; int ldw, K = DM; bool wup = false, wqkv = false;
    if (r < TN1) { const int i = r / I_IN; r -= i * I_IN; W = p.in[15] + (size_t)i * DM * INA; WT = (bf16*)(ws + WS_WIN) + (size_t)i * ZW * DM; ldw = INA;
        if (r < 1024) ncols = 2048; else { W += 2056; WT += (size_t)2048 * DM; r -= 1024; ncols = 1536; } }
    else if (r < TN2) { r -= TN1; const int i = r / I_AO; r -= i * I_AO; W = p.in[19] + (size_t)i * DM * DM; WT = (bf16*)(ws + WS_WAO) + (size_t)i * DM * DM; ldw = DM; ncols = DM; }
    else if (r < TN3) { r -= TN2; const int i = r / I_QKV; r -= i * I_QKV; W = p.in[20] + (size_t)i * DM * QKVW; WT = (bf16*)(ws + WS_WQKV) + (size_t)i * QKVW * DM; ldw = QKVW; ncols = QKVW; wqkv = true; }
    else if (r < TN4) { r -= TN3; const int i = r / I_CO; r -= i * I_CO; W = p.in[24] + (size_t)i * DM * DM; WT = (bf16*)(ws + WS_WCO) + (size_t)i * DM * DM; ldw = DM; ncols = DM; }
    else if (r < TN5) { r -= TN4; const int i = r / I_UP; r -= i * I_UP; W = p.in[25] + (size_t)i * DM * FF2; WT = (bf16*)(ws + WS_WUP) + (size_t)i * FF2 * DM; ldw = FF2; ncols = FF2; wup = true; }
    else if (r < TN6) { r -= TN5; const int i = r / I_DN; r -= i * I_DN; W = p.in[27] + (size_t)i * FF * DM; WT = (bf16*)(ws + WS_WDN) + (size_t)i * DM * FF; ldw = DM; ncols = DM; K = FF; }
    else { r -= TN6; const int i = r / I_ADA; r -= i * I_ADA; W = p.in[13] + (size_t)i * DM * 6144; WT = (bf16*)(ws + WS_ZU) + (size_t)i * 6144 * DM; ldw = 6144; ncols = 6144; }
    const int nblk = ncols / 32, kb = r / nblk, nb = r - kb * nblk;
    int drow = 32 * nb;
    if (wup) drow = (nb < 88) ? 256 * (nb >> 2) + 32 * (nb & 3) : 256 * ((nb - 88) >> 2) + 128 + 32 * ((nb - 88) & 3);
    if (wqkv) { const int head = nb >> 1; drow = 256 * (head >> 2) + 128 * (nb & 1) + 32 * (head & 3); }
    d.W = W + (size_t)(64 * kb) * ldw + 32 * nb; d.WT = WT + (size_t)drow * K + 64 * kb; d.ldw = ldw; d.K = K;
}
__device__ __forceinline__ void tload(const TDesc& d, int lane, float (&v)[32]) {
#pragma unroll
    for (int i = 0; i < 32; ++i) v[i] = d.W[(size_t)(2 * i + (lane >> 5)) * d.ldw + (lane & 31)];
}
__device__ __forceinline__ void tstore(const TDesc& d, int lane, const float (&v)[32], float* scr) {
#pragma unroll
    for (int i = 0; i < 32; ++i) scr[(2 * i + (lane >> 5)) * 33 + (lane & 31)] = v[i];
    LDS_WAIT();
    const int c = lane & 7;
#pragma unroll
    for (int j = 0; j < 4; ++j) { const int n = (lane >> 3) + 8 * j; const float* s = scr + (8 * c) * 33 + n;
        u32x4 o; o.x = pk2(s[0 * 33], s[1 * 33]); o.y = pk2(s[2 * 33], s[3 * 33]); o.z = pk2(s[4 * 33], s[5 * 33]); o.w = pk2(s[6 * 33], s[7 * 33]);
        *(u32x4*)(d.WT + (size_t)n * d.K + 8 * c) = o; }
    LDS_WAIT();
}

__device__ __forceinline__ void prologue(const Params& p, unsigned char* smem) {
    const int tid = otid(), lane = tid & 63, wave = tid >> 6;
    const int gw = obid() * NWAVES + wave, NGW = gridDim.x * NWAVES;
    float* scr = (float*)(smem + wave * 16384);
    unsigned char* ws = p.ws;
    {
        float va[32], vb[32]; TDesc da, db;
        int it = gw;
        if (it < TN7) { tdecode(p, it, da); tload(da, lane, va); }
        while (it < TN7) {
            int nx = it + NGW;
            if (nx < TN7) { tdecode(p, nx, db); tload(db, lane, vb); }
            tstore(da, lane, va, scr);
            it = nx; nx = it + NGW;
            if (it >= TN7) break;
            if (nx < TN7) { tdecode(p, nx, da); tload(da, lane, va); }
            tstore(db, lane, vb, scr);
            it = nx;
        }
    }
    const int gt = obid() * NTHR + tid, NT = gridDim.x * NTHR;
    bf16* Ac = (bf16*)(ws + WS_AC);
    for (int idx = gt; idx < 256 * DM; idx += NT) { const int row = idx >> 10, col = idx & 1023; float v = 0.f;
        if (row < 2) v = p.in[2][row * DM + col]; else if (row < NSEQ) v = p.in[3][(row - 2) * DM + col];
        Ac[idx] = (bf16)f2bf(v * sigmoidf_(v)); }
    f32x2* TAB = (f32x2*)(ws + WS_TAB);
    for (int idx = gt; idx < 8200 * 32; idx += NT) { const int pos = idx >> 5, i = idx & 31;
        const double ang = (double)pos * ROPE_INV[i];
        const double n = rint(ang * 0.6366197723675814); double r = fma(-n, 1.5707963267948966, ang); r = fma(-n, 6.123233995736766e-17, r); const double r2 = r * r;
        const double sn = r * (1.0 + r2 * (-1.0 / 6 + r2 * (1.0 / 120 + r2 * (-1.0 / 5040 + r2 * (1.0 / 362880 + r2 * (-1.0 / 39916800 + r2 * (1.0 / 6227020800.0)))))));
        const double cn = 1.0 + r2 * (-0.5 + r2 * (1.0 / 24 + r2 * (-1.0 / 720 + r2 * (1.0 / 40320 + r2 * (-1.0 / 3628800 + r2 * (1.0 / 479001600.0 + r2 * (-1.0 / 87178291200.0)))))));
        const int qd = ((int)n) & 3; const double c = (qd == 0) ? cn : (qd == 1) ? -sn : (qd == 2) ? -cn : sn, s = (qd == 0) ? sn : (qd == 1) ? cn : (qd == 2) ? -sn : -cn;
        TAB[idx] = (f32x2){(float)c, (float)s}; }
}

__device__ __forceinline__ void norm_phase(const Params& p, int l, int which, unsigned char* smem) {
    const int tid = otid(), lane = tid & 63, wave = tid >> 6;
    const int gw = obid() * NWAVES + wave, NGW = gridDim.x * NWAVES;
    const bool do_gates = (which == 1) && !(l & 1);
    const bool first = (which == 1) && (l == 0);
    float* X = p.out;
    const float* MOD = (const float*)(p.ws + WS_MOD);
    bf16* H = (bf16*)(p.ws + WS_H);
    float* gwl = (float*)smem;
    if (do_gates) {
        const float* W = p.in[15] + (size_t)(l >> 1) * DM * INA + 2048;
        for (int idx = tid; idx < 8192; idx += NTHR) gwl[idx] = W[(size_t)(idx >> 3) * INA + (idx & 7)];
        __syncthreads();
    }
    const float* nw = (which == 1 ? p.in[11] : p.in[12]) + l * DM;
    const int off_sh = l * 6144 + (which == 1 ? 0 : 3072), off_sc = off_sh + 1024;
    f32x4 nwv[4];
#pragma unroll
    for (int j = 0; j < 4; ++j) nwv[j] = *(const f32x4*)(nw + 4 * lane + 256 * j);
    f32x4 vn[4], vn2[4];
#define NORM_SRC(r_) (first ? ((r_) < RP ? p.in[0] + (size_t)(r_) * DM : p.in[1] + (size_t)((r_) - RP) * DM) : X + (size_t)(r_) * DM)
    { const int row = gw; if (row < R) { const float* src = NORM_SRC(row);
#pragma unroll
        for (int j = 0; j < 4; ++j) vn[j] = *(const f32x4*)(src + 4 * lane + 256 * j); }
      const int row2 = gw + NGW; if (row2 < R) { const float* src = NORM_SRC(row2);
#pragma unroll
        for (int j = 0; j < 4; ++j) vn2[j] = *(const f32x4*)(src + 4 * lane + 256 * j); } }
    int cur_sq = -1; f32x4 mulv[4], shv[4];
    for (int row = gw; row < R; row += NGW) {
        const int sq = seq_of(row);
        if (sq != cur_sq) { cur_sq = sq; const float* mrow_ = MOD + (size_t)sq * MODW;
#pragma unroll
            for (int j = 0; j < 4; ++j) { const f32x4 sc = *(const f32x4*)(mrow_ + off_sc + 4 * lane + 256 * j); shv[j] = *(const f32x4*)(mrow_ + off_sh + 4 * lane + 256 * j); mulv[j] = nwv[j] * (sc + 1.f); } }
        f32x4 v[4]; float ss = 0.f;
#pragma unroll
        for (int j = 0; j < 4; ++j) { v[j] = vn[j]; vn[j] = vn2[j]; }
        { const int nrow = row + 2 * NGW; if (nrow < R) { const float* src = NORM_SRC(nrow);
#pragma unroll
            for (int j = 0; j < 4; ++j) vn2[j] = *(const f32x4*)(src + 4 * lane + 256 * j); } }
#pragma unroll
        for (int j = 0; j < 4; ++j) ss += (v[j].x * v[j].x + v[j].y * v[j].y) + (v[j].z * v[j].z + v[j].w * v[j].w);
        if (first) {
#pragma unroll
            for (int j = 0; j < 4; ++j) *(f32x4*)(X + (size_t)row * DM + 4 * lane + 256 * j) = v[j];
        }
        const float rstd = rsqrtf(wave_sum(ss) * (1.f / DM) + EPS);
        float ga[8];
#pragma unroll
        for (int g = 0; g < 8; ++g) ga[g] = 0.f;
#pragma unroll
        for (int j = 0; j < 4; ++j) {
            f32x4 h = v[j] * rstd * mulv[j] + shv[j];
            *(u32x2*)(H + (size_t)row * DM + 4 * lane + 256 * j) = (u32x2){pk2(h.x, h.y), pk2(h.z, h.w)};
            if (do_gates) {
#pragma unroll
                for (int e = 0; e < 4; ++e) { const float* wp = gwl + (4 * lane + 256 * j + e) * 8; const f32x4 w0 = *(const f32x4*)wp, w1 = *(const f32x4*)(wp + 4); const float hv = h[e];
                    ga[0] += hv * w0.x; ga[1] += hv * w0.y; ga[2] += hv * w0.z; ga[3] += hv * w0.w; ga[4] += hv * w1.x; ga[5] += hv * w1.y; ga[6] += hv * w1.z; ga[7] += hv * w1.w; }
            }
        }
        if (do_gates) {
            const float* bif = p.in[16] + (l >> 1) * 8;
#pragma unroll
            for (int g = 0; g < 8; ++g) ga[g] = wave_sum(ga[g]);
            if (lane == 0) { float* G = (float*)(p.ws + WS_GATES) + (size_t)row * 8;
                *(f32x4*)G = (f32x4){ga[0] + bif[0], ga[1] + bif[1], ga[2] + bif[2], ga[3] + bif[3]}; *(f32x4*)(G + 4) = (f32x4){ga[4] + bif[4], ga[5] + bif[5], ga[6] + bif[6], ga[7] + bif[7]}; }
        }
    }
    __syncthreads();
}

__device__ __forceinline__ float scan_add(float v, int lane) {
#pragma unroll
    for (int o = 1; o < 64; o <<= 1) { const float t = shup(v, o); if (lane >= o) v += t; }
    return v;
}
__device__ __forceinline__ float scan_max(float v, int lane) {
#pragma unroll
    for (int o = 1; o < 64; o <<= 1) { const float t = shup(v, o); if (lane >= o) v = fmaxf(v, t); }
    return v;
}
constexpr float KSCALE = 0.08838834764831845f;

__device__ __forceinline__ void head_out(const Params& p, int i, int h, int row, int lane, float hv0, float hv1, unsigned zo, f32x2 on) {
    const float ss = wave_sum(hv0 * hv0 + hv1 * hv1);
    const float rstd = rsqrtf(ss * (1.f / 128.f) + EPS);
    unsigned* CAT = (unsigned*)((bf16*)(p.ws + WS_CAT) + (size_t)row * DM + h * 128);
    CAT[lane] = pk2(hv0 * rstd * on.x * sigmoidf_(bflo(zo)), hv1 * rstd * on.y * sigmoidf_(bfhi(zo)));
}
__device__ __forceinline__ void mlstm_local(const Params& p, int i, int item, unsigned char* smem) {
    const int tid = otid(), lane = tid & 63, wave = tid >> 6, fr = lane & 15, fq = lane >> 4;
    const int b = item >> 9, h = (item >> 7) & 3, c = item & 127, r0 = b * SEQL + c * 64;
    float* ws_l = (float*)smem;
    bf16* kT = (bf16*)(smem + 1024);
    bf16* vT = kT + 128 * 72;
    const float* G = (const float*)(p.ws + WS_GATES);
    const bf16* Z = (const bf16*)(p.ws + WS_ZU);
    if (wave == 0) {
        const float ig = G[(size_t)(r0 + lane) * 8 + h], lf = logsigmoidf(G[(size_t)(r0 + lane) * 8 + 4 + h]);
        const float bs = scan_add(lf, lane), bL = shi(bs, 63);
        const float a = bL - bs + ig, amax = wave_max(a);
        ws_l[lane] = __expf(a - amax);
        if (lane == 0) { float* CS = (float*)(p.ws + WS_CS); CS[item * 2] = bL; CS[item * 2 + 1] = amax; }
    }
    __syncthreads();
    { u32x4 wv[4];
#pragma unroll
      for (int it = 0; it < 4; ++it) { const int q = tid + it * NTHR, which = q >> 10, idx = q & 1023, s = idx & 63, ch = idx >> 6; wv[it] = *(const u32x4*)(Z + (size_t)(r0 + s) * ZW + (which ? 1024 : 512) + h * 128 + ch * 8); }
#pragma unroll
      for (int it = 0; it < 4; ++it) { const int q = tid + it * NTHR, which = q >> 10, idx = q & 1023, s = idx & 63, ch = idx >> 6; const u32x4 w = wv[it];
        bf16* dst = (which ? vT : kT) + (ch * 8) * 72 + s;
        if (which) {
            dst[0 * 72] = (bf16)(w.x & 0xffff); dst[1 * 72] = (bf16)(w.x >> 16); dst[2 * 72] = (bf16)(w.y & 0xffff); dst[3 * 72] = (bf16)(w.y >> 16);
            dst[4 * 72] = (bf16)(w.z & 0xffff); dst[5 * 72] = (bf16)(w.z >> 16); dst[6 * 72] = (bf16)(w.w & 0xffff); dst[7 * 72] = (bf16)(w.w >> 16);
        } else { const float sc = ws_l[s] * KSCALE;
            dst[0 * 72] = (bf16)f2bf(bflo(w.x) * sc); dst[1 * 72] = (bf16)f2bf(bfhi(w.x) * sc); dst[2 * 72] = (bf16)f2bf(bflo(w.y) * sc); dst[3 * 72] = (bf16)f2bf(bfhi(w.y) * sc);
            dst[4 * 72] = (bf16)f2bf(bflo(w.z) * sc); dst[5 * 72] = (bf16)f2bf(bfhi(w.z) * sc); dst[6 * 72] = (bf16)f2bf(bflo(w.w) * sc); dst[7 * 72] = (bf16)f2bf(bfhi(w.w) * sc); } } }
    __syncthreads();
    f32x4 acc[8];
#pragma unroll
    for (int mt = 0; mt < 8; ++mt) acc[mt] = (f32x4){0.f, 0.f, 0.f, 0.f};
#pragma unroll
    for (int ks = 0; ks < 2; ++ks) { const bf16x8 B = *(const bf16x8*)(vT + (16 * wave + fr) * 72 + 32 * ks + 8 * fq);
#pragma unroll
        for (int mt = 0; mt < 8; ++mt) { const bf16x8 A = *(const bf16x8*)(kT + (16 * mt + fr) * 72 + 32 * ks + 8 * fq); acc[mt] = __builtin_amdgcn_mfma_f32_16x16x32_bf16(A, B, acc[mt], 0, 0, 0); } }
    bf16* dCt = (bf16*)(p.ws + WS_DCT) + (size_t)item * 16384;
#pragma unroll
    for (int mt = 0; mt < 8; ++mt) *(u32x2*)(dCt + (16 * wave + fr) * 128 + 16 * mt + 4 * fq) = (u32x2){pk2_sw(acc[mt][0], acc[mt][1]), pk2_sw(acc[mt][2], acc[mt][3])};
    if (tid < 128) { float s = 0.f;
        for (int t = 0; t < 64; ++t) s += bf2f(kT[tid * 72 + t]);
        ((float*)(p.ws + WS_DN))[item * 128 + tid] = s; }
    __syncthreads();
}

__device__ __forceinline__ void mlstm_scan(const Params& p, int i, unsigned char* smem) {
    const float* CS = (const float*)(p.ws + WS_CS); const bf16* dCt = (const bf16*)(p.ws + WS_DCT); const float* DN = (const float*)(p.ws + WS_DN);
    bf16* CSt = (bf16*)(p.ws + WS_CST); float* NS = (float*)(p.ws + WS_NS); float* MS = (float*)(p.ws + WS_MS);
    for (int idx = obid() * NTHR + otid(); idx < 8 * 16384; idx += gridDim.x * NTHR) {
        const int bh = idx >> 14, e = idx & 16383;
        float* csl = (float*)smem;
        __syncthreads(); if (otid() < 256) csl[otid()] = CS[bh * 256 + otid()]; __syncthreads();
        float C = 0.f, m = 0.f, nacc = 0.f;
        float dv[16], dnv[16], dv2[16], dnv2[16];
#define SC_LD(D, DNV, c0_) do { _Pragma("unroll") for (int k_ = 0; k_ < 16; ++k_) { D[k_] = bf2f(dCt[(size_t)(bh * 128 + (c0_) + k_) * 16384 + e]); DNV[k_] = (e < 128) ? DN[(bh * 128 + (c0_) + k_) * 128 + e] : 0.f; } } while (0)
#define SC_RUN(D, DNV, c0_) do { _Pragma("unroll") for (int k_ = 0; k_ < 16; ++k_) { const int item = bh * 128 + (c0_) + k_; const float bL = csl[2 * ((c0_) + k_)], amax = csl[2 * ((c0_) + k_) + 1]; \
                CSt[(size_t)item * 16384 + e] = (bf16)f2bf(C); if (e < 128) NS[item * 128 + e] = nacc; if (e == 0) MS[item] = m; \
                const float mn = fmaxf(bL + m, amax), f1 = __expf(bL + m - mn), f2 = __expf(amax - mn); C = f1 * C + f2 * D[k_]; nacc = f1 * nacc + f2 * DNV[k_]; m = mn; } } while (0)
        SC_LD(dv, dnv, 0);
        for (int c0 = 0; c0 < 128; c0 += 32) {
            SC_LD(dv2, dnv2, c0 + 16);
            SC_RUN(dv, dnv, c0);
            if (c0 + 32 < 128) SC_LD(dv, dnv, c0 + 32);
            SC_RUN(dv2, dnv2, c0 + 16);
        }
#undef SC_LD
#undef SC_RUN
        const int b = bh >> 2, h = bh & 3; const size_t sidx = (size_t)((i * 2 + b) * 4 + h);
        p.out[O_PC + sidx * 16384 + (size_t)(e & 127) * 128 + (e >> 7)] = C;
        if (e < 128) p.out[O_PN + sidx * 128 + e] = nacc;
        if (e == 0) p.out[O_PM + sidx] = m;
    }
}

__device__ __forceinline__ void mlstm_out(const Params& p, int i, int item, unsigned char* smem) {
    const int tid = otid(), lane = tid & 63, wave = tid >> 6, fr = lane & 15, fq = lane >> 4;
    const int b = item >> 9, h = (item >> 7) & 3, c = item & 127, r0 = b * SEQL + c * 64;
    float* d_l = (float*)smem;
    float* M_l = d_l + 64;
    float* wg_l = d_l + 128;
    float* mt_l = d_l + 192;
    float* den_l = d_l + 256;
    float* rs_l = d_l + 320;
    float* qn_l = d_l + 448;
    bf16* q_l = (bf16*)(smem + 2048);
    bf16* k_l = q_l + 64 * 136;
    bf16* vT = k_l + 64 * 136;
    bf16* Sw = vT + 128 * 72;
    float* hbuf = (float*)(Sw + 64 * 72);
    const float* G = (const float*)(p.ws + WS_GATES);
    const bf16* Z = (const bf16*)(p.ws + WS_ZU);
    bf16x8 Bc[4];
    { const bf16* cp = (const bf16*)(p.ws + WS_CST) + (size_t)item * 16384 + (16 * wave + fr) * 128 + 8 * fq;
#pragma unroll
      for (int ks = 0; ks < 4; ++ks) Bc[ks] = *(const bf16x8*)(cp + 32 * ks); }
    if (wave == 0) {
        const float ig = G[(size_t)(r0 + lane) * 8 + h], lf = logsigmoidf(G[(size_t)(r0 + lane) * 8 + 4 + h]);
        const float bs = scan_add(lf, lane), d = ig - bs, gmax = scan_max(d, lane);
        const float mc = ((const float*)(p.ws + WS_MS))[item];
        const float Mt = fmaxf(mc, gmax);
        d_l[lane] = d; M_l[lane] = Mt; wg_l[lane] = __expf(mc - Mt); mt_l[lane] = bs + Mt;
    }
    { u32x4 wv[6];
#pragma unroll
      for (int it = 0; it < 6; ++it) { const int q = tid + it * NTHR, which = q >> 10, idx = q & 1023, s = (which == 2) ? (idx & 63) : (idx >> 4), ch = (which == 2) ? (idx >> 6) : (idx & 15); wv[it] = *(const u32x4*)(Z + (size_t)(r0 + s) * ZW + which * 512 + h * 128 + ch * 8); }
#pragma unroll
      for (int it = 0; it < 6; ++it) { const int q = tid + it * NTHR, which = q >> 10, idx = q & 1023, s = (which == 2) ? (idx & 63) : (idx >> 4), ch = (which == 2) ? (idx >> 6) : (idx & 15); const u32x4 w = wv[it];
        if (which == 0) *(u32x4*)(q_l + s * 136 + ch * 8) = w;
        else if (which == 1) { u32x4 o; o.x = pk2(bflo(w.x) * KSCALE, bfhi(w.x) * KSCALE); o.y = pk2(bflo(w.y) * KSCALE, bfhi(w.y) * KSCALE);
            o.z = pk2(bflo(w.z) * KSCALE, bfhi(w.z) * KSCALE); o.w = pk2(bflo(w.w) * KSCALE, bfhi(w.w) * KSCALE); *(u32x4*)(k_l + s * 136 + ch * 8) = o; }
        else { bf16* dst = vT + (ch * 8) * 72 + s;
            dst[0 * 72] = (bf16)(w.x & 0xffff); dst[1 * 72] = (bf16)(w.x >> 16); dst[2 * 72] = (bf16)(w.y & 0xffff); dst[3 * 72] = (bf16)(w.y >> 16);
            dst[4 * 72] = (bf16)(w.z & 0xffff); dst[5 * 72] = (bf16)(w.z >> 16); dst[6 * 72] = (bf16)(w.w & 0xffff); dst[7 * 72] = (bf16)(w.w >> 16); } } }
    __syncthreads();
    {
        const int mt = wave >> 1, nt0 = 2 * (wave & 1);
        f32x4 a2[2] = {(f32x4){0.f, 0.f, 0.f, 0.f}, (f32x4){0.f, 0.f, 0.f, 0.f}};
#pragma unroll
        for (int ks = 0; ks < 4; ++ks) { const bf16x8 A = *(const bf16x8*)(q_l + (16 * mt + fr) * 136 + 32 * ks + 8 * fq);
#pragma unroll
            for (int n = 0; n < 2; ++n) { const bf16x8 B = *(const bf16x8*)(k_l + (16 * (nt0 + n) + fr) * 136 + 32 * ks + 8 * fq); a2[n] = __builtin_amdgcn_mfma_f32_16x16x32_bf16(A, B, a2[n], 0, 0, 0); } }
        float rsum[4] = {0.f, 0.f, 0.f, 0.f};
#pragma unroll
        for (int n = 0; n < 2; ++n) { const int s = 16 * (nt0 + n) + fr; const float ds = d_l[s];
#pragma unroll
            for (int j = 0; j < 4; ++j) { const int t = 16 * mt + 4 * fq + j; const float wv = (s <= t) ? __expf(ds - M_l[t]) : 0.f; const float val = a2[n][j] * wv; rsum[j] += val; Sw[t * 72 + s] = (bf16)f2bf(val); } }
#pragma unroll
        for (int j = 0; j < 4; ++j) { float v = rsum[j]; v += shx(v, 1); v += shx(v, 2); v += shx(v, 4); v += shx(v, 8); if (fr == 0) rs_l[(wave & 1) * 64 + 16 * mt + 4 * fq + j] = v; }
        { const int t = tid >> 3, part = tid & 7; const float* NS = (const float*)(p.ws + WS_NS) + item * 128 + part * 16;
          const u32x4 qa = *(const u32x4*)(q_l + t * 136 + part * 16), qb = *(const u32x4*)(q_l + t * 136 + part * 16 + 8);
          const f32x4 n0 = *(const f32x4*)NS, n1 = *(const f32x4*)(NS + 4), n2 = *(const f32x4*)(NS + 8), n3 = *(const f32x4*)(NS + 12);
          float v = bflo(qa.x) * n0.x + bfhi(qa.x) * n0.y + bflo(qa.y) * n0.z + bfhi(qa.y) * n0.w + bflo(qa.z) * n1.x + bfhi(qa.z) * n1.y + bflo(qa.w) * n1.z + bfhi(qa.w) * n1.w
                  + bflo(qb.x) * n2.x + bfhi(qb.x) * n2.y + bflo(qb.y) * n2.z + bfhi(qb.y) * n2.w + bflo(qb.z) * n3.x + bfhi(qb.z) * n3.y + bflo(qb.w) * n3.z + bfhi(qb.w) * n3.w;
          v += shx(v, 1); v += shx(v, 2); v += shx(v, 4); if (part == 0) qn_l[t] = v; }
    }
    __syncthreads();
    if (tid < 64) { const int t = tid; const float den = wg_l[t] * qn_l[t] + (rs_l[t] + rs_l[64 + t]); den_l[t] = __builtin_amdgcn_rcpf(fmaxf(fabsf(den), __expf(-mt_l[t]))); }
    f32x4 acc[4];
#pragma unroll
    for (int mt = 0; mt < 4; ++mt) acc[mt] = (f32x4){0.f, 0.f, 0.f, 0.f};
#pragma unroll
    for (int ks = 0; ks < 4; ++ks) { const bf16x8 B = Bc[ks];
#pragma unroll
        for (int mt = 0; mt < 4; ++mt) { const bf16x8 A = *(const bf16x8*)(q_l + (16 * mt + fr) * 136 + 32 * ks + 8 * fq); acc[mt] = __builtin_amdgcn_mfma_f32_16x16x32_bf16(A, B, acc[mt], 0, 0, 0); } }
#pragma unroll
    for (int mt = 0; mt < 4; ++mt)
#pragma unroll
        for (int j = 0; j < 4; ++j) acc[mt][j] *= wg_l[16 * mt + 4 * fq + j];
#pragma unroll
    for (int ks = 0; ks < 2; ++ks) { const bf16x8 B = *(const bf16x8*)(vT + (16 * wave + fr) * 72 + 32 * ks + 8 * fq);
#pragma unroll
        for (int mt = 0; mt < 4; ++mt) { const bf16x8 A = *(const bf16x8*)(Sw + (16 * mt + fr) * 72 + 32 * ks + 8 * fq); acc[mt] = __builtin_amdgcn_mfma_f32_16x16x32_bf16(A, B, acc[mt], 0, 0, 0); } }
    __syncthreads();
#pragma unroll
    for (int mt = 0; mt < 4; ++mt)
#pragma unroll
        for (int j = 0; j < 4; ++j) { const int t = 16 * mt + 4 * fq + j; hbuf[t * 132 + 16 * wave + fr] = acc[mt][j] * den_l[t]; }
    __syncthreads();
    { unsigned zo[8]; const f32x2 on = *(const f32x2*)(p.in[17] + i * 512 + h * 128 + 2 * lane);
#pragma unroll
      for (int tt = 0; tt < 8; ++tt) zo[tt] = *(const unsigned*)(Z + (size_t)(r0 + 8 * wave + tt) * ZW + 1536 + h * 128 + 2 * lane);
#pragma unroll
      for (int tt = 0; tt < 8; ++tt) { const int t = 8 * wave + tt; const f32x2 hv = *(const f32x2*)(hbuf + t * 132 + 2 * lane); head_out(p, i, h, r0 + t, lane, hv.x, hv.y, zo[tt], on); } }
    __syncthreads();
}

__device__ __forceinline__ void mlstm_out2(const Params& p, int i, int itA, int itB, unsigned char* smem) {
    const int tid = otid(), lane = tid & 63, wave = tid >> 6, fr = lane & 15, fq = lane >> 4, hh = wave >> 2, wl = wave & 3, tl = tid & 255;
    const int item_ = hh ? itB : itA; const bool active = item_ < 1024; const int item = active ? item_ : 0;
    const int b = item >> 9, h = (item >> 7) & 3, c = item & 127, r0 = b * SEQL + c * 64;
    unsigned char* sb = smem + hh * 65536;
    float* d_l = (float*)sb;
    float* M_l = d_l + 64;
    float* wg_l = d_l + 128;
    float* mt_l = d_l + 192;
    float* den_l = d_l + 256;
    float* rs_l = d_l + 320;
    float* qn_l = d_l + 384;
    bf16* q_l = (bf16*)(sb + 2048);
    bf16* k_l = q_l + 64 * 136;
    float* hbuf = (float*)(sb + 2048);
    bf16* vT = k_l + 64 * 136;
    bf16* Sw = vT + 128 * 72;
    const float* G = (const float*)(p.ws + WS_GATES);
    const bf16* Z = (const bf16*)(p.ws + WS_ZU);
    bf16x8 Bc[2][4];
#pragma unroll
    for (int n = 0; n < 2; ++n) { const bf16* cp = (const bf16*)(p.ws + WS_CST) + (size_t)item * 16384 + (16 * (2 * wl + n) + fr) * 128 + 8 * fq;
#pragma unroll
        for (int ks = 0; ks < 4; ++ks) Bc[n][ks] = *(const bf16x8*)(cp + 32 * ks); }
    if (wl == 0) {
        const float ig = G[(size_t)(r0 + lane) * 8 + h], lf = logsigmoidf(G[(size_t)(r0 + lane) * 8 + 4 + h]);
        const float bs = scan_add(lf, lane), d = ig - bs, gmax = scan_max(d, lane);
        const float mc = ((const float*)(p.ws + WS_MS))[item];
        const float Mt = fmaxf(mc, gmax);
        d_l[lane] = d; M_l[lane] = Mt; wg_l[lane] = __expf(mc - Mt); mt_l[lane] = bs + Mt;
    }
    { u32x4 wv[12];
#pragma unroll
      for (int it = 0; it < 12; ++it) { const int q = tl + it * 256, which = q >> 10, idx = q & 1023, s = (which == 2) ? (idx & 63) : (idx >> 4), ch = (which == 2) ? (idx >> 6) : (idx & 15); wv[it] = *(const u32x4*)(Z + (size_t)(r0 + s) * ZW + which * 512 + h * 128 + ch * 8); }
#pragma unroll
      for (int it = 0; it < 12; ++it) { const int q = tl + it * 256, which = q >> 10, idx = q & 1023, s = (which == 2) ? (idx & 63) : (idx >> 4), ch = (which == 2) ? (idx >> 6) : (idx & 15); const u32x4 w = wv[it];
        if (which == 0) *(u32x4*)(q_l + s * 136 + ch * 8) = w;
        else if (which == 1) { u32x4 o; o.x = pk2(bflo(w.x) * KSCALE, bfhi(w.x) * KSCALE); o.y = pk2(bflo(w.y) * KSCALE, bfhi(w.y) * KSCALE);
            o.z = pk2(bflo(w.z) * KSCALE, bfhi(w.z) * KSCALE); o.w = pk2(bflo(w.w) * KSCALE, bfhi(w.w) * KSCALE); *(u32x4*)(k_l + s * 136 + ch * 8) = o; }
        else { bf16* dst = vT + (ch * 8) * 72 + s;
            dst[0 * 72] = (bf16)(w.x & 0xffff); dst[1 * 72] = (bf16)(w.x >> 16); dst[2 * 72] = (bf16)(w.y & 0xffff); dst[3 * 72] = (bf16)(w.y >> 16);
            dst[4 * 72] = (bf16)(w.z & 0xffff); dst[5 * 72] = (bf16)(w.z >> 16); dst[6 * 72] = (bf16)(w.w & 0xffff); dst[7 * 72] = (bf16)(w.w >> 16); } } }
    __syncthreads();
    {
        const int mt = wl;
        f32x4 a4[4];
#pragma unroll
        for (int n = 0; n < 4; ++n) a4[n] = (f32x4){0.f, 0.f, 0.f, 0.f};
#pragma unroll
        for (int ks = 0; ks < 4; ++ks) { const bf16x8 A = *(const bf16x8*)(q_l + (16 * mt + fr) * 136 + 32 * ks + 8 * fq);
#pragma unroll
            for (int n = 0; n < 4; ++n) if (n <= mt) { const bf16x8 B = *(const bf16x8*)(k_l + (16 * n + fr) * 136 + 32 * ks + 8 * fq); a4[n] = __builtin_amdgcn_mfma_f32_16x16x32_bf16(A, B, a4[n], 0, 0, 0); } }
        float rsum[4] = {0.f, 0.f, 0.f, 0.f};
#pragma unroll
        for (int n = 0; n < 4; ++n) { const int s = 16 * n + fr; const float ds = d_l[s];
#pragma unroll
            for (int j = 0; j < 4; ++j) { const int t = 16 * mt + 4 * fq + j; const float wv = (s <= t) ? __expf(ds - M_l[t]) : 0.f; const float val = a4[n][j] * wv; rsum[j] += val; Sw[t * 72 + s] = (bf16)f2bf(val); } }
#pragma unroll
        for (int j = 0; j < 4; ++j) { float v = rsum[j]; v += shx(v, 1); v += shx(v, 2); v += shx(v, 4); v += shx(v, 8); if (fr == 0) rs_l[16 * mt + 4 * fq + j] = v; }
        { const int t = tl >> 2, part = tl & 3; const float* NS = (const float*)(p.ws + WS_NS) + item * 128 + part * 32; float v = 0.f;
#pragma unroll
          for (int g = 0; g < 4; ++g) { const u32x4 qa = *(const u32x4*)(q_l + t * 136 + part * 32 + 8 * g); const f32x4 n0 = *(const f32x4*)(NS + 8 * g), n1 = *(const f32x4*)(NS + 8 * g + 4);
              v += bflo(qa.x) * n0.x + bfhi(qa.x) * n0.y + bflo(qa.y) * n0.z + bfhi(qa.y) * n0.w + bflo(qa.z) * n1.x + bfhi(qa.z) * n1.y + bflo(qa.w) * n1.z + bfhi(qa.w) * n1.w; }
          v += shx(v, 1); v += shx(v, 2); if (part == 0) qn_l[t] = v; }
    }
    __syncthreads();
    if (tl < 64) { const int t = tl; const float den = wg_l[t] * qn_l[t] + rs_l[t]; den_l[t] = __builtin_amdgcn_rcpf(fmaxf(fabsf(den), __expf(-mt_l[t]))); }
    f32x4 acc[2][4];
#pragma unroll
    for (int n = 0; n < 2; ++n)
#pragma unroll
        for (int mt = 0; mt < 4; ++mt) acc[n][mt] = (f32x4){0.f, 0.f, 0.f, 0.f};
#pragma unroll
    for (int ks = 0; ks < 4; ++ks)
#pragma unroll
        for (int mt = 0; mt < 4; ++mt) { const bf16x8 A = *(const bf16x8*)(q_l + (16 * mt + fr) * 136 + 32 * ks + 8 * fq);
#pragma unroll
            for (int n = 0; n < 2; ++n) acc[n][mt] = __builtin_amdgcn_mfma_f32_16x16x32_bf16(A, Bc[n][ks], acc[n][mt], 0, 0, 0); }
#pragma unroll
    for (int mt = 0; mt < 4; ++mt)
#pragma unroll
        for (int j = 0; j < 4; ++j) { const float wgv = wg_l[16 * mt + 4 * fq + j]; acc[0][mt][j] *= wgv; acc[1][mt][j] *= wgv; }
#pragma unroll
    for (int ks = 0; ks < 2; ++ks)
#pragma unroll
        for (int mt = 0; mt < 4; ++mt) { const bf16x8 A = *(const bf16x8*)(Sw + (16 * mt + fr) * 72 + 32 * ks + 8 * fq);
#pragma unroll
            for (int n = 0; n < 2; ++n) { const bf16x8 B = *(const bf16x8*)(vT + (16 * (2 * wl + n) + fr) * 72 + 32 * ks + 8 * fq); acc[n][mt] = __builtin_amdgcn_mfma_f32_16x16x32_bf16(A, B, acc[n][mt], 0, 0, 0); } }
    __syncthreads();
#pragma unroll
    for (int n = 0; n < 2; ++n)
#pragma unroll
        for (int mt = 0; mt < 4; ++mt)
#pragma unroll
            for (int j = 0; j < 4; ++j) { const int t = 16 * mt + 4 * fq + j; hbuf[t * 132 + 16 * (2 * wl + n) + fr] = acc[n][mt][j] * den_l[t]; }
    __syncthreads();
    { unsigned zo[16]; const f32x2 on = *(const f32x2*)(p.in[17] + i * 512 + h * 128 + 2 * lane);
#pragma unroll
      for (int tt = 0; tt < 16; ++tt) zo[tt] = *(const unsigned*)(Z + (size_t)(r0 + 16 * wl + tt) * ZW + 1536 + h * 128 + 2 * lane);
#pragma unroll
      for (int tt = 0; tt < 16; ++tt) { const int t = 16 * wl + tt; const f32x2 hv = *(const f32x2*)(hbuf + t * 132 + 2 * lane);
          const float ss = wave_sum(hv.x * hv.x + hv.y * hv.y); const float rstd = rsqrtf(ss * (1.f / 128.f) + EPS);
          if (active) { unsigned* CAT = (unsigned*)((bf16*)(p.ws + WS_CAT) + (size_t)(r0 + t) * DM + h * 128);
              CAT[lane] = pk2(hv.x * rstd * on.x * sigmoidf_(bflo(zo[tt])), hv.y * rstd * on.y * sigmoidf_(bfhi(zo[tt]))); } } }
    __syncthreads();
}

__device__ __forceinline__ void mlstm_sample(const Params& p, int i, int item, unsigned char* smem) {
    const int tid = otid(), lane = tid & 63, wave = tid >> 6;
    const int s = item >> 2, h = item & 3, r0 = RP + 8 * s;
    float* qq = (float*)smem;
    float* kk = qq + 1024;
    float* vv = kk + 1024;
    float* qT = vv + 1024;
    float* kwT = qT + 1024;
    float* part = kwT + 1024;
    float* S_l = part + 4096;
    float* sc = S_l + 64;
    const bf16* Z = (const bf16*)(p.ws + WS_ZU);
    const float* G = (const float*)(p.ws + WS_GATES);
    const size_t sidx = (size_t)((i * 128 + s) * 4 + h);
    const float* n0 = p.in[5] + sidx * 128;
    { bf16 zv[6];
#pragma unroll
      for (int it = 0; it < 6; ++it) { const int q = tid + it * NTHR, which = q >> 10, t = (q >> 7) & 7, d = q & 127; zv[it] = Z[(size_t)(r0 + t) * ZW + which * 512 + h * 128 + d]; }
#pragma unroll
      for (int it = 0; it < 6; ++it) { const int q = tid + it * NTHR, which = q >> 10; float v = bf2f(zv[it]); if (which == 1) v *= KSCALE; qq[q] = v; } }
    if (wave == 0) {
        const int t = lane & 7;
        const float ig = G[(size_t)(r0 + t) * 8 + h], lf = logsigmoidf(G[(size_t)(r0 + t) * 8 + 4 + h]);
        float bs = 0.f;
        for (int u = 0; u < 8; ++u) { const float x = shi(lf, u); if (u <= t) bs += x; }
        const float d = ig - bs; float gmax = -INFINITY;
        for (int u = 0; u < 8; ++u) { const float x = shi(d, u); if (u <= t) gmax = fmaxf(gmax, x); }
        const float m0 = p.in[6][sidx];
        const float Mt = fmaxf(m0, gmax), bL = shi(bs, 7), a = bL - bs + ig;
        float amax = -INFINITY;
        for (int u = 0; u < 8; ++u) amax = fmaxf(amax, shi(a, u));
        const float mnew = fmaxf(bL + m0, amax);
        if (lane < 8) { sc[t] = d; sc[8 + t] = Mt; sc[16 + t] = __expf(m0 - Mt); sc[24 + t] = bs + Mt; sc[32 + t] = __expf(a - mnew); }
        if (lane == 0) { sc[56] = __expf(bL + m0 - mnew); sc[57] = mnew; }
    }
    __syncthreads();
    { const int pr = tid >> 3, part = tid & 7, t = pr >> 3, u = pr & 7; float dot = 0.f;
#pragma unroll
        for (int d = 0; d < 16; ++d) dot += qq[t * 128 + part * 16 + d] * kk[u * 128 + part * 16 + d];
        dot += shx(dot, 1); dot += shx(dot, 2); dot += shx(dot, 4);
        if (part == 0) S_l[pr] = (u <= t) ? dot * __expf(sc[u] - sc[8 + t]) : 0.f; }
    if (tid < 64) { const int t = tid >> 3, part = tid & 7; float dot = 0.f;
#pragma unroll
        for (int d = 0; d < 16; ++d) dot += qq[t * 128 + part * 16 + d] * n0[part * 16 + d];
        dot += shx(dot, 1); dot += shx(dot, 2); dot += shx(dot, 4);
        if (part == 0) sc[40 + t] = dot; }
    for (int idx = tid; idx < 1024; idx += NTHR) { const int dk = idx >> 3, t = idx & 7; qT[idx] = qq[t * 128 + dk]; kwT[idx] = kk[t * 128 + dk] * sc[32 + t]; }
    __syncthreads();
    if (tid < 8) { float rs = 0.f; for (int u = 0; u < 8; ++u) rs += S_l[tid * 8 + u];
        const float den = sc[16 + tid] * sc[40 + tid] + rs; sc[48 + tid] = fmaxf(fabsf(den), __expf(-sc[24 + tid])); }
    {
        const int e = tid & 127, g = tid >> 7; const float wc = sc[56];
        float vr[8], acc[8];
#pragma unroll
        for (int u = 0; u < 8; ++u) { vr[u] = vv[u * 128 + e]; acc[u] = 0.f; }
        const float* Cin = p.in[4] + sidx * 16384; float* Cout = p.out + O_SC + sidx * 16384;
        float cin[32];
#pragma unroll
        for (int k = 0; k < 32; ++k) cin[k] = Cin[(g * 32 + k) * 128 + e];
#pragma unroll
        for (int k = 0; k < 32; ++k) { const int dk = g * 32 + k; const float cv = cin[k];
            const f32x4 q0 = *(const f32x4*)(qT + dk * 8), q1 = *(const f32x4*)(qT + dk * 8 + 4), k0 = *(const f32x4*)(kwT + dk * 8), k1 = *(const f32x4*)(kwT + dk * 8 + 4);
            acc[0] += q0.x * cv; acc[1] += q0.y * cv; acc[2] += q0.z * cv; acc[3] += q0.w * cv; acc[4] += q1.x * cv; acc[5] += q1.y * cv; acc[6] += q1.z * cv; acc[7] += q1.w * cv;
            float cn = wc * cv;
            cn += k0.x * vr[0] + k0.y * vr[1] + k0.z * vr[2] + k0.w * vr[3] + k1.x * vr[4] + k1.y * vr[5] + k1.z * vr[6] + k1.w * vr[7];
            Cout[dk * 128 + e] = cn; }
#pragma unroll
        for (int u = 0; u < 8; ++u) part[(g * 8 + u) * 128 + e] = acc[u];
        if (tid < 128) { float nn = wc * n0[tid];
#pragma unroll
            for (int u = 0; u < 8; ++u) nn += kwT[tid * 8 + u];
            p.out[O_SN + sidx * 128 + tid] = nn; }
        if (tid == 0) p.out[O_SM + sidx] = sc[57];
    }
    __syncthreads();
    {
        const int t = wave; float hv[2];
        const unsigned zo = *(const unsigned*)(Z + (size_t)(r0 + t) * ZW + 1536 + h * 128 + 2 * lane); const f32x2 on = *(const f32x2*)(p.in[17] + i * 512 + h * 128 + 2 * lane);
#pragma unroll
        for (int k = 0; k < 2; ++k) { const int e = 2 * lane + k;
            float num = (part[(0 * 8 + t) * 128 + e] + part[(1 * 8 + t) * 128 + e]) + (part[(2 * 8 + t) * 128 + e] + part[(3 * 8 + t) * 128 + e]);
            num *= sc[16 + t];
#pragma unroll
            for (int u = 0; u < 8; ++u) num += S_l[t * 8 + u] * vv[u * 128 + e];
            hv[k] = num / sc[48 + t]; }
        head_out(p, i, h, r0 + t, lane, hv[0], hv[1], zo, on);
    }
    __syncthreads();
}

__device__ __forceinline__ void unpack8(const u32x4 w, float (&v)[8]) { v[0] = bflo(w.x); v[1] = bfhi(w.x); v[2] = bflo(w.y); v[3] = bfhi(w.y); v[4] = bflo(w.z); v[5] = bfhi(w.z); v[6] = bflo(w.w); v[7] = bfhi(w.w); }
__device__ __forceinline__ void ld8f(const float* s, float (&v)[8]) { const f32x4 a = *(const f32x4*)s, b = *(const f32x4*)(s + 4); v[0] = a.x; v[1] = a.y; v[2] = a.z; v[3] = a.w; v[4] = b.x; v[5] = b.y; v[6] = b.z; v[7] = b.w; }
__device__ __forceinline__ void st8f(float* d, const float (&v)[8]) { *(f32x4*)d = (f32x4){v[0], v[1], v[2], v[3]}; *(f32x4*)(d + 4) = (f32x4){v[4], v[5], v[6], v[7]}; }
__device__ __forceinline__ void shortconv(const Params& p, int i) {
    const bf16* Z = (const bf16*)(p.ws + WS_ZU); bf16* CAT = (bf16*)(p.ws + WS_CAT);
    const float* cw = p.in[18] + i * 3 * 512;
    float cw0[8], cw1[8], cw2[8]; int chc = -1;
    for (int idx = obid() * NTHR + otid(); idx < R * 64; idx += gridDim.x * NTHR) {
        const int row = idx >> 6, ch = (idx & 63) * 8;
        if (ch != chc) { chc = ch; ld8f(cw + ch, cw0); ld8f(cw + 512 + ch, cw1); ld8f(cw + 1024 + ch, cw2); }
        const bool prm = row < RP; const int t = prm ? (row & (SEQL - 1)) : ((row - RP) & 7), S = prm ? SEQL : 8, sq = prm ? (row >> 13) : ((row - RP) >> 3);
        float pr[3][8];
#pragma unroll
        for (int j = 0; j < 3; ++j) { const int tt = t - 2 + j;
            if (tt >= 0) { const bf16* zr = Z + (size_t)(row - 2 + j) * ZW; const u32x4 a = *(const u32x4*)(zr + 2560 + ch), b = *(const u32x4*)(zr + 3072 + ch);
                pr[j][0] = bflo(a.x) * bflo(b.x); pr[j][1] = bfhi(a.x) * bfhi(b.x); pr[j][2] = bflo(a.y) * bflo(b.y); pr[j][3] = bfhi(a.y) * bfhi(b.y);
                pr[j][4] = bflo(a.z) * bflo(b.z); pr[j][5] = bfhi(a.z) * bfhi(b.z); pr[j][6] = bflo(a.w) * bflo(b.w); pr[j][7] = bfhi(a.w) * bfhi(b.w); }
            else if (!prm) { const float* st = p.in[7] + ((size_t)(i * 128 + sq) * 2 + (2 + tt)) * 512 + ch; const f32x4 a = *(const f32x4*)st, b = *(const f32x4*)(st + 4);
                pr[j][0] = a.x; pr[j][1] = a.y; pr[j][2] = a.z; pr[j][3] = a.w; pr[j][4] = b.x; pr[j][5] = b.y; pr[j][6] = b.z; pr[j][7] = b.w; }
            else {
#pragma unroll
                for (int e = 0; e < 8; ++e) pr[j][e] = 0.f; } }
        const u32x4 zb = *(const u32x4*)(Z + (size_t)row * ZW + 2048 + ch);
        float zbf[8] = {bflo(zb.x), bfhi(zb.x), bflo(zb.y), bfhi(zb.y), bflo(zb.z), bfhi(zb.z), bflo(zb.w), bfhi(zb.w)};
        float o[8];
#pragma unroll
        for (int e = 0; e < 8; ++e) o[e] = zbf[e] * (cw0[e] * pr[0][e] + cw1[e] * pr[1][e] + cw2[e] * pr[2][e]);
        *(u32x4*)(CAT + (size_t)row * DM + 512 + ch) = (u32x4){pk2(o[0], o[1]), pk2(o[2], o[3]), pk2(o[4], o[5]), pk2(o[6], o[7])};
        if (t >= S - 2) { float* dst = p.out + (prm ? O_PSC + ((size_t)(i * 2 + sq) * 2 + (t - (S - 2))) * 512 : O_SSC + ((size_t)(i * 128 + sq) * 2 + (t - (S - 2))) * 512) + ch;
            *(f32x4*)dst = (f32x4){pr[2][0], pr[2][1], pr[2][2], pr[2][3]}; *(f32x4*)(dst + 4) = (f32x4){pr[2][4], pr[2][5], pr[2][6], pr[2][7]}; }
    }
}


__device__ __forceinline__ void cache_shift(const Params& p, int jl, int bsel, int nsel) {
    const int tid = otid();
    for (int idx = bsel * NTHR + tid; idx < 2 * 128 * 7680; idx += nsel * NTHR) { const int kv = idx / (128 * 7680), r = idx - kv * (128 * 7680), s = r / 7680, q = r - s * 7680;
        const float* src = (kv ? p.in[9] : p.in[8]) + ((size_t)(jl * 128 + s) * 128 + 8) * 256 + 4 * q; float* dst = p.out + (kv ? O_SWV : O_SWK) + ((size_t)(jl * 128 + s) * 128) * 256 + 4 * q;
        *(f32x4*)dst = *(const f32x4*)src; }
}

template <int NH>
__device__ __forceinline__ void attn_wave(const bf16* K_l, const bf16* Vt_l, int ldvt, int kt0, const bf16x8 (*Bq)[2], int qidx, int kmin, const float* sinkp, bf16* orow, bool store, int fr, int fq) {
    f32x4 s[NH][9];
    float sk[NH], mx[NH];
#pragma unroll
    for (int h = 0; h < NH; ++h) { sk[h] = sinkp[h] * 1.4426950408889634f; mx[h] = sk[h]; }
#pragma unroll
    for (int kt = 0; kt < 9; ++kt) {
        const bf16x8 A0 = *(const bf16x8*)(K_l + (16 * (kt0 + kt) + fr) * 72 + 8 * fq), A1 = *(const bf16x8*)(K_l + (16 * (kt0 + kt) + fr) * 72 + 32 + 8 * fq);
#pragma unroll
        for (int h = 0; h < NH; ++h) { f32x4 a = (f32x4){0.f, 0.f, 0.f, 0.f};
            a = __builtin_amdgcn_mfma_f32_16x16x32_bf16(A0, Bq[h][0], a, 0, 0, 0); a = __builtin_amdgcn_mfma_f32_16x16x32_bf16(A1, Bq[h][1], a, 0, 0, 0);
#pragma unroll
            for (int j = 0; j < 4; ++j) { const int kidx = 16 * (kt0 + kt) + 4 * fq + j;
                const bool valid = (kt == 0) ? ((kidx > qidx - 128) && (kidx >= kmin)) : (kt == 8) ? (kidx <= qidx) : (kidx >= kmin);
                a[j] = valid ? a[j] * 0.18033688011112042f : -INFINITY; mx[h] = fmaxf(mx[h], a[j]); }
            s[h][kt] = a; } }
    float inv[NH];
#pragma unroll
    for (int h = 0; h < NH; ++h) { mx[h] = fmaxf(mx[h], shx(mx[h], 16)); mx[h] = fmaxf(mx[h], shx(mx[h], 32)); }
#pragma unroll
    for (int h = 0; h < NH; ++h) { float sum = 0.f;
#pragma unroll
        for (int kt = 0; kt < 9; ++kt)
#pragma unroll
            for (int j = 0; j < 4; ++j) { const float e = __builtin_amdgcn_exp2f(s[h][kt][j] - mx[h]); s[h][kt][j] = e; sum += e; }
        inv[h] = sum; }
#pragma unroll
    for (int h = 0; h < NH; ++h) { float sum = inv[h]; sum += shx(sum, 16); sum += shx(sum, 32); inv[h] = __builtin_amdgcn_rcpf(sum + __builtin_amdgcn_exp2f(sk[h] - mx[h])); }
    bf16x8 Bp[NH][5];
#pragma unroll
    for (int h = 0; h < NH; ++h)
#pragma unroll
        for (int pp = 0; pp < 5; ++pp) { u32x4 w; w.x = pk2(s[h][2 * pp][0], s[h][2 * pp][1]); w.y = pk2(s[h][2 * pp][2], s[h][2 * pp][3]);
            if (pp < 4) { w.z = pk2(s[h][2 * pp + 1][0], s[h][2 * pp + 1][1]); w.w = pk2(s[h][2 * pp + 1][2], s[h][2 * pp + 1][3]); } else { w.z = 0u; w.w = 0u; }
            Bp[h][pp] = __builtin_bit_cast(bf16x8, w); }
#pragma unroll
    for (int dt = 0; dt < 4; ++dt) { f32x4 a[NH];
#pragma unroll
        for (int h = 0; h < NH; ++h) a[h] = (f32x4){0.f, 0.f, 0.f, 0.f};
#pragma unroll
        for (int pp = 0; pp < 5; ++pp) { const bf16* vp = Vt_l + (16 * dt + fr) * ldvt + 16 * (kt0 + 2 * pp) + 4 * fq;
            const u32x2 lo = *(const u32x2*)vp, hi = *(const u32x2*)(vp + 16); const bf16x8 V = __builtin_bit_cast(bf16x8, (u32x4){lo.x, lo.y, hi.x, hi.y});
#pragma unroll
            for (int h = 0; h < NH; ++h) a[h] = __builtin_amdgcn_mfma_f32_16x16x32_bf16(V, Bp[h][pp], a[h], 0, 0, 0); }
        if (store) {
#pragma unroll
            for (int h = 0; h < NH; ++h) *(u32x2*)(orow + 64 * h + 16 * dt + 4 * fq) = (u32x2){pk2(a[h][0] * inv[h], a[h][1] * inv[h]), pk2(a[h][2] * inv[h], a[h][3] * inv[h])}; } }
}

__device__ __forceinline__ void attn_phase(const Params& p, int jl, unsigned char* smem) {
    const bf16* Z = (const bf16*)(p.ws + WS_ZU); bf16* CAT = (bf16*)(p.ws + WS_CAT);
    const float* sinkp = p.in[23] + jl * 16;
    for (int u = obid(); u < 768; u += gridDim.x) { const int tidu = otid(), lane = tidu & 63, wave = tidu >> 6, fr = lane & 15, fq = lane >> 4;
        if (u < 512) {
            const int b = u >> 8, kvh = (u >> 6) & 3, qb = u & 63, q0 = qb * 128, rb = b * SEQL;
            bf16x8 Bq[4][2];
            { const bf16* qp = Z + (size_t)(rb + q0 + 16 * wave + fr) * QKVW + kvh * 256 + 8 * fq;
#pragma unroll
              for (int hq = 0; hq < 4; ++hq) { Bq[hq][0] = *(const bf16x8*)(qp + hq * 64); Bq[hq][1] = *(const bf16x8*)(qp + hq * 64 + 32); } }
            bf16* K_l = (bf16*)smem;
            bf16* Vt_l = K_l + 256 * 72;
            { u32x4 wv[8];
#pragma unroll
              for (int it = 0; it < 8; ++it) { const int q = tidu + it * NTHR, which = q >> 11, idx = q & 2047, kidx = which ? (idx & 255) : (idx >> 3), ch = which ? (idx >> 8) : (idx & 7); const int pos = q0 - 128 + kidx;
                wv[it] = (u32x4){0u, 0u, 0u, 0u};
                if (pos >= 0) wv[it] = *(const u32x4*)(Z + (size_t)(rb + pos) * QKVW + (which ? 1280 : 1024) + kvh * 64 + ch * 8); }
#pragma unroll
              for (int it = 0; it < 8; ++it) { const int q = tidu + it * NTHR, which = q >> 11, idx = q & 2047, kidx = which ? (idx & 255) : (idx >> 3), ch = which ? (idx >> 8) : (idx & 7); const u32x4 w = wv[it];
                if (!which) *(u32x4*)(K_l + kidx * 72 + ch * 8) = w;
                else { bf16* dst = Vt_l + (ch * 8) * 296 + kidx;
                    dst[0 * 296] = (bf16)(w.x & 0xffff); dst[1 * 296] = (bf16)(w.x >> 16); dst[2 * 296] = (bf16)(w.y & 0xffff); dst[3 * 296] = (bf16)(w.y >> 16);
                    dst[4 * 296] = (bf16)(w.z & 0xffff); dst[5 * 296] = (bf16)(w.z >> 16); dst[6 * 296] = (bf16)(w.w & 0xffff); dst[7 * 296] = (bf16)(w.w >> 16); } } }
            for (int q = tidu; q < 64 * 32; q += NTHR) Vt_l[(q >> 5) * 296 + 256 + (q & 31)] = 0;
            __syncthreads();
            const int row = rb + q0 + 16 * wave + fr;
#pragma unroll
            for (int hg = 0; hg < 2; ++hg) { const int h = kvh * 4 + 2 * hg;
                attn_wave<2>(K_l, Vt_l, 296, wave, Bq + 2 * hg, 128 + 16 * wave + fr, qb == 0 ? 128 : 0, sinkp + h, CAT + (size_t)row * DM + h * 64, true, fr, fq); }
            __syncthreads();
        } else {
            const int us = u - 512, s = us >> 1, kvp = us & 1;
            bf16x8 Bq1[2];
            { const bf16* qp = Z + (size_t)(RP + 8 * s + (fr & 7)) * QKVW + (8 * kvp + wave) * 64 + 8 * fq; Bq1[0] = *(const bf16x8*)qp; Bq1[1] = *(const bf16x8*)(qp + 32); }
            bf16* K_l = (bf16*)smem;
            bf16* Vt_l = K_l + 2 * 144 * 72;
            { f32x4 va[9], vb[9];
              const float* ck = p.in[8] + ((size_t)(jl * 128 + s) * 128) * 256; const float* cv = p.in[9] + ((size_t)(jl * 128 + s) * 128) * 256;
#pragma unroll
              for (int it = 0; it < 9; ++it) { const int q = tidu + it * NTHR, which = q / 2304, r = q - which * 2304, kvl = r / 1152, r2 = r - kvl * 1152, kidx = which ? (r2 % 144) : (r2 >> 3), ch = which ? (r2 / 144) : (r2 & 7); const int kvh = 2 * kvp + kvl;
                va[it] = (f32x4){0.f, 0.f, 0.f, 0.f}; vb[it] = va[it];
                if (kidx < 128) { const float* src = (which ? cv : ck) + (size_t)kidx * 256 + kvh * 64 + ch * 8; va[it] = *(const f32x4*)src; vb[it] = *(const f32x4*)(src + 4); }
                else if (kidx < 136) { const u32x4 w = *(const u32x4*)(Z + (size_t)(RP + 8 * s + kidx - 128) * QKVW + (which ? 1280 : 1024) + kvh * 64 + ch * 8);
                    va[it] = (f32x4){bflo(w.x), bfhi(w.x), bflo(w.y), bfhi(w.y)}; vb[it] = (f32x4){bflo(w.z), bfhi(w.z), bflo(w.w), bfhi(w.w)}; } }
#pragma unroll
              for (int it = 0; it < 9; ++it) { const int q = tidu + it * NTHR, which = q / 2304, r = q - which * 2304, kvl = r / 1152, r2 = r - kvl * 1152, kidx = which ? (r2 % 144) : (r2 >> 3), ch = which ? (r2 / 144) : (r2 & 7);
                const f32x4 a = va[it], c = vb[it];
                if (!which) *(u32x4*)(K_l + (kvl * 144 + kidx) * 72 + ch * 8) = (u32x4){pk2(a[0], a[1]), pk2(a[2], a[3]), pk2(c[0], c[1]), pk2(c[2], c[3])};
                else { bf16* dst = Vt_l + (kvl * 64 + ch * 8) * 168 + kidx; const unsigned p0 = pk2(a[0], a[1]), p1 = pk2(a[2], a[3]), p2 = pk2(c[0], c[1]), p3 = pk2(c[2], c[3]);
                    dst[0 * 168] = (bf16)(p0 & 0xffff); dst[1 * 168] = (bf16)(p0 >> 16); dst[2 * 168] = (bf16)(p1 & 0xffff); dst[3 * 168] = (bf16)(p1 >> 16);
                    dst[4 * 168] = (bf16)(p2 & 0xffff); dst[5 * 168] = (bf16)(p2 >> 16); dst[6 * 168] = (bf16)(p3 & 0xffff); dst[7 * 168] = (bf16)(p3 >> 16); } } }
            for (int q = tidu; q < 2 * 64 * 16; q += NTHR) Vt_l[(q >> 4) * 168 + 144 + (q & 15)] = 0;
            __syncthreads();
            const int kvl = wave >> 2, h = 8 * kvp + wave, row = RP + 8 * s + (fr & 7);
            attn_wave<1>(K_l + kvl * 144 * 72, Vt_l + kvl * 64 * 168, 168, 0, &Bq1, 128 + (fr & 7), 0, sinkp + h, CAT + (size_t)row * DM + h * 64, fr < 8, fr, fq);
            __syncthreads();
        }
    }
}

__device__ __forceinline__ void ffnfix_phase(const Params& p, int l) {
    const bf16* UB = (const bf16*)(p.ws + WS_UB); bf16* ACT = (bf16*)(p.ws + WS_ACT);
    const float* cw = p.in[26] + (size_t)l * 3 * FF2;
    for (int idx = obid() * NTHR + otid(); idx < 256 * 352; idx += gridDim.x * NTHR) {
        const int hr = idx / 352, cc = idx - hr * 352, col = cc * 8, hh = hr >> 1, rr = hr & 1;
        const bool seqstart = (hh & 63) == 0;
        const bf16* own0 = UB + (size_t)(hh * 4 + 0) * FF2; const bf16* own1 = UB + (size_t)(hh * 4 + 1) * FF2;
        const bf16* pm2 = UB + (size_t)((hh - 1) * 4 + 2) * FF2; const bf16* pm1 = UB + (size_t)((hh - 1) * 4 + 3) * FF2;
        float g2[8], g1[8], g0[8], a2[8], a1[8], a0[8];
        if (rr == 0) {
            if (seqstart) {
#pragma unroll
                for (int e = 0; e < 8; ++e) { g2[e] = 0.f; g1[e] = 0.f; a2[e] = 0.f; a1[e] = 0.f; } }
            else { unpack8(*(const u32x4*)(pm2 + col), g2); unpack8(*(const u32x4*)(pm2 + FF + col), a2); unpack8(*(const u32x4*)(pm1 + col), g1); unpack8(*(const u32x4*)(pm1 + FF + col), a1); }
            unpack8(*(const u32x4*)(own0 + col), g0); unpack8(*(const u32x4*)(own0 + FF + col), a0);
        } else {
            if (seqstart) {
#pragma unroll
                for (int e = 0; e < 8; ++e) { g2[e] = 0.f; a2[e] = 0.f; } }
            else { unpack8(*(const u32x4*)(pm1 + col), g2); unpack8(*(const u32x4*)(pm1 + FF + col), a2); }
            unpack8(*(const u32x4*)(own0 + col), g1); unpack8(*(const u32x4*)(own0 + FF + col), a1);
            unpack8(*(const u32x4*)(own1 + col), g0); unpack8(*(const u32x4*)(own1 + FF + col), a0);
        }
        float wg[3][8], wa[3][8];
#pragma unroll
        for (int j = 0; j < 3; ++j) { ld8f(cw + j * FF2 + col, wg[j]); ld8f(cw + j * FF2 + FF + col, wa[j]); }
        float o[8];
#pragma unroll
        for (int e = 0; e < 8; ++e) { const float cgv = wg[0][e] * g2[e] + wg[1][e] * g1[e] + wg[2][e] * g0[e], cav = wa[0][e] * a2[e] + wa[1][e] * a1[e] + wa[2][e] * a0[e]; o[e] = cgv * sigmoidf_(cgv) * cav; }
        *(u32x4*)(ACT + (size_t)(hh * 128 + rr) * FF + col) = (u32x4){pk2(o[0], o[1]), pk2(o[2], o[3]), pk2(o[4], o[5]), pk2(o[6], o[7])};
    }
    for (int idx = obid() * NTHR + otid(); idx < 4 * (FF2 / 8); idx += gridDim.x * NTHR) { const int br = idx / (FF2 / 8), c = (idx - br * (FF2 / 8)) * 8, b = br >> 1, r = br & 1;
        float v[8]; unpack8(*(const u32x4*)(UB + (size_t)((64 * b + 63) * 4 + 2 + r) * FF2 + c), v);
        st8f(p.out + O_PFFN + ((size_t)(l * 2 + b) * 2 + r) * FF2 + c, v); }
}

#define XB_TMO      128
#define XB_XCNT(j)  (256  + 64 * (j))
#define XB_XSUB(j)  (1280 + 64 * (j))
#define XB_XGEN(j)  (2304 + 64 * (j))
#define XB_TOP      3328
#define XB_TOPGEN   3392
#define XCD_BAR_WORDS 3456
#define XB_SPIN_CAP (1u << 18)

__device__ __forceinline__ unsigned xb_ld(unsigned* p)              { return __hip_atomic_load(p, __ATOMIC_RELAXED, __HIP_MEMORY_SCOPE_AGENT); }
__device__ __forceinline__ unsigned xb_add(unsigned* p, unsigned v) { return __hip_atomic_fetch_add(p, v, __ATOMIC_RELAXED, __HIP_MEMORY_SCOPE_AGENT); }
__device__ __forceinline__ unsigned xb_xcc_id() { return (unsigned)__builtin_amdgcn_s_getreg((3 << 11) | 20) & 0xFu; }
#define XB_SPIN(cond, bar) do { unsigned _sp = 0; while (cond) { __builtin_amdgcn_s_sleep(1); \
    if ((++_sp & 255u) == 0u) { if (xb_ld(&(bar)[XB_TMO])) break; if (_sp > XB_SPIN_CAP) { atomicAdd(&(bar)[XB_TMO], 1u); break; } } } } while (0)

struct XcdBarrier {
    unsigned* bar; unsigned x;
    volatile LAS unsigned* st;
};

__device__ __forceinline__ XcdBarrier xcd_barrier_post(unsigned* bar, volatile LAS unsigned* st) {
    XcdBarrier b; b.bar = bar; b.x = xb_xcc_id(); b.st = st;
    if (threadIdx.x == 0) (void)xb_add(&bar[XB_XCNT(b.x)], 1u);
    return b;
}
__device__ __forceinline__ void xcd_barrier_complete(unsigned* bar, unsigned x, unsigned& nloc, unsigned& nx) {
    const unsigned G = gridDim.x * gridDim.y * gridDim.z;
    unsigned sum, cnt, mine, sp = 0u;
    for (;;) {
        sum = 0u; cnt = 0u; mine = 0u;
#pragma unroll
        for (unsigned j = 0; j < 16; ++j) { const unsigned c = xb_ld(&bar[XB_XCNT(j)]); sum += c; cnt += (c > 0u) ? 1u : 0u; mine = (j == x) ? c : mine; }
        if (sum == G) break;
        __builtin_amdgcn_s_sleep(1);
        if ((++sp & 255u) == 0u) { if (xb_ld(&bar[XB_TMO])) break; if (sp > XB_SPIN_CAP) { atomicAdd(&bar[XB_TMO], 1u); break; } }
    }
    nloc = mine > 0u ? mine : 1u; nx = cnt > 0u ? cnt : 1u;
}

__device__ __forceinline__ void xcd_barrier(const XcdBarrier& b) {
    asm volatile("s_waitcnt vmcnt(0)" ::: "memory");
    __syncthreads();
    if (threadIdx.x == 0) {
        unsigned* bar = b.bar;
        __builtin_amdgcn_s_waitcnt(0);
        unsigned nloc = b.st[0], nx = b.st[1];
        if (nloc == 0u) { xcd_barrier_complete(bar, b.x, nloc, nx); b.st[0] = nloc; b.st[1] = nx; }
        const unsigned old = xb_add(&bar[XB_XSUB(b.x)], 1u);
        const unsigned gen = old / nloc;
        if (old + 1u == (gen + 1u) * nloc) {
            __builtin_amdgcn_fence(__ATOMIC_RELEASE, "agent");
            asm volatile("s_waitcnt vmcnt(0)" ::: "memory");
            const unsigned og = xb_add(&bar[XB_TOP], 1u);
            const unsigned tg = og / nx;
            if (og + 1u == (tg + 1u) * nx) xb_add(&bar[XB_TOPGEN], 1u);
            else XB_SPIN(xb_ld(&bar[XB_TOPGEN]) == tg, bar);
            __builtin_amdgcn_fence(__ATOMIC_ACQUIRE, "agent");
            xb_add(&bar[XB_XGEN(b.x)], 1u);
            asm volatile("s_waitcnt vmcnt(0)" ::: "memory");
        } else {
            XB_SPIN(xb_ld(&bar[XB_XGEN(b.x)]) == gen, bar);
            __builtin_amdgcn_fence(__ATOMIC_ACQUIRE, "agent");
            asm volatile("s_waitcnt vmcnt(0)" ::: "memory");
        }
    }
    __syncthreads();
}

__global__ void __launch_bounds__(NTHR, 2) mega(Params p) {
    extern __shared__ __attribute__((aligned(16))) unsigned char lds[];
    cg::grid_group grid = cg::this_grid();
    unsigned char* ws = p.ws;
    volatile LAS unsigned* bst = (volatile LAS unsigned*)((LAS unsigned char*)lds + 147392);
    if (threadIdx.x < 2) bst[threadIdx.x] = 0u;
    __syncthreads();
    XcdBarrier bar; bar.bar = (unsigned*)ws; bar.x = 0; bar.st = bst;
    if (p.hi - p.lo > 1) bar = xcd_barrier_post((unsigned*)ws, bst);
    for (int step = p.lo; step < p.hi; ++step) {
        int nrep = 1; bool skip = false;
        if (step == 0) nrep += (PROBE_PRE & 1); else if (step == 1) nrep += (PROBE_PRE >> 1) & 1; else { const int l_ = (step - 2) / 10, st_ = (step - 2) % 10; nrep += (((l_ & 1) ? PROBE_ODD : PROBE_EVEN) >> st_) & 1; }
        for (int rep = 0; rep < nrep; ++rep) {
            if (PROBE_BAR == 2 && rep > 0) xcd_barrier(bar);
        if (step == 0) prologue(p, lds);
        else if (step == 1) {
            pg8::Gemm g{(const pg8::bf16_t*)(ws + WS_AC), (const pg8::bf16_t*)(ws + WS_ZU), 256, MODW, DM}; pg8::StaticOrder S; S.init(256, MODW, gridDim.x, obid());
            EpiMod E{(float*)(ws + WS_MOD), p.in[14]};
            pg8::gemm_phase<EpiMod, pg8::StaticOrder, true, true>((PG8_LAS unsigned char*)lds, g, S, E);
        } else {
            const int l = (step - 2) / 10, st = (step - 2) % 10; const bool even = !(l & 1); const int i = l >> 1;
            if (st == 0) norm_phase(p, l, 1, lds);
            else if (st == 6) norm_phase(p, l, 2, lds);
            else if (st == 1 || st == 5 || st == 7 || st == 9) {
                pg8::Gemm g; EpiMain E; E.X = p.out; E.O = (bf16*)(ws + WS_ZU); E.gate = nullptr; E.ldc = 0; E.mode = 0; E.cw = nullptr; E.stp = nullptr; E.sout = nullptr; E.qn = nullptr; E.kn = nullptr; E.lyr = i; E.wsb = ws;
                if (st == 1) { g.A = (const pg8::bf16_t*)(ws + WS_H); g.M = R; g.K = DM;
                    if (even) { g.Bt = (const pg8::bf16_t*)(ws + WS_WIN) + (size_t)i * ZW * DM; g.N = ZW; E.ldc = ZW; } else { g.Bt = (const pg8::bf16_t*)(ws + WS_WQKV) + (size_t)i * QKVW * DM; g.N = QKVW; E.ldc = QKVW; E.mode = 3;
                        E.qn = p.in[21] + i * 64; E.kn = p.in[22] + i * 64; } }
                else if (st == 5) { g.A = (const pg8::bf16_t*)(ws + WS_CAT); g.M = RP; g.K = DM; g.N = DM; g.Bt = (const pg8::bf16_t*)(ws + (even ? WS_WAO : WS_WCO)) + (size_t)i * DM * DM;
                    E.mode = 1; E.gate = (const float*)(ws + WS_MOD) + l * 6144 + 2048; }
                else if (st == 7) { g.A = (const pg8::bf16_t*)(ws + WS_H); g.M = R; g.K = DM; g.N = FF2; g.Bt = (const pg8::bf16_t*)(ws + WS_WUP) + (size_t)l * FF2 * DM; E.mode = 2;
                    E.cw = p.in[26] + (size_t)l * 3 * FF2; E.stp = p.in[10] + (size_t)l * 128 * 2 * FF2; E.sout = p.out + O_SFFN + (size_t)l * 128 * 2 * FF2; }
                else { g.A = (const pg8::bf16_t*)(ws + WS_ACT); g.M = RP; g.K = FF; g.N = DM; g.Bt = (const pg8::bf16_t*)(ws + WS_WDN) + (size_t)l * DM * FF; E.mode = 1; E.gate = (const float*)(ws + WS_MOD) + l * 6144 + 5120; }
                if (rep > 0 && E.mode == 1) { E.mode = 0; E.O = (bf16*)(ws + WS_H); E.ldc = DM; }
                if (rep > 0 && E.mode == 1) { E.mode = 0; E.O = (bf16*)(ws + WS_H); E.ldc = DM; }
                pg8::StaticOrder S; S.init(g.M, g.N, gridDim.x, obid());
                pg8::gemm_phase<EpiMain, pg8::StaticOrder, true, true>((PG8_LAS unsigned char*)lds, g, S, E);
                if (E.mode == 3 && rep == 0) { const int G_ = gridDim.x, n2 = S.nwg - G_;
                    if (n2 > 0 && n2 < G_) { if (obid() >= n2) cache_shift(p, i, obid() - n2, G_ - n2); } else cache_shift(p, i, obid(), G_); }
                if (E.mode == 1) mini_gemm((const bf16*)g.A, (const bf16*)g.Bt, g.K, p.out, E.gate, lds);
            }
            else if (st == 2) {
                if (even) { const int G_ = gridDim.x; int il = obid(), is = obid();
                    for (int k = 0; il < 1024 || is < 512; ++k) { const bool do_s = (is < 512) && ((k & 1) || il >= 1024);
                        if (do_s) { mlstm_sample(p, i, is, lds); is += G_; } else { mlstm_local(p, i, il, lds); il += G_; } }
                    shortconv(p, i); }
                else { skip = true; continue; }
            }
            else if (st == 3) { if (even) mlstm_scan(p, i, lds); else attn_phase(p, i, lds); }
            else if (st == 4) { if (!even) { skip = true; continue; } for (int it = obid(); it < 1024; it += 2 * gridDim.x) mlstm_out2(p, i, it, it + gridDim.x, lds); }
            else if (st == 8) ffnfix_phase(p, l);
        }
        }
        if (skip) continue;
        if (step + 1 < p.hi) { if (step == 0) grid.sync(); else { xcd_barrier(bar); if (PROBE_BAR == 1) xcd_barrier(bar); } }
    }
}

#ifndef NLAUNCH_MODE
#define NLAUNCH_MODE 1
#endif
extern "C" void kernel_launch(void* const* d_in, const int* in_sizes, int n_in, void* d_out, int out_size, void* d_ws, size_t ws_size, hipStream_t stream) {
    static int grid = 0;
    if (grid == 0) {
        if (n_in != 28 || (size_t)out_size != O_END || ws_size < WS_END) { fprintf(stderr, "kernel_launch: unexpected shapes: n_in %d out %d ws %zu\n", n_in, out_size, ws_size); grid = -1; return; }
        int dev = 0, cus = 0, per_cu = 0;
        hipGetDevice(&dev); hipDeviceGetAttribute(&cus, hipDeviceAttributeMultiprocessorCount, dev);
        if (hipFuncSetAttribute((const void*)mega, hipFuncAttributeMaxDynamicSharedMemorySize, LDS_BYTES) != hipSuccess) { fprintf(stderr, "kernel_launch: hipFuncSetAttribute failed\n"); grid = -1; return; }
        if (hipOccupancyMaxActiveBlocksPerMultiprocessor(&per_cu, (const void*)mega, NTHR, LDS_BYTES) != hipSuccess || per_cu < 1) { fprintf(stderr, "kernel_launch: occupancy query says %d\n", per_cu); per_cu = 1; }
        (void)hipGetLastError();
        grid = cus * 1;
    }
    if (grid < 0) return;
    Params p{};
    for (int k = 0; k < 28; ++k) p.in[k] = (const float*)d_in[k];
    p.out = (float*)d_out; p.ws = (unsigned char*)d_ws;
    const int NSTEPS = 42;
    if (hipMemsetAsync(d_ws, 0, 16384, stream) != hipSuccess) { fprintf(stderr, "memset failed\n"); return; }
#if NLAUNCH_MODE == 1
    p.lo = 0; p.hi = NSTEPS;
    void* args[] = {&p};
    hipError_t e = hipLaunchCooperativeKernel((const void*)mega, dim3(grid), dim3(NTHR), args, LDS_BYTES, stream);
    if (e != hipSuccess) fprintf(stderr, "cooperative launch failed: %s (grid %d)\n", hipGetErrorString(e), grid);
#else
    for (int s = 0; s < NSTEPS; ++s) { if (s >= 2 && ((s - 2) % 10) == 4 && (((s - 2) / 10) & 1)) continue; p.lo = s; p.hi = s + 1; hipLaunchKernelGGL(mega, dim3(grid), dim3(NTHR), LDS_BYTES, stream, p); }
#endif
}
```

```cpp
#include <hip/hip_runtime.h>
#include <hip/hip_cooperative_groups.h>
#include <cstdio>
#include <cstdint>
namespace cg = cooperative_groups;
__device__ __forceinline__ int otid() { int t = threadIdx.x; asm volatile("" : "+v"(t)); return t; }
__device__ __forceinline__ int obid() { int b = blockIdx.x; asm volatile("" : "+s"(b)); return b; }
__device__ __forceinline__ float shx(float v, int o) { const int l = otid() & 63; return __builtin_bit_cast(float, __builtin_amdgcn_ds_bpermute((l ^ o) << 2, __builtin_bit_cast(int, v))); }
__device__ __forceinline__ float shi(float v, int src) { return __builtin_bit_cast(float, __builtin_amdgcn_ds_bpermute(src << 2, __builtin_bit_cast(int, v))); }
__device__ __forceinline__ float shup(float v, int o) { const int l = otid() & 63; const int src = l >= o ? l - o : l; return __builtin_bit_cast(float, __builtin_amdgcn_ds_bpermute(src << 2, __builtin_bit_cast(int, v))); }
namespace pg8 {
#define PG8_LAS __attribute__((address_space(3)))
typedef unsigned short bf16_t;
typedef short bf16x8 __attribute__((ext_vector_type(8)));
typedef float f32x4 __attribute__((ext_vector_type(4)));
typedef unsigned u32x4 __attribute__((ext_vector_type(4)));
constexpr int BM = 256, BK = 64, HALF = 128, HTB = HALF * BK * 2  , STAGE_BYTES = 8 * HTB, NXCD = 8, WGM = 8;

__host__ __device__ __forceinline__ int lds_byte(int r, int c) { const int st = (r >> 4) * 2 + (c >> 5), rr = r & 15, cc = c & 31, ob = rr * 64 + cc * 2; return st * 1024 + (ob ^ (((ob >> 9) & 1) << 5)); }
__host__ __device__ __forceinline__ void stage_rc(int b, int& R, int& C) { const int st = b / 1024, sb = b % 1024, swz = sb ^ (((sb >> 9) & 1) << 5); R = (st >> 1) * 16 + swz / 64; C = (st & 1) * 32 + (swz % 64) / 2; }
__host__ __device__ __forceinline__ int perm32(int rho) { const int n = rho >> 4, i = rho & 15; return 8 * (i >> 2) + 4 * n + (i & 3); }

struct Unit { int pm, pn; };
struct Gemm { const bf16_t* A; const bf16_t* Bt; int M, N, K; };

struct StaticOrder {
    int nM, nN, nwg, G, c;
    __host__ __device__ void init(int M, int N, int G_, int c_) { nM = M / BM; nN = N / BM; nwg = nM * nN; G = G_; c = c_; }
    __host__ __device__ bool next(int i, Unit& u) const {
        const long L = (long)i * G + c; if (L >= nwg) return false;
        int wgid = (int)L; { const int q = nwg / NXCD, r = nwg % NXCD, xcd = wgid % NXCD, off = wgid / NXCD; wgid = (xcd < r ? xcd * (q + 1) : r * (q + 1) + (xcd - r) * q) + off; }
        const int nig = WGM * nN, gid = wgid / nig, fm = gid * WGM, gsz = (nM - fm) < WGM ? (nM - fm) : WGM;
        u.pm = fm + ((wgid % nig) % gsz); u.pn = (wgid % nig) / gsz; return true;
    }
    __device__ __forceinline__ void a_ready(const Unit&) const {}
    __device__ __forceinline__ void done(const Unit&) const {}
};

__device__ __forceinline__ unsigned cvt_pk_bf16(float lo, float hi) { unsigned r; asm volatile("v_cvt_pk_bf16_f32 %0, %1, %2" : "=v"(r) : "v"(lo), "v"(hi)); return r; }
template <class Epi, class Sched, bool ALIGN_EPI = false, bool SP2 = false>
__device__ __forceinline__ void gemm_phase(PG8_LAS unsigned char* lds, const Gemm g, const Sched& S, const Epi& E) {
    const int tid = otid(), wid = __builtin_amdgcn_readfirstlane(tid >> 6), lane = tid & 63, wr = wid >> 2, wc = wid & 3, fr = lane & 15, fq = lane >> 4;
    const int K = g.K, nt = K / BK;
    unsigned voffA[2], voffB[2];
#pragma unroll
    for (int i = 0; i < 2; ++i) { int R, C; stage_rc(tid * 16 + i * 8192, R, C); const int Rb = Epi::PERM ? ((R & ~31) + perm32(R & 31)) : R;
        const int Ra = 8 * (16 * (R >> 6) + (R & 15)) + ((R >> 4) & 3);
        voffA[i] = (unsigned)(Ra * K + C) * 2u; voffB[i] = (unsigned)(Rb * K + C) * 2u; }
    const size_t kstep = (size_t)(BK * 2);
    const size_t hstep = (size_t)HALF * K * 2;
    const size_t hstepA = (size_t)4 * K * 2;
    const size_t tstep = 2 * hstep;
    const unsigned ldsw = (unsigned)wid * 1024u;
    const int aoff = lds_byte(wr * 64 + fr, fq * 8), boff = lds_byte(wc * 32 + fr, fq * 8);
#define PG8_SA(b, h) (((b) * 2 + (h)) * HTB)
#define PG8_SB(b, h) ((4 + (b) * 2 + (h)) * HTB)
#define PG8_STAGE(bufoff, gbase, voff) do { _Pragma("unroll") for (int _i = 0; _i < 2; ++_i) \
        __builtin_amdgcn_global_load_lds((const unsigned*)((const char*)(gbase) + (voff)[_i]), (PG8_LAS unsigned*)(lds + (bufoff) + ldsw + _i * 8192), 16, 0, 0); } while (0)
#define PG8_LDA(dst, b, h) do { _Pragma("unroll") for (int m = 0; m < 4; ++m) _Pragma("unroll") for (int k = 0; k < 2; ++k) dst[m][k] = *(const PG8_LAS bf16x8*)(lds + PG8_SA(b, h) + aoff + m * 2048 + k * 1024); } while (0)
#define PG8_LDB(dst, b, h) do { _Pragma("unroll") for (int n = 0; n < 2; ++n) _Pragma("unroll") for (int k = 0; k < 2; ++k) dst[n][k] = *(const PG8_LAS bf16x8*)(lds + PG8_SB(b, h) + boff + n * 2048 + k * 1024); } while (0)
#define PG8_MMA(ai, bj, At, Bt) do { __builtin_amdgcn_s_setprio(1); _Pragma("unroll") for (int m = 0; m < 4; ++m) _Pragma("unroll") for (int n = 0; n < 2; ++n) _Pragma("unroll") for (int k = 0; k < 2; ++k) \
        acc[ai][bj][m][n] = __builtin_amdgcn_mfma_f32_16x16x32_bf16(Bt[n][k], At[m][k], acc[ai][bj][m][n], 0, 0, 0); __builtin_amdgcn_s_setprio(0); } while (0)
#define PG8_WAIT_V(n) asm volatile("s_waitcnt vmcnt(" #n ")" ::: "memory")
#define PG8_WAIT_L(n) asm volatile("s_waitcnt lgkmcnt(" #n ")" ::: "memory")
#define PG8_BAR __builtin_amdgcn_s_barrier()
#define PG8_SCHED __builtin_amdgcn_sched_barrier(0)
    Unit cur, nxt; int ui = 0;
    if (!S.next(0, cur)) return;
    f32x4 acc[2][2][4][2];
#pragma unroll
    for (int a = 0; a < 2; ++a)
#pragma unroll
        for (int b = 0; b < 2; ++b)
#pragma unroll
            for (int m = 0; m < 4; ++m)
#pragma unroll
                for (int n = 0; n < 2; ++n) acc[a][b][m][n] = (f32x4){0.f, 0.f, 0.f, 0.f};
    bf16x8 At[4][2], B0[2][2], B1[2][2];
    const char* cA = (const char*)g.A + (size_t)cur.pm * tstep; const char* cB = (const char*)g.Bt + (size_t)cur.pn * tstep;
    S.a_ready(cur);
    if constexpr (SP2) {
        PG8_STAGE(PG8_SB(0, 0), cB, voffB); PG8_STAGE(PG8_SB(0, 1), cB + hstep, voffB); PG8_STAGE(PG8_SA(0, 0), cA, voffA); PG8_STAGE(PG8_SA(0, 1), cA + hstepA, voffA);
        if (wr == 1) PG8_BAR;
        PG8_WAIT_V(2); PG8_BAR;
        PG8_STAGE(PG8_SB(1, 0), cB + kstep, voffB); PG8_STAGE(PG8_SA(1, 0), cA + kstep, voffA); PG8_STAGE(PG8_SB(1, 1), cB + hstep + kstep, voffB);
        PG8_WAIT_V(6); PG8_BAR;
    } else {
        PG8_STAGE(PG8_SB(0, 0), cB, voffB); PG8_STAGE(PG8_SA(0, 0), cA, voffA); PG8_STAGE(PG8_SB(0, 1), cB + hstep, voffB); PG8_STAGE(PG8_SA(0, 1), cA + hstepA, voffA);
        if (wr == 1) PG8_BAR;
        PG8_WAIT_V(4); PG8_BAR;
        PG8_STAGE(PG8_SB(1, 0), cB + kstep, voffB); PG8_STAGE(PG8_SA(1, 0), cA + kstep, voffA); PG8_STAGE(PG8_SB(1, 1), cB + hstep + kstep, voffB);
        PG8_WAIT_V(6); PG8_BAR;
    }
    for (;;) {
        const bool has_next = S.next(ui + 1, nxt);
        const char* nA = has_next ? (const char*)g.A + (size_t)nxt.pm * tstep : cA; const char* nB = has_next ? (const char*)g.Bt + (size_t)nxt.pn * tstep : cB;
        for (int t = 0; t < nt; t += 2) {
            const bool last = (t == nt - 2);
            const char* a1 = cA + (size_t)(t + 1) * kstep;
            const char* a2 = last ? nA : cA + (size_t)(t + 2) * kstep; const char* b2 = last ? nB : cB + (size_t)(t + 2) * kstep;
            const char* a3 = a2 + kstep; const char* b3 = b2 + kstep;
            if (last && has_next) S.a_ready(nxt);
            if constexpr (SP2) {
            PG8_LDB(B0, 0, 0); PG8_LDB(B1, 0, 1); PG8_SCHED; PG8_LDA(At, 0, 0); PG8_STAGE(PG8_SA(1, 1), a1 + hstepA, voffA);
            PG8_WAIT_V(8); PG8_WAIT_L(0); PG8_BAR; PG8_MMA(0, 0, At, B0); PG8_MMA(0, 1, At, B1); PG8_BAR; PG8_SCHED;
            PG8_LDA(At, 0, 1); PG8_STAGE(PG8_SB(0, 0), b2, voffB); PG8_STAGE(PG8_SB(0, 1), b2 + hstep, voffB); PG8_STAGE(PG8_SA(0, 0), a2, voffA);
            PG8_WAIT_V(8); PG8_WAIT_L(0); PG8_BAR; PG8_MMA(1, 0, At, B0); PG8_MMA(1, 1, At, B1); PG8_BAR; PG8_SCHED;
            PG8_LDB(B0, 1, 0); PG8_LDB(B1, 1, 1); PG8_SCHED; PG8_LDA(At, 1, 0); PG8_STAGE(PG8_SA(0, 1), a2 + hstepA, voffA);
            PG8_WAIT_V(8); PG8_WAIT_L(0); PG8_BAR; PG8_MMA(0, 0, At, B0); PG8_MMA(0, 1, At, B1); PG8_BAR; PG8_SCHED;
            PG8_LDA(At, 1, 1); PG8_STAGE(PG8_SB(1, 0), b3, voffB); PG8_STAGE(PG8_SB(1, 1), b3 + hstep, voffB); PG8_STAGE(PG8_SA(1, 0), a3, voffA);
            PG8_WAIT_V(8); PG8_WAIT_L(0); PG8_BAR; PG8_MMA(1, 0, At, B0); PG8_MMA(1, 1, At, B1); PG8_BAR; PG8_SCHED;
            } else {
            PG8_LDB(B0, 0, 0); PG8_SCHED; PG8_LDA(At, 0, 0); PG8_STAGE(PG8_SA(1, 1), a1 + hstepA, voffA);
            PG8_WAIT_L(8); PG8_BAR; PG8_WAIT_L(0); PG8_MMA(0, 0, At, B0); PG8_BAR; PG8_SCHED;
            PG8_LDB(B1, 0, 1); PG8_STAGE(PG8_SB(0, 0), b2, voffB);
            PG8_BAR; PG8_WAIT_L(0); PG8_MMA(0, 1, At, B1); PG8_BAR;
            PG8_LDA(At, 0, 1); PG8_STAGE(PG8_SA(0, 0), a2, voffA);
            PG8_BAR; PG8_WAIT_L(0); PG8_MMA(1, 0, At, B0); PG8_BAR; PG8_SCHED;
            PG8_STAGE(PG8_SB(0, 1), b2 + hstep, voffB);
            PG8_WAIT_V(6); PG8_BAR; PG8_MMA(1, 1, At, B1); PG8_BAR;
            PG8_LDB(B0, 1, 0); PG8_SCHED; PG8_LDA(At, 1, 0); PG8_STAGE(PG8_SA(0, 1), a2 + hstepA, voffA);
            PG8_WAIT_L(8); PG8_BAR; PG8_WAIT_L(0); PG8_MMA(0, 0, At, B0); PG8_BAR; PG8_SCHED;
            PG8_LDB(B1, 1, 1); PG8_STAGE(PG8_SB(1, 0), b3, voffB);
            PG8_BAR; PG8_WAIT_L(0); PG8_MMA(0, 1, At, B1); PG8_BAR;
            PG8_LDA(At, 1, 1); PG8_STAGE(PG8_SA(1, 0), a3, voffA);
            PG8_BAR; PG8_WAIT_L(0); PG8_MMA(1, 0, At, B0); PG8_BAR; PG8_SCHED;
            PG8_STAGE(PG8_SB(1, 1), b3 + hstep, voffB);
            PG8_WAIT_V(6); PG8_BAR; PG8_MMA(1, 1, At, B1); PG8_BAR;
            }
        }
        if constexpr (ALIGN_EPI) { if (wr == 0) PG8_BAR; }
        if constexpr (!Epi::AFTER_DRAIN) { E(acc, cur, wr, wc, fr, fq); S.done(cur); }
        if (!has_next) break;
#pragma unroll
        for (int a = 0; a < 2; ++a)
#pragma unroll
            for (int b = 0; b < 2; ++b)
#pragma unroll
                for (int m = 0; m < 4; ++m)
#pragma unroll
                    for (int n = 0; n < 2; ++n) acc[a][b][m][n] = (f32x4){0.f, 0.f, 0.f, 0.f};
        cur = nxt; cA = nA; cB = nB; ++ui;
        if constexpr (ALIGN_EPI) { if (wr == 1) PG8_BAR; }
    }
    PG8_WAIT_V(0);
    if constexpr (!ALIGN_EPI) { if (wr == 0) PG8_BAR; }
    PG8_BAR;
    if constexpr (Epi::AFTER_DRAIN) { E.fused(acc, cur, wr, wc, fr, fq, lds, wid, lane); S.done(cur); }
#undef PG8_SA
#undef PG8_SB
#undef PG8_STAGE
#undef PG8_LDA
#undef PG8_LDB
#undef PG8_MMA
#undef PG8_WAIT_V
#undef PG8_WAIT_L
#undef PG8_BAR
#undef PG8_SCHED
}
}

typedef unsigned short bf16;
typedef float f32x4 __attribute__((ext_vector_type(4)));
typedef float f32x2 __attribute__((ext_vector_type(2)));
typedef unsigned u32x4 __attribute__((ext_vector_type(4)));
typedef unsigned u32x2 __attribute__((ext_vector_type(2)));
typedef short bf16x8 __attribute__((ext_vector_type(8)));

constexpr int R = 17408, RP = 16384, NSEQ = 130, SEQL = 8192;
constexpr int DM = 1024, INA = 3592, ZW = 3584, QKVW = 1536, FF = 2816, FF2 = 5632, MODW = 24576;
constexpr float EPS = 1e-6f;
constexpr int NWAVES = 8, NTHR = 512;
constexpr int LDS_BYTES = 147456;

constexpr size_t O_Y = 0;
constexpr size_t O_PC = (size_t)R * 1024;
constexpr size_t O_PN = O_PC + 262144;
constexpr size_t O_PM = O_PN + 2048;
constexpr size_t O_PSC = O_PM + 16;
constexpr size_t O_PWK = O_PSC + 4096;
constexpr size_t O_PWV = O_PWK + 131072;
constexpr size_t O_PFFN = O_PWV + 131072;
constexpr size_t O_SC = O_PFFN + 90112;
constexpr size_t O_SN = O_SC + 16777216;
constexpr size_t O_SM = O_SN + 131072;
constexpr size_t O_SSC = O_SM + 1024;
constexpr size_t O_SWK = O_SSC + 262144;
constexpr size_t O_SWV = O_SWK + 8388608;
constexpr size_t O_SFFN = O_SWV + 8388608;
constexpr size_t O_END = O_SFFN + 5767168;

constexpr size_t MiB = 1u << 20;
constexpr size_t WS_WIN = 1 * MiB, WS_WAO = 15 * MiB, WS_WQKV = 19 * MiB, WS_WCO = 25 * MiB, WS_WUP = 29 * MiB, WS_WDN = 73 * MiB;
constexpr size_t WS_AC = 95 * MiB, WS_MOD = 96 * MiB, WS_TAB = 109 * MiB, WS_H = 112 * MiB, WS_CAT = 146 * MiB, WS_GATES = 180 * MiB;
constexpr size_t WS_ZU = 181 * MiB;
constexpr size_t WS_ACT = 368 * MiB;
constexpr size_t WS_DCT = WS_ACT, WS_CST = WS_ACT + 64 * MiB, WS_NS = WS_ACT + 96 * MiB, WS_DN = WS_NS + MiB / 2, WS_CS = WS_NS + MiB, WS_MS = WS_CS + 65536;
constexpr size_t WS_UB = 466 * MiB;
constexpr size_t WS_END = 472 * MiB;

__constant__ double ROPE_INV[32] = {1.0, 0.7498942093324559, 0.5623413251903491, 0.4216965034285822, 0.31622776601683794, 0.23713737056616552, 0.1778279410038923, 0.1333521432163324, 0.1, 0.07498942093324558, 0.05623413251903491, 0.042169650342858224, 0.03162277660168379, 0.023713737056616554, 0.01778279410038923, 0.01333521432163324, 0.01, 0.007498942093324558, 0.005623413251903491, 0.004216965034285823, 0.0031622776601683794, 0.0023713737056616554, 0.0017782794100389228, 0.001333521432163324, 0.001, 0.0007498942093324559, 0.0005623413251903491, 0.00042169650342858224, 0.00031622776601683794, 0.00023713737056616554, 0.00017782794100389227, 0.0001333521432163324};
#ifndef PROBE_PRE
#define PROBE_PRE 0
#define PROBE_EVEN 0
#define PROBE_ODD 0
#endif
#ifndef PROBE_BAR
#define PROBE_BAR 0
#endif
struct Params { const float* in[28]; float* out; unsigned char* ws; int lo, hi; };

__device__ __forceinline__ unsigned f2bf(float f) { unsigned u = __builtin_bit_cast(unsigned, f); return (u + 0x7fffu + ((u >> 16) & 1u)) >> 16; }
__device__ __forceinline__ unsigned pk2(float lo, float hi) { unsigned r; asm("v_cvt_pk_bf16_f32 %0, %1, %2" : "=v"(r) : "v"(lo), "v"(hi)); return r; }
__device__ __forceinline__ unsigned pk2_sw(float lo, float hi) { return f2bf(lo) | (f2bf(hi) << 16); }
__device__ __forceinline__ float bf2f(unsigned h) { return __builtin_bit_cast(float, h << 16); }
__device__ __forceinline__ float bflo(unsigned w) { return __builtin_bit_cast(float, w << 16); }
__device__ __forceinline__ float bfhi(unsigned w) { return __builtin_bit_cast(float, w & 0xffff0000u); }
template <int CTRL> __device__ __forceinline__ float dppf(float x) { return __builtin_bit_cast(float, __builtin_amdgcn_mov_dpp(__builtin_bit_cast(int, x), CTRL, 0xF, 0xF, true)); }
__device__ __forceinline__ float rdl(float x, int l) { return __builtin_bit_cast(float, __builtin_amdgcn_readlane(__builtin_bit_cast(int, x), l)); }
__device__ __forceinline__ float wave_sum(float v) {
    v += dppf<0xB1>(v); v += dppf<0x4E>(v); v += dppf<0x141>(v); v += dppf<0x140>(v);
    return (rdl(v, 0) + rdl(v, 16)) + (rdl(v, 32) + rdl(v, 48));
}
__device__ __forceinline__ float wave_max(float v) {
    v = fmaxf(v, dppf<0xB1>(v)); v = fmaxf(v, dppf<0x4E>(v)); v = fmaxf(v, dppf<0x141>(v)); v = fmaxf(v, dppf<0x140>(v));
    return fmaxf(fmaxf(rdl(v, 0), rdl(v, 16)), fmaxf(rdl(v, 32), rdl(v, 48)));
}
__device__ __forceinline__ float logsigmoidf(float f) { return fminf(f, 0.f) - log1pf(__expf(-fabsf(f))); }
__device__ __forceinline__ float sigmoidf_(float x) { return __builtin_amdgcn_rcpf(1.f + __builtin_amdgcn_exp2f(x * -1.4426950408889634f)); }
__device__ __forceinline__ int seq_of(int row) { return row < RP ? (row >> 13) : 2 + ((row - RP) >> 3); }
#define LAS __attribute__((address_space(3)))
#define LDS_WAIT() asm volatile("s_waitcnt lgkmcnt(0)" ::: "memory")

__device__ __forceinline__ float dpp_shr1f(float x) { return __builtin_bit_cast(float, __builtin_amdgcn_mov_dpp(__builtin_bit_cast(int, x), 0x111, 0xF, 0xF, false)); }
__device__ __forceinline__ f32x4 dpp_shr1(const f32x4 v) { f32x4 r; r.x = dpp_shr1f(v.x); r.y = dpp_shr1f(v.y); r.z = dpp_shr1f(v.z); r.w = dpp_shr1f(v.w); return r; }
struct EpiMain {
    static constexpr bool PERM = true, AFTER_DRAIN = false;
    int mode;
    bf16* O; int ldc; float* X; const float* gate;
    const float* qn; const float* kn; int lyr; unsigned char* wsb;
    const float* cw; const float* stp; float* sout;
    __device__ __forceinline__ void operator()(const pg8::f32x4 (&acc)[2][2][4][2], const pg8::Unit& u, int wr, int wc, int fr, int fq) const {
        const int rowb = u.pm * 256 + 8 * (16 * wr + fr), col0 = u.pn * 256 + wc * 32 + 8 * fq;
        if (mode == 0) {
#pragma unroll
            for (int ai = 0; ai < 2; ++ai)
#pragma unroll
                for (int m = 0; m < 4; ++m) { bf16* rowp = O + (size_t)(rowb + 4 * ai + m) * ldc + col0;
#pragma unroll
                    for (int bj = 0; bj < 2; ++bj) { const pg8::f32x4 v0 = acc[ai][bj][m][0], v1 = acc[ai][bj][m][1]; u32x4 w;
                        w.x = pg8::cvt_pk_bf16(v0[0], v0[1]); w.y = pg8::cvt_pk_bf16(v0[2], v0[3]); w.z = pg8::cvt_pk_bf16(v1[0], v1[1]); w.w = pg8::cvt_pk_bf16(v1[2], v1[3]);
                        *(u32x4*)(rowp + bj * 128) = w; } }
        } else if (mode == 1) {
            f32x4 gv[2][2];
            { const float* gp = gate + (size_t)(u.pm >> 5) * MODW + col0;
#pragma unroll
              for (int bj = 0; bj < 2; ++bj)
#pragma unroll
                  for (int n = 0; n < 2; ++n) gv[bj][n] = *(const f32x4*)(gp + bj * 128 + 4 * n); }
#pragma unroll
            for (int am = 0; am < 4; ++am) { const int ai = am >> 1, m0 = (am & 1) * 2;
                f32x4 xv[2][2][2];
#pragma unroll
                for (int mm = 0; mm < 2; ++mm) { const float* xp = X + (size_t)(rowb + 4 * ai + m0 + mm) * DM + col0;
#pragma unroll
                    for (int bj = 0; bj < 2; ++bj)
#pragma unroll
                        for (int n = 0; n < 2; ++n) xv[mm][bj][n] = *(const f32x4*)(xp + bj * 128 + 4 * n); }
#pragma unroll
                for (int mm = 0; mm < 2; ++mm) { float* xp = X + (size_t)(rowb + 4 * ai + m0 + mm) * DM + col0;
#pragma unroll
                    for (int bj = 0; bj < 2; ++bj)
#pragma unroll
                        for (int n = 0; n < 2; ++n) *(f32x4*)(xp + bj * 128 + 4 * n) = xv[mm][bj][n] + gv[bj][n] * acc[ai][bj][m0 + mm][n]; }
            }
        } else if (mode == 3) {
            int fq3 = fq; asm volatile("" : "+v"(fq3));
            const int head = 4 * u.pn + wc; const bool prm = u.pm < 64;
            const f32x2* TAB = (const f32x2*)(wsb + WS_TAB);
            const int sq = prm ? (u.pm >> 5) : ((rowb - RP) >> 3);
            const float* nwp = (head < 16 ? qn : kn) + 8 * fq3;
            f32x4 ca, sa, cb, sb;
            { const int pos0 = prm ? (rowb & (SEQL - 1)) : SEQL; const f32x4* tp = (const f32x4*)(TAB + pos0 * 32 + 8 * fq3); const f32x4 c0 = tp[0], c1 = tp[1], c2 = tp[2], c3 = tp[3];
              ca = (f32x4){c0[0], c0[2], c1[0], c1[2]}; sa = (f32x4){c0[1], c0[3], c1[1], c1[3]}; cb = (f32x4){c2[0], c2[2], c3[0], c3[2]}; sb = (f32x4){c2[1], c2[3], c3[1], c3[3]};
            }
#pragma unroll
            for (int j = 0; j < 8; ++j) { const int row = rowb + j, t = prm ? (row & (SEQL - 1)) : j;
                f32x4 x1a = acc[j >> 2][0][j & 3][0], x1b = acc[j >> 2][0][j & 3][1], x2a = acc[j >> 2][1][j & 3][0], x2b = acc[j >> 2][1][j & 3][1];
                if (head < 20) {
                    float ss = (x1a[0] * x1a[0] + x1a[1] * x1a[1]) + (x1a[2] * x1a[2] + x1a[3] * x1a[3]) + (x1b[0] * x1b[0] + x1b[1] * x1b[1]) + (x1b[2] * x1b[2] + x1b[3] * x1b[3])
                             + (x2a[0] * x2a[0] + x2a[1] * x2a[1]) + (x2a[2] * x2a[2] + x2a[3] * x2a[3]) + (x2b[0] * x2b[0] + x2b[1] * x2b[1]) + (x2b[2] * x2b[2] + x2b[3] * x2b[3]);
                    ss += shx(ss, 16); ss += shx(ss, 32);
                    const float rstd = rsqrtf(ss * (1.f / 64.f) + EPS);
                    const f32x4 y1a = x1a * rstd * *(const f32x4*)nwp, y1b = x1b * rstd * *(const f32x4*)(nwp + 4), y2a = x2a * rstd * *(const f32x4*)(nwp + 32), y2b = x2b * rstd * *(const f32x4*)(nwp + 36);
                    x1a = y1a * ca - y2a * sa; x1b = y1b * cb - y2b * sb; x2a = y2a * ca + y1a * sa; x2b = y2b * cb + y1b * sb;
                }
                bf16* zp = O + (size_t)row * QKVW + head * 64 + 8 * fq3;
                *(u32x4*)zp = (u32x4){pk2(x1a[0], x1a[1]), pk2(x1a[2], x1a[3]), pk2(x1b[0], x1b[1]), pk2(x1b[2], x1b[3])};
                *(u32x4*)(zp + 32) = (u32x4){pk2(x2a[0], x2a[1]), pk2(x2a[2], x2a[3]), pk2(x2b[0], x2b[1]), pk2(x2b[2], x2b[3])};
                if (head >= 16 && (!prm || t >= SEQL - 128)) {
                    float* dst = X + (head < 20 ? (prm ? O_PWK : O_SWK) : (prm ? O_PWV : O_SWV)) + (prm ? ((size_t)(lyr * 2 + sq) * 128 + (t - (SEQL - 128))) * 256 : ((size_t)(lyr * 128 + sq) * 128 + 120 + j) * 256) + ((head - 16) & 3) * 64 + 8 * fq3;
                    *(f32x4*)dst = x1a; *(f32x4*)(dst + 4) = x1b; *(f32x4*)(dst + 32) = x2a; *(f32x4*)(dst + 36) = x2b; }
                if (head < 20) { const f32x4* t1 = (const f32x4*)(TAB + 32 + 8 * fq3); const f32x4 e0 = t1[0], e1 = t1[1], e2 = t1[2], e3 = t1[3];
                    const f32x4 dca = (f32x4){e0[0], e0[2], e1[0], e1[2]}, dsa = (f32x4){e0[1], e0[3], e1[1], e1[3]}, dcb = (f32x4){e2[0], e2[2], e3[0], e3[2]}, dsb = (f32x4){e2[1], e2[3], e3[1], e3[3]};
                    const f32x4 na = ca * dca - sa * dsa, nb = cb * dcb - sb * dsb; sa = sa * dca + ca * dsa; sb = sb * dcb + cb * dsb; ca = na; cb = nb; }
                asm volatile("" ::: "memory");
            }
        } else {
            const bool smp = u.pm >= 64; const int sq = (rowb - RP) >> 3;
            bf16* UB = (bf16*)(wsb + WS_UB); bf16* ACT = (bf16*)(wsb + WS_ACT);
#pragma unroll
            for (int n = 0; n < 2; ++n) {
                const int cf = u.pn * 128 + wc * 32 + 8 * fq + 4 * n;
                const f32x4 wg0 = *(const f32x4*)(cw + cf), wg1 = *(const f32x4*)(cw + FF2 + cf), wg2 = *(const f32x4*)(cw + 2 * FF2 + cf);
                const f32x4 wa0 = *(const f32x4*)(cw + FF + cf), wa1 = *(const f32x4*)(cw + FF2 + FF + cf), wa2 = *(const f32x4*)(cw + 2 * FF2 + FF + cf);
                f32x4 g2, g1, a2, a1;
                if (smp) { const float* st = stp + (size_t)sq * 2 * FF2; g2 = *(const f32x4*)(st + cf); a2 = *(const f32x4*)(st + FF + cf); g1 = *(const f32x4*)(st + FF2 + cf); a1 = *(const f32x4*)(st + FF2 + FF + cf); }
                else { g2 = dpp_shr1(acc[1][0][2][n]); g1 = dpp_shr1(acc[1][0][3][n]); a2 = dpp_shr1(acc[1][1][2][n]); a1 = dpp_shr1(acc[1][1][3][n]); }
#pragma unroll
                for (int j = 0; j < 8; ++j) { const f32x4 G = acc[j >> 2][0][j & 3][n], A = acc[j >> 2][1][j & 3][n];
                    const f32x4 cg = wg0 * g2 + wg1 * g1 + wg2 * G, ca = wa0 * a2 + wa1 * a1 + wa2 * A;
                    if (smp || fr != 0 || j >= 2)
                        *(u32x2*)(ACT + (size_t)(rowb + j) * FF + cf) = (u32x2){pg8::cvt_pk_bf16(cg[0] * sigmoidf_(cg[0]) * ca[0], cg[1] * sigmoidf_(cg[1]) * ca[1]), pg8::cvt_pk_bf16(cg[2] * sigmoidf_(cg[2]) * ca[2], cg[3] * sigmoidf_(cg[3]) * ca[3])};
                    if (smp) { if (j >= 6) { float* d = sout + ((size_t)sq * 2 + (j - 6)) * FF2; *(f32x4*)(d + cf) = G; *(f32x4*)(d + FF + cf) = A; } }
                    else if ((fr == 0 && j < 2) || (fr == 15 && j >= 6)) { bf16* d = UB + ((size_t)(u.pm * 2 + wr) * 4 + (j < 2 ? j : j - 4)) * FF2;
                        *(u32x2*)(d + cf) = (u32x2){pk2(G[0], G[1]), pk2(G[2], G[3])}; *(u32x2*)(d + FF + cf) = (u32x2){pk2(A[0], A[1]), pk2(A[2], A[3])}; }
                    g2 = g1; g1 = G; a2 = a1; a1 = A; }
            }
        }
    }
};
struct EpiMod {
    static constexpr bool PERM = true, AFTER_DRAIN = false;
    float* O; const float* bias;
    __device__ __forceinline__ void operator()(const pg8::f32x4 (&acc)[2][2][4][2], const pg8::Unit& u, int wr, int wc, int fr, int fq) const {
        const int rowb = u.pm * 256 + 8 * (16 * wr + fr), col0 = u.pn * 256 + wc * 32 + 8 * fq;
#pragma unroll
        for (int ai = 0; ai < 2; ++ai)
#pragma unroll
            for (int m = 0; m < 4; ++m) { const int row = rowb + 4 * ai + m;
                if (row < NSEQ) {
#pragma unroll
                    for (int bj = 0; bj < 2; ++bj)
#pragma unroll
                        for (int n = 0; n < 2; ++n) { const f32x4 b = *(const f32x4*)(bias + col0 + bj * 128 + 4 * n);
                            *(f32x4*)(O + (size_t)row * MODW + col0 + bj * 128 + 4 * n) = acc[ai][bj][m][n] + b; } } }
    }
};


__device__ __forceinline__ void mini_gemm(const bf16* A, const bf16* Bt, int K, float* X, const float* gate, unsigned char* smem) {
    const int tid = otid(), lane = tid & 63, wave = tid >> 6, fr = lane & 15, fq = lane >> 4;
    float* part = (float*)smem;
    const int nks = K / 256;
    for (int u = obid(); u < 256; u += gridDim.x) {
        const int rm = u >> 4, cn = u & 15;
        const bf16* Ap = A + (size_t)(RP + 64 * rm + fr) * K + wave * (K / 8) + 8 * fq;
        const bf16* Bp = Bt + (size_t)(64 * cn + fr) * K + wave * (K / 8) + 8 * fq;
        f32x4 acc[4][4];
#pragma unroll
        for (int i = 0; i < 4; ++i)
#pragma unroll
            for (int j = 0; j < 4; ++j) acc[i][j] = (f32x4){0.f, 0.f, 0.f, 0.f};
        bf16x8 a0[4], b0[4], a1[4], b1[4];
#define MG_LD(a, b, ks) do { _Pragma("unroll") for (int i_ = 0; i_ < 4; ++i_) { a[i_] = *(const bf16x8*)(Ap + (size_t)(16 * i_) * K + 32 * (ks)); b[i_] = *(const bf16x8*)(Bp + (size_t)(16 * i_) * K + 32 * (ks)); } } while (0)
#define MG_MMA(a, b) do { _Pragma("unroll") for (int i_ = 0; i_ < 4; ++i_) _Pragma("unroll") for (int j_ = 0; j_ < 4; ++j_) acc[i_][j_] = __builtin_amdgcn_mfma_f32_16x16x32_bf16(b[j_], a[i_], acc[i_][j_], 0, 0, 0); } while (0)
        MG_LD(a0, b0, 0);
        for (int ks = 0; ks < nks; ks += 2) {
            if (ks + 1 < nks) MG_LD(a1, b1, ks + 1);
            MG_MMA(a0, b0);
            if (ks + 2 < nks) MG_LD(a0, b0, ks + 2);
            if (ks + 1 < nks) MG_MMA(a1, b1);
        }
#undef MG_LD
#undef MG_MMA
#pragma unroll
        for (int i = 0; i < 4; ++i)
#pragma unroll
            for (int j = 0; j < 4; ++j) *(f32x4*)(part + (wave * 64 + 16 * i + fr) * 68 + 16 * j + 4 * fq) = acc[i][j];
        __syncthreads();
        {
            const int row = tid >> 3, c0 = (tid & 7) * 8;
            f32x4 s0 = (f32x4){0.f, 0.f, 0.f, 0.f}, s1 = s0;
#pragma unroll
            for (int w = 0; w < 8; ++w) { s0 = s0 + *(const f32x4*)(part + (w * 64 + row) * 68 + c0); s1 = s1 + *(const f32x4*)(part + (w * 64 + row) * 68 + c0 + 4); }
            const int grow = RP + 64 * rm + row, col = 64 * cn + c0; const int sq = 2 + ((grow - RP) >> 3);
            const float* gp = gate + (size_t)sq * MODW + col; float* xp = X + (size_t)grow * DM + col;
            const f32x4 g0 = *(const f32x4*)gp, g1 = *(const f32x4*)(gp + 4);
            *(f32x4*)xp = *(const f32x4*)xp + g0 * s0; *(f32x4*)(xp + 4) = *(const f32x4*)(xp + 4) + g1 * s1;
        }
        __syncthreads();
    }
}
struct TDesc { const float* W; bf16* WT; int ldw, K; };
constexpr int I_IN = 1792, I_AO = 512, I_QKV = 768, I_CO = 512, I_UP = 2816, I_DN = 1408, I_ADA = 3072;
constexpr int TN1 = 2 * I_IN, TN2 = TN1 + 2 * I_AO, TN3 = TN2 + 2 * I_QKV, TN4 = TN3 + 2 * I_CO, TN5 = TN4 + 4 * I_UP, TN6 = TN5 + 4 * I_DN, TN7 = TN6 + 4 * I_ADA;
__device__ __forceinline__ void tdecode(const Params& p, int it, TDesc& d) {
    unsigned char* ws = p.ws; int r = it, ncols; const float* W; bf16* WT; int ldw, K = DM; bool wup = false, wqkv = false;
    if (r < TN1) { const int i = r / I_IN; r -= i * I_IN; W = p.in[15] + (size_t)i * DM * INA; WT = (bf16*)(ws + WS_WIN) + (size_t)i * ZW * DM; ldw = INA;
        if (r < 1024) ncols = 2048; else { W += 2056; WT += (size_t)2048 * DM; r -= 1024; ncols = 1536; } }
    else if (r < TN2) { r -= TN1; const int i = r / I_AO; r -= i * I_AO; W = p.in[19] + (size_t)i * DM * DM; WT = (bf16*)(ws + WS_WAO) + (size_t)i * DM * DM; ldw = DM; ncols = DM; }
    else if (r < TN3) { r -= TN2; const int i = r / I_QKV; r -= i * I_QKV; W = p.in[20] + (size_t)i * DM * QKVW; WT = (bf16*)(ws + WS_WQKV) + (size_t)i * QKVW * DM; ldw = QKVW; ncols = QKVW; wqkv = true; }
    else if (r < TN4) { r -= TN3; const int i = r / I_CO; r -= i * I_CO; W = p.in[24] + (size_t)i * DM * DM; WT = (bf16*)(ws + WS_WCO) + (size_t)i * DM * DM; ldw = DM; ncols = DM; }
    else if (r < TN5) { r -= TN4; const int i = r / I_UP; r -= i * I_UP; W = p.in[25] + (size_t)i * DM * FF2; WT = (bf16*)(ws + WS_WUP) + (size_t)i * FF2 * DM; ldw = FF2; ncols = FF2; wup = true; }
    else if (r < TN6) { r -= TN5; const int i = r / I_DN; r -= i * I_DN; W = p.in[27] + (size_t)i * FF * DM; WT = (bf16*)(ws + WS_WDN) + (size_t)i * DM * FF; ldw = DM; ncols = DM; K = FF; }
    else { r -= TN6; const int i = r / I_ADA; r -= i * I_ADA; W = p.in[13] + (size_t)i * DM * 6144; WT = (bf16*)(ws + WS_ZU) + (size_t)i * 6144 * DM; ldw = 6144; ncols = 6144; }
    const int nblk = ncols / 32, kb = r / nblk, nb = r - kb * nblk;
    int drow = 32 * nb;
    if (wup) drow = (nb < 88) ? 256 * (nb >> 2) + 32 * (nb & 3) : 256 * ((nb - 88) >> 2) + 128 + 32 * ((nb - 88) & 3);
    if (wqkv) { const int head = nb >> 1; drow = 256 * (head >> 2) + 128 * (nb & 1) + 32 * (head & 3); }
    d.W = W + (size_t)(64 * kb) * ldw + 32 * nb; d.WT = WT + (size_t)drow * K + 64 * kb; d.ldw = ldw; d.K = K;
}
__device__ __forceinline__ void tload(const TDesc& d, int lane, float (&v)[32]) {
#pragma unroll
    for (int i = 0; i < 32; ++i) v[i] = d.W[(size_t)(2 * i + (lane >> 5)) * d.ldw + (lane & 31)];
}
__device__ __forceinline__ void tstore(const TDesc& d, int lane, const float (&v)[32], float* scr) {
#pragma unroll
    for (int i = 0; i < 32; ++i) scr[(2 * i + (lane >> 5)) * 33 + (lane & 31)] = v[i];
    LDS_WAIT();
    const int c = lane & 7;
#pragma unroll
    for (int j = 0; j < 4; ++j) { const int n = (lane >> 3) + 8 * j; const float* s = scr + (8 * c) * 33 + n;
        u32x4 o; o.x = pk2(s[0 * 33], s[1 * 33]); o.y = pk2(s[2 * 33], s[3 * 33]); o.z = pk2(s[4 * 33], s[5 * 33]); o.w = pk2(s[6 * 33], s[7 * 33]);
        *(u32x4*)(d.WT + (size_t)n * d.K + 8 * c) = o; }
    LDS_WAIT();
}

__device__ __forceinline__ void prologue(const Params& p, unsigned char* smem) {
    const int tid = otid(), lane = tid & 63, wave = tid >> 6;
    const int gw = obid() * NWAVES + wave, NGW = gridDim.x * NWAVES;
    float* scr = (float*)(smem + wave * 16384);
    unsigned char* ws = p.ws;
    {
        float va[32], vb[32]; TDesc da, db;
        int it = gw;
        if (it < TN7) { tdecode(p, it, da); tload(da, lane, va); }
        while (it < TN7) {
            int nx = it + NGW;
            if (nx < TN7) { tdecode(p, nx, db); tload(db, lane, vb); }
            tstore(da, lane, va, scr);
            it = nx; nx = it + NGW;
            if (it >= TN7) break;
            if (nx < TN7) { tdecode(p, nx, da); tload(da, lane, va); }
            tstore(db, lane, vb, scr);
            it = nx;
        }
    }
    const int gt = obid() * NTHR + tid, NT = gridDim.x * NTHR;
    bf16* Ac = (bf16*)(ws + WS_AC);
    for (int idx = gt; idx < 256 * DM; idx += NT) { const int row = idx >> 10, col = idx & 1023; float v = 0.f;
        if (row < 2) v = p.in[2][row * DM + col]; else if (row < NSEQ) v = p.in[3][(row - 2) * DM + col];
        Ac[idx] = (bf16)f2bf(v * sigmoidf_(v)); }
    f32x2* TAB = (f32x2*)(ws + WS_TAB);
    for (int idx = gt; idx < 8200 * 32; idx += NT) { const int pos = idx >> 5, i = idx & 31;
        const double ang = (double)pos * ROPE_INV[i];
        const double n = rint(ang * 0.6366197723675814); double r = fma(-n, 1.5707963267948966, ang); r = fma(-n, 6.123233995736766e-17, r); const double r2 = r * r;
        const double sn = r * (1.0 + r2 * (-1.0 / 6 + r2 * (1.0 / 120 + r2 * (-1.0 / 5040 + r2 * (1.0 / 362880 + r2 * (-1.0 / 39916800 + r2 * (1.0 / 6227020800.0)))))));
        const double cn = 1.0 + r2 * (-0.5 + r2 * (1.0 / 24 + r2 * (-1.0 / 720 + r2 * (1.0 / 40320 + r2 * (-1.0 / 3628800 + r2 * (1.0 / 479001600.0 + r2 * (-1.0 / 87178291200.0)))))));
        const int qd = ((int)n) & 3; const double c = (qd == 0) ? cn : (qd == 1) ? -sn : (qd == 2) ? -cn : sn, s = (qd == 0) ? sn : (qd == 1) ? cn : (qd == 2) ? -sn : -cn;
        TAB[idx] = (f32x2){(float)c, (float)s}; }
}

__device__ __forceinline__ void norm_phase(const Params& p, int l, int which, unsigned char* smem) {
    const int tid = otid(), lane = tid & 63, wave = tid >> 6;
    const int gw = obid() * NWAVES + wave, NGW = gridDim.x * NWAVES;
    const bool do_gates = (which == 1) && !(l & 1);
    const bool first = (which == 1) && (l == 0);
    float* X = p.out;
    const float* MOD = (const float*)(p.ws + WS_MOD);
    bf16* H = (bf16*)(p.ws + WS_H);
    float* gwl = (float*)smem;
    if (do_gates) {
        const float* W = p.in[15] + (size_t)(l >> 1) * DM * INA + 2048;
        for (int idx = tid; idx < 8192; idx += NTHR) gwl[idx] = W[(size_t)(idx >> 3) * INA + (idx & 7)];
        __syncthreads();
    }
    f32x4 gwa[4][4];
#pragma unroll
    for (int j = 0; j < 4; ++j)
#pragma unroll
        for (int e = 0; e < 4; ++e) gwa[j][e] = do_gates ? *(const f32x4*)(gwl + (4 * lane + 256 * j + e) * 8) : (f32x4){0.f, 0.f, 0.f, 0.f};
    const float* nw = (which == 1 ? p.in[11] : p.in[12]) + l * DM;
    const int off_sh = l * 6144 + (which == 1 ? 0 : 3072), off_sc = off_sh + 1024;
    f32x4 nwv[4];
#pragma unroll
    for (int j = 0; j < 4; ++j) nwv[j] = *(const f32x4*)(nw + 4 * lane + 256 * j);
    f32x4 vn[4], vn2[4];
#define NORM_SRC(r_) (first ? ((r_) < RP ? p.in[0] + (size_t)(r_) * DM : p.in[1] + (size_t)((r_) - RP) * DM) : X + (size_t)(r_) * DM)
    { const int row = gw; if (row < R) { const float* src = NORM_SRC(row);
#pragma unroll
        for (int j = 0; j < 4; ++j) vn[j] = *(const f32x4*)(src + 4 * lane + 256 * j); }
      const int row2 = gw + NGW; if (row2 < R) { const float* src = NORM_SRC(row2);
#pragma unroll
        for (int j = 0; j < 4; ++j) vn2[j] = *(const f32x4*)(src + 4 * lane + 256 * j); } }
    int cur_sq = -1; f32x4 mulv[4], shv[4];
    for (int row = gw; row < R; row += NGW) {
        const int sq = seq_of(row);
        if (sq != cur_sq) { cur_sq = sq; const float* mrow_ = MOD + (size_t)sq * MODW;
#pragma unroll
            for (int j = 0; j < 4; ++j) { const f32x4 sc = *(const f32x4*)(mrow_ + off_sc + 4 * lane + 256 * j); shv[j] = *(const f32x4*)(mrow_ + off_sh + 4 * lane + 256 * j); mulv[j] = nwv[j] * (sc + 1.f); } }
        f32x4 v[4]; float ss = 0.f;
#pragma unroll
        for (int j = 0; j < 4; ++j) { v[j] = vn[j]; vn[j] = vn2[j]; }
        { const int nrow = row + 2 * NGW; if (nrow < R) { const float* src = NORM_SRC(nrow);
#pragma unroll
            for (int j = 0; j < 4; ++j) vn2[j] = *(const f32x4*)(src + 4 * lane + 256 * j); } }
#pragma unroll
        for (int j = 0; j < 4; ++j) ss += (v[j].x * v[j].x + v[j].y * v[j].y) + (v[j].z * v[j].z + v[j].w * v[j].w);
        if (first) {
#pragma unroll
            for (int j = 0; j < 4; ++j) *(f32x4*)(X + (size_t)row * DM + 4 * lane + 256 * j) = v[j];
        }
        const float rstd = rsqrtf(wave_sum(ss) * (1.f / DM) + EPS);
        float ga[8];
#pragma unroll
        for (int g = 0; g < 8; ++g) ga[g] = 0.f;
#pragma unroll
        for (int j = 0; j < 4; ++j) {
            f32x4 h = v[j] * rstd * mulv[j] + shv[j];
            *(u32x2*)(H + (size_t)row * DM + 4 * lane + 256 * j) = (u32x2){pk2(h.x, h.y), pk2(h.z, h.w)};
            if (do_gates) {
#pragma unroll
                for (int e = 0; e < 4; ++e) { const float* wp = gwl + (4 * lane + 256 * j + e) * 8; const f32x4 w0 = gwa[j][e], w1 = *(const f32x4*)(wp + 4); const float hv = h[e];
                    ga[0] += hv * w0.x; ga[1] += hv * w0.y; ga[2] += hv * w0.z; ga[3] += hv * w0.w; ga[4] += hv * w1.x; ga[5] += hv * w1.y; ga[6] += hv * w1.z; ga[7] += hv * w1.w; }
            }
        }
        if (do_gates) {
            const float* bif = p.in[16] + (l >> 1) * 8;
#pragma unroll
            for (int g = 0; g < 8; ++g) ga[g] = wave_sum(ga[g]);
            if (lane == 0) { float* G = (float*)(p.ws + WS_GATES) + (size_t)row * 8;
                *(f32x4*)G = (f32x4){ga[0] + bif[0], ga[1] + bif[1], ga[2] + bif[2], ga[3] + bif[3]}; *(f32x4*)(G + 4) = (f32x4){ga[4] + bif[4], ga[5] + bif[5], ga[6] + bif[6], ga[7] + bif[7]}; }
        }
    }
    __syncthreads();
}

__device__ __forceinline__ float scan_add(float v, int lane) {
#pragma unroll
    for (int o = 1; o < 64; o <<= 1) { const float t = shup(v, o); if (lane >= o) v += t; }
    return v;
}
__device__ __forceinline__ float scan_max(float v, int lane) {
#pragma unroll
    for (int o = 1; o < 64; o <<= 1) { const float t = shup(v, o); if (lane >= o) v = fmaxf(v, t); }
    return v;
}
constexpr float KSCALE = 0.08838834764831845f;

__device__ __forceinline__ void head_out(const Params& p, int i, int h, int row, int lane, float hv0, float hv1, unsigned zo, f32x2 on) {
    const float ss = wave_sum(hv0 * hv0 + hv1 * hv1);
    const float rstd = rsqrtf(ss * (1.f / 128.f) + EPS);
    unsigned* CAT = (unsigned*)((bf16*)(p.ws + WS_CAT) + (size_t)row * DM + h * 128);
    CAT[lane] = pk2(hv0 * rstd * on.x * sigmoidf_(bflo(zo)), hv1 * rstd * on.y * sigmoidf_(bfhi(zo)));
}
__device__ __forceinline__ void mlstm_local(const Params& p, int i, int item, unsigned char* smem) {
    const int tid = otid(), lane = tid & 63, wave = tid >> 6, fr = lane & 15, fq = lane >> 4;
    const int b = item >> 9, h = (item >> 7) & 3, c = item & 127, r0 = b * SEQL + c * 64;
    float* ws_l = (float*)smem;
    bf16* kT = (bf16*)(smem + 1024);
    bf16* vT = kT + 128 * 72;
    const float* G = (const float*)(p.ws + WS_GATES);
    const bf16* Z = (const bf16*)(p.ws + WS_ZU);
    if (wave == 0) {
        const float ig = G[(size_t)(r0 + lane) * 8 + h], lf = logsigmoidf(G[(size_t)(r0 + lane) * 8 + 4 + h]);
        const float bs = scan_add(lf, lane), bL = shi(bs, 63);
        const float a = bL - bs + ig, amax = wave_max(a);
        ws_l[lane] = __expf(a - amax);
        if (lane == 0) { float* CS = (float*)(p.ws + WS_CS); CS[item * 2] = bL; CS[item * 2 + 1] = amax; }
    }
    __syncthreads();
    { u32x4 wv[4];
#pragma unroll
      for (int it = 0; it < 4; ++it) { const int q = tid + it * NTHR, which = q >> 10, idx = q & 1023, s = idx & 63, ch = idx >> 6; wv[it] = *(const u32x4*)(Z + (size_t)(r0 + s) * ZW + (which ? 1024 : 512) + h * 128 + ch * 8); }
#pragma unroll
      for (int it = 0; it < 4; ++it) { const int q = tid + it * NTHR, which = q >> 10, idx = q & 1023, s = idx & 63, ch = idx >> 6; const u32x4 w = wv[it];
        bf16* dst = (which ? vT : kT) + (ch * 8) * 72 + s;
        if (which) {
            dst[0 * 72] = (bf16)(w.x & 0xffff); dst[1 * 72] = (bf16)(w.x >> 16); dst[2 * 72] = (bf16)(w.y & 0xffff); dst[3 * 72] = (bf16)(w.y >> 16);
            dst[4 * 72] = (bf16)(w.z & 0xffff); dst[5 * 72] = (bf16)(w.z >> 16); dst[6 * 72] = (bf16)(w.w & 0xffff); dst[7 * 72] = (bf16)(w.w >> 16);
        } else { const float sc = ws_l[s] * KSCALE;
            dst[0 * 72] = (bf16)f2bf(bflo(w.x) * sc); dst[1 * 72] = (bf16)f2bf(bfhi(w.x) * sc); dst[2 * 72] = (bf16)f2bf(bflo(w.y) * sc); dst[3 * 72] = (bf16)f2bf(bfhi(w.y) * sc);
            dst[4 * 72] = (bf16)f2bf(bflo(w.z) * sc); dst[5 * 72] = (bf16)f2bf(bfhi(w.z) * sc); dst[6 * 72] = (bf16)f2bf(bflo(w.w) * sc); dst[7 * 72] = (bf16)f2bf(bfhi(w.w) * sc); } } }
    __syncthreads();
    f32x4 acc[8];
#pragma unroll
    for (int mt = 0; mt < 8; ++mt) acc[mt] = (f32x4){0.f, 0.f, 0.f, 0.f};
#pragma unroll
    for (int ks = 0; ks < 2; ++ks) { const bf16x8 B = *(const bf16x8*)(vT + (16 * wave + fr) * 72 + 32 * ks + 8 * fq);
#pragma unroll
        for (int mt = 0; mt < 8; ++mt) { const bf16x8 A = *(const bf16x8*)(kT + (16 * mt + fr) * 72 + 32 * ks + 8 * fq); acc[mt] = __builtin_amdgcn_mfma_f32_16x16x32_bf16(A, B, acc[mt], 0, 0, 0); } }
    bf16* dCt = (bf16*)(p.ws + WS_DCT) + (size_t)item * 16384;
#pragma unroll
    for (int mt = 0; mt < 8; ++mt) *(u32x2*)(dCt + (16 * wave + fr) * 128 + 16 * mt + 4 * fq) = (u32x2){pk2_sw(acc[mt][0], acc[mt][1]), pk2_sw(acc[mt][2], acc[mt][3])};
    if (tid < 128) { float s = 0.f;
        for (int t = 0; t < 64; ++t) s += bf2f(kT[tid * 72 + t]);
        ((float*)(p.ws + WS_DN))[item * 128 + tid] = s; }
    __syncthreads();
}

__device__ __forceinline__ void mlstm_scan(const Params& p, int i, unsigned char* smem) {
    const float* CS = (const float*)(p.ws + WS_CS); const bf16* dCt = (const bf16*)(p.ws + WS_DCT); const float* DN = (const float*)(p.ws + WS_DN);
    bf16* CSt = (bf16*)(p.ws + WS_CST); float* NS = (float*)(p.ws + WS_NS); float* MS = (float*)(p.ws + WS_MS);
    for (int idx = obid() * NTHR + otid(); idx < 8 * 16384; idx += gridDim.x * NTHR) {
        const int bh = idx >> 14, e = idx & 16383;
        float* csl = (float*)smem;
        __syncthreads(); if (otid() < 256) csl[otid()] = CS[bh * 256 + otid()]; __syncthreads();
        float C = 0.f, m = 0.f, nacc = 0.f;
        float dv[16], dnv[16], dv2[16], dnv2[16];
#define SC_LD(D, DNV, c0_) do { _Pragma("unroll") for (int k_ = 0; k_ < 16; ++k_) { D[k_] = bf2f(dCt[(size_t)(bh * 128 + (c0_) + k_) * 16384 + e]); DNV[k_] = (e < 128) ? DN[(bh * 128 + (c0_) + k_) * 128 + e] : 0.f; } } while (0)
#define SC_RUN(D, DNV, c0_) do { _Pragma("unroll") for (int k_ = 0; k_ < 16; ++k_) { const int item = bh * 128 + (c0_) + k_; const float bL = csl[2 * ((c0_) + k_)], amax = csl[2 * ((c0_) + k_) + 1]; \
                CSt[(size_t)item * 16384 + e] = (bf16)f2bf(C); if (e < 128) NS[item * 128 + e] = nacc; if (e == 0) MS[item] = m; \
                const float mn = fmaxf(bL + m, amax), f1 = __expf(bL + m - mn), f2 = __expf(amax - mn); C = f1 * C + f2 * D[k_]; nacc = f1 * nacc + f2 * DNV[k_]; m = mn; } } while (0)
        SC_LD(dv, dnv, 0);
        for (int c0 = 0; c0 < 128; c0 += 32) {
            SC_LD(dv2, dnv2, c0 + 16);
            SC_RUN(dv, dnv, c0);
            if (c0 + 32 < 128) SC_LD(dv, dnv, c0 + 32);
            SC_RUN(dv2, dnv2, c0 + 16);
        }
#undef SC_LD
#undef SC_RUN
        const int b = bh >> 2, h = bh & 3; const size_t sidx = (size_t)((i * 2 + b) * 4 + h);
        p.out[O_PC + sidx * 16384 + (size_t)(e & 127) * 128 + (e >> 7)] = C;
        if (e < 128) p.out[O_PN + sidx * 128 + e] = nacc;
        if (e == 0) p.out[O_PM + sidx] = m;
    }
}

__device__ __forceinline__ void mlstm_out(const Params& p, int i, int item, unsigned char* smem) {
    const int tid = otid(), lane = tid & 63, wave = tid >> 6, fr = lane & 15, fq = lane >> 4;
    const int b = item >> 9, h = (item >> 7) & 3, c = item & 127, r0 = b * SEQL + c * 64;
    float* d_l = (float*)smem;
    float* M_l = d_l + 64;
    float* wg_l = d_l + 128;
    float* mt_l = d_l + 192;
    float* den_l = d_l + 256;
    float* rs_l = d_l + 320;
    float* qn_l = d_l + 448;
    bf16* q_l = (bf16*)(smem + 2048);
    bf16* k_l = q_l + 64 * 136;
    bf16* vT = k_l + 64 * 136;
    bf16* Sw = vT + 128 * 72;
    float* hbuf = (float*)(Sw + 64 * 72);
    const float* G = (const float*)(p.ws + WS_GATES);
    const bf16* Z = (const bf16*)(p.ws + WS_ZU);
    bf16x8 Bc[4];
    { const bf16* cp = (const bf16*)(p.ws + WS_CST) + (size_t)item * 16384 + (16 * wave + fr) * 128 + 8 * fq;
#pragma unroll
      for (int ks = 0; ks < 4; ++ks) Bc[ks] = *(const bf16x8*)(cp + 32 * ks); }
    if (wave == 0) {
        const float ig = G[(size_t)(r0 + lane) * 8 + h], lf = logsigmoidf(G[(size_t)(r0 + lane) * 8 + 4 + h]);
        const float bs = scan_add(lf, lane), d = ig - bs, gmax = scan_max(d, lane);
        const float mc = ((const float*)(p.ws + WS_MS))[item];
        const float Mt = fmaxf(mc, gmax);
        d_l[lane] = d; M_l[lane] = Mt; wg_l[lane] = __expf(mc - Mt); mt_l[lane] = bs + Mt;
    }
    { u32x4 wv[6];
#pragma unroll
      for (int it = 0; it < 6; ++it) { const int q = tid + it * NTHR, which = q >> 10, idx = q & 1023, s = (which == 2) ? (idx & 63) : (idx >> 4), ch = (which == 2) ? (idx >> 6) : (idx & 15); wv[it] = *(const u32x4*)(Z + (size_t)(r0 + s) * ZW + which * 512 + h * 128 + ch * 8); }
#pragma unroll
      for (int it = 0; it < 6; ++it) { const int q = tid + it * NTHR, which = q >> 10, idx = q & 1023, s = (which == 2) ? (idx & 63) : (idx >> 4), ch = (which == 2) ? (idx >> 6) : (idx & 15); const u32x4 w = wv[it];
        if (which == 0) *(u32x4*)(q_l + s * 136 + ch * 8) = w;
        else if (which == 1) { u32x4 o; o.x = pk2(bflo(w.x) * KSCALE, bfhi(w.x) * KSCALE); o.y = pk2(bflo(w.y) * KSCALE, bfhi(w.y) * KSCALE);
            o.z = pk2(bflo(w.z) * KSCALE, bfhi(w.z) * KSCALE); o.w = pk2(bflo(w.w) * KSCALE, bfhi(w.w) * KSCALE); *(u32x4*)(k_l + s * 136 + ch * 8) = o; }
        else { bf16* dst = vT + (ch * 8) * 72 + s;
            dst[0 * 72] = (bf16)(w.x & 0xffff); dst[1 * 72] = (bf16)(w.x >> 16); dst[2 * 72] = (bf16)(w.y & 0xffff); dst[3 * 72] = (bf16)(w.y >> 16);
            dst[4 * 72] = (bf16)(w.z & 0xffff); dst[5 * 72] = (bf16)(w.z >> 16); dst[6 * 72] = (bf16)(w.w & 0xffff); dst[7 * 72] = (bf16)(w.w >> 16); } } }
    __syncthreads();
    {
        const int mt = wave >> 1, nt0 = 2 * (wave & 1);
        f32x4 a2[2] = {(f32x4){0.f, 0.f, 0.f, 0.f}, (f32x4){0.f, 0.f, 0.f, 0.f}};
#pragma unroll
        for (int ks = 0; ks < 4; ++ks) { const bf16x8 A = *(const bf16x8*)(q_l + (16 * mt + fr) * 136 + 32 * ks + 8 * fq);
#pragma unroll
            for (int n = 0; n < 2; ++n) { const bf16x8 B = *(const bf16x8*)(k_l + (16 * (nt0 + n) + fr) * 136 + 32 * ks + 8 * fq); a2[n] = __builtin_amdgcn_mfma_f32_16x16x32_bf16(A, B, a2[n], 0, 0, 0); } }
        float rsum[4] = {0.f, 0.f, 0.f, 0.f};
#pragma unroll
        for (int n = 0; n < 2; ++n) { const int s = 16 * (nt0 + n) + fr; const float ds = d_l[s];
#pragma unroll
            for (int j = 0; j < 4; ++j) { const int t = 16 * mt + 4 * fq + j; const float wv = (s <= t) ? __expf(ds - M_l[t]) : 0.f; const float val = a2[n][j] * wv; rsum[j] += val; Sw[t * 72 + s] = (bf16)f2bf(val); } }
#pragma unroll
        for (int j = 0; j < 4; ++j) { float v = rsum[j]; v += shx(v, 1); v += shx(v, 2); v += shx(v, 4); v += shx(v, 8); if (fr == 0) rs_l[(wave & 1) * 64 + 16 * mt + 4 * fq + j] = v; }
        { const int t = tid >> 3, part = tid & 7; const float* NS = (const float*)(p.ws + WS_NS) + item * 128 + part * 16;
          const u32x4 qa = *(const u32x4*)(q_l + t * 136 + part * 16), qb = *(const u32x4*)(q_l + t * 136 + part * 16 + 8);
          const f32x4 n0 = *(const f32x4*)NS, n1 = *(const f32x4*)(NS + 4), n2 = *(const f32x4*)(NS + 8), n3 = *(const f32x4*)(NS + 12);
          float v = bflo(qa.x) * n0.x + bfhi(qa.x) * n0.y + bflo(qa.y) * n0.z + bfhi(qa.y) * n0.w + bflo(qa.z) * n1.x + bfhi(qa.z) * n1.y + bflo(qa.w) * n1.z + bfhi(qa.w) * n1.w
                  + bflo(qb.x) * n2.x + bfhi(qb.x) * n2.y + bflo(qb.y) * n2.z + bfhi(qb.y) * n2.w + bflo(qb.z) * n3.x + bfhi(qb.z) * n3.y + bflo(qb.w) * n3.z + bfhi(qb.w) * n3.w;
          v += shx(v, 1); v += shx(v, 2); v += shx(v, 4); if (part == 0) qn_l[t] = v; }
    }
    __syncthreads();
    if (tid < 64) { const int t = tid; const float den = wg_l[t] * qn_l[t] + (rs_l[t] + rs_l[64 + t]); den_l[t] = __builtin_amdgcn_rcpf(fmaxf(fabsf(den), __expf(-mt_l[t]))); }
    f32x4 acc[4];
#pragma unroll
    for (int mt = 0; mt < 4; ++mt) acc[mt] = (f32x4){0.f, 0.f, 0.f, 0.f};
#pragma unroll
    for (int ks = 0; ks < 4; ++ks) { const bf16x8 B = Bc[ks];
#pragma unroll
        for (int mt = 0; mt < 4; ++mt) { const bf16x8 A = *(const bf16x8*)(q_l + (16 * mt + fr) * 136 + 32 * ks + 8 * fq); acc[mt] = __builtin_amdgcn_mfma_f32_16x16x32_bf16(A, B, acc[mt], 0, 0, 0); } }
#pragma unroll
    for (int mt = 0; mt < 4; ++mt)
#pragma unroll
        for (int j = 0; j < 4; ++j) acc[mt][j] *= wg_l[16 * mt + 4 * fq + j];
#pragma unroll
    for (int ks = 0; ks < 2; ++ks) { const bf16x8 B = *(const bf16x8*)(vT + (16 * wave + fr) * 72 + 32 * ks + 8 * fq);
#pragma unroll
        for (int mt = 0; mt < 4; ++mt) { const bf16x8 A = *(const bf16x8*)(Sw + (16 * mt + fr) * 72 + 32 * ks + 8 * fq); acc[mt] = __builtin_amdgcn_mfma_f32_16x16x32_bf16(A, B, acc[mt], 0, 0, 0); } }
    __syncthreads();
#pragma unroll
    for (int mt = 0; mt < 4; ++mt)
#pragma unroll
        for (int j = 0; j < 4; ++j) { const int t = 16 * mt + 4 * fq + j; hbuf[t * 132 + 16 * wave + fr] = acc[mt][j] * den_l[t]; }
    __syncthreads();
    { unsigned zo[8]; const f32x2 on = *(const f32x2*)(p.in[17] + i * 512 + h * 128 + 2 * lane);
#pragma unroll
      for (int tt = 0; tt < 8; ++tt) zo[tt] = *(const unsigned*)(Z + (size_t)(r0 + 8 * wave + tt) * ZW + 1536 + h * 128 + 2 * lane);
#pragma unroll
      for (int tt = 0; tt < 8; ++tt) { const int t = 8 * wave + tt; const f32x2 hv = *(const f32x2*)(hbuf + t * 132 + 2 * lane); head_out(p, i, h, r0 + t, lane, hv.x, hv.y, zo[tt], on); } }
    __syncthreads();
}

__device__ __forceinline__ void mlstm_out2(const Params& p, int i, int itA, int itB, unsigned char* smem) {
    const int tid = otid(), lane = tid & 63, wave = tid >> 6, fr = lane & 15, fq = lane >> 4, hh = wave >> 2, wl = wave & 3, tl = tid & 255;
    const int item_ = hh ? itB : itA; const bool active = item_ < 1024; const int item = active ? item_ : 0;
    const int b = item >> 9, h = (item >> 7) & 3, c = item & 127, r0 = b * SEQL + c * 64;
    unsigned char* sb = smem + hh * 65536;
    float* d_l = (float*)sb;
    float* M_l = d_l + 64;
    float* wg_l = d_l + 128;
    float* mt_l = d_l + 192;
    float* den_l = d_l + 256;
    float* rs_l = d_l + 320;
    float* qn_l = d_l + 384;
    bf16* q_l = (bf16*)(sb + 2048);
    bf16* k_l = q_l + 64 * 136;
    float* hbuf = (float*)(sb + 2048);
    bf16* vT = k_l + 64 * 136;
    bf16* Sw = vT + 128 * 72;
    const float* G = (const float*)(p.ws + WS_GATES);
    const bf16* Z = (const bf16*)(p.ws + WS_ZU);
    bf16x8 Bc[2][4];
#pragma unroll
    for (int n = 0; n < 2; ++n) { const bf16* cp = (const bf16*)(p.ws + WS_CST) + (size_t)item * 16384 + (16 * (2 * wl + n) + fr) * 128 + 8 * fq;
#pragma unroll
        for (int ks = 0; ks < 4; ++ks) Bc[n][ks] = *(const bf16x8*)(cp + 32 * ks); }
    if (wl == 0) {
        const float ig = G[(size_t)(r0 + lane) * 8 + h], lf = logsigmoidf(G[(size_t)(r0 + lane) * 8 + 4 + h]);
        const float bs = scan_add(lf, lane), d = ig - bs, gmax = scan_max(d, lane);
        const float mc = ((const float*)(p.ws + WS_MS))[item];
        const float Mt = fmaxf(mc, gmax);
        d_l[lane] = d; M_l[lane] = Mt; wg_l[lane] = __expf(mc - Mt); mt_l[lane] = bs + Mt;
    }
    { u32x4 wv[12];
#pragma unroll
      for (int it = 0; it < 12; ++it) { const int q = tl + it * 256, which = q >> 10, idx = q & 1023, s = (which == 2) ? (idx & 63) : (idx >> 4), ch = (which == 2) ? (idx >> 6) : (idx & 15); wv[it] = *(const u32x4*)(Z + (size_t)(r0 + s) * ZW + which * 512 + h * 128 + ch * 8); }
#pragma unroll
      for (int it = 0; it < 12; ++it) { const int q = tl + it * 256, which = q >> 10, idx = q & 1023, s = (which == 2) ? (idx & 63) : (idx >> 4), ch = (which == 2) ? (idx >> 6) : (idx & 15); const u32x4 w = wv[it];
        if (which == 0) *(u32x4*)(q_l + s * 136 + ch * 8) = w;
        else if (which == 1) { u32x4 o; o.x = pk2(bflo(w.x) * KSCALE, bfhi(w.x) * KSCALE); o.y = pk2(bflo(w.y) * KSCALE, bfhi(w.y) * KSCALE);
            o.z = pk2(bflo(w.z) * KSCALE, bfhi(w.z) * KSCALE); o.w = pk2(bflo(w.w) * KSCALE, bfhi(w.w) * KSCALE); *(u32x4*)(k_l + s * 136 + ch * 8) = o; }
        else { bf16* dst = vT + (ch * 8) * 72 + s;
            dst[0 * 72] = (bf16)(w.x & 0xffff); dst[1 * 72] = (bf16)(w.x >> 16); dst[2 * 72] = (bf16)(w.y & 0xffff); dst[3 * 72] = (bf16)(w.y >> 16);
            dst[4 * 72] = (bf16)(w.z & 0xffff); dst[5 * 72] = (bf16)(w.z >> 16); dst[6 * 72] = (bf16)(w.w & 0xffff); dst[7 * 72] = (bf16)(w.w >> 16); } } }
    __syncthreads();
    {
        const int mt = wl;
        f32x4 a4[4];
#pragma unroll
        for (int n = 0; n < 4; ++n) a4[n] = (f32x4){0.f, 0.f, 0.f, 0.f};
#pragma unroll
        for (int ks = 0; ks < 4; ++ks) { const bf16x8 A = *(const bf16x8*)(q_l + (16 * mt + fr) * 136 + 32 * ks + 8 * fq);
#pragma unroll
            for (int n = 0; n < 4; ++n) if (n <= mt) { const bf16x8 B = *(const bf16x8*)(k_l + (16 * n + fr) * 136 + 32 * ks + 8 * fq); a4[n] = __builtin_amdgcn_mfma_f32_16x16x32_bf16(A, B, a4[n], 0, 0, 0); } }
        float rsum[4] = {0.f, 0.f, 0.f, 0.f};
#pragma unroll
        for (int n = 0; n < 4; ++n) { const int s = 16 * n + fr; const float ds = d_l[s];
#pragma unroll
            for (int j = 0; j < 4; ++j) { const int t = 16 * mt + 4 * fq + j; const float wv = (s <= t) ? __expf(ds - M_l[t]) : 0.f; const float val = a4[n][j] * wv; rsum[j] += val; Sw[t * 72 + s] = (bf16)f2bf(val); } }
#pragma unroll
        for (int j = 0; j < 4; ++j) { float v = rsum[j]; v += shx(v, 1); v += shx(v, 2); v += shx(v, 4); v += shx(v, 8); if (fr == 0) rs_l[16 * mt + 4 * fq + j] = v; }
        { const int t = tl >> 2, part = tl & 3; const float* NS = (const float*)(p.ws + WS_NS) + item * 128 + part * 32; float v = 0.f;
#pragma unroll
          for (int g = 0; g < 4; ++g) { const u32x4 qa = *(const u32x4*)(q_l + t * 136 + part * 32 + 8 * g); const f32x4 n0 = *(const f32x4*)(NS + 8 * g), n1 = *(const f32x4*)(NS + 8 * g + 4);
              v += bflo(qa.x) * n0.x + bfhi(qa.x) * n0.y + bflo(qa.y) * n0.z + bfhi(qa.y) * n0.w + bflo(qa.z) * n1.x + bfhi(qa.z) * n1.y + bflo(qa.w) * n1.z + bfhi(qa.w) * n1.w; }
          v += shx(v, 1); v += shx(v, 2); if (part == 0) qn_l[t] = v; }
    }
    __syncthreads();
    if (tl < 64) { const int t = tl; const float den = wg_l[t] * qn_l[t] + rs_l[t]; den_l[t] = __builtin_amdgcn_rcpf(fmaxf(fabsf(den), __expf(-mt_l[t]))); }
    f32x4 acc[2][4];
#pragma unroll
    for (int n = 0; n < 2; ++n)
#pragma unroll
        for (int mt = 0; mt < 4; ++mt) acc[n][mt] = (f32x4){0.f, 0.f, 0.f, 0.f};
#pragma unroll
    for (int ks = 0; ks < 4; ++ks)
#pragma unroll
        for (int mt = 0; mt < 4; ++mt) { const bf16x8 A = *(const bf16x8*)(q_l + (16 * mt + fr) * 136 + 32 * ks + 8 * fq);
#pragma unroll
            for (int n = 0; n < 2; ++n) acc[n][mt] = __builtin_amdgcn_mfma_f32_16x16x32_bf16(A, Bc[n][ks], acc[n][mt], 0, 0, 0); }
#pragma unroll
    for (int mt = 0; mt < 4; ++mt)
#pragma unroll
        for (int j = 0; j < 4; ++j) { const float wgv = wg_l[16 * mt + 4 * fq + j]; acc[0][mt][j] *= wgv; acc[1][mt][j] *= wgv; }
#pragma unroll
    for (int ks = 0; ks < 2; ++ks)
#pragma unroll
        for (int mt = 0; mt < 4; ++mt) { const bf16x8 A = *(const bf16x8*)(Sw + (16 * mt + fr) * 72 + 32 * ks + 8 * fq);
#pragma unroll
            for (int n = 0; n < 2; ++n) { const bf16x8 B = *(const bf16x8*)(vT + (16 * (2 * wl + n) + fr) * 72 + 32 * ks + 8 * fq); acc[n][mt] = __builtin_amdgcn_mfma_f32_16x16x32_bf16(A, B, acc[n][mt], 0, 0, 0); } }
    __syncthreads();
#pragma unroll
    for (int n = 0; n < 2; ++n)
#pragma unroll
        for (int mt = 0; mt < 4; ++mt)
#pragma unroll
            for (int j = 0; j < 4; ++j) { const int t = 16 * mt + 4 * fq + j; hbuf[t * 132 + 16 * (2 * wl + n) + fr] = acc[n][mt][j] * den_l[t]; }
    __syncthreads();
    { unsigned zo[16]; const f32x2 on = *(const f32x2*)(p.in[17] + i * 512 + h * 128 + 2 * lane);
#pragma unroll
      for (int tt = 0; tt < 16; ++tt) zo[tt] = *(const unsigned*)(Z + (size_t)(r0 + 16 * wl + tt) * ZW + 1536 + h * 128 + 2 * lane);
#pragma unroll
      for (int tt = 0; tt < 16; ++tt) { const int t = 16 * wl + tt; const f32x2 hv = *(const f32x2*)(hbuf + t * 132 + 2 * lane);
          const float ss = wave_sum(hv.x * hv.x + hv.y * hv.y); const float rstd = rsqrtf(ss * (1.f / 128.f) + EPS);
          if (active) { unsigned* CAT = (unsigned*)((bf16*)(p.ws + WS_CAT) + (size_t)(r0 + t) * DM + h * 128);
              CAT[lane] = pk2(hv.x * rstd * on.x * sigmoidf_(bflo(zo[tt])), hv.y * rstd * on.y * sigmoidf_(bfhi(zo[tt]))); } } }
    __syncthreads();
}

__device__ __forceinline__ void mlstm_sample(const Params& p, int i, int item, unsigned char* smem) {
    const int tid = otid(), lane = tid & 63, wave = tid >> 6;
    const int s = item >> 2, h = item & 3, r0 = RP + 8 * s;
    float* qq = (float*)smem;
    float* kk = qq + 1024;
    float* vv = kk + 1024;
    float* qT = vv + 1024;
    float* kwT = qT + 1024;
    float* part = kwT + 1024;
    float* S_l = part + 4096;
    float* sc = S_l + 64;
    const bf16* Z = (const bf16*)(p.ws + WS_ZU);
    const float* G = (const float*)(p.ws + WS_GATES);
    const size_t sidx = (size_t)((i * 128 + s) * 4 + h);
    const float* n0 = p.in[5] + sidx * 128;
    { bf16 zv[6];
#pragma unroll
      for (int it = 0; it < 6; ++it) { const int q = tid + it * NTHR, which = q >> 10, t = (q >> 7) & 7, d = q & 127; zv[it] = Z[(size_t)(r0 + t) * ZW + which * 512 + h * 128 + d]; }
#pragma unroll
      for (int it = 0; it < 6; ++it) { const int q = tid + it * NTHR, which = q >> 10; float v = bf2f(zv[it]); if (which == 1) v *= KSCALE; qq[q] = v; } }
    if (wave == 0) {
        const int t = lane & 7;
        const float ig = G[(size_t)(r0 + t) * 8 + h], lf = logsigmoidf(G[(size_t)(r0 + t) * 8 + 4 + h]);
        float bs = 0.f;
        for (int u = 0; u < 8; ++u) { const float x = shi(lf, u); if (u <= t) bs += x; }
        const float d = ig - bs; float gmax = -INFINITY;
        for (int u = 0; u < 8; ++u) { const float x = shi(d, u); if (u <= t) gmax = fmaxf(gmax, x); }
        const float m0 = p.in[6][sidx];
        const float Mt = fmaxf(m0, gmax), bL = shi(bs, 7), a = bL - bs + ig;
        float amax = -INFINITY;
        for (int u = 0; u < 8; ++u) amax = fmaxf(amax, shi(a, u));
        const float mnew = fmaxf(bL + m0, amax);
        if (lane < 8) { sc[t] = d; sc[8 + t] = Mt; sc[16 + t] = __expf(m0 - Mt); sc[24 + t] = bs + Mt; sc[32 + t] = __expf(a - mnew); }
        if (lane == 0) { sc[56] = __expf(bL + m0 - mnew); sc[57] = mnew; }
    }
    __syncthreads();
    { const int pr = tid >> 3, part = tid & 7, t = pr >> 3, u = pr & 7; float dot = 0.f;
#pragma unroll
        for (int d = 0; d < 16; ++d) dot += qq[t * 128 + part * 16 + d] * kk[u * 128 + part * 16 + d];
        dot += shx(dot, 1); dot += shx(dot, 2); dot += shx(dot, 4);
        if (part == 0) S_l[pr] = (u <= t) ? dot * __expf(sc[u] - sc[8 + t]) : 0.f; }
    if (tid < 64) { const int t = tid >> 3, part = tid & 7; float dot = 0.f;
#pragma unroll
        for (int d = 0; d < 16; ++d) dot += qq[t * 128 + part * 16 + d] * n0[part * 16 + d];
        dot += shx(dot, 1); dot += shx(dot, 2); dot += shx(dot, 4);
        if (part == 0) sc[40 + t] = dot; }
    for (int idx = tid; idx < 1024; idx += NTHR) { const int dk = idx >> 3, t = idx & 7; qT[idx] = qq[t * 128 + dk]; kwT[idx] = kk[t * 128 + dk] * sc[32 + t]; }
    __syncthreads();
    if (tid < 8) { float rs = 0.f; for (int u = 0; u < 8; ++u) rs += S_l[tid * 8 + u];
        const float den = sc[16 + tid] * sc[40 + tid] + rs; sc[48 + tid] = fmaxf(fabsf(den), __expf(-sc[24 + tid])); }
    {
        const int e = tid & 127, g = tid >> 7; const float wc = sc[56];
        float vr[8], acc[8];
#pragma unroll
        for (int u = 0; u < 8; ++u) { vr[u] = vv[u * 128 + e]; acc[u] = 0.f; }
        const float* Cin = p.in[4] + sidx * 16384; float* Cout = p.out + O_SC + sidx * 16384;
        float cin[32];
#pragma unroll
        for (int k = 0; k < 32; ++k) cin[k] = Cin[(g * 32 + k) * 128 + e];
#pragma unroll
        for (int k = 0; k < 32; ++k) { const int dk = g * 32 + k; const float cv = cin[k];
            const f32x4 q0 = *(const f32x4*)(qT + dk * 8), q1 = *(const f32x4*)(qT + dk * 8 + 4), k0 = *(const f32x4*)(kwT + dk * 8), k1 = *(const f32x4*)(kwT + dk * 8 + 4);
            acc[0] += q0.x * cv; acc[1] += q0.y * cv; acc[2] += q0.z * cv; acc[3] += q0.w * cv; acc[4] += q1.x * cv; acc[5] += q1.y * cv; acc[6] += q1.z * cv; acc[7] += q1.w * cv;
            float cn = wc * cv;
            cn += k0.x * vr[0] + k0.y * vr[1] + k0.z * vr[2] + k0.w * vr[3] + k1.x * vr[4] + k1.y * vr[5] + k1.z * vr[6] + k1.w * vr[7];
            Cout[dk * 128 + e] = cn; }
#pragma unroll
        for (int u = 0; u < 8; ++u) part[(g * 8 + u) * 128 + e] = acc[u];
        if (tid < 128) { float nn = wc * n0[tid];
#pragma unroll
            for (int u = 0; u < 8; ++u) nn += kwT[tid * 8 + u];
            p.out[O_SN + sidx * 128 + tid] = nn; }
        if (tid == 0) p.out[O_SM + sidx] = sc[57];
    }
    __syncthreads();
    {
        const int t = wave; float hv[2];
        const unsigned zo = *(const unsigned*)(Z + (size_t)(r0 + t) * ZW + 1536 + h * 128 + 2 * lane); const f32x2 on = *(const f32x2*)(p.in[17] + i * 512 + h * 128 + 2 * lane);
#pragma unroll
        for (int k = 0; k < 2; ++k) { const int e = 2 * lane + k;
            float num = (part[(0 * 8 + t) * 128 + e] + part[(1 * 8 + t) * 128 + e]) + (part[(2 * 8 + t) * 128 + e] + part[(3 * 8 + t) * 128 + e]);
            num *= sc[16 + t];
#pragma unroll
            for (int u = 0; u < 8; ++u) num += S_l[t * 8 + u] * vv[u * 128 + e];
            hv[k] = num / sc[48 + t]; }
        head_out(p, i, h, r0 + t, lane, hv[0], hv[1], zo, on);
    }
    __syncthreads();
}

__device__ __forceinline__ void unpack8(const u32x4 w, float (&v)[8]) { v[0] = bflo(w.x); v[1] = bfhi(w.x); v[2] = bflo(w.y); v[3] = bfhi(w.y); v[4] = bflo(w.z); v[5] = bfhi(w.z); v[6] = bflo(w.w); v[7] = bfhi(w.w); }
__device__ __forceinline__ void ld8f(const float* s, float (&v)[8]) { const f32x4 a = *(const f32x4*)s, b = *(const f32x4*)(s + 4); v[0] = a.x; v[1] = a.y; v[2] = a.z; v[3] = a.w; v[4] = b.x; v[5] = b.y; v[6] = b.z; v[7] = b.w; }
__device__ __forceinline__ void st8f(float* d, const float (&v)[8]) { *(f32x4*)d = (f32x4){v[0], v[1], v[2], v[3]}; *(f32x4*)(d + 4) = (f32x4){v[4], v[5], v[6], v[7]}; }
__device__ __forceinline__ void shortconv(const Params& p, int i) {
    const bf16* Z = (const bf16*)(p.ws + WS_ZU); bf16* CAT = (bf16*)(p.ws + WS_CAT);
    const float* cw = p.in[18] + i * 3 * 512;
    float cw0[8], cw1[8], cw2[8]; int chc = -1;
    for (int idx = obid() * NTHR + otid(); idx < R * 64; idx += gridDim.x * NTHR) {
        const int row = idx >> 6, ch = (idx & 63) * 8;
        if (ch != chc) { chc = ch; ld8f(cw + ch, cw0); ld8f(cw + 512 + ch, cw1); ld8f(cw + 1024 + ch, cw2); }
        const bool prm = row < RP; const int t = prm ? (row & (SEQL - 1)) : ((row - RP) & 7), S = prm ? SEQL : 8, sq = prm ? (row >> 13) : ((row - RP) >> 3);
        float pr[3][8];
#pragma unroll
        for (int j = 0; j < 3; ++j) { const int tt = t - 2 + j;
            if (tt >= 0) { const bf16* zr = Z + (size_t)(row - 2 + j) * ZW; const u32x4 a = *(const u32x4*)(zr + 2560 + ch), b = *(const u32x4*)(zr + 3072 + ch);
                pr[j][0] = bflo(a.x) * bflo(b.x); pr[j][1] = bfhi(a.x) * bfhi(b.x); pr[j][2] = bflo(a.y) * bflo(b.y); pr[j][3] = bfhi(a.y) * bfhi(b.y);
                pr[j][4] = bflo(a.z) * bflo(b.z); pr[j][5] = bfhi(a.z) * bfhi(b.z); pr[j][6] = bflo(a.w) * bflo(b.w); pr[j][7] = bfhi(a.w) * bfhi(b.w); }
            else if (!prm) { const float* st = p.in[7] + ((size_t)(i * 128 + sq) * 2 + (2 + tt)) * 512 + ch; const f32x4 a = *(const f32x4*)st, b = *(const f32x4*)(st + 4);
                pr[j][0] = a.x; pr[j][1] = a.y; pr[j][2] = a.z; pr[j][3] = a.w; pr[j][4] = b.x; pr[j][5] = b.y; pr[j][6] = b.z; pr[j][7] = b.w; }
            else {
#pragma unroll
                for (int e = 0; e < 8; ++e) pr[j][e] = 0.f; } }
        const u32x4 zb = *(const u32x4*)(Z + (size_t)row * ZW + 2048 + ch);
        float zbf[8] = {bflo(zb.x), bfhi(zb.x), bflo(zb.y), bfhi(zb.y), bflo(zb.z), bfhi(zb.z), bflo(zb.w), bfhi(zb.w)};
        float o[8];
#pragma unroll
        for (int e = 0; e < 8; ++e) o[e] = zbf[e] * (cw0[e] * pr[0][e] + cw1[e] * pr[1][e] + cw2[e] * pr[2][e]);
        *(u32x4*)(CAT + (size_t)row * DM + 512 + ch) = (u32x4){pk2(o[0], o[1]), pk2(o[2], o[3]), pk2(o[4], o[5]), pk2(o[6], o[7])};
        if (t >= S - 2) { float* dst = p.out + (prm ? O_PSC + ((size_t)(i * 2 + sq) * 2 + (t - (S - 2))) * 512 : O_SSC + ((size_t)(i * 128 + sq) * 2 + (t - (S - 2))) * 512) + ch;
            *(f32x4*)dst = (f32x4){pr[2][0], pr[2][1], pr[2][2], pr[2][3]}; *(f32x4*)(dst + 4) = (f32x4){pr[2][4], pr[2][5], pr[2][6], pr[2][7]}; }
    }
}


__device__ __forceinline__ void cache_shift(const Params& p, int jl, int bsel, int nsel) {
    const int tid = otid();
    for (int idx = bsel * NTHR + tid; idx < 2 * 128 * 7680; idx += nsel * NTHR) { const int kv = idx / (128 * 7680), r = idx - kv * (128 * 7680), s = r / 7680, q = r - s * 7680;
        const float* src = (kv ? p.in[9] : p.in[8]) + ((size_t)(jl * 128 + s) * 128 + 8) * 256 + 4 * q; float* dst = p.out + (kv ? O_SWV : O_SWK) + ((size_t)(jl * 128 + s) * 128) * 256 + 4 * q;
        *(f32x4*)dst = *(const f32x4*)src; }
}

template <int NH>
__device__ __forceinline__ void attn_wave(const bf16* K_l, const bf16* Vt_l, int ldvt, int kt0, const bf16x8 (*Bq)[2], int qidx, int kmin, const float* sinkp, bf16* orow, bool store, int fr, int fq) {
    f32x4 s[NH][9];
    float sk[NH], mx[NH];
#pragma unroll
    for (int h = 0; h < NH; ++h) { sk[h] = sinkp[h] * 1.4426950408889634f; mx[h] = sk[h]; }
#pragma unroll
    for (int kt = 0; kt < 9; ++kt) {
        const bf16x8 A0 = *(const bf16x8*)(K_l + (16 * (kt0 + kt) + fr) * 72 + 8 * fq), A1 = *(const bf16x8*)(K_l + (16 * (kt0 + kt) + fr) * 72 + 32 + 8 * fq);
#pragma unroll
        for (int h = 0; h < NH; ++h) { f32x4 a = (f32x4){0.f, 0.f, 0.f, 0.f};
            a = __builtin_amdgcn_mfma_f32_16x16x32_bf16(A0, Bq[h][0], a, 0, 0, 0); a = __builtin_amdgcn_mfma_f32_16x16x32_bf16(A1, Bq[h][1], a, 0, 0, 0);
#pragma unroll
            for (int j = 0; j < 4; ++j) { const int kidx = 16 * (kt0 + kt) + 4 * fq + j;
                const bool valid = (kt == 0) ? ((kidx > qidx - 128) && (kidx >= kmin)) : (kt == 8) ? (kidx <= qidx) : (kidx >= kmin);
                a[j] = valid ? a[j] * 0.18033688011112042f : -INFINITY; mx[h] = fmaxf(mx[h], a[j]); }
            s[h][kt] = a; } }
    float inv[NH];
#pragma unroll
    for (int h = 0; h < NH; ++h) { mx[h] = fmaxf(mx[h], shx(mx[h], 16)); mx[h] = fmaxf(mx[h], shx(mx[h], 32)); }
#pragma unroll
    for (int h = 0; h < NH; ++h) { float sum = 0.f;
#pragma unroll
        for (int kt = 0; kt < 9; ++kt)
#pragma unroll
            for (int j = 0; j < 4; ++j) { const float e = __builtin_amdgcn_exp2f(s[h][kt][j] - mx[h]); s[h][kt][j] = e; sum += e; }
        inv[h] = sum; }
#pragma unroll
    for (int h = 0; h < NH; ++h) { float sum = inv[h]; sum += shx(sum, 16); sum += shx(sum, 32); inv[h] = __builtin_amdgcn_rcpf(sum + __builtin_amdgcn_exp2f(sk[h] - mx[h])); }
    bf16x8 Bp[NH][5];
#pragma unroll
    for (int h = 0; h < NH; ++h)
#pragma unroll
        for (int pp = 0; pp < 5; ++pp) { u32x4 w; w.x = pk2(s[h][2 * pp][0], s[h][2 * pp][1]); w.y = pk2(s[h][2 * pp][2], s[h][2 * pp][3]);
            if (pp < 4) { w.z = pk2(s[h][2 * pp + 1][0], s[h][2 * pp + 1][1]); w.w = pk2(s[h][2 * pp + 1][2], s[h][2 * pp + 1][3]); } else { w.z = 0u; w.w = 0u; }
            Bp[h][pp] = __builtin_bit_cast(bf16x8, w); }
#pragma unroll
    for (int dt = 0; dt < 4; ++dt) { f32x4 a[NH];
#pragma unroll
        for (int h = 0; h < NH; ++h) a[h] = (f32x4){0.f, 0.f, 0.f, 0.f};
#pragma unroll
        for (int pp = 0; pp < 5; ++pp) { const bf16* vp = Vt_l + (16 * dt + fr) * ldvt + 16 * (kt0 + 2 * pp) + 4 * fq;
            const u32x2 lo = *(const u32x2*)vp, hi = *(const u32x2*)(vp + 16); const bf16x8 V = __builtin_bit_cast(bf16x8, (u32x4){lo.x, lo.y, hi.x, hi.y});
#pragma unroll
            for (int h = 0; h < NH; ++h) a[h] = __builtin_amdgcn_mfma_f32_16x16x32_bf16(V, Bp[h][pp], a[h], 0, 0, 0); }
        if (store) {
#pragma unroll
            for (int h = 0; h < NH; ++h) *(u32x2*)(orow + 64 * h + 16 * dt + 4 * fq) = (u32x2){pk2(a[h][0] * inv[h], a[h][1] * inv[h]), pk2(a[h][2] * inv[h], a[h][3] * inv[h])}; } }
}

__device__ __forceinline__ void attn_phase(const Params& p, int jl, unsigned char* smem) {
    const bf16* Z = (const bf16*)(p.ws + WS_ZU); bf16* CAT = (bf16*)(p.ws + WS_CAT);
    const float* sinkp = p.in[23] + jl * 16;
    for (int u = obid(); u < 768; u += gridDim.x) { const int tidu = otid(), lane = tidu & 63, wave = tidu >> 6, fr = lane & 15, fq = lane >> 4;
        if (u < 512) {
            const int b = u >> 8, kvh = (u >> 6) & 3, qb = u & 63, q0 = qb * 128, rb = b * SEQL;
            bf16x8 Bq[4][2];
            { const bf16* qp = Z + (size_t)(rb + q0 + 16 * wave + fr) * QKVW + kvh * 256 + 8 * fq;
#pragma unroll
              for (int hq = 0; hq < 4; ++hq) { Bq[hq][0] = *(const bf16x8*)(qp + hq * 64); Bq[hq][1] = *(const bf16x8*)(qp + hq * 64 + 32); } }
            bf16* K_l = (bf16*)smem;
            bf16* Vt_l = K_l + 256 * 72;
            { u32x4 wv[8];
#pragma unroll
              for (int it = 0; it < 8; ++it) { const int q = tidu + it * NTHR, which = q >> 11, idx = q & 2047, kidx = which ? (idx & 255) : (idx >> 3), ch = which ? (idx >> 8) : (idx & 7); const int pos = q0 - 128 + kidx;
                wv[it] = (u32x4){0u, 0u, 0u, 0u};
                if (pos >= 0) wv[it] = *(const u32x4*)(Z + (size_t)(rb + pos) * QKVW + (which ? 1280 : 1024) + kvh * 64 + ch * 8); }
#pragma unroll
              for (int it = 0; it < 8; ++it) { const int q = tidu + it * NTHR, which = q >> 11, idx = q & 2047, kidx = which ? (idx & 255) : (idx >> 3), ch = which ? (idx >> 8) : (idx & 7); const u32x4 w = wv[it];
                if (!which) *(u32x4*)(K_l + kidx * 72 + ch * 8) = w;
                else { bf16* dst = Vt_l + (ch * 8) * 296 + kidx;
                    dst[0 * 296] = (bf16)(w.x & 0xffff); dst[1 * 296] = (bf16)(w.x >> 16); dst[2 * 296] = (bf16)(w.y & 0xffff); dst[3 * 296] = (bf16)(w.y >> 16);
                    dst[4 * 296] = (bf16)(w.z & 0xffff); dst[5 * 296] = (bf16)(w.z >> 16); dst[6 * 296] = (bf16)(w.w & 0xffff); dst[7 * 296] = (bf16)(w.w >> 16); } } }
            for (int q = tidu; q < 64 * 32; q += NTHR) Vt_l[(q >> 5) * 296 + 256 + (q & 31)] = 0;
            __syncthreads();
            const int row = rb + q0 + 16 * wave + fr;
#pragma unroll
            for (int hg = 0; hg < 2; ++hg) { const int h = kvh * 4 + 2 * hg;
                attn_wave<2>(K_l, Vt_l, 296, wave, Bq + 2 * hg, 128 + 16 * wave + fr, qb == 0 ? 128 : 0, sinkp + h, CAT + (size_t)row * DM + h * 64, true, fr, fq); }
            __syncthreads();
        } else {
            const int us = u - 512, s = us >> 1, kvp = us & 1;
            bf16x8 Bq1[2];
            { const bf16* qp = Z + (size_t)(RP + 8 * s + (fr & 7)) * QKVW + (8 * kvp + wave) * 64 + 8 * fq; Bq1[0] = *(const bf16x8*)qp; Bq1[1] = *(const bf16x8*)(qp + 32); }
            bf16* K_l = (bf16*)smem;
            bf16* Vt_l = K_l + 2 * 144 * 72;
            { f32x4 va[9], vb[9];
              const float* ck = p.in[8] + ((size_t)(jl * 128 + s) * 128) * 256; const float* cv = p.in[9] + ((size_t)(jl * 128 + s) * 128) * 256;
#pragma unroll
              for (int it = 0; it < 9; ++it) { const int q = tidu + it * NTHR, which = q / 2304, r = q - which * 2304, kvl = r / 1152, r2 = r - kvl * 1152, kidx = which ? (r2 % 144) : (r2 >> 3), ch = which ? (r2 / 144) : (r2 & 7); const int kvh = 2 * kvp + kvl;
                va[it] = (f32x4){0.f, 0.f, 0.f, 0.f}; vb[it] = va[it];
                if (kidx < 128) { const float* src = (which ? cv : ck) + (size_t)kidx * 256 + kvh * 64 + ch * 8; va[it] = *(const f32x4*)src; vb[it] = *(const f32x4*)(src + 4); }
                else if (kidx < 136) { const u32x4 w = *(const u32x4*)(Z + (size_t)(RP + 8 * s + kidx - 128) * QKVW + (which ? 1280 : 1024) + kvh * 64 + ch * 8);
                    va[it] = (f32x4){bflo(w.x), bfhi(w.x), bflo(w.y), bfhi(w.y)}; vb[it] = (f32x4){bflo(w.z), bfhi(w.z), bflo(w.w), bfhi(w.w)}; } }
#pragma unroll
              for (int it = 0; it < 9; ++it) { const int q = tidu + it * NTHR, which = q / 2304, r = q - which * 2304, kvl = r / 1152, r2 = r - kvl * 1152, kidx = which ? (r2 % 144) : (r2 >> 3), ch = which ? (r2 / 144) : (r2 & 7);
                const f32x4 a = va[it], c = vb[it];
                if (!which) *(u32x4*)(K_l + (kvl * 144 + kidx) * 72 + ch * 8) = (u32x4){pk2(a[0], a[1]), pk2(a[2], a[3]), pk2(c[0], c[1]), pk2(c[2], c[3])};
                else { bf16* dst = Vt_l + (kvl * 64 + ch * 8) * 168 + kidx; const unsigned p0 = pk2(a[0], a[1]), p1 = pk2(a[2], a[3]), p2 = pk2(c[0], c[1]), p3 = pk2(c[2], c[3]);
                    dst[0 * 168] = (bf16)(p0 & 0xffff); dst[1 * 168] = (bf16)(p0 >> 16); dst[2 * 168] = (bf16)(p1 & 0xffff); dst[3 * 168] = (bf16)(p1 >> 16);
                    dst[4 * 168] = (bf16)(p2 & 0xffff); dst[5 * 168] = (bf16)(p2 >> 16); dst[6 * 168] = (bf16)(p3 & 0xffff); dst[7 * 168] = (bf16)(p3 >> 16); } } }
            for (int q = tidu; q < 2 * 64 * 16; q += NTHR) Vt_l[(q >> 4) * 168 + 144 + (q & 15)] = 0;
            __syncthreads();
            const int kvl = wave >> 2, h = 8 * kvp + wave, row = RP + 8 * s + (fr & 7);
            attn_wave<1>(K_l + kvl * 144 * 72, Vt_l + kvl * 64 * 168, 168, 0, &Bq1, 128 + (fr & 7), 0, sinkp + h, CAT + (size_t)row * DM + h * 64, fr < 8, fr, fq);
            __syncthreads();
        }
    }
}

__device__ __forceinline__ void ffnfix_phase(const Params& p, int l) {
    const bf16* UB = (const bf16*)(p.ws + WS_UB); bf16* ACT = (bf16*)(p.ws + WS_ACT);
    const float* cw = p.in[26] + (size_t)l * 3 * FF2;
    for (int idx = obid() * NTHR + otid(); idx < 256 * 352; idx += gridDim.x * NTHR) {
        const int hr = idx / 352, cc = idx - hr * 352, col = cc * 8, hh = hr >> 1, rr = hr & 1;
        const bool seqstart = (hh & 63) == 0;
        const bf16* own0 = UB + (size_t)(hh * 4 + 0) * FF2; const bf16* own1 = UB + (size_t)(hh * 4 + 1) * FF2;
        const bf16* pm2 = UB + (size_t)((hh - 1) * 4 + 2) * FF2; const bf16* pm1 = UB + (size_t)((hh - 1) * 4 + 3) * FF2;
        float g2[8], g1[8], g0[8], a2[8], a1[8], a0[8];
        if (rr == 0) {
            if (seqstart) {
#pragma unroll
                for (int e = 0; e < 8; ++e) { g2[e] = 0.f; g1[e] = 0.f; a2[e] = 0.f; a1[e] = 0.f; } }
            else { unpack8(*(const u32x4*)(pm2 + col), g2); unpack8(*(const u32x4*)(pm2 + FF + col), a2); unpack8(*(const u32x4*)(pm1 + col), g1); unpack8(*(const u32x4*)(pm1 + FF + col), a1); }
            unpack8(*(const u32x4*)(own0 + col), g0); unpack8(*(const u32x4*)(own0 + FF + col), a0);
        } else {
            if (seqstart) {
#pragma unroll
                for (int e = 0; e < 8; ++e) { g2[e] = 0.f; a2[e] = 0.f; } }
            else { unpack8(*(const u32x4*)(pm1 + col), g2); unpack8(*(const u32x4*)(pm1 + FF + col), a2); }
            unpack8(*(const u32x4*)(own0 + col), g1); unpack8(*(const u32x4*)(own0 + FF + col), a1);
            unpack8(*(const u32x4*)(own1 + col), g0); unpack8(*(const u32x4*)(own1 + FF + col), a0);
        }
        float wg[3][8], wa[3][8];
#pragma unroll
        for (int j = 0; j < 3; ++j) { ld8f(cw + j * FF2 + col, wg[j]); ld8f(cw + j * FF2 + FF + col, wa[j]); }
        float o[8];
#pragma unroll
        for (int e = 0; e < 8; ++e) { const float cgv = wg[0][e] * g2[e] + wg[1][e] * g1[e] + wg[2][e] * g0[e], cav = wa[0][e] * a2[e] + wa[1][e] * a1[e] + wa[2][e] * a0[e]; o[e] = cgv * sigmoidf_(cgv) * cav; }
        *(u32x4*)(ACT + (size_t)(hh * 128 + rr) * FF + col) = (u32x4){pk2(o[0], o[1]), pk2(o[2], o[3]), pk2(o[4], o[5]), pk2(o[6], o[7])};
    }
    for (int idx = obid() * NTHR + otid(); idx < 4 * (FF2 / 8); idx += gridDim.x * NTHR) { const int br = idx / (FF2 / 8), c = (idx - br * (FF2 / 8)) * 8, b = br >> 1, r = br & 1;
        float v[8]; unpack8(*(const u32x4*)(UB + (size_t)((64 * b + 63) * 4 + 2 + r) * FF2 + c), v);
        st8f(p.out + O_PFFN + ((size_t)(l * 2 + b) * 2 + r) * FF2 + c, v); }
}

#define XB_TMO      128
#define XB_XCNT(j)  (256  + 64 * (j))
#define XB_XSUB(j)  (1280 + 64 * (j))
#define XB_XGEN(j)  (2304 + 64 * (j))
#define XB_TOP      3328
#define XB_TOPGEN   3392
#define XCD_BAR_WORDS 3456
#define XB_SPIN_CAP (1u << 18)

__device__ __forceinline__ unsigned xb_ld(unsigned* p)              { return __hip_atomic_load(p, __ATOMIC_RELAXED, __HIP_MEMORY_SCOPE_AGENT); }
__device__ __forceinline__ unsigned xb_add(unsigned* p, unsigned v) { return __hip_atomic_fetch_add(p, v, __ATOMIC_RELAXED, __HIP_MEMORY_SCOPE_AGENT); }
__device__ __forceinline__ unsigned xb_xcc_id() { return (unsigned)__builtin_amdgcn_s_getreg((3 << 11) | 20) & 0xFu; }
#define XB_SPIN(cond, bar) do { unsigned _sp = 0; while (cond) { __builtin_amdgcn_s_sleep(1); \
    if ((++_sp & 255u) == 0u) { if (xb_ld(&(bar)[XB_TMO])) break; if (_sp > XB_SPIN_CAP) { atomicAdd(&(bar)[XB_TMO], 1u); break; } } } } while (0)

struct XcdBarrier {
    unsigned* bar; unsigned x;
    volatile LAS unsigned* st;
};

__device__ __forceinline__ XcdBarrier xcd_barrier_post(unsigned* bar, volatile LAS unsigned* st) {
    XcdBarrier b; b.bar = bar; b.x = xb_xcc_id(); b.st = st;
    if (threadIdx.x == 0) (void)xb_add(&bar[XB_XCNT(b.x)], 1u);
    return b;
}
__device__ __forceinline__ void xcd_barrier_complete(unsigned* bar, unsigned x, unsigned& nloc, unsigned& nx) {
    const unsigned G = gridDim.x * gridDim.y * gridDim.z;
    unsigned sum, cnt, mine, sp = 0u;
    for (;;) {
        sum = 0u; cnt = 0u; mine = 0u;
#pragma unroll
        for (unsigned j = 0; j < 16; ++j) { const unsigned c = xb_ld(&bar[XB_XCNT(j)]); sum += c; cnt += (c > 0u) ? 1u : 0u; mine = (j == x) ? c : mine; }
        if (sum == G) break;
        __builtin_amdgcn_s_sleep(1);
        if ((++sp & 255u) == 0u) { if (xb_ld(&bar[XB_TMO])) break; if (sp > XB_SPIN_CAP) { atomicAdd(&bar[XB_TMO], 1u); break; } }
    }
    nloc = mine > 0u ? mine : 1u; nx = cnt > 0u ? cnt : 1u;
}

__device__ __forceinline__ void xcd_barrier(const XcdBarrier& b) {
    asm volatile("s_waitcnt vmcnt(0)" ::: "memory");
    __syncthreads();
    if (threadIdx.x == 0) {
        unsigned* bar = b.bar;
        __builtin_amdgcn_s_waitcnt(0);
        unsigned nloc = b.st[0], nx = b.st[1];
        if (nloc == 0u) { xcd_barrier_complete(bar, b.x, nloc, nx); b.st[0] = nloc; b.st[1] = nx; }
        const unsigned old = xb_add(&bar[XB_XSUB(b.x)], 1u);
        const unsigned gen = old / nloc;
        if (old + 1u == (gen + 1u) * nloc) {
            __builtin_amdgcn_fence(__ATOMIC_RELEASE, "agent");
            asm volatile("s_waitcnt vmcnt(0)" ::: "memory");
            const unsigned og = xb_add(&bar[XB_TOP], 1u);
            const unsigned tg = og / nx;
            if (og + 1u == (tg + 1u) * nx) xb_add(&bar[XB_TOPGEN], 1u);
            else XB_SPIN(xb_ld(&bar[XB_TOPGEN]) == tg, bar);
            __builtin_amdgcn_fence(__ATOMIC_ACQUIRE, "agent");
            xb_add(&bar[XB_XGEN(b.x)], 1u);
            asm volatile("s_waitcnt vmcnt(0)" ::: "memory");
        } else {
            XB_SPIN(xb_ld(&bar[XB_XGEN(b.x)]) == gen, bar);
            __builtin_amdgcn_fence(__ATOMIC_ACQUIRE, "agent");
            asm volatile("s_waitcnt vmcnt(0)" ::: "memory");
        }
    }
    __syncthreads();
}

__global__ void __launch_bounds__(NTHR, 2) mega(Params p) {
    extern __shared__ __attribute__((aligned(16))) unsigned char lds[];
    cg::grid_group grid = cg::this_grid();
    unsigned char* ws = p.ws;
    volatile LAS unsigned* bst = (volatile LAS unsigned*)((LAS unsigned char*)lds + 147392);
    if (threadIdx.x < 2) bst[threadIdx.x] = 0u;
    __syncthreads();
    XcdBarrier bar; bar.bar = (unsigned*)ws; bar.x = 0; bar.st = bst;
    if (p.hi - p.lo > 1) bar = xcd_barrier_post((unsigned*)ws, bst);
    for (int step = p.lo; step < p.hi; ++step) {
        int nrep = 1; bool skip = false;
        if (step == 0) nrep += (PROBE_PRE & 1); else if (step == 1) nrep += (PROBE_PRE >> 1) & 1; else { const int l_ = (step - 2) / 10, st_ = (step - 2) % 10; nrep += (((l_ & 1) ? PROBE_ODD : PROBE_EVEN) >> st_) & 1; }
        for (int rep = 0; rep < nrep; ++rep) {
            if (PROBE_BAR == 2 && rep > 0) xcd_barrier(bar);
        if (step == 0) prologue(p, lds);
        else if (step == 1) {
            pg8::Gemm g{(const pg8::bf16_t*)(ws + WS_AC), (const pg8::bf16_t*)(ws + WS_ZU), 256, MODW, DM}; pg8::StaticOrder S; S.init(256, MODW, gridDim.x, obid());
            EpiMod E{(float*)(ws + WS_MOD), p.in[14]};
            pg8::gemm_phase<EpiMod, pg8::StaticOrder, true, true>((PG8_LAS unsigned char*)lds, g, S, E);
        } else {
            const int l = (step - 2) / 10, st = (step - 2) % 10; const bool even = !(l & 1); const int i = l >> 1;
            if (st == 0) norm_phase(p, l, 1, lds);
            else if (st == 6) norm_phase(p, l, 2, lds);
            else if (st == 1 || st == 5 || st == 7 || st == 9) {
                pg8::Gemm g; EpiMain E; E.X = p.out; E.O = (bf16*)(ws + WS_ZU); E.gate = nullptr; E.ldc = 0; E.mode = 0; E.cw = nullptr; E.stp = nullptr; E.sout = nullptr; E.qn = nullptr; E.kn = nullptr; E.lyr = i; E.wsb = ws;
                if (st == 1) { g.A = (const pg8::bf16_t*)(ws + WS_H); g.M = R; g.K = DM;
                    if (even) { g.Bt = (const pg8::bf16_t*)(ws + WS_WIN) + (size_t)i * ZW * DM; g.N = ZW; E.ldc = ZW; } else { g.Bt = (const pg8::bf16_t*)(ws + WS_WQKV) + (size_t)i * QKVW * DM; g.N = QKVW; E.ldc = QKVW; E.mode = 3;
                        E.qn = p.in[21] + i * 64; E.kn = p.in[22] + i * 64; } }
                else if (st == 5) { g.A = (const pg8::bf16_t*)(ws + WS_CAT); g.M = RP; g.K = DM; g.N = DM; g.Bt = (const pg8::bf16_t*)(ws + (even ? WS_WAO : WS_WCO)) + (size_t)i * DM * DM;
                    E.mode = 1; E.gate = (const float*)(ws + WS_MOD) + l * 6144 + 2048; }
                else if (st == 7) { g.A = (const pg8::bf16_t*)(ws + WS_H); g.M = R; g.K = DM; g.N = FF2; g.Bt = (const pg8::bf16_t*)(ws + WS_WUP) + (size_t)l * FF2 * DM; E.mode = 2;
                    E.cw = p.in[26] + (size_t)l * 3 * FF2; E.stp = p.in[10] + (size_t)l * 128 * 2 * FF2; E.sout = p.out + O_SFFN + (size_t)l * 128 * 2 * FF2; }
                else { g.A = (const pg8::bf16_t*)(ws + WS_ACT); g.M = RP; g.K = FF; g.N = DM; g.Bt = (const pg8::bf16_t*)(ws + WS_WDN) + (size_t)l * DM * FF; E.mode = 1; E.gate = (const float*)(ws + WS_MOD) + l * 6144 + 5120; }
                if (rep > 0 && E.mode == 1) { E.mode = 0; E.O = (bf16*)(ws + WS_H); E.ldc = DM; }
                if (rep > 0 && E.mode == 1) { E.mode = 0; E.O = (bf16*)(ws + WS_H); E.ldc = DM; }
                pg8::StaticOrder S; S.init(g.M, g.N, gridDim.x, obid());
                pg8::gemm_phase<EpiMain, pg8::StaticOrder, true, true>((PG8_LAS unsigned char*)lds, g, S, E);
                if (E.mode == 3 && rep == 0) { const int G_ = gridDim.x, n2 = S.nwg - G_;
                    if (n2 > 0 && n2 < G_) { if (obid() >= n2) cache_shift(p, i, obid() - n2, G_ - n2); } else cache_shift(p, i, obid(), G_); }
                if (E.mode == 1) mini_gemm((const bf16*)g.A, (const bf16*)g.Bt, g.K, p.out, E.gate, lds);
            }
            else if (st == 2) {
                if (even) { const int G_ = gridDim.x; int il = obid(), is = obid();
                    for (int k = 0; il < 1024 || is < 512; ++k) { const bool do_s = (is < 512) && ((k & 1) || il >= 1024);
                        if (do_s) { mlstm_sample(p, i, is, lds); is += G_; } else { mlstm_local(p, i, il, lds); il += G_; } }
                    shortconv(p, i); }
                else { skip = true; continue; }
            }
            else if (st == 3) { if (even) mlstm_scan(p, i, lds); else attn_phase(p, i, lds); }
            else if (st == 4) { if (!even) { skip = true; continue; } for (int it = obid(); it < 1024; it += 2 * gridDim.x) mlstm_out2(p, i, it, it + gridDim.x, lds); }
            else if (st == 8) ffnfix_phase(p, l);
        }
        }
        if (skip) continue;
        if (step + 1 < p.hi) { if (step == 0) grid.sync(); else { xcd_barrier(bar); if (PROBE_BAR == 1) xcd_barrier(bar); } }
    }
}

#ifndef NLAUNCH_MODE
#define NLAUNCH_MODE 1
#endif
extern "C" void kernel_launch(void* const* d_in, const int* in_sizes, int n_in, void* d_out, int out_size, void* d_ws, size_t ws_size, hipStream_t stream) {
    static int grid = 0;
    if (grid == 0) {
        if (n_in != 28 || (size_t)out_size != O_END || ws_size < WS_END) { fprintf(stderr, "kernel_launch: unexpected shapes: n_in %d out %d ws %zu\n", n_in, out_size, ws_size); grid = -1; return; }
        int dev = 0, cus = 0, per_cu = 0;
        hipGetDevice(&dev); hipDeviceGetAttribute(&cus, hipDeviceAttributeMultiprocessorCount, dev);
        if (hipFuncSetAttribute((const void*)mega, hipFuncAttributeMaxDynamicSharedMemorySize, LDS_BYTES) != hipSuccess) { fprintf(stderr, "kernel_launch: hipFuncSetAttribute failed\n"); grid = -1; return; }
        if (hipOccupancyMaxActiveBlocksPerMultiprocessor(&per_cu, (const void*)mega, NTHR, LDS_BYTES) != hipSuccess || per_cu < 1) { fprintf(stderr, "kernel_launch: occupancy query says %d\n", per_cu); per_cu = 1; }
        (void)hipGetLastError();
        grid = cus * 1;
    }
    if (grid < 0) return;
    Params p{};
    for (int k = 0; k < 28; ++k) p.in[k] = (const float*)d_in[k];
    p.out = (float*)d_out; p.ws = (unsigned char*)d_ws;
    const int NSTEPS = 42;
    if (hipMemsetAsync(d_ws, 0, 16384, stream) != hipSuccess) { fprintf(stderr, "memset failed\n"); return; }
#if NLAUNCH_MODE == 1
    p.lo = 0; p.hi = NSTEPS;
    void* args[] = {&p};
    hipError_t e = hipLaunchCooperativeKernel((const void*)mega, dim3(grid), dim3(NTHR), args, LDS_BYTES, stream);
    if (e != hipSuccess) fprintf(stderr, "cooperative launch failed: %s (grid %d)\n", hipGetErrorString(e), grid);
#else
    for (int s = 0; s < NSTEPS; ++s) { if (s >= 2 && ((s - 2) % 10) == 4 && (((s - 2) / 10) & 1)) continue; p.lo = s; p.hi = s + 1; hipLaunchKernelGGL(mega, dim3(grid), dim3(NTHR), LDS_BYTES, stream, p); }
#endif
}
```

```cpp
#include <hip/hip_runtime.h>
#include <hip/hip_cooperative_groups.h>
#include <cstdio>
#include <cstdint>
namespace cg = cooperative_groups;
__device__ __forceinline__ int otid() { int t = threadIdx.x; asm volatile("" : "+v"(t)); return t; }
__device__ __forceinline__ int obid() { int b = blockIdx.x; asm volatile("" : "+s"(b)); return b; }
__device__ __forceinline__ float shx(float v, int o) { const int l = otid() & 63; return __builtin_bit_cast(float, __builtin_amdgcn_ds_bpermute((l ^ o) << 2, __builtin_bit_cast(int, v))); }
__device__ __forceinline__ float shi(float v, int src) { return __builtin_bit_cast(float, __builtin_amdgcn_ds_bpermute(src << 2, __builtin_bit_cast(int, v))); }
__device__ __forceinline__ float shup(float v, int o) { const int l = otid() & 63; const int src = l >= o ? l - o : l; return __builtin_bit_cast(float, __builtin_amdgcn_ds_bpermute(src << 2, __builtin_bit_cast(int, v))); }
namespace pg8 {
#define PG8_LAS __attribute__((address_space(3)))
typedef unsigned short bf16_t;
typedef short bf16x8 __attribute__((ext_vector_type(8)));
typedef float f32x4 __attribute__((ext_vector_type(4)));
typedef unsigned u32x4 __attribute__((ext_vector_type(4)));
constexpr int BM = 256, BK = 64, HALF = 128, HTB = HALF * BK * 2  , STAGE_BYTES = 8 * HTB, NXCD = 8, WGM = 8;

__host__ __device__ __forceinline__ int lds_byte(int r, int c) { const int st = (r >> 4) * 2 + (c >> 5), rr = r & 15, cc = c & 31, ob = rr * 64 + cc * 2; return st * 1024 + (ob ^ (((ob >> 9) & 1) << 5)); }
__host__ __device__ __forceinline__ void stage_rc(int b, int& R, int& C) { const int st = b / 1024, sb = b % 1024, swz = sb ^ (((sb >> 9) & 1) << 5); R = (st >> 1) * 16 + swz / 64; C = (st & 1) * 32 + (swz % 64) / 2; }
__host__ __device__ __forceinline__ int perm32(int rho) { const int n = rho >> 4, i = rho & 15; return 8 * (i >> 2) + 4 * n + (i & 3); }

struct Unit { int pm, pn; };
struct Gemm { const bf16_t* A; const bf16_t* Bt; int M, N, K; };

struct StaticOrder {
    int nM, nN, nwg, G, c;
    __host__ __device__ void init(int M, int N, int G_, int c_) { nM = M / BM; nN = N / BM; nwg = nM * nN; G = G_; c = c_; }
    __host__ __device__ bool next(int i, Unit& u) const {
        const long L = (long)i * G + c; if (L >= nwg) return false;
        int wgid = (int)L; { const int q = nwg / NXCD, r = nwg % NXCD, xcd = wgid % NXCD, off = wgid / NXCD; wgid = (xcd < r ? xcd * (q + 1) : r * (q + 1) + (xcd - r) * q) + off; }
        const int nig = WGM * nN, gid = wgid / nig, fm = gid * WGM, gsz = (nM - fm) < WGM ? (nM - fm) : WGM;
        u.pm = fm + ((wgid % nig) % gsz); u.pn = (wgid % nig) / gsz; return true;
    }
    __device__ __forceinline__ void a_ready(const Unit&) const {}
    __device__ __forceinline__ void done(const Unit&) const {}
};

__device__ __forceinline__ unsigned cvt_pk_bf16(float lo, float hi) { unsigned r; asm volatile("v_cvt_pk_bf16_f32 %0, %1, %2" : "=v"(r) : "v"(lo), "v"(hi)); return r; }
template <class Epi, class Sched, bool ALIGN_EPI = false, bool SP2 = false>
__device__ __forceinline__ void gemm_phase(PG8_LAS unsigned char* lds, const Gemm g, const Sched& S, const Epi& E) {
    const int tid = otid(), wid = __builtin_amdgcn_readfirstlane(tid >> 6), lane = tid & 63, wr = wid >> 2, wc = wid & 3, fr = lane & 15, fq = lane >> 4;
    const int K = g.K, nt = K / BK;
    unsigned voffA[2], voffB[2];
#pragma unroll
    for (int i = 0; i < 2; ++i) { int R, C; stage_rc(tid * 16 + i * 8192, R, C); const int Rb = Epi::PERM ? ((R & ~31) + perm32(R & 31)) : R;
        const int Ra = 8 * (16 * (R >> 6) + (R & 15)) + ((R >> 4) & 3);
        voffA[i] = (unsigned)(Ra * K + C) * 2u; voffB[i] = (unsigned)(Rb * K + C) * 2u; }
    const size_t kstep = (size_t)(BK * 2);
    const size_t hstep = (size_t)HALF * K * 2;
    const size_t hstepA = (size_t)4 * K * 2;
    const size_t tstep = 2 * hstep;
    const unsigned ldsw = (unsigned)wid * 1024u;
    const int aoff = lds_byte(wr * 64 + fr, fq * 8), boff = lds_byte(wc * 32 + fr, fq * 8);
#define PG8_SA(b, h) (((b) * 2 + (h)) * HTB)
#define PG8_SB(b, h) ((4 + (b) * 2 + (h)) * HTB)
#define PG8_STAGE(bufoff, gbase, voff) do { _Pragma("unroll") for (int _i = 0; _i < 2; ++_i) \
        __builtin_amdgcn_global_load_lds((const unsigned*)((const char*)(gbase) + (voff)[_i]), (PG8_LAS unsigned*)(lds + (bufoff) + ldsw + _i * 8192), 16, 0, 0); } while (0)
#define PG8_LDA(dst, b, h) do { _Pragma("unroll") for (int m = 0; m < 4; ++m) _Pragma("unroll") for (int k = 0; k < 2; ++k) dst[m][k] = *(const PG8_LAS bf16x8*)(lds + PG8_SA(b, h) + aoff + m * 2048 + k * 1024); } while (0)
#define PG8_LDB(dst, b, h) do { _Pragma("unroll") for (int n = 0; n < 2; ++n) _Pragma("unroll") for (int k = 0; k < 2; ++k) dst[n][k] = *(const PG8_LAS bf16x8*)(lds + PG8_SB(b, h) + boff + n * 2048 + k * 1024); } while (0)
#define PG8_MMA(ai, bj, At, Bt) do { __builtin_amdgcn_s_setprio(1); _Pragma("unroll") for (int m = 0; m < 4; ++m) _Pragma("unroll") for (int n = 0; n < 2; ++n) _Pragma("unroll") for (int k = 0; k < 2; ++k) \
        acc[ai][bj][m][n] = __builtin_amdgcn_mfma_f32_16x16x32_bf16(Bt[n][k], At[m][k], acc[ai][bj][m][n], 0, 0, 0); __builtin_amdgcn_s_setprio(0); } while (0)
#define PG8_WAIT_V(n) asm volatile("s_waitcnt vmcnt(" #n ")" ::: "memory")
#define PG8_WAIT_L(n) asm volatile("s_waitcnt lgkmcnt(" #n ")" ::: "memory")
#define PG8_BAR __builtin_amdgcn_s_barrier()
#define PG8_SCHED __builtin_amdgcn_sched_barrier(0)
    Unit cur, nxt; int ui = 0;
    if (!S.next(0, cur)) return;
    f32x4 acc[2][2][4][2];
#pragma unroll
    for (int a = 0; a < 2; ++a)
#pragma unroll
        for (int b = 0; b < 2; ++b)
#pragma unroll
            for (int m = 0; m < 4; ++m)
#pragma unroll
                for (int n = 0; n < 2; ++n) acc[a][b][m][n] = (f32x4){0.f, 0.f, 0.f, 0.f};
    bf16x8 At[4][2], B0[2][2], B1[2][2];
    const char* cA = (const char*)g.A + (size_t)cur.pm * tstep; const char* cB = (const char*)g.Bt + (size_t)cur.pn * tstep;
    S.a_ready(cur);
    if constexpr (SP2) {
        PG8_STAGE(PG8_SB(0, 0), cB, voffB); PG8_STAGE(PG8_SB(0, 1), cB + hstep, voffB); PG8_STAGE(PG8_SA(0, 0), cA, voffA); PG8_STAGE(PG8_SA(0, 1), cA + hstepA, voffA);
        if (wr == 1) PG8_BAR;
        PG8_WAIT_V(2); PG8_BAR;
        PG8_STAGE(PG8_SB(1, 0), cB + kstep, voffB); PG8_STAGE(PG8_SA(1, 0), cA + kstep, voffA); PG8_STAGE(PG8_SB(1, 1), cB + hstep + kstep, voffB);
        PG8_WAIT_V(6); PG8_BAR;
    } else {
        PG8_STAGE(PG8_SB(0, 0), cB, voffB); PG8_STAGE(PG8_SA(0, 0), cA, voffA); PG8_STAGE(PG8_SB(0, 1), cB + hstep, voffB); PG8_STAGE(PG8_SA(0, 1), cA + hstepA, voffA);
        if (wr == 1) PG8_BAR;
        PG8_WAIT_V(4); PG8_BAR;
        PG8_STAGE(PG8_SB(1, 0), cB + kstep, voffB); PG8_STAGE(PG8_SA(1, 0), cA + kstep, voffA); PG8_STAGE(PG8_SB(1, 1), cB + hstep + kstep, voffB);
        PG8_WAIT_V(6); PG8_BAR;
    }
    for (;;) {
        const bool has_next = S.next(ui + 1, nxt);
        const char* nA = has_next ? (const char*)g.A + (size_t)nxt.pm * tstep : cA; const char* nB = has_next ? (const char*)g.Bt + (size_t)nxt.pn * tstep : cB;
        for (int t = 0; t < nt; t += 2) {
            const bool last = (t == nt - 2);
            const char* a1 = cA + (size_t)(t + 1) * kstep;
            const char* a2 = last ? nA : cA + (size_t)(t + 2) * kstep; const char* b2 = last ? nB : cB + (size_t)(t + 2) * kstep;
            const char* a3 = a2 + kstep; const char* b3 = b2 + kstep;
            if (last && has_next) S.a_ready(nxt);
            if constexpr (SP2) {
            PG8_LDB(B0, 0, 0); PG8_LDB(B1, 0, 1); PG8_SCHED; PG8_LDA(At, 0, 0); PG8_STAGE(PG8_SA(1, 1), a1 + hstepA, voffA);
            PG8_WAIT_V(8); PG8_WAIT_L(0); PG8_BAR; PG8_MMA(0, 0, At, B0); PG8_MMA(0, 1, At, B1); PG8_BAR; PG8_SCHED;
            PG8_LDA(At, 0, 1); PG8_STAGE(PG8_SB(0, 0), b2, voffB); PG8_STAGE(PG8_SB(0, 1), b2 + hstep, voffB); PG8_STAGE(PG8_SA(0, 0), a2, voffA);
            PG8_WAIT_V(8); PG8_WAIT_L(0); PG8_BAR; PG8_MMA(1, 0, At, B0); PG8_MMA(1, 1, At, B1); PG8_BAR; PG8_SCHED;
            PG8_LDB(B0, 1, 0); PG8_LDB(B1, 1, 1); PG8_SCHED; PG8_LDA(At, 1, 0); PG8_STAGE(PG8_SA(0, 1), a2 + hstepA, voffA);
            PG8_WAIT_V(8); PG8_WAIT_L(0); PG8_BAR; PG8_MMA(0, 0, At, B0); PG8_MMA(0, 1, At, B1); PG8_BAR; PG8_SCHED;
            PG8_LDA(At, 1, 1); PG8_STAGE(PG8_SB(1, 0), b3, voffB); PG8_STAGE(PG8_SB(1, 1), b3 + hstep, voffB); PG8_STAGE(PG8_SA(1, 0), a3, voffA);
            PG8_WAIT_V(8); PG8_WAIT_L(0); PG8_BAR; PG8_MMA(1, 0, At, B0); PG8_MMA(1, 1, At, B1); PG8_BAR; PG8_SCHED;
            } else {
            PG8_LDB(B0, 0, 0); PG8_SCHED; PG8_LDA(At, 0, 0); PG8_STAGE(PG8_SA(1, 1), a1 + hstepA, voffA);
            PG8_WAIT_L(8); PG8_BAR; PG8_WAIT_L(0); PG8_MMA(0, 0, At, B0); PG8_BAR; PG8_SCHED;
            PG8_LDB(B1, 0, 1); PG8_STAGE(PG8_SB(0, 0), b2, voffB);
            PG8_BAR; PG8_WAIT_L(0); PG8_MMA(0, 1, At, B1); PG8_BAR;
            PG8_LDA(At, 0, 1); PG8_STAGE(PG8_SA(0, 0), a2, voffA);
            PG8_BAR; PG8_WAIT_L(0); PG8_MMA(1, 0, At, B0); PG8_BAR; PG8_SCHED;
            PG8_STAGE(PG8_SB(0, 1), b2 + hstep, voffB);
            PG8_WAIT_V(6); PG8_BAR; PG8_MMA(1, 1, At, B1); PG8_BAR;
            PG8_LDB(B0, 1, 0); PG8_SCHED; PG8_LDA(At, 1, 0); PG8_STAGE(PG8_SA(0, 1), a2 + hstepA, voffA);
            PG8_WAIT_L(8); PG8_BAR; PG8_WAIT_L(0); PG8_MMA(0, 0, At, B0); PG8_BAR; PG8_SCHED;
            PG8_LDB(B1, 1, 1); PG8_STAGE(PG8_SB(1, 0), b3, voffB);
            PG8_BAR; PG8_WAIT_L(0); PG8_MMA(0, 1, At, B1); PG8_BAR;
            PG8_LDA(At, 1, 1); PG8_STAGE(PG8_SA(1, 0), a3, voffA);
            PG8_BAR; PG8_WAIT_L(0); PG8_MMA(1, 0, At, B0); PG8_BAR; PG8_SCHED;
            PG8_STAGE(PG8_SB(1, 1), b3 + hstep, voffB);
            PG8_WAIT_V(6); PG8_BAR; PG8_MMA(1, 1, At, B1); PG8_BAR;
            }
        }
        if constexpr (ALIGN_EPI) { if (wr == 0) PG8_BAR; }
        if constexpr (!Epi::AFTER_DRAIN) { E(acc, cur, wr, wc, fr, fq); S.done(cur); }
        if (!has_next) break;
#pragma unroll
        for (int a = 0; a < 2; ++a)
#pragma unroll
            for (int b = 0; b < 2; ++b)
#pragma unroll
                for (int m = 0; m < 4; ++m)
#pragma unroll
                    for (int n = 0; n < 2; ++n) acc[a][b][m][n] = (f32x4){0.f, 0.f, 0.f, 0.f};
        cur = nxt; cA = nA; cB = nB; ++ui;
        if constexpr (ALIGN_EPI) { if (wr == 1) PG8_BAR; }
    }
    PG8_WAIT_V(0);
    if constexpr (!ALIGN_EPI) { if (wr == 0) PG8_BAR; }
    PG8_BAR;
    if constexpr (Epi::AFTER_DRAIN) { E.fused(acc, cur, wr, wc, fr, fq, lds, wid, lane); S.done(cur); }
#undef PG8_SA
#undef PG8_SB
#undef PG8_STAGE
#undef PG8_LDA
#undef PG8_LDB
#undef PG8_MMA
#undef PG8_WAIT_V
#undef PG8_WAIT_L
#undef PG8_BAR
#undef PG8_SCHED
}
}

typedef unsigned short bf16;
typedef float f32x4 __attribute__((ext_vector_type(4)));
typedef float f32x2 __attribute__((ext_vector_type(2)));
typedef unsigned u32x4 __attribute__((ext_vector_type(4)));
typedef unsigned u32x2 __attribute__((ext_vector_type(2)));
typedef short bf16x8 __attribute__((ext_vector_type(8)));

constexpr int R = 17408, RP = 16384, NSEQ = 130, SEQL = 8192;
constexpr int DM = 1024, INA = 3592, ZW = 3584, QKVW = 1536, FF = 2816, FF2 = 5632, MODW = 24576;
constexpr float EPS = 1e-6f;
constexpr int NWAVES = 8, NTHR = 512;
constexpr int LDS_BYTES = 147456;

constexpr size_t O_Y = 0;
constexpr size_t O_PC = (size_t)R * 1024;
constexpr size_t O_PN = O_PC + 262144;
constexpr size_t O_PM = O_PN + 2048;
constexpr size_t O_PSC = O_PM + 16;
constexpr size_t O_PWK = O_PSC + 4096;
constexpr size_t O_PWV = O_PWK + 131072;
constexpr size_t O_PFFN = O_PWV + 131072;
constexpr size_t O_SC = O_PFFN + 90112;
constexpr size_t O_SN = O_SC + 16777216;
constexpr size_t O_SM = O_SN + 131072;
constexpr size_t O_SSC = O_SM + 1024;
constexpr size_t O_SWK = O_SSC + 262144;
constexpr size_t O_SWV = O_SWK + 8388608;
constexpr size_t O_SFFN = O_SWV + 8388608;
constexpr size_t O_END = O_SFFN + 5767168;

constexpr size_t MiB = 1u << 20;
constexpr size_t WS_WIN = 1 * MiB, WS_WAO = 15 * MiB, WS_WQKV = 19 * MiB, WS_WCO = 25 * MiB, WS_WUP = 29 * MiB, WS_WDN = 73 * MiB;
constexpr size_t WS_AC = 95 * MiB, WS_MOD = 96 * MiB, WS_TAB = 109 * MiB, WS_H = 112 * MiB, WS_CAT = 146 * MiB, WS_GATES = 180 * MiB;
constexpr size_t WS_ZU = 181 * MiB;
constexpr size_t WS_ACT = 368 * MiB;
constexpr size_t WS_DCT = WS_ACT, WS_CST = WS_ACT + 64 * MiB, WS_NS = WS_ACT + 96 * MiB, WS_DN = WS_NS + MiB / 2, WS_CS = WS_NS + MiB, WS_MS = WS_CS + 65536;
constexpr size_t WS_UB = 466 * MiB;
constexpr size_t WS_END = 472 * MiB;

__constant__ double ROPE_INV[32] = {1.0, 0.7498942093324559, 0.5623413251903491, 0.4216965034285822, 0.31622776601683794, 0.23713737056616552, 0.1778279410038923, 0.1333521432163324, 0.1, 0.07498942093324558, 0.05623413251903491, 0.042169650342858224, 0.03162277660168379, 0.023713737056616554, 0.01778279410038923, 0.01333521432163324, 0.01, 0.007498942093324558, 0.005623413251903491, 0.004216965034285823, 0.0031622776601683794, 0.0023713737056616554, 0.0017782794100389228, 0.001333521432163324, 0.001, 0.0007498942093324559, 0.0005623413251903491, 0.00042169650342858224, 0.00031622776601683794, 0.00023713737056616554, 0.00017782794100389227, 0.0001333521432163324};
#ifndef PROBE_PRE
#define PROBE_PRE 0
#define PROBE_EVEN 0
#define PROBE_ODD 0
#endif
#ifndef PROBE_BAR
#define PROBE_BAR 0
#endif
struct Params { const float* in[28]; float* out; unsigned char* ws; int lo, hi; };

__device__ __forceinline__ unsigned f2bf(float f) { unsigned u = __builtin_bit_cast(unsigned, f); return (u + 0x7fffu + ((u >> 16) & 1u)) >> 16; }
__device__ __forceinline__ unsigned pk2(float lo, float hi) { unsigned r; asm("v_cvt_pk_bf16_f32 %0, %1, %2" : "=v"(r) : "v"(lo), "v"(hi)); return r; }
__device__ __forceinline__ unsigned pk2_sw(float lo, float hi) { return f2bf(lo) | (f2bf(hi) << 16); }
__device__ __forceinline__ float bf2f(unsigned h) { return __builtin_bit_cast(float, h << 16); }
__device__ __forceinline__ float bflo(unsigned w) { return __builtin_bit_cast(float, w << 16); }
__device__ __forceinline__ float bfhi(unsigned w) { return __builtin_bit_cast(float, w & 0xffff0000u); }
template <int CTRL> __device__ __forceinline__ float dppf(float x) { return __builtin_bit_cast(float, __builtin_amdgcn_mov_dpp(__builtin_bit_cast(int, x), CTRL, 0xF, 0xF, true)); }
__device__ __forceinline__ float rdl(float x, int l) { return __builtin_bit_cast(float, __builtin_amdgcn_readlane(__builtin_bit_cast(int, x), l)); }
__device__ __forceinline__ float wave_sum(float v) {
    v += dppf<0xB1>(v); v += dppf<0x4E>(v); v += dppf<0x141>(v); v += dppf<0x140>(v);
    return (rdl(v, 0) + rdl(v, 16)) + (rdl(v, 32) + rdl(v, 48));
}
__device__ __forceinline__ float wave_max(float v) {
    v = fmaxf(v, dppf<0xB1>(v)); v = fmaxf(v, dppf<0x4E>(v)); v = fmaxf(v, dppf<0x141>(v)); v = fmaxf(v, dppf<0x140>(v));
    return fmaxf(fmaxf(rdl(v, 0), rdl(v, 16)), fmaxf(rdl(v, 32), rdl(v, 48)));
}
__device__ __forceinline__ float logsigmoidf(float f) { return fminf(f, 0.f) - log1pf(__expf(-fabsf(f))); }
__device__ __forceinline__ float sigmoidf_(float x) { return __builtin_amdgcn_rcpf(1.f + __builtin_amdgcn_exp2f(x * -1.4426950408889634f)); }
__device__ __forceinline__ int seq_of(int row) { return row < RP ? (row >> 13) : 2 + ((row - RP) >> 3); }
#define LAS __attribute__((address_space(3)))
#define LDS_WAIT() asm volatile("s_waitcnt lgkmcnt(0)" ::: "memory")

__device__ __forceinline__ float dpp_shr1f(float x) { return __builtin_bit_cast(float, __builtin_amdgcn_mov_dpp(__builtin_bit_cast(int, x), 0x111, 0xF, 0xF, false)); }
__device__ __forceinline__ f32x4 dpp_shr1(const f32x4 v) { f32x4 r; r.x = dpp_shr1f(v.x); r.y = dpp_shr1f(v.y); r.z = dpp_shr1f(v.z); r.w = dpp_shr1f(v.w); return r; }
struct EpiMain {
    static constexpr bool PERM = true, AFTER_DRAIN = false;
    int mode;
    bf16* O; int ldc; float* X; const float* gate;
    const float* qn; const float* kn; int lyr; unsigned char* wsb;
    const float* cw; const float* stp; float* sout;
    __device__ __forceinline__ void operator()(const pg8::f32x4 (&acc)[2][2][4][2], const pg8::Unit& u, int wr, int wc, int fr, int fq) const {
        const int rowb = u.pm * 256 + 8 * (16 * wr + fr), col0 = u.pn * 256 + wc * 32 + 8 * fq;
        if (mode == 0) {
#pragma unroll
            for (int ai = 0; ai < 2; ++ai)
#pragma unroll
                for (int m = 0; m < 4; ++m) { bf16* rowp = O + (size_t)(rowb + 4 * ai + m) * ldc + col0;
#pragma unroll
                    for (int bj = 0; bj < 2; ++bj) { const pg8::f32x4 v0 = acc[ai][bj][m][0], v1 = acc[ai][bj][m][1]; u32x4 w;
                        w.x = pg8::cvt_pk_bf16(v0[0], v0[1]); w.y = pg8::cvt_pk_bf16(v0[2], v0[3]); w.z = pg8::cvt_pk_bf16(v1[0], v1[1]); w.w = pg8::cvt_pk_bf16(v1[2], v1[3]);
                        *(u32x4*)(rowp + bj * 128) = w; } }
        } else if (mode == 1) {
            f32x4 gv[2][2];
            { const float* gp = gate + (size_t)(u.pm >> 5) * MODW + col0;
#pragma unroll
              for (int bj = 0; bj < 2; ++bj)
#pragma unroll
                  for (int n = 0; n < 2; ++n) gv[bj][n] = *(const f32x4*)(gp + bj * 128 + 4 * n); }
#pragma unroll
            for (int am = 0; am < 4; ++am) { const int ai = am >> 1, m0 = (am & 1) * 2;
                f32x4 xv[2][2][2];
#pragma unroll
                for (int mm = 0; mm < 2; ++mm) { const float* xp = X + (size_t)(rowb + 4 * ai + m0 + mm) * DM + col0;
#pragma unroll
                    for (int bj = 0; bj < 2; ++bj)
#pragma unroll
                        for (int n = 0; n < 2; ++n) xv[mm][bj][n] = *(const f32x4*)(xp + bj * 128 + 4 * n); }
#pragma unroll
                for (int mm = 0; mm < 2; ++mm) { float* xp = X + (size_t)(rowb + 4 * ai + m0 + mm) * DM + col0;
#pragma unroll
                    for (int bj = 0; bj < 2; ++bj)
#pragma unroll
                        for (int n = 0; n < 2; ++n) *(f32x4*)(xp + bj * 128 + 4 * n) = xv[mm][bj][n] + gv[bj][n] * acc[ai][bj][m0 + mm][n]; }
            }
        } else if (mode == 3) {
            int fq3 = fq; asm volatile("" : "+v"(fq3));
            const int head = 4 * u.pn + wc; const bool prm = u.pm < 64;
            const f32x2* TAB = (const f32x2*)(wsb + WS_TAB);
            const int sq = prm ? (u.pm >> 5) : ((rowb - RP) >> 3);
            const float* nwp = (head < 16 ? qn : kn) + 8 * fq3;
            const f32x4 w1a = *(const f32x4*)nwp, w1b = *(const f32x4*)(nwp + 4), w2a = *(const f32x4*)(nwp + 32), w2b = *(const f32x4*)(nwp + 36);
            f32x4 ca, sa, cb, sb;
            { const int pos0 = prm ? (rowb & (SEQL - 1)) : SEQL; const f32x4* tp = (const f32x4*)(TAB + pos0 * 32 + 8 * fq3); const f32x4 c0 = tp[0], c1 = tp[1], c2 = tp[2], c3 = tp[3];
              ca = (f32x4){c0[0], c0[2], c1[0], c1[2]}; sa = (f32x4){c0[1], c0[3], c1[1], c1[3]}; cb = (f32x4){c2[0], c2[2], c3[0], c3[2]}; sb = (f32x4){c2[1], c2[3], c3[1], c3[3]};
            }
#pragma unroll
            for (int j = 0; j < 8; ++j) { const int row = rowb + j, t = prm ? (row & (SEQL - 1)) : j;
                f32x4 x1a = acc[j >> 2][0][j & 3][0], x1b = acc[j >> 2][0][j & 3][1], x2a = acc[j >> 2][1][j & 3][0], x2b = acc[j >> 2][1][j & 3][1];
                if (head < 20) {
                    float ss = (x1a[0] * x1a[0] + x1a[1] * x1a[1]) + (x1a[2] * x1a[2] + x1a[3] * x1a[3]) + (x1b[0] * x1b[0] + x1b[1] * x1b[1]) + (x1b[2] * x1b[2] + x1b[3] * x1b[3])
                             + (x2a[0] * x2a[0] + x2a[1] * x2a[1]) + (x2a[2] * x2a[2] + x2a[3] * x2a[3]) + (x2b[0] * x2b[0] + x2b[1] * x2b[1]) + (x2b[2] * x2b[2] + x2b[3] * x2b[3]);
                    ss += shx(ss, 16); ss += shx(ss, 32);
                    const float rstd = rsqrtf(ss * (1.f / 64.f) + EPS);
                    const f32x4 y1a = x1a * rstd * w1a, y1b = x1b * rstd * w1b, y2a = x2a * rstd * w2a, y2b = x2b * rstd * w2b;
                    x1a = y1a * ca - y2a * sa; x1b = y1b * cb - y2b * sb; x2a = y2a * ca + y1a * sa; x2b = y2b * cb + y1b * sb;
                }
                bf16* zp = O + (size_t)row * QKVW + head * 64 + 8 * fq3;
                *(u32x4*)zp = (u32x4){pk2(x1a[0], x1a[1]), pk2(x1a[2], x1a[3]), pk2(x1b[0], x1b[1]), pk2(x1b[2], x1b[3])};
                *(u32x4*)(zp + 32) = (u32x4){pk2(x2a[0], x2a[1]), pk2(x2a[2], x2a[3]), pk2(x2b[0], x2b[1]), pk2(x2b[2], x2b[3])};
                if (head >= 16 && (!prm || t >= SEQL - 128)) {
                    float* dst = X + (head < 20 ? (prm ? O_PWK : O_SWK) : (prm ? O_PWV : O_SWV)) + (prm ? ((size_t)(lyr * 2 + sq) * 128 + (t - (SEQL - 128))) * 256 : ((size_t)(lyr * 128 + sq) * 128 + 120 + j) * 256) + ((head - 16) & 3) * 64 + 8 * fq3;
                    *(f32x4*)dst = x1a; *(f32x4*)(dst + 4) = x1b; *(f32x4*)(dst + 32) = x2a; *(f32x4*)(dst + 36) = x2b; }
                if (head < 20) { const f32x4* t1 = (const f32x4*)(TAB + 32 + 8 * fq3); const f32x4 e0 = t1[0], e1 = t1[1], e2 = t1[2], e3 = t1[3];
                    const f32x4 dca = (f32x4){e0[0], e0[2], e1[0], e1[2]}, dsa = (f32x4){e0[1], e0[3], e1[1], e1[3]}, dcb = (f32x4){e2[0], e2[2], e3[0], e3[2]}, dsb = (f32x4){e2[1], e2[3], e3[1], e3[3]};
                    const f32x4 na = ca * dca - sa * dsa, nb = cb * dcb - sb * dsb; sa = sa * dca + ca * dsa; sb = sb * dcb + cb * dsb; ca = na; cb = nb; }
                asm volatile("" ::: "memory");
            }
        } else {
            const bool smp = u.pm >= 64; const int sq = (rowb - RP) >> 3;
            bf16* UB = (bf16*)(wsb + WS_UB); bf16* ACT = (bf16*)(wsb + WS_ACT);
#pragma unroll
            for (int n = 0; n < 2; ++n) {
                const int cf = u.pn * 128 + wc * 32 + 8 * fq + 4 * n;
                const f32x4 wg0 = *(const f32x4*)(cw + cf), wg1 = *(const f32x4*)(cw + FF2 + cf), wg2 = *(const f32x4*)(cw + 2 * FF2 + cf);
                const f32x4 wa0 = *(const f32x4*)(cw + FF + cf), wa1 = *(const f32x4*)(cw + FF2 + FF + cf), wa2 = *(const f32x4*)(cw + 2 * FF2 + FF + cf);
                f32x4 g2, g1, a2, a1;
                if (smp) { const float* st = stp + (size_t)sq * 2 * FF2; g2 = *(const f32x4*)(st + cf); a2 = *(const f32x4*)(st + FF + cf); g1 = *(const f32x4*)(st + FF2 + cf); a1 = *(const f32x4*)(st + FF2 + FF + cf); }
                else { g2 = dpp_shr1(acc[1][0][2][n]); g1 = dpp_shr1(acc[1][0][3][n]); a2 = dpp_shr1(acc[1][1][2][n]); a1 = dpp_shr1(acc[1][1][3][n]); }
#pragma unroll
                for (int j = 0; j < 8; ++j) { const f32x4 G = acc[j >> 2][0][j & 3][n], A = acc[j >> 2][1][j & 3][n];
                    const f32x4 cg = wg0 * g2 + wg1 * g1 + wg2 * G, ca = wa0 * a2 + wa1 * a1 + wa2 * A;
                    if (smp || fr != 0 || j >= 2)
                        *(u32x2*)(ACT + (size_t)(rowb + j) * FF + cf) = (u32x2){pg8::cvt_pk_bf16(cg[0] * sigmoidf_(cg[0]) * ca[0], cg[1] * sigmoidf_(cg[1]) * ca[1]), pg8::cvt_pk_bf16(cg[2] * sigmoidf_(cg[2]) * ca[2], cg[3] * sigmoidf_(cg[3]) * ca[3])};
                    if (smp) { if (j >= 6) { float* d = sout + ((size_t)sq * 2 + (j - 6)) * FF2; *(f32x4*)(d + cf) = G; *(f32x4*)(d + FF + cf) = A; } }
                    else if ((fr == 0 && j < 2) || (fr == 15 && j >= 6)) { bf16* d = UB + ((size_t)(u.pm * 2 + wr) * 4 + (j < 2 ? j : j - 4)) * FF2;
                        *(u32x2*)(d + cf) = (u32x2){pk2(G[0], G[1]), pk2(G[2], G[3])}; *(u32x2*)(d + FF + cf) = (u32x2){pk2(A[0], A[1]), pk2(A[2], A[3])}; }
                    g2 = g1; g1 = G; a2 = a1; a1 = A; }
            }
        }
    }
};
struct EpiMod {
    static constexpr bool PERM = true, AFTER_DRAIN = false;
    float* O; const float* bias;
    __device__ __forceinline__ void operator()(const pg8::f32x4 (&acc)[2][2][4][2], const pg8::Unit& u, int wr, int wc, int fr, int fq) const {
        const int rowb = u.pm * 256 + 8 * (16 * wr + fr), col0 = u.pn * 256 + wc * 32 + 8 * fq;
#pragma unroll
        for (int ai = 0; ai < 2; ++ai)
#pragma unroll
            for (int m = 0; m < 4; ++m) { const int row = rowb + 4 * ai + m;
                if (row < NSEQ) {
#pragma unroll
                    for (int bj = 0; bj < 2; ++bj)
#pragma unroll
                        for (int n = 0; n < 2; ++n) { const f32x4 b = *(const f32x4*)(bias + col0 + bj * 128 + 4 * n);
                            *(f32x4*)(O + (size_t)row * MODW + col0 + bj * 128 + 4 * n) = acc[ai][bj][m][n] + b; } } }
    }
};


__device__ __forceinline__ void mini_gemm(const bf16* A, const bf16* Bt, int K, float* X, const float* gate, unsigned char* smem) {
    const int tid = otid(), lane = tid & 63, wave = tid >> 6, fr = lane & 15, fq = lane >> 4;
    float* part = (float*)smem;
    const int nks = K / 256;
    for (int u = obid(); u < 256; u += gridDim.x) {
        const int rm = u >> 4, cn = u & 15;
        const bf16* Ap = A + (size_t)(RP + 64 * rm + fr) * K + wave * (K / 8) + 8 * fq;
        const bf16* Bp = Bt + (size_t)(64 * cn + fr) * K + wave * (K / 8) + 8 * fq;
        f32x4 acc[4][4];
#pragma unroll
        for (int i = 0; i < 4; ++i)
#pragma unroll
            for (int j = 0; j < 4; ++j) acc[i][j] = (f32x4){0.f, 0.f, 0.f, 0.f};
        bf16x8 a0[4], b0[4], a1[4], b1[4];
#define MG_LD(a, b, ks) do { _Pragma("unroll") for (int i_ = 0; i_ < 4; ++i_) { a[i_] = *(const bf16x8*)(Ap + (size_t)(16 * i_) * K + 32 * (ks)); b[i_] = *(const bf16x8*)(Bp + (size_t)(16 * i_) * K + 32 * (ks)); } } while (0)
#define MG_MMA(a, b) do { _Pragma("unroll") for (int i_ = 0; i_ < 4; ++i_) _Pragma("unroll") for (int j_ = 0; j_ < 4; ++j_) acc[i_][j_] = __builtin_amdgcn_mfma_f32_16x16x32_bf16(b[j_], a[i_], acc[i_][j_], 0, 0, 0); } while (0)
        MG_LD(a0, b0, 0);
        for (int ks = 0; ks < nks; ks += 2) {
            if (ks + 1 < nks) MG_LD(a1, b1, ks + 1);
            MG_MMA(a0, b0);
            if (ks + 2 < nks) MG_LD(a0, b0, ks + 2);
            if (ks + 1 < nks) MG_MMA(a1, b1);
        }
#undef MG_LD
#undef MG_MMA
#pragma unroll
        for (int i = 0; i < 4; ++i)
#pragma unroll
            for (int j = 0; j < 4; ++j) *(f32x4*)(part + (wave * 64 + 16 * i + fr) * 68 + 16 * j + 4 * fq) = acc[i][j];
        __syncthreads();
        {
            const int row = tid >> 3, c0 = (tid & 7) * 8;
            f32x4 s0 = (f32x4){0.f, 0.f, 0.f, 0.f}, s1 = s0;
#pragma unroll
            for (int w = 0; w < 8; ++w) { s0 = s0 + *(const f32x4*)(part + (w * 64 + row) * 68 + c0); s1 = s1 + *(const f32x4*)(part + (w * 64 + row) * 68 + c0 + 4); }
            const int grow = RP + 64 * rm + row, col = 64 * cn + c0; const int sq = 2 + ((grow - RP) >> 3);
            const float* gp = gate + (size_t)sq * MODW + col; float* xp = X + (size_t)grow * DM + col;
            const f32x4 g0 = *(const f32x4*)gp, g1 = *(const f32x4*)(gp + 4);
            *(f32x4*)xp = *(const f32x4*)xp + g0 * s0; *(f32x4*)(xp + 4) = *(const f32x4*)(xp + 4) + g1 * s1;
        }
        __syncthreads();
    }
}
struct TDesc { const float* W; bf16* WT; int ldw, K; };
constexpr int I_IN = 1792, I_AO = 512, I_QKV = 768, I_CO = 512, I_UP = 2816, I_DN = 1408, I_ADA = 3072;
constexpr int TN1 = 2 * I_IN, TN2 = TN1 + 2 * I_AO, TN3 = TN2 + 2 * I_QKV, TN4 = TN3 + 2 * I_CO, TN5 = TN4 + 4 * I_UP, TN6 = TN5 + 4 * I_DN, TN7 = TN6 + 4 * I_ADA;
__device__ __forceinline__ void tdecode(const Params& p, int it, TDesc& d) {
    unsigned char* ws = p.ws; int r = it, ncols; const float* W; bf16* WT; int ldw, K = DM; bool wup = false, wqkv = false;
    if (r < TN1) { const int i = r / I_IN; r -= i * I_IN; W = p.in[15] + (size_t)i * DM * INA; WT = (bf16*)(ws + WS_WIN) + (size_t)i * ZW * DM; ldw = INA;
        if (r < 1024) ncols = 2048; else { W += 2056; WT += (size_t)2048 * DM; r -= 1024; ncols = 1536; } }
    else if (r < TN2) { r -= TN1; const int i = r / I_AO; r -= i * I_AO; W = p.in[19] + (size_t)i * DM * DM; WT = (bf16*)(ws + WS_WAO) + (size_t)i * DM * DM; ldw = DM; ncols = DM; }
    else if (r < TN3) { r -= TN2; const int i = r / I_QKV; r -= i * I_QKV; W = p.in[20] + (size_t)i * DM * QKVW; WT = (bf16*)(ws + WS_WQKV) + (size_t)i * QKVW * DM; ldw = QKVW; ncols = QKVW; wqkv = true; }
    else if (r < TN4) { r -= TN3; const int i = r / I_CO; r -= i * I_CO; W = p.in[24] + (size_t)i * DM * DM; WT = (bf16*)(ws + WS_WCO) + (size_t)i * DM * DM; ldw = DM; ncols = DM; }
    else if (r < TN5) { r -= TN4; const int i = r / I_UP; r -= i * I_UP; W = p.in[25] + (size_t)i * DM * FF2; WT = (bf16*)(ws + WS_WUP) + (size_t)i * FF2 * DM; ldw = FF2; ncols = FF2; wup = true; }
    else if (r < TN6) { r -= TN5; const int i = r / I_DN; r -= i * I_DN; W = p.in[27] + (size_t)i * FF * DM; WT = (bf16*)(ws + WS_WDN) + (size_t)i * DM * FF; ldw = DM; ncols = DM; K = FF; }
    else { r -= TN6; const int i = r / I_ADA; r -= i * I_ADA; W = p.in[13] + (size_t)i * DM * 6144; WT = (bf16*)(ws + WS_ZU) + (size_t)i * 6144 * DM; ldw = 6144; ncols = 6144; }
    const int nblk = ncols / 32, kb = r / nblk, nb = r - kb * nblk;
    int drow = 32 * nb;
    if (wup) drow = (nb < 88) ? 256 * (nb >> 2) + 32 * (nb & 3) : 256 * ((nb - 88) >> 2) + 128 + 32 * ((nb - 88) & 3);
    if (wqkv) { const int head = nb >> 1; drow = 256 * (head >> 2) + 128 * (nb & 1) + 32 * (head & 3); }
    d.W = W + (size_t)(64 * kb) * ldw + 32 * nb; d.WT = WT + (size_t)drow * K + 64 * kb; d.ldw = ldw; d.K = K;
}
__device__ __forceinline__ void tload(const TDesc& d, int lane, float (&v)[32]) {
#pragma unroll
    for (int i = 0; i < 32; ++i) v[i] = d.W[(size_t)(2 * i + (lane >> 5)) * d.ldw + (lane & 31)];
}
__device__ __forceinline__ void tstore(const TDesc& d, int lane, const float (&v)[32], float* scr) {
#pragma unroll
    for (int i = 0; i < 32; ++i) scr[(2 * i + (lane >> 5)) * 33 + (lane & 31)] = v[i];
    LDS_WAIT();
    const int c = lane & 7;
#pragma unroll
    for (int j = 0; j < 4; ++j) { const int n = (lane >> 3) + 8 * j; const float* s = scr + (8 * c) * 33 + n;
        u32x4 o; o.x = pk2(s[0 * 33], s[1 * 33]); o.y = pk2(s[2 * 33], s[3 * 33]); o.z = pk2(s[4 * 33], s[5 * 33]); o.w = pk2(s[6 * 33], s[7 * 33]);
        *(u32x4*)(d.WT + (size_t)n * d.K + 8 * c) = o; }
    LDS_WAIT();
}

__device__ __forceinline__ void prologue(const Params& p, unsigned char* smem) {
    const int tid = otid(), lane = tid & 63, wave = tid >> 6;
    const int gw = obid() * NWAVES + wave, NGW = gridDim.x * NWAVES;
    float* scr = (float*)(smem + wave * 16384);
    unsigned char* ws = p.ws;
    {
        float va[32], vb[32]; TDesc da, db;
        int it = gw;
        if (it < TN7) { tdecode(p, it, da); tload(da, lane, va); }
        while (it < TN7) {
            int nx = it + NGW;
            if (nx < TN7) { tdecode(p, nx, db); tload(db, lane, vb); }
            tstore(da, lane, va, scr);
            it = nx; nx = it + NGW;
            if (it >= TN7) break;
            if (nx < TN7) { tdecode(p, nx, da); tload(da, lane, va); }
            tstore(db, lane, vb, scr);
            it = nx;
        }
    }
    const int gt = obid() * NTHR + tid, NT = gridDim.x * NTHR;
    bf16* Ac = (bf16*)(ws + WS_AC);
    for (int idx = gt; idx < 256 * DM; idx += NT) { const int row = idx >> 10, col = idx & 1023; float v = 0.f;
        if (row < 2) v = p.in[2][row * DM + col]; else if (row < NSEQ) v = p.in[3][(row - 2) * DM + col];
        Ac[idx] = (bf16)f2bf(v * sigmoidf_(v)); }
    f32x2* TAB = (f32x2*)(ws + WS_TAB);
    for (int idx = gt; idx < 8200 * 32; idx += NT) { const int pos = idx >> 5, i = idx & 31;
        const double ang = (double)pos * ROPE_INV[i];
        const double n = rint(ang * 0.6366197723675814); double r = fma(-n, 1.5707963267948966, ang); r = fma(-n, 6.123233995736766e-17, r); const double r2 = r * r;
        const double sn = r * (1.0 + r2 * (-1.0 / 6 + r2 * (1.0 / 120 + r2 * (-1.0 / 5040 + r2 * (1.0 / 362880 + r2 * (-1.0 / 39916800 + r2 * (1.0 / 6227020800.0)))))));
        const double cn = 1.0 + r2 * (-0.5 + r2 * (1.0 / 24 + r2 * (-1.0 / 720 + r2 * (1.0 / 40320 + r2 * (-1.0 / 3628800 + r2 * (1.0 / 479001600.0 + r2 * (-1.0 / 87178291200.0)))))));
        const int qd = ((int)n) & 3; const double c = (qd == 0) ? cn : (qd == 1) ? -sn : (qd == 2) ? -cn : sn, s = (qd == 0) ? sn : (qd == 1) ? cn : (qd == 2) ? -sn : -cn;
        TAB[idx] = (f32x2){(float)c, (float)s}; }
}

__device__ __forceinline__ void norm_phase(const Params& p, int l, int which, unsigned char* smem) {
    const int tid = otid(), lane = tid & 63, wave = tid >> 6;
    const int gw = obid() * NWAVES + wave, NGW = gridDim.x * NWAVES;
    const bool do_gates = (which == 1) && !(l & 1);
    const bool first = (which == 1) && (l == 0);
    float* X = p.out;
    const float* MOD = (const float*)(p.ws + WS_MOD);
    bf16* H = (bf16*)(p.ws + WS_H);
    float* gwl = (float*)smem;
    if (do_gates) {
        const float* W = p.in[15] + (size_t)(l >> 1) * DM * INA + 2048;
        for (int idx = tid; idx < 8192; idx += NTHR) gwl[idx] = W[(size_t)(idx >> 3) * INA + (idx & 7)];
        __syncthreads();
    }
    f32x4 gwa[4][4];
#pragma unroll
    for (int j = 0; j < 4; ++j)
#pragma unroll
        for (int e = 0; e < 4; ++e) gwa[j][e] = do_gates ? *(const f32x4*)(gwl + (4 * lane + 256 * j + e) * 8) : (f32x4){0.f, 0.f, 0.f, 0.f};
    const float* nw = (which == 1 ? p.in[11] : p.in[12]) + l * DM;
    const int off_sh = l * 6144 + (which == 1 ? 0 : 3072), off_sc = off_sh + 1024;
    f32x4 nwv[4];
#pragma unroll
    for (int j = 0; j < 4; ++j) nwv[j] = *(const f32x4*)(nw + 4 * lane + 256 * j);
    f32x4 vn[4], vn2[4];
#define NORM_SRC(r_) (first ? ((r_) < RP ? p.in[0] + (size_t)(r_) * DM : p.in[1] + (size_t)((r_) - RP) * DM) : X + (size_t)(r_) * DM)
    { const int row = gw; if (row < R) { const float* src = NORM_SRC(row);
#pragma unroll
        for (int j = 0; j < 4; ++j) vn[j] = *(const f32x4*)(src + 4 * lane + 256 * j); }
      const int row2 = gw + NGW; if (row2 < R) { const float* src = NORM_SRC(row2);
#pragma unroll
        for (int j = 0; j < 4; ++j) vn2[j] = *(const f32x4*)(src + 4 * lane + 256 * j); } }
    int cur_sq = -1; f32x4 mulv[4], shv[4];
    for (int row = gw; row < R; row += NGW) {
        const int sq = seq_of(row);
        if (sq != cur_sq) { cur_sq = sq; const float* mrow_ = MOD + (size_t)sq * MODW;
#pragma unroll
            for (int j = 0; j < 4; ++j) { const f32x4 sc = *(const f32x4*)(mrow_ + off_sc + 4 * lane + 256 * j); shv[j] = *(const f32x4*)(mrow_ + off_sh + 4 * lane + 256 * j); mulv[j] = nwv[j] * (sc + 1.f); } }
        f32x4 v[4]; float ss = 0.f;
#pragma unroll
        for (int j = 0; j < 4; ++j) { v[j] = vn[j]; vn[j] = vn2[j]; }
        { const int nrow = row + 2 * NGW; if (nrow < R) { const float* src = NORM_SRC(nrow);
#pragma unroll
            for (int j = 0; j < 4; ++j) vn2[j] = *(const f32x4*)(src + 4 * lane + 256 * j); } }
#pragma unroll
        for (int j = 0; j < 4; ++j) ss += (v[j].x * v[j].x + v[j].y * v[j].y) + (v[j].z * v[j].z + v[j].w * v[j].w);
        if (first) {
#pragma unroll
            for (int j = 0; j < 4; ++j) *(f32x4*)(X + (size_t)row * DM + 4 * lane + 256 * j) = v[j];
        }
        const float rstd = rsqrtf(wave_sum(ss) * (1.f / DM) + EPS);
        float ga[8];
#pragma unroll
        for (int g = 0; g < 8; ++g) ga[g] = 0.f;
#pragma unroll
        for (int j = 0; j < 4; ++j) {
            f32x4 h = v[j] * rstd * mulv[j] + shv[j];
            *(u32x2*)(H + (size_t)row * DM + 4 * lane + 256 * j) = (u32x2){pk2(h.x, h.y), pk2(h.z, h.w)};
            if (do_gates) {
#pragma unroll
                for (int e = 0; e < 4; ++e) { const float* wp = gwl + (4 * lane + 256 * j + e) * 8; const f32x4 w0 = gwa[j][e], w1 = *(const f32x4*)(wp + 4); const float hv = h[e];
                    ga[0] += hv * w0.x; ga[1] += hv * w0.y; ga[2] += hv * w0.z; ga[3] += hv * w0.w; ga[4] += hv * w1.x; ga[5] += hv * w1.y; ga[6] += hv * w1.z; ga[7] += hv * w1.w; }
            }
        }
        if (do_gates) {
            const float* bif = p.in[16] + (l >> 1) * 8;
#pragma unroll
            for (int g = 0; g < 8; ++g) ga[g] = wave_sum(ga[g]);
            if (lane == 0) { float* G = (float*)(p.ws + WS_GATES) + (size_t)row * 8;
                *(f32x4*)G = (f32x4){ga[0] + bif[0], ga[1] + bif[1], ga[2] + bif[2], ga[3] + bif[3]}; *(f32x4*)(G + 4) = (f32x4){ga[4] + bif[4], ga[5] + bif[5], ga[6] + bif[6], ga[7] + bif[7]}; }
        }
    }
    __syncthreads();
}

__device__ __forceinline__ float scan_add(float v, int lane) {
#pragma unroll
    for (int o = 1; o < 64; o <<= 1) { const float t = shup(v, o); if (lane >= o) v += t; }
    return v;
}
__device__ __forceinline__ float scan_max(float v, int lane) {
#pragma unroll
    for (int o = 1; o < 64; o <<= 1) { const float t = shup(v, o); if (lane >= o) v = fmaxf(v, t); }
    return v;
}
constexpr float KSCALE = 0.08838834764831845f;

__device__ __forceinline__ void head_out(const Params& p, int i, int h, int row, int lane, float hv0, float hv1, unsigned zo, f32x2 on) {
    const float ss = wave_sum(hv0 * hv0 + hv1 * hv1);
    const float rstd = rsqrtf(ss * (1.f / 128.f) + EPS);
    unsigned* CAT = (unsigned*)((bf16*)(p.ws + WS_CAT) + (size_t)row * DM + h * 128);
    CAT[lane] = pk2(hv0 * rstd * on.x * sigmoidf_(bflo(zo)), hv1 * rstd * on.y * sigmoidf_(bfhi(zo)));
}
__device__ __forceinline__ void mlstm_local(const Params& p, int i, int item, unsigned char* smem) {
    const int tid = otid(), lane = tid & 63, wave = tid >> 6, fr = lane & 15, fq = lane >> 4;
    const int b = item >> 9, h = (item >> 7) & 3, c = item & 127, r0 = b * SEQL + c * 64;
    float* ws_l = (float*)smem;
    bf16* kT = (bf16*)(smem + 1024);
    bf16* vT = kT + 128 * 72;
    const float* G = (const float*)(p.ws + WS_GATES);
    const bf16* Z = (const bf16*)(p.ws + WS_ZU);
    if (wave == 0) {
        const float ig = G[(size_t)(r0 + lane) * 8 + h], lf = logsigmoidf(G[(size_t)(r0 + lane) * 8 + 4 + h]);
        const float bs = scan_add(lf, lane), bL = shi(bs, 63);
        const float a = bL - bs + ig, amax = wave_max(a);
        ws_l[lane] = __expf(a - amax);
        if (lane == 0) { float* CS = (float*)(p.ws + WS_CS); CS[item * 2] = bL; CS[item * 2 + 1] = amax; }
    }
    __syncthreads();
    { u32x4 wv[4];
#pragma unroll
      for (int it = 0; it < 4; ++it) { const int q = tid + it * NTHR, which = q >> 10, idx = q & 1023, s = idx & 63, ch = idx >> 6; wv[it] = *(const u32x4*)(Z + (size_t)(r0 + s) * ZW + (which ? 1024 : 512) + h * 128 + ch * 8); }
#pragma unroll
      for (int it = 0; it < 4; ++it) { const int q = tid + it * NTHR, which = q >> 10, idx = q & 1023, s = idx & 63, ch = idx >> 6; const u32x4 w = wv[it];
        bf16* dst = (which ? vT : kT) + (ch * 8) * 72 + s;
        if (which) {
            dst[0 * 72] = (bf16)(w.x & 0xffff); dst[1 * 72] = (bf16)(w.x >> 16); dst[2 * 72] = (bf16)(w.y & 0xffff); dst[3 * 72] = (bf16)(w.y >> 16);
            dst[4 * 72] = (bf16)(w.z & 0xffff); dst[5 * 72] = (bf16)(w.z >> 16); dst[6 * 72] = (bf16)(w.w & 0xffff); dst[7 * 72] = (bf16)(w.w >> 16);
        } else { const float sc = ws_l[s] * KSCALE;
            dst[0 * 72] = (bf16)f2bf(bflo(w.x) * sc); dst[1 * 72] = (bf16)f2bf(bfhi(w.x) * sc); dst[2 * 72] = (bf16)f2bf(bflo(w.y) * sc); dst[3 * 72] = (bf16)f2bf(bfhi(w.y) * sc);
            dst[4 * 72] = (bf16)f2bf(bflo(w.z) * sc); dst[5 * 72] = (bf16)f2bf(bfhi(w.z) * sc); dst[6 * 72] = (bf16)f2bf(bflo(w.w) * sc); dst[7 * 72] = (bf16)f2bf(bfhi(w.w) * sc); } } }
    __syncthreads();
    f32x4 acc[8];
#pragma unroll
    for (int mt = 0; mt < 8; ++mt) acc[mt] = (f32x4){0.f, 0.f, 0.f, 0.f};
#pragma unroll
    for (int ks = 0; ks < 2; ++ks) { const bf16x8 B = *(const bf16x8*)(vT + (16 * wave + fr) * 72 + 32 * ks + 8 * fq);
#pragma unroll
        for (int mt = 0; mt < 8; ++mt) { const bf16x8 A = *(const bf16x8*)(kT + (16 * mt + fr) * 72 + 32 * ks + 8 * fq); acc[mt] = __builtin_amdgcn_mfma_f32_16x16x32_bf16(A, B, acc[mt], 0, 0, 0); } }
    bf16* dCt = (bf16*)(p.ws + WS_DCT) + (size_t)item * 16384;
#pragma unroll
    for (int mt = 0; mt < 8; ++mt) *(u32x2*)(dCt + (16 * wave + fr) * 128 + 16 * mt + 4 * fq) = (u32x2){pk2_sw(acc[mt][0], acc[mt][1]), pk2_sw(acc[mt][2], acc[mt][3])};
    if (tid < 128) { float s = 0.f;
        for (int t = 0; t < 64; ++t) s += bf2f(kT[tid * 72 + t]);
        ((float*)(p.ws + WS_DN))[item * 128 + tid] = s; }
    __syncthreads();
}

__device__ __forceinline__ void mlstm_scan(const Params& p, int i, unsigned char* smem) {
    const float* CS = (const float*)(p.ws + WS_CS); const bf16* dCt = (const bf16*)(p.ws + WS_DCT); const float* DN = (const float*)(p.ws + WS_DN);
    bf16* CSt = (bf16*)(p.ws + WS_CST); float* NS = (float*)(p.ws + WS_NS); float* MS = (float*)(p.ws + WS_MS);
    for (int idx = obid() * NTHR + otid(); idx < 8 * 16384; idx += gridDim.x * NTHR) {
        const int bh = idx >> 14, e = idx & 16383;
        float* csl = (float*)smem;
        __syncthreads(); if (otid() < 256) csl[otid()] = CS[bh * 256 + otid()]; __syncthreads();
        float C = 0.f, m = 0.f, nacc = 0.f;
        float dv[16], dnv[16], dv2[16], dnv2[16];
#define SC_LD(D, DNV, c0_) do { _Pragma("unroll") for (int k_ = 0; k_ < 16; ++k_) { D[k_] = bf2f(dCt[(size_t)(bh * 128 + (c0_) + k_) * 16384 + e]); DNV[k_] = (e < 128) ? DN[(bh * 128 + (c0_) + k_) * 128 + e] : 0.f; } } while (0)
#define SC_RUN(D, DNV, c0_) do { _Pragma("unroll") for (int k_ = 0; k_ < 16; ++k_) { const int item = bh * 128 + (c0_) + k_; const float bL = csl[2 * ((c0_) + k_)], amax = csl[2 * ((c0_) + k_) + 1]; \
                CSt[(size_t)item * 16384 + e] = (bf16)f2bf(C); if (e < 128) NS[item * 128 + e] = nacc; if (e == 0) MS[item] = m; \
                const float mn = fmaxf(bL + m, amax), f1 = __expf(bL + m - mn), f2 = __expf(amax - mn); C = f1 * C + f2 * D[k_]; nacc = f1 * nacc + f2 * DNV[k_]; m = mn; } } while (0)
        SC_LD(dv, dnv, 0);
        for (int c0 = 0; c0 < 128; c0 += 32) {
            SC_LD(dv2, dnv2, c0 + 16);
            SC_RUN(dv, dnv, c0);
            if (c0 + 32 < 128) SC_LD(dv, dnv, c0 + 32);
            SC_RUN(dv2, dnv2, c0 + 16);
        }
#undef SC_LD
#undef SC_RUN
        const int b = bh >> 2, h = bh & 3; const size_t sidx = (size_t)((i * 2 + b) * 4 + h);
        p.out[O_PC + sidx * 16384 + (size_t)(e & 127) * 128 + (e >> 7)] = C;
        if (e < 128) p.out[O_PN + sidx * 128 + e] = nacc;
        if (e == 0) p.out[O_PM + sidx] = m;
    }
}

__device__ __forceinline__ void mlstm_out(const Params& p, int i, int item, unsigned char* smem) {
    const int tid = otid(), lane = tid & 63, wave = tid >> 6, fr = lane & 15, fq = lane >> 4;
    const int b = item >> 9, h = (item >> 7) & 3, c = item & 127, r0 = b * SEQL + c * 64;
    float* d_l = (float*)smem;
    float* M_l = d_l + 64;
    float* wg_l = d_l + 128;
    float* mt_l = d_l + 192;
    float* den_l = d_l + 256;
    float* rs_l = d_l + 320;
    float* qn_l = d_l + 448;
    bf16* q_l = (bf16*)(smem + 2048);
    bf16* k_l = q_l + 64 * 136;
    bf16* vT = k_l + 64 * 136;
    bf16* Sw = vT + 128 * 72;
    float* hbuf = (float*)(Sw + 64 * 72);
    const float* G = (const float*)(p.ws + WS_GATES);
    const bf16* Z = (const bf16*)(p.ws + WS_ZU);
    bf16x8 Bc[4];
    { const bf16* cp = (const bf16*)(p.ws + WS_CST) + (size_t)item * 16384 + (16 * wave + fr) * 128 + 8 * fq;
#pragma unroll
      for (int ks = 0; ks < 4; ++ks) Bc[ks] = *(const bf16x8*)(cp + 32 * ks); }
    if (wave == 0) {
        const float ig = G[(size_t)(r0 + lane) * 8 + h], lf = logsigmoidf(G[(size_t)(r0 + lane) * 8 + 4 + h]);
        const float bs = scan_add(lf, lane), d = ig - bs, gmax = scan_max(d, lane);
        const float mc = ((const float*)(p.ws + WS_MS))[item];
        const float Mt = fmaxf(mc, gmax);
        d_l[lane] = d; M_l[lane] = Mt; wg_l[lane] = __expf(mc - Mt); mt_l[lane] = bs + Mt;
    }
    { u32x4 wv[6];
#pragma unroll
      for (int it = 0; it < 6; ++it) { const int q = tid + it * NTHR, which = q >> 10, idx = q & 1023, s = (which == 2) ? (idx & 63) : (idx >> 4), ch = (which == 2) ? (idx >> 6) : (idx & 15); wv[it] = *(const u32x4*)(Z + (size_t)(r0 + s) * ZW + which * 512 + h * 128 + ch * 8); }
#pragma unroll
      for (int it = 0; it < 6; ++it) { const int q = tid + it * NTHR, which = q >> 10, idx = q & 1023, s = (which == 2) ? (idx & 63) : (idx >> 4), ch = (which == 2) ? (idx >> 6) : (idx & 15); const u32x4 w = wv[it];
        if (which == 0) *(u32x4*)(q_l + s * 136 + ch * 8) = w;
        else if (which == 1) { u32x4 o; o.x = pk2(bflo(w.x) * KSCALE, bfhi(w.x) * KSCALE); o.y = pk2(bflo(w.y) * KSCALE, bfhi(w.y) * KSCALE);
            o.z = pk2(bflo(w.z) * KSCALE, bfhi(w.z) * KSCALE); o.w = pk2(bflo(w.w) * KSCALE, bfhi(w.w) * KSCALE); *(u32x4*)(k_l + s * 136 + ch * 8) = o; }
        else { bf16* dst = vT + (ch * 8) * 72 + s;
            dst[0 * 72] = (bf16)(w.x & 0xffff); dst[1 * 72] = (bf16)(w.x >> 16); dst[2 * 72] = (bf16)(w.y & 0xffff); dst[3 * 72] = (bf16)(w.y >> 16);
            dst[4 * 72] = (bf16)(w.z & 0xffff); dst[5 * 72] = (bf16)(w.z >> 16); dst[6 * 72] = (bf16)(w.w & 0xffff); dst[7 * 72] = (bf16)(w.w >> 16); } } }
    __syncthreads();
    {
        const int mt = wave >> 1, nt0 = 2 * (wave & 1);
        f32x4 a2[2] = {(f32x4){0.f, 0.f, 0.f, 0.f}, (f32x4){0.f, 0.f, 0.f, 0.f}};
#pragma unroll
        for (int ks = 0; ks < 4; ++ks) { const bf16x8 A = *(const bf16x8*)(q_l + (16 * mt + fr) * 136 + 32 * ks + 8 * fq);
#pragma unroll
            for (int n = 0; n < 2; ++n) { const bf16x8 B = *(const bf16x8*)(k_l + (16 * (nt0 + n) + fr) * 136 + 32 * ks + 8 * fq); a2[n] = __builtin_amdgcn_mfma_f32_16x16x32_bf16(A, B, a2[n], 0, 0, 0); } }
        float rsum[4] = {0.f, 0.f, 0.f, 0.f};
#pragma unroll
        for (int n = 0; n < 2; ++n) { const int s = 16 * (nt0 + n) + fr; const float ds = d_l[s];
#pragma unroll
            for (int j = 0; j < 4; ++j) { const int t = 16 * mt + 4 * fq + j; const float wv = (s <= t) ? __expf(ds - M_l[t]) : 0.f; const float val = a2[n][j] * wv; rsum[j] += val; Sw[t * 72 + s] = (bf16)f2bf(val); } }
#pragma unroll
        for (int j = 0; j < 4; ++j) { float v = rsum[j]; v += shx(v, 1); v += shx(v, 2); v += shx(v, 4); v += shx(v, 8); if (fr == 0) rs_l[(wave & 1) * 64 + 16 * mt + 4 * fq + j] = v; }
        { const int t = tid >> 3, part = tid & 7; const float* NS = (const float*)(p.ws + WS_NS) + item * 128 + part * 16;
          const u32x4 qa = *(const u32x4*)(q_l + t * 136 + part * 16), qb = *(const u32x4*)(q_l + t * 136 + part * 16 + 8);
          const f32x4 n0 = *(const f32x4*)NS, n1 = *(const f32x4*)(NS + 4), n2 = *(const f32x4*)(NS + 8), n3 = *(const f32x4*)(NS + 12);
          float v = bflo(qa.x) * n0.x + bfhi(qa.x) * n0.y + bflo(qa.y) * n0.z + bfhi(qa.y) * n0.w + bflo(qa.z) * n1.x + bfhi(qa.z) * n1.y + bflo(qa.w) * n1.z + bfhi(qa.w) * n1.w
                  + bflo(qb.x) * n2.x + bfhi(qb.x) * n2.y + bflo(qb.y) * n2.z + bfhi(qb.y) * n2.w + bflo(qb.z) * n3.x + bfhi(qb.z) * n3.y + bflo(qb.w) * n3.z + bfhi(qb.w) * n3.w;
          v += shx(v, 1); v += shx(v, 2); v += shx(v, 4); if (part == 0) qn_l[t] = v; }
    }
    __syncthreads();
    if (tid < 64) { const int t = tid; const float den = wg_l[t] * qn_l[t] + (rs_l[t] + rs_l[64 + t]); den_l[t] = __builtin_amdgcn_rcpf(fmaxf(fabsf(den), __expf(-mt_l[t]))); }
    f32x4 acc[4];
#pragma unroll
    for (int mt = 0; mt < 4; ++mt) acc[mt] = (f32x4){0.f, 0.f, 0.f, 0.f};
#pragma unroll
    for (int ks = 0; ks < 4; ++ks) { const bf16x8 B = Bc[ks];
#pragma unroll
        for (int mt = 0; mt < 4; ++mt) { const bf16x8 A = *(const bf16x8*)(q_l + (16 * mt + fr) * 136 + 32 * ks + 8 * fq); acc[mt] = __builtin_amdgcn_mfma_f32_16x16x32_bf16(A, B, acc[mt], 0, 0, 0); } }
#pragma unroll
    for (int mt = 0; mt < 4; ++mt)
#pragma unroll
        for (int j = 0; j < 4; ++j) acc[mt][j] *= wg_l[16 * mt + 4 * fq + j];
#pragma unroll
    for (int ks = 0; ks < 2; ++ks) { const bf16x8 B = *(const bf16x8*)(vT + (16 * wave + fr) * 72 + 32 * ks + 8 * fq);
#pragma unroll
        for (int mt = 0; mt < 4; ++mt) { const bf16x8 A = *(const bf16x8*)(Sw + (16 * mt + fr) * 72 + 32 * ks + 8 * fq); acc[mt] = __builtin_amdgcn_mfma_f32_16x16x32_bf16(A, B, acc[mt], 0, 0, 0); } }
    __syncthreads();
#pragma unroll
    for (int mt = 0; mt < 4; ++mt)
#pragma unroll
        for (int j = 0; j < 4; ++j) { const int t = 16 * mt + 4 * fq + j; hbuf[t * 132 + 16 * wave + fr] = acc[mt][j] * den_l[t]; }
    __syncthreads();
    { unsigned zo[8]; const f32x2 on = *(const f32x2*)(p.in[17] + i * 512 + h * 128 + 2 * lane);
#pragma unroll
      for (int tt = 0; tt < 8; ++tt) zo[tt] = *(const unsigned*)(Z + (size_t)(r0 + 8 * wave + tt) * ZW + 1536 + h * 128 + 2 * lane);
#pragma unroll
      for (int tt = 0; tt < 8; ++tt) { const int t = 8 * wave + tt; const f32x2 hv = *(const f32x2*)(hbuf + t * 132 + 2 * lane); head_out(p, i, h, r0 + t, lane, hv.x, hv.y, zo[tt], on); } }
    __syncthreads();
}

__device__ __forceinline__ void mlstm_out2(const Params& p, int i, int itA, int itB, unsigned char* smem) {
    const int tid = otid(), lane = tid & 63, wave = tid >> 6, fr = lane & 15, fq = lane >> 4, hh = wave >> 2, wl = wave & 3, tl = tid & 255;
    const int item_ = hh ? itB : itA; const bool active = item_ < 1024; const int item = active ? item_ : 0;
    const int b = item >> 9, h = (item >> 7) & 3, c = item & 127, r0 = b * SEQL + c * 64;
    unsigned char* sb = smem + hh * 65536;
    float* d_l = (float*)sb;
    float* M_l = d_l + 64;
    float* wg_l = d_l + 128;
    float* mt_l = d_l + 192;
    float* den_l = d_l + 256;
    float* rs_l = d_l + 320;
    float* qn_l = d_l + 384;
    bf16* q_l = (bf16*)(sb + 2048);
    bf16* k_l = q_l + 64 * 136;
    float* hbuf = (float*)(sb + 2048);
    bf16* vT = k_l + 64 * 136;
    bf16* Sw = vT + 128 * 72;
    const float* G = (const float*)(p.ws + WS_GATES);
    const bf16* Z = (const bf16*)(p.ws + WS_ZU);
    bf16x8 Bc[2][4];
#pragma unroll
    for (int n = 0; n < 2; ++n) { const bf16* cp = (const bf16*)(p.ws + WS_CST) + (size_t)item * 16384 + (16 * (2 * wl + n) + fr) * 128 + 8 * fq;
#pragma unroll
        for (int ks = 0; ks < 4; ++ks) Bc[n][ks] = *(const bf16x8*)(cp + 32 * ks); }
    if (wl == 0) {
        const float ig = G[(size_t)(r0 + lane) * 8 + h], lf = logsigmoidf(G[(size_t)(r0 + lane) * 8 + 4 + h]);
        const float bs = scan_add(lf, lane), d = ig - bs, gmax = scan_max(d, lane);
        const float mc = ((const float*)(p.ws + WS_MS))[item];
        const float Mt = fmaxf(mc, gmax);
        d_l[lane] = d; M_l[lane] = Mt; wg_l[lane] = __expf(mc - Mt); mt_l[lane] = bs + Mt;
    }
    { u32x4 wv[12];
#pragma unroll
      for (int it = 0; it < 12; ++it) { const int q = tl + it * 256, which = q >> 10, idx = q & 1023, s = (which == 2) ? (idx & 63) : (idx >> 4), ch = (which == 2) ? (idx >> 6) : (idx & 15); wv[it] = *(const u32x4*)(Z + (size_t)(r0 + s) * ZW + which * 512 + h * 128 + ch * 8); }
#pragma unroll
      for (int it = 0; it < 12; ++it) { const int q = tl + it * 256, which = q >> 10, idx = q & 1023, s = (which == 2) ? (idx & 63) : (idx >> 4), ch = (which == 2) ? (idx >> 6) : (idx & 15); const u32x4 w = wv[it];
        if (which == 0) *(u32x4*)(q_l + s * 136 + ch * 8) = w;
        else if (which == 1) { u32x4 o; o.x = pk2(bflo(w.x) * KSCALE, bfhi(w.x) * KSCALE); o.y = pk2(bflo(w.y) * KSCALE, bfhi(w.y) * KSCALE);
            o.z = pk2(bflo(w.z) * KSCALE, bfhi(w.z) * KSCALE); o.w = pk2(bflo(w.w) * KSCALE, bfhi(w.w) * KSCALE); *(u32x4*)(k_l + s * 136 + ch * 8) = o; }
        else { bf16* dst = vT + (ch * 8) * 72 + s;
            dst[0 * 72] = (bf16)(w.x & 0xffff); dst[1 * 72] = (bf16)(w.x >> 16); dst[2 * 72] = (bf16)(w.y & 0xffff); dst[3 * 72] = (bf16)(w.y >> 16);
            dst[4 * 72] = (bf16)(w.z & 0xffff); dst[5 * 72] = (bf16)(w.z >> 16); dst[6 * 72] = (bf16)(w.w & 0xffff); dst[7 * 72] = (bf16)(w.w >> 16); } } }
    __syncthreads();
    {
        const int mt = wl;
        f32x4 a4[4];
#pragma unroll
        for (int n = 0; n < 4; ++n) a4[n] = (f32x4){0.f, 0.f, 0.f, 0.f};
#pragma unroll
        for (int ks = 0; ks < 4; ++ks) { const bf16x8 A = *(const bf16x8*)(q_l + (16 * mt + fr) * 136 + 32 * ks + 8 * fq);
#pragma unroll
            for (int n = 0; n < 4; ++n) if (n <= mt) { const bf16x8 B = *(const bf16x8*)(k_l + (16 * n + fr) * 136 + 32 * ks + 8 * fq); a4[n] = __builtin_amdgcn_mfma_f32_16x16x32_bf16(A, B, a4[n], 0, 0, 0); } }
        float rsum[4] = {0.f, 0.f, 0.f, 0.f};
#pragma unroll
        for (int n = 0; n < 4; ++n) { const int s = 16 * n + fr; const float ds = d_l[s];
#pragma unroll
            for (int j = 0; j < 4; ++j) { const int t = 16 * mt + 4 * fq + j; const float wv = (s <= t) ? __expf(ds - M_l[t]) : 0.f; const float val = a4[n][j] * wv; rsum[j] += val; Sw[t * 72 + s] = (bf16)f2bf(val); } }
#pragma unroll
        for (int j = 0; j < 4; ++j) { float v = rsum[j]; v += shx(v, 1); v += shx(v, 2); v += shx(v, 4); v += shx(v, 8); if (fr == 0) rs_l[16 * mt + 4 * fq + j] = v; }
        { const int t = tl >> 2, part = tl & 3; const float* NS = (const float*)(p.ws + WS_NS) + item * 128 + part * 32; float v = 0.f;
#pragma unroll
          for (int g = 0; g < 4; ++g) { const u32x4 qa = *(const u32x4*)(q_l + t * 136 + part * 32 + 8 * g); const f32x4 n0 = *(const f32x4*)(NS + 8 * g), n1 = *(const f32x4*)(NS + 8 * g + 4);
              v += bflo(qa.x) * n0.x + bfhi(qa.x) * n0.y + bflo(qa.y) * n0.z + bfhi(qa.y) * n0.w + bflo(qa.z) * n1.x + bfhi(qa.z) * n1.y + bflo(qa.w) * n1.z + bfhi(qa.w) * n1.w; }
          v += shx(v, 1); v += shx(v, 2); if (part == 0) qn_l[t] = v; }
    }
    __syncthreads();
    if (tl < 64) { const int t = tl; const float den = wg_l[t] * qn_l[t] + rs_l[t]; den_l[t] = __builtin_amdgcn_rcpf(fmaxf(fabsf(den), __expf(-mt_l[t]))); }
    f32x4 acc[2][4];
#pragma unroll
    for (int n = 0; n < 2; ++n)
#pragma unroll
        for (int mt = 0; mt < 4; ++mt) acc[n][mt] = (f32x4){0.f, 0.f, 0.f, 0.f};
#pragma unroll
    for (int ks = 0; ks < 4; ++ks)
#pragma unroll
        for (int mt = 0; mt < 4; ++mt) { const bf16x8 A = *(const bf16x8*)(q_l + (16 * mt + fr) * 136 + 32 * ks + 8 * fq);
#pragma unroll
            for (int n = 0; n < 2; ++n) acc[n][mt] = __builtin_amdgcn_mfma_f32_16x16x32_bf16(A, Bc[n][ks], acc[n][mt], 0, 0, 0); }
#pragma unroll
    for (int mt = 0; mt < 4; ++mt)
#pragma unroll
        for (int j = 0; j < 4; ++j) { const float wgv = wg_l[16 * mt + 4 * fq + j]; acc[0][mt][j] *= wgv; acc[1][mt][j] *= wgv; }
#pragma unroll
    for (int ks = 0; ks < 2; ++ks)
#pragma unroll
        for (int mt = 0; mt < 4; ++mt) { const bf16x8 A = *(const bf16x8*)(Sw + (16 * mt + fr) * 72 + 32 * ks + 8 * fq);
#pragma unroll
            for (int n = 0; n < 2; ++n) { const bf16x8 B = *(const bf16x8*)(vT + (16 * (2 * wl + n) + fr) * 72 + 32 * ks + 8 * fq); acc[n][mt] = __builtin_amdgcn_mfma_f32_16x16x32_bf16(A, B, acc[n][mt], 0, 0, 0); } }
    __syncthreads();
#pragma unroll
    for (int n = 0; n < 2; ++n)
#pragma unroll
        for (int mt = 0; mt < 4; ++mt)
#pragma unroll
            for (int j = 0; j < 4; ++j) { const int t = 16 * mt + 4 * fq + j; hbuf[t * 132 + 16 * (2 * wl + n) + fr] = acc[n][mt][j] * den_l[t]; }
    __syncthreads();
    { unsigned zo[16]; const f32x2 on = *(const f32x2*)(p.in[17] + i * 512 + h * 128 + 2 * lane);
#pragma unroll
      for (int tt = 0; tt < 16; ++tt) zo[tt] = *(const unsigned*)(Z + (size_t)(r0 + 16 * wl + tt) * ZW + 1536 + h * 128 + 2 * lane);
#pragma unroll
      for (int tt = 0; tt < 16; ++tt) { const int t = 16 * wl + tt; const f32x2 hv = *(const f32x2*)(hbuf + t * 132 + 2 * lane);
          const float ss = wave_sum(hv.x * hv.x + hv.y * hv.y); const float rstd = rsqrtf(ss * (1.f / 128.f) + EPS);
          if (active) { unsigned* CAT = (unsigned*)((bf16*)(p.ws + WS_CAT) + (size_t)(r0 + t) * DM + h * 128);
              CAT[lane] = pk2(hv.x * rstd * on.x * sigmoidf_(bflo(zo[tt])), hv.y * rstd * on.y * sigmoidf_(bfhi(zo[tt]))); } } }
    __syncthreads();
}

__device__ __forceinline__ void mlstm_sample(const Params& p, int i, int item, unsigned char* smem) {
    const int tid = otid(), lane = tid & 63, wave = tid >> 6;
    const int s = item >> 2, h = item & 3, r0 = RP + 8 * s;
    float* qq = (float*)smem;
    float* kk = qq + 1024;
    float* vv = kk + 1024;
    float* qT = vv + 1024;
    float* kwT = qT + 1024;
    float* part = kwT + 1024;
    float* S_l = part + 4096;
    float* sc = S_l + 64;
    const bf16* Z = (const bf16*)(p.ws + WS_ZU);
    const float* G = (const float*)(p.ws + WS_GATES);
    const size_t sidx = (size_t)((i * 128 + s) * 4 + h);
    const float* n0 = p.in[5] + sidx * 128;
    { bf16 zv[6];
#pragma unroll
      for (int it = 0; it < 6; ++it) { const int q = tid + it * NTHR, which = q >> 10, t = (q >> 7) & 7, d = q & 127; zv[it] = Z[(size_t)(r0 + t) * ZW + which * 512 + h * 128 + d]; }
#pragma unroll
      for (int it = 0; it < 6; ++it) { const int q = tid + it * NTHR, which = q >> 10; float v = bf2f(zv[it]); if (which == 1) v *= KSCALE; qq[q] = v; } }
    if (wave == 0) {
        const int t = lane & 7;
        const float ig = G[(size_t)(r0 + t) * 8 + h], lf = logsigmoidf(G[(size_t)(r0 + t) * 8 + 4 + h]);
        float bs = 0.f;
        for (int u = 0; u < 8; ++u) { const float x = shi(lf, u); if (u <= t) bs += x; }
        const float d = ig - bs; float gmax = -INFINITY;
        for (int u = 0; u < 8; ++u) { const float x = shi(d, u); if (u <= t) gmax = fmaxf(gmax, x); }
        const float m0 = p.in[6][sidx];
        const float Mt = fmaxf(m0, gmax), bL = shi(bs, 7), a = bL - bs + ig;
        float amax = -INFINITY;
        for (int u = 0; u < 8; ++u) amax = fmaxf(amax, shi(a, u));
        const float mnew = fmaxf(bL + m0, amax);
        if (lane < 8) { sc[t] = d; sc[8 + t] = Mt; sc[16 + t] = __expf(m0 - Mt); sc[24 + t] = bs + Mt; sc[32 + t] = __expf(a - mnew); }
        if (lane == 0) { sc[56] = __expf(bL + m0 - mnew); sc[57] = mnew; }
    }
    __syncthreads();
    { const int pr = tid >> 3, part = tid & 7, t = pr >> 3, u = pr & 7; float dot = 0.f;
#pragma unroll
        for (int d = 0; d < 16; ++d) dot += qq[t * 128 + part * 16 + d] * kk[u * 128 + part * 16 + d];
        dot += shx(dot, 1); dot += shx(dot, 2); dot += shx(dot, 4);
        if (part == 0) S_l[pr] = (u <= t) ? dot * __expf(sc[u] - sc[8 + t]) : 0.f; }
    if (tid < 64) { const int t = tid >> 3, part = tid & 7; float dot = 0.f;
#pragma unroll
        for (int d = 0; d < 16; ++d) dot += qq[t * 128 + part * 16 + d] * n0[part * 16 + d];
        dot += shx(dot, 1); dot += shx(dot, 2); dot += shx(dot, 4);
        if (part == 0) sc[40 + t] = dot; }
    for (int idx = tid; idx < 1024; idx += NTHR) { const int dk = idx >> 3, t = idx & 7; qT[idx] = qq[t * 128 + dk]; kwT[idx] = kk[t * 128 + dk] * sc[32 + t]; }
    __syncthreads();
    if (tid < 8) { float rs = 0.f; for (int u = 0; u < 8; ++u) rs += S_l[tid * 8 + u];
        const float den = sc[16 + tid] * sc[40 + tid] + rs; sc[48 + tid] = fmaxf(fabsf(den), __expf(-sc[24 + tid])); }
    {
        const int e = tid & 127, g = tid >> 7; const float wc = sc[56];
        float vr[8], acc[8];
#pragma unroll
        for (int u = 0; u < 8; ++u) { vr[u] = vv[u * 128 + e]; acc[u] = 0.f; }
        const float* Cin = p.in[4] + sidx * 16384; float* Cout = p.out + O_SC + sidx * 16384;
        float cin[32];
#pragma unroll
        for (int k = 0; k < 32; ++k) cin[k] = Cin[(g * 32 + k) * 128 + e];
#pragma unroll
        for (int k = 0; k < 32; ++k) { const int dk = g * 32 + k; const float cv = cin[k];
            const f32x4 q0 = *(const f32x4*)(qT + dk * 8), q1 = *(const f32x4*)(qT + dk * 8 + 4), k0 = *(const f32x4*)(kwT + dk * 8), k1 = *(const f32x4*)(kwT + dk * 8 + 4);
            acc[0] += q0.x * cv; acc[1] += q0.y * cv; acc[2] += q0.z * cv; acc[3] += q0.w * cv; acc[4] += q1.x * cv; acc[5] += q1.y * cv; acc[6] += q1.z * cv; acc[7] += q1.w * cv;
            float cn = wc * cv;
            cn += k0.x * vr[0] + k0.y * vr[1] + k0.z * vr[2] + k0.w * vr[3] + k1.x * vr[4] + k1.y * vr[5] + k1.z * vr[6] + k1.w * vr[7];
            Cout[dk * 128 + e] = cn; }
#pragma unroll
        for (int u = 0; u < 8; ++u) part[(g * 8 + u) * 128 + e] = acc[u];
        if (tid < 128) { float nn = wc * n0[tid];
#pragma unroll
            for (int u = 0; u < 8; ++u) nn += kwT[tid * 8 + u];
            p.out[O_SN + sidx * 128 + tid] = nn; }
        if (tid == 0) p.out[O_SM + sidx] = sc[57];
    }
    __syncthreads();
    {
        const int t = wave; float hv[2];
        const unsigned zo = *(const unsigned*)(Z + (size_t)(r0 + t) * ZW + 1536 + h * 128 + 2 * lane); const f32x2 on = *(const f32x2*)(p.in[17] + i * 512 + h * 128 + 2 * lane);
#pragma unroll
        for (int k = 0; k < 2; ++k) { const int e = 2 * lane + k;
            float num = (part[(0 * 8 + t) * 128 + e] + part[(1 * 8 + t) * 128 + e]) + (part[(2 * 8 + t) * 128 + e] + part[(3 * 8 + t) * 128 + e]);
            num *= sc[16 + t];
#pragma unroll
            for (int u = 0; u < 8; ++u) num += S_l[t * 8 + u] * vv[u * 128 + e];
            hv[k] = num / sc[48 + t]; }
        head_out(p, i, h, r0 + t, lane, hv[0], hv[1], zo, on);
    }
    __syncthreads();
}

__device__ __forceinline__ void unpack8(const u32x4 w, float (&v)[8]) { v[0] = bflo(w.x); v[1] = bfhi(w.x); v[2] = bflo(w.y); v[3] = bfhi(w.y); v[4] = bflo(w.z); v[5] = bfhi(w.z); v[6] = bflo(w.w); v[7] = bfhi(w.w); }
__device__ __forceinline__ void ld8f(const float* s, float (&v)[8]) { const f32x4 a = *(const f32x4*)s, b = *(const f32x4*)(s + 4); v[0] = a.x; v[1] = a.y; v[2] = a.z; v[3] = a.w; v[4] = b.x; v[5] = b.y; v[6] = b.z; v[7] = b.w; }
__device__ __forceinline__ void st8f(float* d, const float (&v)[8]) { *(f32x4*)d = (f32x4){v[0], v[1], v[2], v[3]}; *(f32x4*)(d + 4) = (f32x4){v[4], v[5], v[6], v[7]}; }
__device__ __forceinline__ void shortconv(const Params& p, int i) {
    const bf16* Z = (const bf16*)(p.ws + WS_ZU); bf16* CAT = (bf16*)(p.ws + WS_CAT);
    const float* cw = p.in[18] + i * 3 * 512;
    float cw0[8], cw1[8], cw2[8]; int chc = -1;
    for (int idx = obid() * NTHR + otid(); idx < R * 64; idx += gridDim.x * NTHR) {
        const int row = idx >> 6, ch = (idx & 63) * 8;
        if (ch != chc) { chc = ch; ld8f(cw + ch, cw0); ld8f(cw + 512 + ch, cw1); ld8f(cw + 1024 + ch, cw2); }
        const bool prm = row < RP; const int t = prm ? (row & (SEQL - 1)) : ((row - RP) & 7), S = prm ? SEQL : 8, sq = prm ? (row >> 13) : ((row - RP) >> 3);
        float pr[3][8];
#pragma unroll
        for (int j = 0; j < 3; ++j) { const int tt = t - 2 + j;
            if (tt >= 0) { const bf16* zr = Z + (size_t)(row - 2 + j) * ZW; const u32x4 a = *(const u32x4*)(zr + 2560 + ch), b = *(const u32x4*)(zr + 3072 + ch);
                pr[j][0] = bflo(a.x) * bflo(b.x); pr[j][1] = bfhi(a.x) * bfhi(b.x); pr[j][2] = bflo(a.y) * bflo(b.y); pr[j][3] = bfhi(a.y) * bfhi(b.y);
                pr[j][4] = bflo(a.z) * bflo(b.z); pr[j][5] = bfhi(a.z) * bfhi(b.z); pr[j][6] = bflo(a.w) * bflo(b.w); pr[j][7] = bfhi(a.w) * bfhi(b.w); }
            else if (!prm) { const float* st = p.in[7] + ((size_t)(i * 128 + sq) * 2 + (2 + tt)) * 512 + ch; const f32x4 a = *(const f32x4*)st, b = *(const f32x4*)(st + 4);
                pr[j][0] = a.x; pr[j][1] = a.y; pr[j][2] = a.z; pr[j][3] = a.w; pr[j][4] = b.x; pr[j][5] = b.y; pr[j][6] = b.z; pr[j][7] = b.w; }
            else {
#pragma unroll
                for (int e = 0; e < 8; ++e) pr[j][e] = 0.f; } }
        const u32x4 zb = *(const u32x4*)(Z + (size_t)row * ZW + 2048 + ch);
        float zbf[8] = {bflo(zb.x), bfhi(zb.x), bflo(zb.y), bfhi(zb.y), bflo(zb.z), bfhi(zb.z), bflo(zb.w), bfhi(zb.w)};
        float o[8];
#pragma unroll
        for (int e = 0; e < 8; ++e) o[e] = zbf[e] * (cw0[e] * pr[0][e] + cw1[e] * pr[1][e] + cw2[e] * pr[2][e]);
        *(u32x4*)(CAT + (size_t)row * DM + 512 + ch) = (u32x4){pk2(o[0], o[1]), pk2(o[2], o[3]), pk2(o[4], o[5]), pk2(o[6], o[7])};
        if (t >= S - 2) { float* dst = p.out + (prm ? O_PSC + ((size_t)(i * 2 + sq) * 2 + (t - (S - 2))) * 512 : O_SSC + ((size_t)(i * 128 + sq) * 2 + (t - (S - 2))) * 512) + ch;
            *(f32x4*)dst = (f32x4){pr[2][0], pr[2][1], pr[2][2], pr[2][3]}; *(f32x4*)(dst + 4) = (f32x4){pr[2][4], pr[2][5], pr[2][6], pr[2][7]}; }
    }
}


__device__ __forceinline__ void cache_shift(const Params& p, int jl, int bsel, int nsel) {
    const int tid = otid();
    for (int idx = bsel * NTHR + tid; idx < 2 * 128 * 7680; idx += nsel * NTHR) { const int kv = idx / (128 * 7680), r = idx - kv * (128 * 7680), s = r / 7680, q = r - s * 7680;
        const float* src = (kv ? p.in[9] : p.in[8]) + ((size_t)(jl * 128 + s) * 128 + 8) * 256 + 4 * q; float* dst = p.out + (kv ? O_SWV : O_SWK) + ((size_t)(jl * 128 + s) * 128) * 256 + 4 * q;
        *(f32x4*)dst = *(const f32x4*)src; }
}

template <int NH>
__device__ __forceinline__ void attn_wave(const bf16* K_l, const bf16* Vt_l, int ldvt, int kt0, const bf16x8 (*Bq)[2], int qidx, int kmin, const float* sinkp, bf16* orow, bool store, int fr, int fq) {
    f32x4 s[NH][9];
    float sk[NH], mx[NH];
#pragma unroll
    for (int h = 0; h < NH; ++h) { sk[h] = sinkp[h] * 1.4426950408889634f; mx[h] = sk[h]; }
#pragma unroll
    for (int kt = 0; kt < 9; ++kt) {
        const bf16x8 A0 = *(const bf16x8*)(K_l + (16 * (kt0 + kt) + fr) * 72 + 8 * fq), A1 = *(const bf16x8*)(K_l + (16 * (kt0 + kt) + fr) * 72 + 32 + 8 * fq);
#pragma unroll
        for (int h = 0; h < NH; ++h) { f32x4 a = (f32x4){0.f, 0.f, 0.f, 0.f};
            a = __builtin_amdgcn_mfma_f32_16x16x32_bf16(A0, Bq[h][0], a, 0, 0, 0); a = __builtin_amdgcn_mfma_f32_16x16x32_bf16(A1, Bq[h][1], a, 0, 0, 0);
#pragma unroll
            for (int j = 0; j < 4; ++j) { const int kidx = 16 * (kt0 + kt) + 4 * fq + j;
                const bool valid = (kt == 0) ? ((kidx > qidx - 128) && (kidx >= kmin)) : (kt == 8) ? (kidx <= qidx) : (kidx >= kmin);
                a[j] = valid ? a[j] * 0.18033688011112042f : -INFINITY; mx[h] = fmaxf(mx[h], a[j]); }
            s[h][kt] = a; } }
    float inv[NH];
#pragma unroll
    for (int h = 0; h < NH; ++h) { mx[h] = fmaxf(mx[h], shx(mx[h], 16)); mx[h] = fmaxf(mx[h], shx(mx[h], 32)); }
#pragma unroll
    for (int h = 0; h < NH; ++h) { float sum = 0.f;
#pragma unroll
        for (int kt = 0; kt < 9; ++kt)
#pragma unroll
            for (int j = 0; j < 4; ++j) { const float e = __builtin_amdgcn_exp2f(s[h][kt][j] - mx[h]); s[h][kt][j] = e; sum += e; }
        inv[h] = sum; }
#pragma unroll
    for (int h = 0; h < NH; ++h) { float sum = inv[h]; sum += shx(sum, 16); sum += shx(sum, 32); inv[h] = __builtin_amdgcn_rcpf(sum + __builtin_amdgcn_exp2f(sk[h] - mx[h])); }
    bf16x8 Bp[NH][5];
#pragma unroll
    for (int h = 0; h < NH; ++h)
#pragma unroll
        for (int pp = 0; pp < 5; ++pp) { u32x4 w; w.x = pk2(s[h][2 * pp][0], s[h][2 * pp][1]); w.y = pk2(s[h][2 * pp][2], s[h][2 * pp][3]);
            if (pp < 4) { w.z = pk2(s[h][2 * pp + 1][0], s[h][2 * pp + 1][1]); w.w = pk2(s[h][2 * pp + 1][2], s[h][2 * pp + 1][3]); } else { w.z = 0u; w.w = 0u; }
            Bp[h][pp] = __builtin_bit_cast(bf16x8, w); }
#pragma unroll
    for (int dt = 0; dt < 4; ++dt) { f32x4 a[NH];
#pragma unroll
        for (int h = 0; h < NH; ++h) a[h] = (f32x4){0.f, 0.f, 0.f, 0.f};
#pragma unroll
        for (int pp = 0; pp < 5; ++pp) { const bf16* vp = Vt_l + (16 * dt + fr) * ldvt + 16 * (kt0 + 2 * pp) + 4 * fq;
            const u32x2 lo = *(const u32x2*)vp, hi = *(const u32x2*)(vp + 16); const bf16x8 V = __builtin_bit_cast(bf16x8, (u32x4){lo.x, lo.y, hi.x, hi.y});
#pragma unroll
            for (int h = 0; h < NH; ++h) a[h] = __builtin_amdgcn_mfma_f32_16x16x32_bf16(V, Bp[h][pp], a[h], 0, 0, 0); }
        if (store) {
#pragma unroll
            for (int h = 0; h < NH; ++h) *(u32x2*)(orow + 64 * h + 16 * dt + 4 * fq) = (u32x2){pk2(a[h][0] * inv[h], a[h][1] * inv[h]), pk2(a[h][2] * inv[h], a[h][3] * inv[h])}; } }
}

__device__ __forceinline__ void attn_phase(const Params& p, int jl, unsigned char* smem) {
    const bf16* Z = (const bf16*)(p.ws + WS_ZU); bf16* CAT = (bf16*)(p.ws + WS_CAT);
    const float* sinkp = p.in[23] + jl * 16;
    for (int u = obid(); u < 768; u += gridDim.x) { const int tidu = otid(), lane = tidu & 63, wave = tidu >> 6, fr = lane & 15, fq = lane >> 4;
        if (u < 512) {
            const int b = u >> 8, kvh = (u >> 6) & 3, qb = u & 63, q0 = qb * 128, rb = b * SEQL;
            bf16x8 Bq[4][2];
            { const bf16* qp = Z + (size_t)(rb + q0 + 16 * wave + fr) * QKVW + kvh * 256 + 8 * fq;
#pragma unroll
              for (int hq = 0; hq < 4; ++hq) { Bq[hq][0] = *(const bf16x8*)(qp + hq * 64); Bq[hq][1] = *(const bf16x8*)(qp + hq * 64 + 32); } }
            bf16* K_l = (bf16*)smem;
            bf16* Vt_l = K_l + 256 * 72;
            { u32x4 wv[8];
#pragma unroll
              for (int it = 0; it < 8; ++it) { const int q = tidu + it * NTHR, which = q >> 11, idx = q & 2047, kidx = which ? (idx & 255) : (idx >> 3), ch = which ? (idx >> 8) : (idx & 7); const int pos = q0 - 128 + kidx;
                wv[it] = (u32x4){0u, 0u, 0u, 0u};
                if (pos >= 0) wv[it] = *(const u32x4*)(Z + (size_t)(rb + pos) * QKVW + (which ? 1280 : 1024) + kvh * 64 + ch * 8); }
#pragma unroll
              for (int it = 0; it < 8; ++it) { const int q = tidu + it * NTHR, which = q >> 11, idx = q & 2047, kidx = which ? (idx & 255) : (idx >> 3), ch = which ? (idx >> 8) : (idx & 7); const u32x4 w = wv[it];
                if (!which) *(u32x4*)(K_l + kidx * 72 + ch * 8) = w;
                else { bf16* dst = Vt_l + (ch * 8) * 296 + kidx;
                    dst[0 * 296] = (bf16)(w.x & 0xffff); dst[1 * 296] = (bf16)(w.x >> 16); dst[2 * 296] = (bf16)(w.y & 0xffff); dst[3 * 296] = (bf16)(w.y >> 16);
                    dst[4 * 296] = (bf16)(w.z & 0xffff); dst[5 * 296] = (bf16)(w.z >> 16); dst[6 * 296] = (bf16)(w.w & 0xffff); dst[7 * 296] = (bf16)(w.w >> 16); } } }
            for (int q = tidu; q < 64 * 32; q += NTHR) Vt_l[(q >> 5) * 296 + 256 + (q & 31)] = 0;
            __syncthreads();
            const int row = rb + q0 + 16 * wave + fr;
#pragma unroll
            for (int hg = 0; hg < 2; ++hg) { const int h = kvh * 4 + 2 * hg;
                attn_wave<2>(K_l, Vt_l, 296, wave, Bq + 2 * hg, 128 + 16 * wave + fr, qb == 0 ? 128 : 0, sinkp + h, CAT + (size_t)row * DM + h * 64, true, fr, fq); }
            __syncthreads();
        } else {
            const int us = u - 512, s = us >> 1, kvp = us & 1;
            bf16x8 Bq1[2];
            { const bf16* qp = Z + (size_t)(RP + 8 * s + (fr & 7)) * QKVW + (8 * kvp + wave) * 64 + 8 * fq; Bq1[0] = *(const bf16x8*)qp; Bq1[1] = *(const bf16x8*)(qp + 32); }
            bf16* K_l = (bf16*)smem;
            bf16* Vt_l = K_l + 2 * 144 * 72;
            { f32x4 va[9], vb[9];
              const float* ck = p.in[8] + ((size_t)(jl * 128 + s) * 128) * 256; const float* cv = p.in[9] + ((size_t)(jl * 128 + s) * 128) * 256;
#pragma unroll
              for (int it = 0; it < 9; ++it) { const int q = tidu + it * NTHR, which = q / 2304, r = q - which * 2304, kvl = r / 1152, r2 = r - kvl * 1152, kidx = which ? (r2 % 144) : (r2 >> 3), ch = which ? (r2 / 144) : (r2 & 7); const int kvh = 2 * kvp + kvl;
                va[it] = (f32x4){0.f, 0.f, 0.f, 0.f}; vb[it] = va[it];
                if (kidx < 128) { const float* src = (which ? cv : ck) + (size_t)kidx * 256 + kvh * 64 + ch * 8; va[it] = *(const f32x4*)src; vb[it] = *(const f32x4*)(src + 4); }
                else if (kidx < 136) { const u32x4 w = *(const u32x4*)(Z + (size_t)(RP + 8 * s + kidx - 128) * QKVW + (which ? 1280 : 1024) + kvh * 64 + ch * 8);
                    va[it] = (f32x4){bflo(w.x), bfhi(w.x), bflo(w.y), bfhi(w.y)}; vb[it] = (f32x4){bflo(w.z), bfhi(w.z), bflo(w.w), bfhi(w.w)}; } }
#pragma unroll
              for (int it = 0; it < 9; ++it) { const int q = tidu + it * NTHR, which = q / 2304, r = q - which * 2304, kvl = r / 1152, r2 = r - kvl * 1152, kidx = which ? (r2 % 144) : (r2 >> 3), ch = which ? (r2 / 144) : (r2 & 7);
                const f32x4 a = va[it], c = vb[it];
                if (!which) *(u32x4*)(K_l + (kvl * 144 + kidx) * 72 + ch * 8) = (u32x4){pk2(a[0], a[1]), pk2(a[2], a[3]), pk2(c[0], c[1]), pk2(c[2], c[3])};
                else { bf16* dst = Vt_l + (kvl * 64 + ch * 8) * 168 + kidx; const unsigned p0 = pk2(a[0], a[1]), p1 = pk2(a[2], a[3]), p2 = pk2(c[0], c[1]), p3 = pk2(c[2], c[3]);
                    dst[0 * 168] = (bf16)(p0 & 0xffff); dst[1 * 168] = (bf16)(p0 >> 16); dst[2 * 168] = (bf16)(p1 & 0xffff); dst[3 * 168] = (bf16)(p1 >> 16);
                    dst[4 * 168] = (bf16)(p2 & 0xffff); dst[5 * 168] = (bf16)(p2 >> 16); dst[6 * 168] = (bf16)(p3 & 0xffff); dst[7 * 168] = (bf16)(p3 >> 16); } } }
            for (int q = tidu; q < 2 * 64 * 16; q += NTHR) Vt_l[(q >> 4) * 168 + 144 + (q & 15)] = 0;
            __syncthreads();
            const int kvl = wave >> 2, h = 8 * kvp + wave, row = RP + 8 * s + (fr & 7);
            attn_wave<1>(K_l + kvl * 144 * 72, Vt_l + kvl * 64 * 168, 168, 0, &Bq1, 128 + (fr & 7), 0, sinkp + h, CAT + (size_t)row * DM + h * 64, fr < 8, fr, fq);
            __syncthreads();
        }
    }
}

__device__ __forceinline__ void ffnfix_phase(const Params& p, int l) {
    const bf16* UB = (const bf16*)(p.ws + WS_UB); bf16* ACT = (bf16*)(p.ws + WS_ACT);
    const float* cw = p.in[26] + (size_t)l * 3 * FF2;
    for (int idx = obid() * NTHR + otid(); idx < 256 * 352; idx += gridDim.x * NTHR) {
        const int hr = idx / 352, cc = idx - hr * 352, col = cc * 8, hh = hr >> 1, rr = hr & 1;
        const bool seqstart = (hh & 63) == 0;
        const bf16* own0 = UB + (size_t)(hh * 4 + 0) * FF2; const bf16* own1 = UB + (size_t)(hh * 4 + 1) * FF2;
        const bf16* pm2 = UB + (size_t)((hh - 1) * 4 + 2) * FF2; const bf16* pm1 = UB + (size_t)((hh - 1) * 4 + 3) * FF2;
        float g2[8], g1[8], g0[8], a2[8], a1[8], a0[8];
        if (rr == 0) {
            if (seqstart) {
#pragma unroll
                for (int e = 0; e < 8; ++e) { g2[e] = 0.f; g1[e] = 0.f; a2[e] = 0.f; a1[e] = 0.f; } }
            else { unpack8(*(const u32x4*)(pm2 + col), g2); unpack8(*(const u32x4*)(pm2 + FF + col), a2); unpack8(*(const u32x4*)(pm1 + col), g1); unpack8(*(const u32x4*)(pm1 + FF + col), a1); }
            unpack8(*(const u32x4*)(own0 + col), g0); unpack8(*(const u32x4*)(own0 + FF + col), a0);
        } else {
            if (seqstart) {
#pragma unroll
                for (int e = 0; e < 8; ++e) { g2[e] = 0.f; a2[e] = 0.f; } }
            else { unpack8(*(const u32x4*)(pm1 + col), g2); unpack8(*(const u32x4*)(pm1 + FF + col), a2); }
            unpack8(*(const u32x4*)(own0 + col), g1); unpack8(*(const u32x4*)(own0 + FF + col), a1);
            unpack8(*(const u32x4*)(own1 + col), g0); unpack8(*(const u32x4*)(own1 + FF + col), a0);
        }
        float wg[3][8], wa[3][8];
#pragma unroll
        for (int j = 0; j < 3; ++j) { ld8f(cw + j * FF2 + col, wg[j]); ld8f(cw + j * FF2 + FF + col, wa[j]); }
        float o[8];
#pragma unroll
        for (int e = 0; e < 8; ++e) { const float cgv = wg[0][e] * g2[e] + wg[1][e] * g1[e] + wg[2][e] * g0[e], cav = wa[0][e] * a2[e] + wa[1][e] * a1[e] + wa[2][e] * a0[e]; o[e] = cgv * sigmoidf_(cgv) * cav; }
        *(u32x4*)(ACT + (size_t)(hh * 128 + rr) * FF + col) = (u32x4){pk2(o[0], o[1]), pk2(o[2], o[3]), pk2(o[4], o[5]), pk2(o[6], o[7])};
    }
    for (int idx = obid() * NTHR + otid(); idx < 4 * (FF2 / 8); idx += gridDim.x * NTHR) { const int br = idx / (FF2 / 8), c = (idx - br * (FF2 / 8)) * 8, b = br >> 1, r = br & 1;
        float v[8]; unpack8(*(const u32x4*)(UB + (size_t)((64 * b + 63) * 4 + 2 + r) * FF2 + c), v);
        st8f(p.out + O_PFFN + ((size_t)(l * 2 + b) * 2 + r) * FF2 + c, v); }
}

#define XB_TMO      128
#define XB_XCNT(j)  (256  + 64 * (j))
#define XB_XSUB(j)  (1280 + 64 * (j))
#define XB_XGEN(j)  (2304 + 64 * (j))
#define XB_TOP      3328
#define XB_TOPGEN   3392
#define XCD_BAR_WORDS 3456
#define XB_SPIN_CAP (1u << 18)

__device__ __forceinline__ unsigned xb_ld(unsigned* p)              { return __hip_atomic_load(p, __ATOMIC_RELAXED, __HIP_MEMORY_SCOPE_AGENT); }
__device__ __forceinline__ unsigned xb_add(unsigned* p, unsigned v) { return __hip_atomic_fetch_add(p, v, __ATOMIC_RELAXED, __HIP_MEMORY_SCOPE_AGENT); }
__device__ __forceinline__ unsigned xb_xcc_id() { return (unsigned)__builtin_amdgcn_s_getreg((3 << 11) | 20) & 0xFu; }
#define XB_SPIN(cond, bar) do { unsigned _sp = 0; while (cond) { __builtin_amdgcn_s_sleep(1); \
    if ((++_sp & 255u) == 0u) { if (xb_ld(&(bar)[XB_TMO])) break; if (_sp > XB_SPIN_CAP) { atomicAdd(&(bar)[XB_TMO], 1u); break; } } } } while (0)

struct XcdBarrier {
    unsigned* bar; unsigned x;
    volatile LAS unsigned* st;
};

__device__ __forceinline__ XcdBarrier xcd_barrier_post(unsigned* bar, volatile LAS unsigned* st) {
    XcdBarrier b; b.bar = bar; b.x = xb_xcc_id(); b.st = st;
    if (threadIdx.x == 0) (void)xb_add(&bar[XB_XCNT(b.x)], 1u);
    return b;
}
__device__ __forceinline__ void xcd_barrier_complete(unsigned* bar, unsigned x, unsigned& nloc, unsigned& nx) {
    const unsigned G = gridDim.x * gridDim.y * gridDim.z;
    unsigned sum, cnt, mine, sp = 0u;
    for (;;) {
        sum = 0u; cnt = 0u; mine = 0u;
#pragma unroll
        for (unsigned j = 0; j < 16; ++j) { const unsigned c = xb_ld(&bar[XB_XCNT(j)]); sum += c; cnt += (c > 0u) ? 1u : 0u; mine = (j == x) ? c : mine; }
        if (sum == G) break;
        __builtin_amdgcn_s_sleep(1);
        if ((++sp & 255u) == 0u) { if (xb_ld(&bar[XB_TMO])) break; if (sp > XB_SPIN_CAP) { atomicAdd(&bar[XB_TMO], 1u); break; } }
    }
    nloc = mine > 0u ? mine : 1u; nx = cnt > 0u ? cnt : 1u;
}

__device__ __forceinline__ void xcd_barrier(const XcdBarrier& b) {
    asm volatile("s_waitcnt vmcnt(0)" ::: "memory");
    __syncthreads();
    if (threadIdx.x == 0) {
        unsigned* bar = b.bar;
        __builtin_amdgcn_s_waitcnt(0);
        unsigned nloc = b.st[0], nx = b.st[1];
        if (nloc == 0u) { xcd_barrier_complete(bar, b.x, nloc, nx); b.st[0] = nloc; b.st[1] = nx; }
        const unsigned old = xb_add(&bar[XB_XSUB(b.x)], 1u);
        const unsigned gen = old / nloc;
        if (old + 1u == (gen + 1u) * nloc) {
            __builtin_amdgcn_fence(__ATOMIC_RELEASE, "agent");
            asm volatile("s_waitcnt vmcnt(0)" ::: "memory");
            const unsigned og = xb_add(&bar[XB_TOP], 1u);
            const unsigned tg = og / nx;
            if (og + 1u == (tg + 1u) * nx) xb_add(&bar[XB_TOPGEN], 1u);
            else XB_SPIN(xb_ld(&bar[XB_TOPGEN]) == tg, bar);
            __builtin_amdgcn_fence(__ATOMIC_ACQUIRE, "agent");
            xb_add(&bar[XB_XGEN(b.x)], 1u);
            asm volatile("s_waitcnt vmcnt(0)" ::: "memory");
        } else {
            XB_SPIN(xb_ld(&bar[XB_XGEN(b.x)]) == gen, bar);
            __builtin_amdgcn_fence(__ATOMIC_ACQUIRE, "agent");
            asm volatile("s_waitcnt vmcnt(0)" ::: "memory");
        }
    }
    __syncthreads();
}

__global__ void __launch_bounds__(NTHR, 2) mega(Params p) {
    extern __shared__ __attribute__((aligned(16))) unsigned char lds[];
    cg::grid_group grid = cg::this_grid();
    unsigned char* ws = p.ws;
    volatile LAS unsigned* bst = (volatile LAS unsigned*)((LAS unsigned char*)lds + 147392);
    if (threadIdx.x < 2) bst[threadIdx.x] = 0u;
    __syncthreads();
    XcdBarrier bar; bar.bar = (unsigned*)ws; bar.x = 0; bar.st = bst;
    if (p.hi - p.lo > 1) bar = xcd_barrier_post((unsigned*)ws, bst);
    for (int step = p.lo; step < p.hi; ++step) {
        int nrep = 1; bool skip = false;
        if (step == 0) nrep += (PROBE_PRE & 1); else if (step == 1) nrep += (PROBE_PRE >> 1) & 1; else { const int l_ = (step - 2) / 10, st_ = (step - 2) % 10; nrep += (((l_ & 1) ? PROBE_ODD : PROBE_EVEN) >> st_) & 1; }
        for (int rep = 0; rep < nrep; ++rep) {
            if (PROBE_BAR == 2 && rep > 0) xcd_barrier(bar);
        if (step == 0) prologue(p, lds);
        else if (step == 1) {
            pg8::Gemm g{(const pg8::bf16_t*)(ws + WS_AC), (const pg8::bf16_t*)(ws + WS_ZU), 256, MODW, DM}; pg8::StaticOrder S; S.init(256, MODW, gridDim.x, obid());
            EpiMod E{(float*)(ws + WS_MOD), p.in[14]};
            pg8::gemm_phase<EpiMod, pg8::StaticOrder, true, true>((PG8_LAS unsigned char*)lds, g, S, E);
        } else {
            const int l = (step - 2) / 10, st = (step - 2) % 10; const bool even = !(l & 1); const int i = l >> 1;
            if (st == 0) norm_phase(p, l, 1, lds);
            else if (st == 6) norm_phase(p, l, 2, lds);
            else if (st == 1 || st == 5 || st == 7 || st == 9) {
                pg8::Gemm g; EpiMain E; E.X = p.out; E.O = (bf16*)(ws + WS_ZU); E.gate = nullptr; E.ldc = 0; E.mode = 0; E.cw = nullptr; E.stp = nullptr; E.sout = nullptr; E.qn = nullptr; E.kn = nullptr; E.lyr = i; E.wsb = ws;
                if (st == 1) { g.A = (const pg8::bf16_t*)(ws + WS_H); g.M = R; g.K = DM;
                    if (even) { g.Bt = (const pg8::bf16_t*)(ws + WS_WIN) + (size_t)i * ZW * DM; g.N = ZW; E.ldc = ZW; } else { g.Bt = (const pg8::bf16_t*)(ws + WS_WQKV) + (size_t)i * QKVW * DM; g.N = QKVW; E.ldc = QKVW; E.mode = 3;
                        E.qn = p.in[21] + i * 64; E.kn = p.in[22] + i * 64; } }
                else if (st == 5) { g.A = (const pg8::bf16_t*)(ws + WS_CAT); g.M = RP; g.K = DM; g.N = DM; g.Bt = (const pg8::bf16_t*)(ws + (even ? WS_WAO : WS_WCO)) + (size_t)i * DM * DM;
                    E.mode = 1; E.gate = (const float*)(ws + WS_MOD) + l * 6144 + 2048; }
                else if (st == 7) { g.A = (const pg8::bf16_t*)(ws + WS_H); g.M = R; g.K = DM; g.N = FF2; g.Bt = (const pg8::bf16_t*)(ws + WS_WUP) + (size_t)l * FF2 * DM; E.mode = 2;
                    E.cw = p.in[26] + (size_t)l * 3 * FF2; E.stp = p.in[10] + (size_t)l * 128 * 2 * FF2; E.sout = p.out + O_SFFN + (size_t)l * 128 * 2 * FF2; }
                else { g.A = (const pg8::bf16_t*)(ws + WS_ACT); g.M = RP; g.K = FF; g.N = DM; g.Bt = (const pg8::bf16_t*)(ws + WS_WDN) + (size_t)l * DM * FF; E.mode = 1; E.gate = (const float*)(ws + WS_MOD) + l * 6144 + 5120; }
                if (rep > 0 && E.mode == 1) { E.mode = 0; E.O = (bf16*)(ws + WS_H); E.ldc = DM; }
                if (rep > 0 && E.mode == 1) { E.mode = 0; E.O = (bf16*)(ws + WS_H); E.ldc = DM; }
                pg8::StaticOrder S; S.init(g.M, g.N, gridDim.x, obid());
                pg8::gemm_phase<EpiMain, pg8::StaticOrder, true, true>((PG8_LAS unsigned char*)lds, g, S, E);
                if (E.mode == 3 && rep == 0) { const int G_ = gridDim.x, n2 = S.nwg - G_;
                    if (n2 > 0 && n2 < G_) { if (obid() >= n2) cache_shift(p, i, obid() - n2, G_ - n2); } else cache_shift(p, i, obid(), G_); }
                if (E.mode == 1) mini_gemm((const bf16*)g.A, (const bf16*)g.Bt, g.K, p.out, E.gate, lds);
            }
            else if (st == 2) {
                if (even) { const int G_ = gridDim.x; int il = obid(), is = obid();
                    for (int k = 0; il < 1024 || is < 512; ++k) { const bool do_s = (is < 512) && ((k & 1) || il >= 1024);
                        if (do_s) { mlstm_sample(p, i, is, lds); is += G_; } else { mlstm_local(p, i, il, lds); il += G_; } }
                    shortconv(p, i); }
                else { skip = true; continue; }
            }
            else if (st == 3) { if (even) mlstm_scan(p, i, lds); else attn_phase(p, i, lds); }
            else if (st == 4) { if (!even) { skip = true; continue; } for (int it = obid(); it < 1024; it += 2 * gridDim.x) mlstm_out2(p, i, it, it + gridDim.x, lds); }
            else if (st == 8) ffnfix_phase(p, l);
        }
        }
        if (skip) continue;
        if (step + 1 < p.hi) { if (step == 0) grid.sync(); else { xcd_barrier(bar); if (PROBE_BAR == 1) xcd_barrier(bar); } }
    }
}

#ifndef NLAUNCH_MODE
#define NLAUNCH_MODE 1
#endif
extern "C" void kernel_launch(void* const* d_in, const int* in_sizes, int n_in, void* d_out, int out_size, void* d_ws, size_t ws_size, hipStream_t stream) {
    static int grid = 0;
    if (grid == 0) {
        if (n_in != 28 || (size_t)out_size != O_END || ws_size < WS_END) { fprintf(stderr, "kernel_launch: unexpected shapes: n_in %d out %d ws %zu\n", n_in, out_size, ws_size); grid = -1; return; }
        int dev = 0, cus = 0, per_cu = 0;
        hipGetDevice(&dev); hipDeviceGetAttribute(&cus, hipDeviceAttributeMultiprocessorCount, dev);
        if (hipFuncSetAttribute((const void*)mega, hipFuncAttributeMaxDynamicSharedMemorySize, LDS_BYTES) != hipSuccess) { fprintf(stderr, "kernel_launch: hipFuncSetAttribute failed\n"); grid = -1; return; }
        if (hipOccupancyMaxActiveBlocksPerMultiprocessor(&per_cu, (const void*)mega, NTHR, LDS_BYTES) != hipSuccess || per_cu < 1) { fprintf(stderr, "kernel_launch: occupancy query says %d\n", per_cu); per_cu = 1; }
        (void)hipGetLastError();
        grid = cus * 1;
    }
    if (grid < 0) return;
    Params p{};
    for (int k = 0; k < 28; ++k) p.in[k] = (const float*)d_in[k];
    p.out = (float*)d_out; p.ws = (unsigned char*)d_ws;
    const int NSTEPS = 42;
    if (hipMemsetAsync(d_ws, 0, 16384, stream) != hipSuccess) { fprintf(stderr, "memset failed\n"); return; }
#if NLAUNCH_MODE == 1
    p.lo = 0; p.hi = NSTEPS;
    void* args[] = {&p};
    hipError_t e = hipLaunchCooperativeKernel((const void*)mega, dim3(grid), dim3(NTHR), args, LDS_BYTES, stream);
    if (e != hipSuccess) fprintf(stderr, "cooperative launch failed: %s (grid %d)\n", hipGetErrorString(e), grid);
#else
    for (int s = 0; s < NSTEPS; ++s) { if (s >= 2 && ((s - 2) % 10) == 4 && (((s - 2) / 10) & 1)) continue; p.lo = s; p.hi = s + 1; hipLaunchKernelGGL(mega, dim3(grid), dim3(NTHR), LDS_BYTES, stream, p); }
#endif
}
```

```cpp
#include <hip/hip_runtime.h>
#include <hip/hip_cooperative_groups.h>
#include <cstdio>
#include <cstdint>
namespace cg = cooperative_groups;
__device__ __forceinline__ int otid() { int t = threadIdx.x; asm volatile("" : "+v"(t)); return t; }
__device__ __forceinline__ int obid() { int b = blockIdx.x; asm volatile("" : "+s"(b)); return b; }
__device__ __forceinline__ float shx(float v, int o) { const int l = otid() & 63; return __builtin_bit_cast(float, __builtin_amdgcn_ds_bpermute((l ^ o) << 2, __builtin_bit_cast(int, v))); }
__device__ __forceinline__ float shi(float v, int src) { return __builtin_bit_cast(float, __builtin_amdgcn_ds_bpermute(src << 2, __builtin_bit_cast(int, v))); }
__device__ __forceinline__ float shup(float v, int o) { const int l = otid() & 63; const int src = l >= o ? l - o : l; return __builtin_bit_cast(float, __builtin_amdgcn_ds_bpermute(src << 2, __builtin_bit_cast(int, v))); }
namespace pg8 {
#define PG8_LAS __attribute__((address_space(3)))
typedef unsigned short bf16_t;
typedef short bf16x8 __attribute__((ext_vector_type(8)));
typedef float f32x4 __attribute__((ext_vector_type(4)));
typedef unsigned u32x4 __attribute__((ext_vector_type(4)));
constexpr int BM = 256, BK = 64, HALF = 128, HTB = HALF * BK * 2  , STAGE_BYTES = 8 * HTB, NXCD = 8, WGM = 8;

__host__ __device__ __forceinline__ int lds_byte(int r, int c) { const int st = (r >> 4) * 2 + (c >> 5), rr = r & 15, cc = c & 31, ob = rr * 64 + cc * 2; return st * 1024 + (ob ^ (((ob >> 9) & 1) << 5)); }
__host__ __device__ __forceinline__ void stage_rc(int b, int& R, int& C) { const int st = b / 1024, sb = b % 1024, swz = sb ^ (((sb >> 9) & 1) << 5); R = (st >> 1) * 16 + swz / 64; C = (st & 1) * 32 + (swz % 64) / 2; }
__host__ __device__ __forceinline__ int perm32(int rho) { const int n = rho >> 4, i = rho & 15; return 8 * (i >> 2) + 4 * n + (i & 3); }

struct Unit { int pm, pn; };
struct Gemm { const bf16_t* A; const bf16_t* Bt; int M, N, K; };

struct StaticOrder {
    int nM, nN, nwg, G, c;
    __host__ __device__ void init(int M, int N, int G_, int c_) { nM = M / BM; nN = N / BM; nwg = nM * nN; G = G_; c = c_; }
    __host__ __device__ bool next(int i, Unit& u) const {
        const long L = (long)i * G + c; if (L >= nwg) return false;
        int wgid = (int)L; { const int q = nwg / NXCD, r = nwg % NXCD, xcd = wgid % NXCD, off = wgid / NXCD; wgid = (xcd < r ? xcd * (q + 1) : r * (q + 1) + (xcd - r) * q) + off; }
        const int nig = WGM * nN, gid = wgid / nig, fm = gid * WGM, gsz = (nM - fm) < WGM ? (nM - fm) : WGM;
        u.pm = fm + ((wgid % nig) % gsz); u.pn = (wgid % nig) / gsz; return true;
    }
    __device__ __forceinline__ void a_ready(const Unit&) const {}
    __device__ __forceinline__ void done(const Unit&) const {}
};

__device__ __forceinline__ unsigned cvt_pk_bf16(float lo, float hi) { unsigned r; asm volatile("v_cvt_pk_bf16_f32 %0, %1, %2" : "=v"(r) : "v"(lo), "v"(hi)); return r; }
template <class Epi, class Sched, bool ALIGN_EPI = false, bool SP2 = false>
__device__ __forceinline__ void gemm_phase(PG8_LAS unsigned char* lds, const Gemm g, const Sched& S, const Epi& E) {
    const int tid = otid(), wid = __builtin_amdgcn_readfirstlane(tid >> 6), lane = tid & 63, wr = wid >> 2, wc = wid & 3, fr = lane & 15, fq = lane >> 4;
    const int K = g.K, nt = K / BK;
    unsigned voffA[2], voffB[2];
#pragma unroll
    for (int i = 0; i < 2; ++i) { int R, C; stage_rc(tid * 16 + i * 8192, R, C); const int Rb = Epi::PERM ? ((R & ~31) + perm32(R & 31)) : R;
        const int Ra = 8 * (16 * (R >> 6) + (R & 15)) + ((R >> 4) & 3);
        voffA[i] = (unsigned)(Ra * K + C) * 2u; voffB[i] = (unsigned)(Rb * K + C) * 2u; }
    const size_t kstep = (size_t)(BK * 2);
    const size_t hstep = (size_t)HALF * K * 2;
    const size_t hstepA = (size_t)4 * K * 2;
    const size_t tstep = 2 * hstep;
    const unsigned ldsw = (unsigned)wid * 1024u;
    const int aoff = lds_byte(wr * 64 + fr, fq * 8), boff = lds_byte(wc * 32 + fr, fq * 8);
#define PG8_SA(b, h) (((b) * 2 + (h)) * HTB)
#define PG8_SB(b, h) ((4 + (b) * 2 + (h)) * HTB)
#define PG8_STAGE(bufoff, gbase, voff) do { _Pragma("unroll") for (int _i = 0; _i < 2; ++_i) \
        __builtin_amdgcn_global_load_lds((const unsigned*)((const char*)(gbase) + (voff)[_i]), (PG8_LAS unsigned*)(lds + (bufoff) + ldsw + _i * 8192), 16, 0, 0); } while (0)
#define PG8_LDA(dst, b, h) do { _Pragma("unroll") for (int m = 0; m < 4; ++m) _Pragma("unroll") for (int k = 0; k < 2; ++k) dst[m][k] = *(const PG8_LAS bf16x8*)(lds + PG8_SA(b, h) + aoff + m * 2048 + k * 1024); } while (0)
#define PG8_LDB(dst, b, h) do { _Pragma("unroll") for (int n = 0; n < 2; ++n) _Pragma("unroll") for (int k = 0; k < 2; ++k) dst[n][k] = *(const PG8_LAS bf16x8*)(lds + PG8_SB(b, h) + boff + n * 2048 + k * 1024); } while (0)
#define PG8_MMA(ai, bj, At, Bt) do { __builtin_amdgcn_s_setprio(1); _Pragma("unroll") for (int m = 0; m < 4; ++m) _Pragma("unroll") for (int n = 0; n < 2; ++n) _Pragma("unroll") for (int k = 0; k < 2; ++k) \
        acc[ai][bj][m][n] = __builtin_amdgcn_mfma_f32_16x16x32_bf16(Bt[n][k], At[m][k], acc[ai][bj][m][n], 0, 0, 0); __builtin_amdgcn_s_setprio(0); } while (0)
#define PG8_WAIT_V(n) asm volatile("s_waitcnt vmcnt(" #n ")" ::: "memory")
#define PG8_WAIT_L(n) asm volatile("s_waitcnt lgkmcnt(" #n ")" ::: "memory")
#define PG8_BAR __builtin_amdgcn_s_barrier()
#define PG8_SCHED __builtin_amdgcn_sched_barrier(0)
    Unit cur, nxt; int ui = 0;
    if (!S.next(0, cur)) return;
    f32x4 acc[2][2][4][2];
#pragma unroll
    for (int a = 0; a < 2; ++a)
#pragma unroll
        for (int b = 0; b < 2; ++b)
#pragma unroll
            for (int m = 0; m < 4; ++m)
#pragma unroll
                for (int n = 0; n < 2; ++n) acc[a][b][m][n] = (f32x4){0.f, 0.f, 0.f, 0.f};
    bf16x8 At[4][2], B0[2][2], B1[2][2];
    const char* cA = (const char*)g.A + (size_t)cur.pm * tstep; const char* cB = (const char*)g.Bt + (size_t)cur.pn * tstep;
    S.a_ready(cur);
    if constexpr (SP2) {
        PG8_STAGE(PG8_SB(0, 0), cB, voffB); PG8_STAGE(PG8_SB(0, 1), cB + hstep, voffB); PG8_STAGE(PG8_SA(0, 0), cA, voffA); PG8_STAGE(PG8_SA(0, 1), cA + hstepA, voffA);
        if (wr == 1) PG8_BAR;
        PG8_WAIT_V(2); PG8_BAR;
        PG8_STAGE(PG8_SB(1, 0), cB + kstep, voffB); PG8_STAGE(PG8_SA(1, 0), cA + kstep, voffA); PG8_STAGE(PG8_SB(1, 1), cB + hstep + kstep, voffB);
        PG8_WAIT_V(6); PG8_BAR;
    } else {
        PG8_STAGE(PG8_SB(0, 0), cB, voffB); PG8_STAGE(PG8_SA(0, 0), cA, voffA); PG8_STAGE(PG8_SB(0, 1), cB + hstep, voffB); PG8_STAGE(PG8_SA(0, 1), cA + hstepA, voffA);
        if (wr == 1) PG8_BAR;
        PG8_WAIT_V(4); PG8_BAR;
        PG8_STAGE(PG8_SB(1, 0), cB + kstep, voffB); PG8_STAGE(PG8_SA(1, 0), cA + kstep, voffA); PG8_STAGE(PG8_SB(1, 1), cB + hstep + kstep, voffB);
        PG8_WAIT_V(6); PG8_BAR;
    }
    for (;;) {
        const bool has_next = S.next(ui + 1, nxt);
        const char* nA = has_next ? (const char*)g.A + (size_t)nxt.pm * tstep : cA; const char* nB = has_next ? (const char*)g.Bt + (size_t)nxt.pn * tstep : cB;
        for (int t = 0; t < nt; t += 2) {
            const bool last = (t == nt - 2);
            const char* a1 = cA + (size_t)(t + 1) * kstep;
            const char* a2 = last ? nA : cA + (size_t)(t + 2) * kstep; const char* b2 = last ? nB : cB + (size_t)(t + 2) * kstep;
            const char* a3 = a2 + kstep; const char* b3 = b2 + kstep;
            if (last && has_next) S.a_ready(nxt);
            if constexpr (SP2) {
            PG8_LDB(B0, 0, 0); PG8_LDB(B1, 0, 1); PG8_SCHED; PG8_LDA(At, 0, 0); PG8_STAGE(PG8_SA(1, 1), a1 + hstepA, voffA);
            PG8_WAIT_V(8); PG8_WAIT_L(0); PG8_BAR; PG8_MMA(0, 0, At, B0); PG8_MMA(0, 1, At, B1); PG8_BAR; PG8_SCHED;
            PG8_LDA(At, 0, 1); PG8_STAGE(PG8_SB(0, 0), b2, voffB); PG8_STAGE(PG8_SB(0, 1), b2 + hstep, voffB); PG8_STAGE(PG8_SA(0, 0), a2, voffA);
            PG8_WAIT_V(8); PG8_WAIT_L(0); PG8_BAR; PG8_MMA(1, 0, At, B0); PG8_MMA(1, 1, At, B1); PG8_BAR; PG8_SCHED;
            PG8_LDB(B0, 1, 0); PG8_LDB(B1, 1, 1); PG8_SCHED; PG8_LDA(At, 1, 0); PG8_STAGE(PG8_SA(0, 1), a2 + hstepA, voffA);
            PG8_WAIT_V(8); PG8_WAIT_L(0); PG8_BAR; PG8_MMA(0, 0, At, B0); PG8_MMA(0, 1, At, B1); PG8_BAR; PG8_SCHED;
            PG8_LDA(At, 1, 1); PG8_STAGE(PG8_SB(1, 0), b3, voffB); PG8_STAGE(PG8_SB(1, 1), b3 + hstep, voffB); PG8_STAGE(PG8_SA(1, 0), a3, voffA);
            PG8_WAIT_V(8); PG8_WAIT_L(0); PG8_BAR; PG8_MMA(1, 0, At, B0); PG8_MMA(1, 1, At, B1); PG8_BAR; PG8_SCHED;
            } else {
            PG8_LDB(B0, 0, 0); PG8_SCHED; PG8_LDA(At, 0, 0); PG8_STAGE(PG8_SA(1, 1), a1 + hstepA, voffA);
            PG8_WAIT_L(8); PG8_BAR; PG8_WAIT_L(0); PG8_MMA(0, 0, At, B0); PG8_BAR; PG8_SCHED;
            PG8_LDB(B1, 0, 1); PG8_STAGE(PG8_SB(0, 0), b2, voffB);
            PG8_BAR; PG8_WAIT_L(0); PG8_MMA(0, 1, At, B1); PG8_BAR;
            PG8_LDA(At, 0, 1); PG8_STAGE(PG8_SA(0, 0), a2, voffA);
            PG8_BAR; PG8_WAIT_L(0); PG8_MMA(1, 0, At, B0); PG8_BAR; PG8_SCHED;
            PG8_STAGE(PG8_SB(0, 1), b2 + hstep, voffB);
            PG8_WAIT_V(6); PG8_BAR; PG8_MMA(1, 1, At, B1); PG8_BAR;
            PG8_LDB(B0, 1, 0); PG8_SCHED; PG8_LDA(At, 1, 0); PG8_STAGE(PG8_SA(0, 1), a2 + hstepA, voffA);
            PG8_WAIT_L(8); PG8_BAR; PG8_WAIT_L(0); PG8_MMA(0, 0, At, B0); PG8_BAR; PG8_SCHED;
            PG8_LDB(B1, 1, 1); PG8_STAGE(PG8_SB(1, 0), b3, voffB);
            PG8_BAR; PG8_WAIT_L(0); PG8_MMA(0, 1, At, B1); PG8_BAR;
            PG8_LDA(At, 1, 1); PG8_STAGE(PG8_SA(1, 0), a3, voffA);
            PG8_BAR; PG8_WAIT_L(0); PG8_MMA(1, 0, At, B0); PG8_BAR; PG8_SCHED;
            PG8_STAGE(PG8_SB(1, 1), b3 + hstep, voffB);
            PG8_WAIT_V(6); PG8_BAR; PG8_MMA(1, 1, At, B1); PG8_BAR;
            }
        }
        if constexpr (ALIGN_EPI) { if (wr == 0) PG8_BAR; }
        if constexpr (!Epi::AFTER_DRAIN) { E(acc, cur, wr, wc, fr, fq); S.done(cur); }
        if (!has_next) break;
#pragma unroll
        for (int a = 0; a < 2; ++a)
#pragma unroll
            for (int b = 0; b < 2; ++b)
#pragma unroll
                for (int m = 0; m < 4; ++m)
#pragma unroll
                    for (int n = 0; n < 2; ++n) acc[a][b][m][n] = (f32x4){0.f, 0.f, 0.f, 0.f};
        cur = nxt; cA = nA; cB = nB; ++ui;
        if constexpr (ALIGN_EPI) { if (wr == 1) PG8_BAR; }
    }
    PG8_WAIT_V(0);
    if constexpr (!ALIGN_EPI) { if (wr == 0) PG8_BAR; }
    PG8_BAR;
    if constexpr (Epi::AFTER_DRAIN) { E.fused(acc, cur, wr, wc, fr, fq, lds, wid, lane); S.done(cur); }
#undef PG8_SA
#undef PG8_SB
#undef PG8_STAGE
#undef PG8_LDA
#undef PG8_LDB
#undef PG8_MMA
#undef PG8_WAIT_V
#undef PG8_WAIT_L
#undef PG8_BAR
#undef PG8_SCHED
}
}

typedef unsigned short bf16;
typedef float f32x4 __attribute__((ext_vector_type(4)));
typedef float f32x2 __attribute__((ext_vector_type(2)));
typedef unsigned u32x4 __attribute__((ext_vector_type(4)));
typedef unsigned u32x2 __attribute__((ext_vector_type(2)));
typedef short bf16x8 __attribute__((ext_vector_type(8)));

constexpr int R = 17408, RP = 16384, NSEQ = 130, SEQL = 8192;
constexpr int DM = 1024, INA = 3592, ZW = 3584, QKVW = 1536, FF = 2816, FF2 = 5632, MODW = 24576;
constexpr float EPS = 1e-6f;
constexpr int NWAVES = 8, NTHR = 512;
constexpr int LDS_BYTES = 147456;

constexpr size_t O_Y = 0;
constexpr size_t O_PC = (size_t)R * 1024;
constexpr size_t O_PN = O_PC + 262144;
constexpr size_t O_PM = O_PN + 2048;
constexpr size_t O_PSC = O_PM + 16;
constexpr size_t O_PWK = O_PSC + 4096;
constexpr size_t O_PWV = O_PWK + 131072;
constexpr size_t O_PFFN = O_PWV + 131072;
constexpr size_t O_SC = O_PFFN + 90112;
constexpr size_t O_SN = O_SC + 16777216;
constexpr size_t O_SM = O_SN + 131072;
constexpr size_t O_SSC = O_SM + 1024;
constexpr size_t O_SWK = O_SSC + 262144;
constexpr size_t O_SWV = O_SWK + 8388608;
constexpr size_t O_SFFN = O_SWV + 8388608;
constexpr size_t O_END = O_SFFN + 5767168;

constexpr size_t MiB = 1u << 20;
constexpr size_t WS_WIN = 1 * MiB, WS_WAO = 15 * MiB, WS_WQKV = 19 * MiB, WS_WCO = 25 * MiB, WS_WUP = 29 * MiB, WS_WDN = 73 * MiB;
constexpr size_t WS_AC = 95 * MiB, WS_MOD = 96 * MiB, WS_TAB = 109 * MiB, WS_H = 112 * MiB, WS_CAT = 146 * MiB, WS_GATES = 180 * MiB;
constexpr size_t WS_ZU = 181 * MiB;
constexpr size_t WS_ACT = 368 * MiB;
constexpr size_t WS_DCT = WS_ACT, WS_CST = WS_ACT + 64 * MiB, WS_NS = WS_ACT + 96 * MiB, WS_DN = WS_NS + MiB / 2, WS_CS = WS_NS + MiB, WS_MS = WS_CS + 65536;
constexpr size_t WS_UB = 466 * MiB;
constexpr size_t WS_END = 472 * MiB;

__constant__ double ROPE_INV[32] = {1.0, 0.7498942093324559, 0.5623413251903491, 0.4216965034285822, 0.31622776601683794, 0.23713737056616552, 0.1778279410038923, 0.1333521432163324, 0.1, 0.07498942093324558, 0.05623413251903491, 0.042169650342858224, 0.03162277660168379, 0.023713737056616554, 0.01778279410038923, 0.01333521432163324, 0.01, 0.007498942093324558, 0.005623413251903491, 0.004216965034285823, 0.0031622776601683794, 0.0023713737056616554, 0.0017782794100389228, 0.001333521432163324, 0.001, 0.0007498942093324559, 0.0005623413251903491, 0.00042169650342858224, 0.00031622776601683794, 0.00023713737056616554, 0.00017782794100389227, 0.0001333521432163324};
#ifndef PROBE_PRE
#define PROBE_PRE 0
#define PROBE_EVEN 0
#define PROBE_ODD 0
#endif
#ifndef PROBE_BAR
#define PROBE_BAR 0
#endif
struct Params { const float* in[28]; float* out; unsigned char* ws; int lo, hi; };

__device__ __forceinline__ unsigned f2bf(float f) { unsigned u = __builtin_bit_cast(unsigned, f); return (u + 0x7fffu + ((u >> 16) & 1u)) >> 16; }
__device__ __forceinline__ unsigned pk2(float lo, float hi) { unsigned r; asm("v_cvt_pk_bf16_f32 %0, %1, %2" : "=v"(r) : "v"(lo), "v"(hi)); return r; }
__device__ __forceinline__ unsigned pk2_sw(float lo, float hi) { return f2bf(lo) | (f2bf(hi) << 16); }
__device__ __forceinline__ float bf2f(unsigned h) { return __builtin_bit_cast(float, h << 16); }
__device__ __forceinline__ float bflo(unsigned w) { return __builtin_bit_cast(float, w << 16); }
__device__ __forceinline__ float bfhi(unsigned w) { return __builtin_bit_cast(float, w & 0xffff0000u); }
template <int CTRL> __device__ __forceinline__ float dppf(float x) { return __builtin_bit_cast(float, __builtin_amdgcn_mov_dpp(__builtin_bit_cast(int, x), CTRL, 0xF, 0xF, true)); }
__device__ __forceinline__ float rdl(float x, int l) { return __builtin_bit_cast(float, __builtin_amdgcn_readlane(__builtin_bit_cast(int, x), l)); }
__device__ __forceinline__ float wave_sum(float v) {
    v += dppf<0xB1>(v); v += dppf<0x4E>(v); v += dppf<0x141>(v); v += dppf<0x140>(v);
    return (rdl(v, 0) + rdl(v, 16)) + (rdl(v, 32) + rdl(v, 48));
}
__device__ __forceinline__ float wave_max(float v) {
    v = fmaxf(v, dppf<0xB1>(v)); v = fmaxf(v, dppf<0x4E>(v)); v = fmaxf(v, dppf<0x141>(v)); v = fmaxf(v, dppf<0x140>(v));
    return fmaxf(fmaxf(rdl(v, 0), rdl(v, 16)), fmaxf(rdl(v, 32), rdl(v, 48)));
}
__device__ __forceinline__ float logsigmoidf(float f) { return fminf(f, 0.f) - log1pf(__expf(-fabsf(f))); }
__device__ __forceinline__ float sigmoidf_(float x) { return __builtin_amdgcn_rcpf(1.f + __builtin_amdgcn_exp2f(x * -1.4426950408889634f)); }
__device__ __forceinline__ int seq_of(int row) { return row < RP ? (row >> 13) : 2 + ((row - RP) >> 3); }
#define LAS __attribute__((address_space(3)))
#define LDS_WAIT() asm volatile("s_waitcnt lgkmcnt(0)" ::: "memory")

__device__ __forceinline__ float dpp_shr1f(float x) { return __builtin_bit_cast(float, __builtin_amdgcn_mov_dpp(__builtin_bit_cast(int, x), 0x111, 0xF, 0xF, false)); }
__device__ __forceinline__ f32x4 dpp_shr1(const f32x4 v) { f32x4 r; r.x = dpp_shr1f(v.x); r.y = dpp_shr1f(v.y); r.z = dpp_shr1f(v.z); r.w = dpp_shr1f(v.w); return r; }
struct EpiMain {
    static constexpr bool PERM = true, AFTER_DRAIN = false;
    int mode;
    bf16* O; int ldc; float* X; const float* gate;
    const float* qn; const float* kn; int lyr; unsigned char* wsb;
    const float* cw; const float* stp; float* sout;
    __device__ __forceinline__ void operator()(const pg8::f32x4 (&acc)[2][2][4][2], const pg8::Unit& u, int wr, int wc, int fr, int fq) const {
        const int rowb = u.pm * 256 + 8 * (16 * wr + fr), col0 = u.pn * 256 + wc * 32 + 8 * fq;
        if (mode == 0) {
#pragma unroll
            for (int ai = 0; ai < 2; ++ai)
#pragma unroll
                for (int m = 0; m < 4; ++m) { bf16* rowp = O + (size_t)(rowb + 4 * ai + m) * ldc + col0;
#pragma unroll
                    for (int bj = 0; bj < 2; ++bj) { const pg8::f32x4 v0 = acc[ai][bj][m][0], v1 = acc[ai][bj][m][1]; u32x4 w;
                        w.x = pg8::cvt_pk_bf16(v0[0], v0[1]); w.y = pg8::cvt_pk_bf16(v0[2], v0[3]); w.z = pg8::cvt_pk_bf16(v1[0], v1[1]); w.w = pg8::cvt_pk_bf16(v1[2], v1[3]);
                        *(u32x4*)(rowp + bj * 128) = w; } }
        } else if (mode == 1) {
            f32x4 gv[2][2];
            { const float* gp = gate + (size_t)(u.pm >> 5) * MODW + col0;
#pragma unroll
              for (int bj = 0; bj < 2; ++bj)
#pragma unroll
                  for (int n = 0; n < 2; ++n) gv[bj][n] = *(const f32x4*)(gp + bj * 128 + 4 * n); }
#pragma unroll
            for (int am = 0; am < 4; ++am) { const int ai = am >> 1, m0 = (am & 1) * 2;
                f32x4 xv[2][2][2];
#pragma unroll
                for (int mm = 0; mm < 2; ++mm) { const float* xp = X + (size_t)(rowb + 4 * ai + m0 + mm) * DM + col0;
#pragma unroll
                    for (int bj = 0; bj < 2; ++bj)
#pragma unroll
                        for (int n = 0; n < 2; ++n) xv[mm][bj][n] = *(const f32x4*)(xp + bj * 128 + 4 * n); }
#pragma unroll
                for (int mm = 0; mm < 2; ++mm) { float* xp = X + (size_t)(rowb + 4 * ai + m0 + mm) * DM + col0;
#pragma unroll
                    for (int bj = 0; bj < 2; ++bj)
#pragma unroll
                        for (int n = 0; n < 2; ++n) *(f32x4*)(xp + bj * 128 + 4 * n) = xv[mm][bj][n] + gv[bj][n] * acc[ai][bj][m0 + mm][n]; }
            }
        } else if (mode == 3) {
            int fq3 = fq; asm volatile("" : "+v"(fq3));
            const int head = 4 * u.pn + wc; const bool prm = u.pm < 64;
            const f32x2* TAB = (const f32x2*)(wsb + WS_TAB);
            const int sq = prm ? (u.pm >> 5) : ((rowb - RP) >> 3);
            const float* nwp = (head < 16 ? qn : kn) + 8 * fq3;
            const f32x4 w1a = *(const f32x4*)nwp, w1b = *(const f32x4*)(nwp + 4), w2a = *(const f32x4*)(nwp + 32), w2b = *(const f32x4*)(nwp + 36);
            f32x4 ca, sa, cb, sb;
            { const int pos0 = prm ? (rowb & (SEQL - 1)) : SEQL; const f32x4* tp = (const f32x4*)(TAB + pos0 * 32 + 8 * fq3); const f32x4 c0 = tp[0], c1 = tp[1], c2 = tp[2], c3 = tp[3];
              ca = (f32x4){c0[0], c0[2], c1[0], c1[2]}; sa = (f32x4){c0[1], c0[3], c1[1], c1[3]}; cb = (f32x4){c2[0], c2[2], c3[0], c3[2]}; sb = (f32x4){c2[1], c2[3], c3[1], c3[3]};
            }
#pragma unroll
            for (int j = 0; j < 8; ++j) { const int row = rowb + j, t = prm ? (row & (SEQL - 1)) : j;
                f32x4 x1a = acc[j >> 2][0][j & 3][0], x1b = acc[j >> 2][0][j & 3][1], x2a = acc[j >> 2][1][j & 3][0], x2b = acc[j >> 2][1][j & 3][1];
                if (head < 20) {
                    float ss = (x1a[0] * x1a[0] + x1a[1] * x1a[1]) + (x1a[2] * x1a[2] + x1a[3] * x1a[3]) + (x1b[0] * x1b[0] + x1b[1] * x1b[1]) + (x1b[2] * x1b[2] + x1b[3] * x1b[3])
                             + (x2a[0] * x2a[0] + x2a[1] * x2a[1]) + (x2a[2] * x2a[2] + x2a[3] * x2a[3]) + (x2b[0] * x2b[0] + x2b[1] * x2b[1]) + (x2b[2] * x2b[2] + x2b[3] * x2b[3]);
                    ss += shx(ss, 16); ss += shx(ss, 32);
                    const float rstd = rsqrtf(ss * (1.f / 64.f) + EPS);
                    const f32x4 y1a = x1a * rstd * w1a, y1b = x1b * rstd * w1b, y2a = x2a * rstd * w2a, y2b = x2b * rstd * w2b;
                    x1a = y1a * ca - y2a * sa; x1b = y1b * cb - y2b * sb; x2a = y2a * ca + y1a * sa; x2b = y2b * cb + y1b * sb;
                }
                bf16* zp = O + (size_t)row * QKVW + head * 64 + 8 * fq3;
                *(u32x4*)zp = (u32x4){pk2(x1a[0], x1a[1]), pk2(x1a[2], x1a[3]), pk2(x1b[0], x1b[1]), pk2(x1b[2], x1b[3])};
                *(u32x4*)(zp + 32) = (u32x4){pk2(x2a[0], x2a[1]), pk2(x2a[2], x2a[3]), pk2(x2b[0], x2b[1]), pk2(x2b[2], x2b[3])};
                if (head >= 16 && (!prm || t >= SEQL - 128)) {
                    float* dst = X + (head < 20 ? (prm ? O_PWK : O_SWK) : (prm ? O_PWV : O_SWV)) + (prm ? ((size_t)(lyr * 2 + sq) * 128 + (t - (SEQL - 128))) * 256 : ((size_t)(lyr * 128 + sq) * 128 + 120 + j) * 256) + ((head - 16) & 3) * 64 + 8 * fq3;
                    *(f32x4*)dst = x1a; *(f32x4*)(dst + 4) = x1b; *(f32x4*)(dst + 32) = x2a; *(f32x4*)(dst + 36) = x2b; }
                if (head < 20) { const f32x4* t1 = (const f32x4*)(TAB + 32 + 8 * fq3); const f32x4 e0 = t1[0], e1 = t1[1], e2 = t1[2], e3 = t1[3];
                    const f32x4 dca = (f32x4){e0[0], e0[2], e1[0], e1[2]}, dsa = (f32x4){e0[1], e0[3], e1[1], e1[3]}, dcb = (f32x4){e2[0], e2[2], e3[0], e3[2]}, dsb = (f32x4){e2[1], e2[3], e3[1], e3[3]};
                    const f32x4 na = ca * dca - sa * dsa, nb = cb * dcb - sb * dsb; sa = sa * dca + ca * dsa; sb = sb * dcb + cb * dsb; ca = na; cb = nb; }
                asm volatile("" ::: "memory");
            }
        } else {
            const bool smp = u.pm >= 64; const int sq = (rowb - RP) >> 3;
            bf16* UB = (bf16*)(wsb + WS_UB); bf16* ACT = (bf16*)(wsb + WS_ACT);
#pragma unroll
            for (int n = 0; n < 2; ++n) {
                const int cf = u.pn * 128 + wc * 32 + 8 * fq + 4 * n;
                const f32x4 wg0 = *(const f32x4*)(cw + cf), wg1 = *(const f32x4*)(cw + FF2 + cf), wg2 = *(const f32x4*)(cw + 2 * FF2 + cf);
                const f32x4 wa0 = *(const f32x4*)(cw + FF + cf), wa1 = *(const f32x4*)(cw + FF2 + FF + cf), wa2 = *(const f32x4*)(cw + 2 * FF2 + FF + cf);
                f32x4 g2, g1, a2, a1;
                if (smp) { const float* st = stp + (size_t)sq * 2 * FF2; g2 = *(const f32x4*)(st + cf); a2 = *(const f32x4*)(st + FF + cf); g1 = *(const f32x4*)(st + FF2 + cf); a1 = *(const f32x4*)(st + FF2 + FF + cf); }
                else { g2 = dpp_shr1(acc[1][0][2][n]); g1 = dpp_shr1(acc[1][0][3][n]); a2 = dpp_shr1(acc[1][1][2][n]); a1 = dpp_shr1(acc[1][1][3][n]); }
#pragma unroll
                for (int j = 0; j < 8; ++j) { const f32x4 G = acc[j >> 2][0][j & 3][n], A = acc[j >> 2][1][j & 3][n];
                    const f32x4 cg = wg0 * g2 + wg1 * g1 + wg2 * G, ca = wa0 * a2 + wa1 * a1 + wa2 * A;
                    if (smp || fr != 0 || j >= 2)
                        *(u32x2*)(ACT + (size_t)(rowb + j) * FF + cf) = (u32x2){pg8::cvt_pk_bf16(cg[0] * sigmoidf_(cg[0]) * ca[0], cg[1] * sigmoidf_(cg[1]) * ca[1]), pg8::cvt_pk_bf16(cg[2] * sigmoidf_(cg[2]) * ca[2], cg[3] * sigmoidf_(cg[3]) * ca[3])};
                    if (smp) { if (j >= 6) { float* d = sout + ((size_t)sq * 2 + (j - 6)) * FF2; *(f32x4*)(d + cf) = G; *(f32x4*)(d + FF + cf) = A; } }
                    else if ((fr == 0 && j < 2) || (fr == 15 && j >= 6)) { bf16* d = UB + ((size_t)(u.pm * 2 + wr) * 4 + (j < 2 ? j : j - 4)) * FF2;
                        *(u32x2*)(d + cf) = (u32x2){pk2(G[0], G[1]), pk2(G[2], G[3])}; *(u32x2*)(d + FF + cf) = (u32x2){pk2(A[0], A[1]), pk2(A[2], A[3])}; }
                    g2 = g1; g1 = G; a2 = a1; a1 = A; }
            }
        }
    }
};
struct EpiMod {
    static constexpr bool PERM = true, AFTER_DRAIN = false;
    float* O; const float* bias;
    __device__ __forceinline__ void operator()(const pg8::f32x4 (&acc)[2][2][4][2], const pg8::Unit& u, int wr, int wc, int fr, int fq) const {
        const int rowb = u.pm * 256 + 8 * (16 * wr + fr), col0 = u.pn * 256 + wc * 32 + 8 * fq;
#pragma unroll
        for (int ai = 0; ai < 2; ++ai)
#pragma unroll
            for (int m = 0; m < 4; ++m) { const int row = rowb + 4 * ai + m;
                if (row < NSEQ) {
#pragma unroll
                    for (int bj = 0; bj < 2; ++bj)
#pragma unroll
                        for (int n = 0; n < 2; ++n) { const f32x4 b = *(const f32x4*)(bias + col0 + bj * 128 + 4 * n);
                            *(f32x4*)(O + (size_t)row * MODW + col0 + bj * 128 + 4 * n) = acc[ai][bj][m][n] + b; } } }
    }
};


__device__ __forceinline__ void mini_gemm(const bf16* A, const bf16* Bt, int K, float* X, const float* gate, unsigned char* smem) {
    const int tid = otid(), lane = tid & 63, wave = tid >> 6, fr = lane & 15, fq = lane >> 4;
    float* part = (float*)smem;
    const int nks = K / 256;
    for (int u = obid(); u < 256; u += gridDim.x) {
        const int rm = u >> 4, cn = u & 15;
        const bf16* Ap = A + (size_t)(RP + 64 * rm + fr) * K + wave * (K / 8) + 8 * fq;
        const bf16* Bp = Bt + (size_t)(64 * cn + fr) * K + wave * (K / 8) + 8 * fq;
        f32x4 acc[4][4];
#pragma unroll
        for (int i = 0; i < 4; ++i)
#pragma unroll
            for (int j = 0; j < 4; ++j) acc[i][j] = (f32x4){0.f, 0.f, 0.f, 0.f};
        bf16x8 a0[4], b0[4], a1[4], b1[4];
#define MG_LD(a, b, ks) do { _Pragma("unroll") for (int i_ = 0; i_ < 4; ++i_) { a[i_] = *(const bf16x8*)(Ap + (size_t)(16 * i_) * K + 32 * (ks)); b[i_] = *(const bf16x8*)(Bp + (size_t)(16 * i_) * K + 32 * (ks)); } } while (0)
#define MG_MMA(a, b) do { _Pragma("unroll") for (int i_ = 0; i_ < 4; ++i_) _Pragma("unroll") for (int j_ = 0; j_ < 4; ++j_) acc[i_][j_] = __builtin_amdgcn_mfma_f32_16x16x32_bf16(b[j_], a[i_], acc[i_][j_], 0, 0, 0); } while (0)
        MG_LD(a0, b0, 0);
        for (int ks = 0; ks < nks; ks += 2) {
            if (ks + 1 < nks) MG_LD(a1, b1, ks + 1);
            MG_MMA(a0, b0);
            if (ks + 2 < nks) MG_LD(a0, b0, ks + 2);
            if (ks + 1 < nks) MG_MMA(a1, b1);
        }
#undef MG_LD
#undef MG_MMA
#pragma unroll
        for (int i = 0; i < 4; ++i)
#pragma unroll
            for (int j = 0; j < 4; ++j) *(f32x4*)(part + (wave * 64 + 16 * i + fr) * 68 + 16 * j + 4 * fq) = acc[i][j];
        __syncthreads();
        {
            const int row = tid >> 3, c0 = (tid & 7) * 8;
            f32x4 s0 = (f32x4){0.f, 0.f, 0.f, 0.f}, s1 = s0;
#pragma unroll
            for (int w = 0; w < 8; ++w) { s0 = s0 + *(const f32x4*)(part + (w * 64 + row) * 68 + c0); s1 = s1 + *(const f32x4*)(part + (w * 64 + row) * 68 + c0 + 4); }
            const int grow = RP + 64 * rm + row, col = 64 * cn + c0; const int sq = 2 + ((grow - RP) >> 3);
            const float* gp = gate + (size_t)sq * MODW + col; float* xp = X + (size_t)grow * DM + col;
            const f32x4 g0 = *(const f32x4*)gp, g1 = *(const f32x4*)(gp + 4);
            *(f32x4*)xp = *(const f32x4*)xp + g0 * s0; *(f32x4*)(xp + 4) = *(const f32x4*)(xp + 4) + g1 * s1;
        }
        __syncthreads();
    }
}
struct TDesc { const float* W; bf16* WT; int ldw, K; };
constexpr int I_IN = 1792, I_AO = 512, I_QKV = 768, I_CO = 512, I_UP = 2816, I_DN = 1408, I_ADA = 3072;
constexpr int TN1 = 2 * I_IN, TN2 = TN1 + 2 * I_AO, TN3 = TN2 + 2 * I_QKV, TN4 = TN3 + 2 * I_CO, TN5 = TN4 + 4 * I_UP, TN6 = TN5 + 4 * I_DN, TN7 = TN6 + 4 * I_ADA;
__device__ __forceinline__ void tdecode(const Params& p, int it, TDesc& d) {
    unsigned char* ws = p.ws; int r = it, ncols; const float* W; bf16* WT; int ldw, K = DM; bool wup = false, wqkv = false;
    if (r < TN1) { const int i = r / I_IN; r -= i * I_IN; W = p.in[15] + (size_t)i * DM * INA; WT = (bf16*)(ws + WS_WIN) + (size_t)i * ZW * DM; ldw = INA;
        if (r < 1024) ncols = 2048; else { W += 2056; WT += (size_t)2048 * DM; r -= 1024; ncols = 1536; } }
    else if (r < TN2) { r -= TN1; const int i = r / I_AO; r -= i * I_AO; W = p.in[19] + (size_t)i * DM * DM; WT = (bf16*)(ws + WS_WAO) + (size_t)i * DM * DM; ldw = DM; ncols = DM; }
    else if (r < TN3) { r -= TN2; const int i = r / I_QKV; r -= i * I_QKV; W = p.in[20] + (size_t)i * DM * QKVW; WT = (bf16*)(ws + WS_WQKV) + (size_t)i * QKVW * DM; ldw = QKVW; ncols = QKVW; wqkv = true; }
    else if (r < TN4) { r -= TN3; const int i = r / I_CO; r -= i * I_CO; W = p.in[24] + (size_t)i * DM * DM; WT = (bf16*)(ws + WS_WCO) + (size_t)i * DM * DM; ldw = DM; ncols = DM; }
    else if (r < TN5) { r -= TN4; const int i = r / I_UP; r -= i * I_UP; W = p.in[25] + (size_t)i * DM * FF2; WT = (bf16*)(ws + WS_WUP) + (size_t)i * FF2 * DM; ldw = FF2; ncols = FF2; wup = true; }
    else if (r < TN6) { r -= TN5; const int i = r / I_DN; r -= i * I_DN; W = p.in[27] + (size_t)i * FF * DM; WT = (bf16*)(ws + WS_WDN) + (size_t)i * DM * FF; ldw = DM; ncols = DM; K = FF; }
    else { r -= TN6; const int i = r / I_ADA; r -= i * I_ADA; W = p.in[13] + (size_t)i * DM * 6144; WT = (bf16*)(ws + WS_ZU) + (size_t)i * 6144 * DM; ldw = 6144; ncols = 6144; }
    const int nblk = ncols / 32, kb = r / nblk, nb = r - kb * nblk;
    int drow = 32 * nb;
    if (wup) drow = (nb < 88) ? 256 * (nb >> 2) + 32 * (nb & 3) : 256 * ((nb - 88) >> 2) + 128 + 32 * ((nb - 88) & 3);
    if (wqkv) { const int head = nb >> 1; drow = 256 * (head >> 2) + 128 * (nb & 1) + 32 * (head & 3); }
    d.W = W + (size_t)(64 * kb) * ldw + 32 * nb; d.WT = WT + (size_t)drow * K + 64 * kb; d.ldw = ldw; d.K = K;
}
__device__ __forceinline__ void tload(const TDesc& d, int lane, float (&v)[32]) {
#pragma unroll
    for (int i = 0; i < 32; ++i) v[i] = __builtin_nontemporal_load(d.W + (size_t)(2 * i + (lane >> 5)) * d.ldw + (lane & 31));
}
__device__ __forceinline__ void tstore(const TDesc& d, int lane, const float (&v)[32], float* scr) {
#pragma unroll
    for (int i = 0; i < 32; ++i) scr[(2 * i + (lane >> 5)) * 33 + (lane & 31)] = v[i];
    LDS_WAIT();
    const int c = lane & 7;
#pragma unroll
    for (int j = 0; j < 4; ++j) { const int n = (lane >> 3) + 8 * j; const float* s = scr + (8 * c) * 33 + n;
        u32x4 o; o.x = pk2(s[0 * 33], s[1 * 33]); o.y = pk2(s[2 * 33], s[3 * 33]); o.z = pk2(s[4 * 33], s[5 * 33]); o.w = pk2(s[6 * 33], s[7 * 33]);
        *(u32x4*)(d.WT + (size_t)n * d.K + 8 * c) = o; }
    LDS_WAIT();
}

__device__ __forceinline__ void prologue(const Params& p, unsigned char* smem) {
    const int tid = otid(), lane = tid & 63, wave = tid >> 6;
    const int gw = obid() * NWAVES + wave, NGW = gridDim.x * NWAVES;
    float* scr = (float*)(smem + wave * 16384);
    unsigned char* ws = p.ws;
    {
        float va[32], vb[32]; TDesc da, db;
        int it = gw;
        if (it < TN7) { tdecode(p, it, da); tload(da, lane, va); }
        while (it < TN7) {
            int nx = it + NGW;
            if (nx < TN7) { tdecode(p, nx, db); tload(db, lane, vb); }
            tstore(da, lane, va, scr);
            it = nx; nx = it + NGW;
            if (it >= TN7) break;
            if (nx < TN7) { tdecode(p, nx, da); tload(da, lane, va); }
            tstore(db, lane, vb, scr);
            it = nx;
        }
    }
    const int gt = obid() * NTHR + tid, NT = gridDim.x * NTHR;
    bf16* Ac = (bf16*)(ws + WS_AC);
    for (int idx = gt; idx < 256 * DM; idx += NT) { const int row = idx >> 10, col = idx & 1023; float v = 0.f;
        if (row < 2) v = p.in[2][row * DM + col]; else if (row < NSEQ) v = p.in[3][(row - 2) * DM + col];
        Ac[idx] = (bf16)f2bf(v * sigmoidf_(v)); }
    f32x2* TAB = (f32x2*)(ws + WS_TAB);
    for (int idx = gt; idx < 8200 * 32; idx += NT) { const int pos = idx >> 5, i = idx & 31;
        const double ang = (double)pos * ROPE_INV[i];
        const double n = rint(ang * 0.6366197723675814); double r = fma(-n, 1.5707963267948966, ang); r = fma(-n, 6.123233995736766e-17, r); const double r2 = r * r;
        const double sn = r * (1.0 + r2 * (-1.0 / 6 + r2 * (1.0 / 120 + r2 * (-1.0 / 5040 + r2 * (1.0 / 362880 + r2 * (-1.0 / 39916800 + r2 * (1.0 / 6227020800.0)))))));
        const double cn = 1.0 + r2 * (-0.5 + r2 * (1.0 / 24 + r2 * (-1.0 / 720 + r2 * (1.0 / 40320 + r2 * (-1.0 / 3628800 + r2 * (1.0 / 479001600.0 + r2 * (-1.0 / 87178291200.0)))))));
        const int qd = ((int)n) & 3; const double c = (qd == 0) ? cn : (qd == 1) ? -sn : (qd == 2) ? -cn : sn, s = (qd == 0) ? sn : (qd == 1) ? cn : (qd == 2) ? -sn : -cn;
        TAB[idx] = (f32x2){(float)c, (float)s}; }
}

__device__ __forceinline__ void norm_phase(const Params& p, int l, int which, unsigned char* smem) {
    const int tid = otid(), lane = tid & 63, wave = tid >> 6;
    const int gw = obid() * NWAVES + wave, NGW = gridDim.x * NWAVES;
    const bool do_gates = (which == 1) && !(l & 1);
    const bool first = (which == 1) && (l == 0);
    float* X = p.out;
    const float* MOD = (const float*)(p.ws + WS_MOD);
    bf16* H = (bf16*)(p.ws + WS_H);
    float* gwl = (float*)smem;
    if (do_gates) {
        const float* W = p.in[15] + (size_t)(l >> 1) * DM * INA + 2048;
        for (int idx = tid; idx < 8192; idx += NTHR) gwl[idx] = W[(size_t)(idx >> 3) * INA + (idx & 7)];
        __syncthreads();
    }
    f32x4 gwa[4][4];
#pragma unroll
    for (int j = 0; j < 4; ++j)
#pragma unroll
        for (int e = 0; e < 4; ++e) gwa[j][e] = do_gates ? *(const f32x4*)(gwl + (4 * lane + 256 * j + e) * 8) : (f32x4){0.f, 0.f, 0.f, 0.f};
    const float* nw = (which == 1 ? p.in[11] : p.in[12]) + l * DM;
    const int off_sh = l * 6144 + (which == 1 ? 0 : 3072), off_sc = off_sh + 1024;
    f32x4 nwv[4];
#pragma unroll
    for (int j = 0; j < 4; ++j) nwv[j] = *(const f32x4*)(nw + 4 * lane + 256 * j);
    f32x4 vn[4], vn2[4];
#define NORM_SRC(r_) (first ? ((r_) < RP ? p.in[0] + (size_t)(r_) * DM : p.in[1] + (size_t)((r_) - RP) * DM) : X + (size_t)(r_) * DM)
    { const int row = gw; if (row < R) { const float* src = NORM_SRC(row);
#pragma unroll
        for (int j = 0; j < 4; ++j) vn[j] = *(const f32x4*)(src + 4 * lane + 256 * j); }
      const int row2 = gw + NGW; if (row2 < R) { const float* src = NORM_SRC(row2);
#pragma unroll
        for (int j = 0; j < 4; ++j) vn2[j] = *(const f32x4*)(src + 4 * lane + 256 * j); } }
    int cur_sq = -1; f32x4 mulv[4], shv[4];
    for (int row = gw; row < R; row += NGW) {
        const int sq = seq_of(row);
        if (sq != cur_sq) { cur_sq = sq; const float* mrow_ = MOD + (size_t)sq * MODW;
#pragma unroll
            for (int j = 0; j < 4; ++j) { const f32x4 sc = *(const f32x4*)(mrow_ + off_sc + 4 * lane + 256 * j); shv[j] = *(const f32x4*)(mrow_ + off_sh + 4 * lane + 256 * j); mulv[j] = nwv[j] * (sc + 1.f); } }
        f32x4 v[4]; float ss = 0.f;
#pragma unroll
        for (int j = 0; j < 4; ++j) { v[j] = vn[j]; vn[j] = vn2[j]; }
        { const int nrow = row + 2 * NGW; if (nrow < R) { const float* src = NORM_SRC(nrow);
#pragma unroll
            for (int j = 0; j < 4; ++j) vn2[j] = *(const f32x4*)(src + 4 * lane + 256 * j); } }
#pragma unroll
        for (int j = 0; j < 4; ++j) ss += (v[j].x * v[j].x + v[j].y * v[j].y) + (v[j].z * v[j].z + v[j].w * v[j].w);
        if (first) {
#pragma unroll
            for (int j = 0; j < 4; ++j) *(f32x4*)(X + (size_t)row * DM + 4 * lane + 256 * j) = v[j];
        }
        const float rstd = rsqrtf(wave_sum(ss) * (1.f / DM) + EPS);
        float ga[8];
#pragma unroll
        for (int g = 0; g < 8; ++g) ga[g] = 0.f;
#pragma unroll
        for (int j = 0; j < 4; ++j) {
            f32x4 h = v[j] * rstd * mulv[j] + shv[j];
            *(u32x2*)(H + (size_t)row * DM + 4 * lane + 256 * j) = (u32x2){pk2(h.x, h.y), pk2(h.z, h.w)};
            if (do_gates) {
#pragma unroll
                for (int e = 0; e < 4; ++e) { const float* wp = gwl + (4 * lane + 256 * j + e) * 8; const f32x4 w0 = gwa[j][e], w1 = *(const f32x4*)(wp + 4); const float hv = h[e];
                    ga[0] += hv * w0.x; ga[1] += hv * w0.y; ga[2] += hv * w0.z; ga[3] += hv * w0.w; ga[4] += hv * w1.x; ga[5] += hv * w1.y; ga[6] += hv * w1.z; ga[7] += hv * w1.w; }
            }
        }
        if (do_gates) {
            const float* bif = p.in[16] + (l >> 1) * 8;
#pragma unroll
            for (int g = 0; g < 8; ++g) ga[g] = wave_sum(ga[g]);
            if (lane == 0) { float* G = (float*)(p.ws + WS_GATES) + (size_t)row * 8;
                *(f32x4*)G = (f32x4){ga[0] + bif[0], ga[1] + bif[1], ga[2] + bif[2], ga[3] + bif[3]}; *(f32x4*)(G + 4) = (f32x4){ga[4] + bif[4], ga[5] + bif[5], ga[6] + bif[6], ga[7] + bif[7]}; }
        }
    }
    __syncthreads();
}

__device__ __forceinline__ float scan_add(float v, int lane) {
#pragma unroll
    for (int o = 1; o < 64; o <<= 1) { const float t = shup(v, o); if (lane >= o) v += t; }
    return v;
}
__device__ __forceinline__ float scan_max(float v, int lane) {
#pragma unroll
    for (int o = 1; o < 64; o <<= 1) { const float t = shup(v, o); if (lane >= o) v = fmaxf(v, t); }
    return v;
}
constexpr float KSCALE = 0.08838834764831845f;

__device__ __forceinline__ void head_out(const Params& p, int i, int h, int row, int lane, float hv0, float hv1, unsigned zo, f32x2 on) {
    const float ss = wave_sum(hv0 * hv0 + hv1 * hv1);
    const float rstd = rsqrtf(ss * (1.f / 128.f) + EPS);
    unsigned* CAT = (unsigned*)((bf16*)(p.ws + WS_CAT) + (size_t)row * DM + h * 128);
    CAT[lane] = pk2(hv0 * rstd * on.x * sigmoidf_(bflo(zo)), hv1 * rstd * on.y * sigmoidf_(bfhi(zo)));
}
__device__ __forceinline__ void mlstm_local(const Params& p, int i, int item, unsigned char* smem) {
    const int tid = otid(), lane = tid & 63, wave = tid >> 6, fr = lane & 15, fq = lane >> 4;
    const int b = item >> 9, h = (item >> 7) & 3, c = item & 127, r0 = b * SEQL + c * 64;
    float* ws_l = (float*)smem;
    bf16* kT = (bf16*)(smem + 1024);
    bf16* vT = kT + 128 * 72;
    const float* G = (const float*)(p.ws + WS_GATES);
    const bf16* Z = (const bf16*)(p.ws + WS_ZU);
    if (wave == 0) {
        const float ig = G[(size_t)(r0 + lane) * 8 + h], lf = logsigmoidf(G[(size_t)(r0 + lane) * 8 + 4 + h]);
        const float bs = scan_add(lf, lane), bL = shi(bs, 63);
        const float a = bL - bs + ig, amax = wave_max(a);
        ws_l[lane] = __expf(a - amax);
        if (lane == 0) { float* CS = (float*)(p.ws + WS_CS); CS[item * 2] = bL; CS[item * 2 + 1] = amax; }
    }
    __syncthreads();
    { u32x4 wv[4];
#pragma unroll
      for (int it = 0; it < 4; ++it) { const int q = tid + it * NTHR, which = q >> 10, idx = q & 1023, s = idx & 63, ch = idx >> 6; wv[it] = *(const u32x4*)(Z + (size_t)(r0 + s) * ZW + (which ? 1024 : 512) + h * 128 + ch * 8); }
#pragma unroll
      for (int it = 0; it < 4; ++it) { const int q = tid + it * NTHR, which = q >> 10, idx = q & 1023, s = idx & 63, ch = idx >> 6; const u32x4 w = wv[it];
        bf16* dst = (which ? vT : kT) + (ch * 8) * 72 + s;
        if (which) {
            dst[0 * 72] = (bf16)(w.x & 0xffff); dst[1 * 72] = (bf16)(w.x >> 16); dst[2 * 72] = (bf16)(w.y & 0xffff); dst[3 * 72] = (bf16)(w.y >> 16);
            dst[4 * 72] = (bf16)(w.z & 0xffff); dst[5 * 72] = (bf16)(w.z >> 16); dst[6 * 72] = (bf16)(w.w & 0xffff); dst[7 * 72] = (bf16)(w.w >> 16);
        } else { const float sc = ws_l[s] * KSCALE;
            dst[0 * 72] = (bf16)f2bf(bflo(w.x) * sc); dst[1 * 72] = (bf16)f2bf(bfhi(w.x) * sc); dst[2 * 72] = (bf16)f2bf(bflo(w.y) * sc); dst[3 * 72] = (bf16)f2bf(bfhi(w.y) * sc);
            dst[4 * 72] = (bf16)f2bf(bflo(w.z) * sc); dst[5 * 72] = (bf16)f2bf(bfhi(w.z) * sc); dst[6 * 72] = (bf16)f2bf(bflo(w.w) * sc); dst[7 * 72] = (bf16)f2bf(bfhi(w.w) * sc); } } }
    __syncthreads();
    f32x4 acc[8];
#pragma unroll
    for (int mt = 0; mt < 8; ++mt) acc[mt] = (f32x4){0.f, 0.f, 0.f, 0.f};
#pragma unroll
    for (int ks = 0; ks < 2; ++ks) { const bf16x8 B = *(const bf16x8*)(vT + (16 * wave + fr) * 72 + 32 * ks + 8 * fq);
#pragma unroll
        for (int mt = 0; mt < 8; ++mt) { const bf16x8 A = *(const bf16x8*)(kT + (16 * mt + fr) * 72 + 32 * ks + 8 * fq); acc[mt] = __builtin_amdgcn_mfma_f32_16x16x32_bf16(A, B, acc[mt], 0, 0, 0); } }
    bf16* dCt = (bf16*)(p.ws + WS_DCT) + (size_t)item * 16384;
#pragma unroll
    for (int mt = 0; mt < 8; ++mt) *(u32x2*)(dCt + (16 * wave + fr) * 128 + 16 * mt + 4 * fq) = (u32x2){pk2_sw(acc[mt][0], acc[mt][1]), pk2_sw(acc[mt][2], acc[mt][3])};
    if (tid < 128) { float s = 0.f;
        for (int t = 0; t < 64; ++t) s += bf2f(kT[tid * 72 + t]);
        ((float*)(p.ws + WS_DN))[item * 128 + tid] = s; }
    __syncthreads();
}

__device__ __forceinline__ void mlstm_scan(const Params& p, int i, unsigned char* smem) {
    const float* CS = (const float*)(p.ws + WS_CS); const bf16* dCt = (const bf16*)(p.ws + WS_DCT); const float* DN = (const float*)(p.ws + WS_DN);
    bf16* CSt = (bf16*)(p.ws + WS_CST); float* NS = (float*)(p.ws + WS_NS); float* MS = (float*)(p.ws + WS_MS);
    for (int idx = obid() * NTHR + otid(); idx < 8 * 16384; idx += gridDim.x * NTHR) {
        const int bh = idx >> 14, e = idx & 16383;
        float* csl = (float*)smem;
        __syncthreads(); if (otid() < 256) csl[otid()] = CS[bh * 256 + otid()]; __syncthreads();
        float C = 0.f, m = 0.f, nacc = 0.f;
        float dv[16], dnv[16], dv2[16], dnv2[16];
#define SC_LD(D, DNV, c0_) do { _Pragma("unroll") for (int k_ = 0; k_ < 16; ++k_) { D[k_] = bf2f(dCt[(size_t)(bh * 128 + (c0_) + k_) * 16384 + e]); DNV[k_] = (e < 128) ? DN[(bh * 128 + (c0_) + k_) * 128 + e] : 0.f; } } while (0)
#define SC_RUN(D, DNV, c0_) do { _Pragma("unroll") for (int k_ = 0; k_ < 16; ++k_) { const int item = bh * 128 + (c0_) + k_; const float bL = csl[2 * ((c0_) + k_)], amax = csl[2 * ((c0_) + k_) + 1]; \
                CSt[(size_t)item * 16384 + e] = (bf16)f2bf(C); if (e < 128) NS[item * 128 + e] = nacc; if (e == 0) MS[item] = m; \
                const float mn = fmaxf(bL + m, amax), f1 = __expf(bL + m - mn), f2 = __expf(amax - mn); C = f1 * C + f2 * D[k_]; nacc = f1 * nacc + f2 * DNV[k_]; m = mn; } } while (0)
        SC_LD(dv, dnv, 0);
        for (int c0 = 0; c0 < 128; c0 += 32) {
            SC_LD(dv2, dnv2, c0 + 16);
            SC_RUN(dv, dnv, c0);
            if (c0 + 32 < 128) SC_LD(dv, dnv, c0 + 32);
            SC_RUN(dv2, dnv2, c0 + 16);
        }
#undef SC_LD
#undef SC_RUN
        const int b = bh >> 2, h = bh & 3; const size_t sidx = (size_t)((i * 2 + b) * 4 + h);
        p.out[O_PC + sidx * 16384 + (size_t)(e & 127) * 128 + (e >> 7)] = C;
        if (e < 128) p.out[O_PN + sidx * 128 + e] = nacc;
        if (e == 0) p.out[O_PM + sidx] = m;
    }
}

__device__ __forceinline__ void mlstm_out(const Params& p, int i, int item, unsigned char* smem) {
    const int tid = otid(), lane = tid & 63, wave = tid >> 6, fr = lane & 15, fq = lane >> 4;
    const int b = item >> 9, h = (item >> 7) & 3, c = item & 127, r0 = b * SEQL + c * 64;
    float* d_l = (float*)smem;
    float* M_l = d_l + 64;
    float* wg_l = d_l + 128;
    float* mt_l = d_l + 192;
    float* den_l = d_l + 256;
    float* rs_l = d_l + 320;
    float* qn_l = d_l + 448;
    bf16* q_l = (bf16*)(smem + 2048);
    bf16* k_l = q_l + 64 * 136;
    bf16* vT = k_l + 64 * 136;
    bf16* Sw = vT + 128 * 72;
    float* hbuf = (float*)(Sw + 64 * 72);
    const float* G = (const float*)(p.ws + WS_GATES);
    const bf16* Z = (const bf16*)(p.ws + WS_ZU);
    bf16x8 Bc[4];
    { const bf16* cp = (const bf16*)(p.ws + WS_CST) + (size_t)item * 16384 + (16 * wave + fr) * 128 + 8 * fq;
#pragma unroll
      for (int ks = 0; ks < 4; ++ks) Bc[ks] = *(const bf16x8*)(cp + 32 * ks); }
    if (wave == 0) {
        const float ig = G[(size_t)(r0 + lane) * 8 + h], lf = logsigmoidf(G[(size_t)(r0 + lane) * 8 + 4 + h]);
        const float bs = scan_add(lf, lane), d = ig - bs, gmax = scan_max(d, lane);
        const float mc = ((const float*)(p.ws + WS_MS))[item];
        const float Mt = fmaxf(mc, gmax);
        d_l[lane] = d; M_l[lane] = Mt; wg_l[lane] = __expf(mc - Mt); mt_l[lane] = bs + Mt;
    }
    { u32x4 wv[6];
#pragma unroll
      for (int it = 0; it < 6; ++it) { const int q = tid + it * NTHR, which = q >> 10, idx = q & 1023, s = (which == 2) ? (idx & 63) : (idx >> 4), ch = (which == 2) ? (idx >> 6) : (idx & 15); wv[it] = *(const u32x4*)(Z + (size_t)(r0 + s) * ZW + which * 512 + h * 128 + ch * 8); }
#pragma unroll
      for (int it = 0; it < 6; ++it) { const int q = tid + it * NTHR, which = q >> 10, idx = q & 1023, s = (which == 2) ? (idx & 63) : (idx >> 4), ch = (which == 2) ? (idx >> 6) : (idx & 15); const u32x4 w = wv[it];
        if (which == 0) *(u32x4*)(q_l + s * 136 + ch * 8) = w;
        else if (which == 1) { u32x4 o; o.x = pk2(bflo(w.x) * KSCALE, bfhi(w.x) * KSCALE); o.y = pk2(bflo(w.y) * KSCALE, bfhi(w.y) * KSCALE);
            o.z = pk2(bflo(w.z) * KSCALE, bfhi(w.z) * KSCALE); o.w = pk2(bflo(w.w) * KSCALE, bfhi(w.w) * KSCALE); *(u32x4*)(k_l + s * 136 + ch * 8) = o; }
        else { bf16* dst = vT + (ch * 8) * 72 + s;
            dst[0 * 72] = (bf16)(w.x & 0xffff); dst[1 * 72] = (bf16)(w.x >> 16); dst[2 * 72] = (bf16)(w.y & 0xffff); dst[3 * 72] = (bf16)(w.y >> 16);
            dst[4 * 72] = (bf16)(w.z & 0xffff); dst[5 * 72] = (bf16)(w.z >> 16); dst[6 * 72] = (bf16)(w.w & 0xffff); dst[7 * 72] = (bf16)(w.w >> 16); } } }
    __syncthreads();
    {
        const int mt = wave >> 1, nt0 = 2 * (wave & 1);
        f32x4 a2[2] = {(f32x4){0.f, 0.f, 0.f, 0.f}, (f32x4){0.f, 0.f, 0.f, 0.f}};
#pragma unroll
        for (int ks = 0; ks < 4; ++ks) { const bf16x8 A = *(const bf16x8*)(q_l + (16 * mt + fr) * 136 + 32 * ks + 8 * fq);
#pragma unroll
            for (int n = 0; n < 2; ++n) { const bf16x8 B = *(const bf16x8*)(k_l + (16 * (nt0 + n) + fr) * 136 + 32 * ks + 8 * fq); a2[n] = __builtin_amdgcn_mfma_f32_16x16x32_bf16(A, B, a2[n], 0, 0, 0); } }
        float rsum[4] = {0.f, 0.f, 0.f, 0.f};
#pragma unroll
        for (int n = 0; n < 2; ++n) { const int s = 16 * (nt0 + n) + fr; const float ds = d_l[s];
#pragma unroll
            for (int j = 0; j < 4; ++j) { const int t = 16 * mt + 4 * fq + j; const float wv = (s <= t) ? __expf(ds - M_l[t]) : 0.f; const float val = a2[n][j] * wv; rsum[j] += val; Sw[t * 72 + s] = (bf16)f2bf(val); } }
#pragma unroll
        for (int j = 0; j < 4; ++j) { float v = rsum[j]; v += shx(v, 1); v += shx(v, 2); v += shx(v, 4); v += shx(v, 8); if (fr == 0) rs_l[(wave & 1) * 64 + 16 * mt + 4 * fq + j] = v; }
        { const int t = tid >> 3, part = tid & 7; const float* NS = (const float*)(p.ws + WS_NS) + item * 128 + part * 16;
          const u32x4 qa = *(const u32x4*)(q_l + t * 136 + part * 16), qb = *(const u32x4*)(q_l + t * 136 + part * 16 + 8);
          const f32x4 n0 = *(const f32x4*)NS, n1 = *(const f32x4*)(NS + 4), n2 = *(const f32x4*)(NS + 8), n3 = *(const f32x4*)(NS + 12);
          float v = bflo(qa.x) * n0.x + bfhi(qa.x) * n0.y + bflo(qa.y) * n0.z + bfhi(qa.y) * n0.w + bflo(qa.z) * n1.x + bfhi(qa.z) * n1.y + bflo(qa.w) * n1.z + bfhi(qa.w) * n1.w
                  + bflo(qb.x) * n2.x + bfhi(qb.x) * n2.y + bflo(qb.y) * n2.z + bfhi(qb.y) * n2.w + bflo(qb.z) * n3.x + bfhi(qb.z) * n3.y + bflo(qb.w) * n3.z + bfhi(qb.w) * n3.w;
          v += shx(v, 1); v += shx(v, 2); v += shx(v, 4); if (part == 0) qn_l[t] = v; }
    }
    __syncthreads();
    if (tid < 64) { const int t = tid; const float den = wg_l[t] * qn_l[t] + (rs_l[t] + rs_l[64 + t]); den_l[t] = __builtin_amdgcn_rcpf(fmaxf(fabsf(den), __expf(-mt_l[t]))); }
    f32x4 acc[4];
#pragma unroll
    for (int mt = 0; mt < 4; ++mt) acc[mt] = (f32x4){0.f, 0.f, 0.f, 0.f};
#pragma unroll
    for (int ks = 0; ks < 4; ++ks) { const bf16x8 B = Bc[ks];
#pragma unroll
        for (int mt = 0; mt < 4; ++mt) { const bf16x8 A = *(const bf16x8*)(q_l + (16 * mt + fr) * 136 + 32 * ks + 8 * fq); acc[mt] = __builtin_amdgcn_mfma_f32_16x16x32_bf16(A, B, acc[mt], 0, 0, 0); } }
#pragma unroll
    for (int mt = 0; mt < 4; ++mt)
#pragma unroll
        for (int j = 0; j < 4; ++j) acc[mt][j] *= wg_l[16 * mt + 4 * fq + j];
#pragma unroll
    for (int ks = 0; ks < 2; ++ks) { const bf16x8 B = *(const bf16x8*)(vT + (16 * wave + fr) * 72 + 32 * ks + 8 * fq);
#pragma unroll
        for (int mt = 0; mt < 4; ++mt) { const bf16x8 A = *(const bf16x8*)(Sw + (16 * mt + fr) * 72 + 32 * ks + 8 * fq); acc[mt] = __builtin_amdgcn_mfma_f32_16x16x32_bf16(A, B, acc[mt], 0, 0, 0); } }
    __syncthreads();
#pragma unroll
    for (int mt = 0; mt < 4; ++mt)
#pragma unroll
        for (int j = 0; j < 4; ++j) { const int t = 16 * mt + 4 * fq + j; hbuf[t * 132 + 16 * wave + fr] = acc[mt][j] * den_l[t]; }
    __syncthreads();
    { unsigned zo[8]; const f32x2 on = *(const f32x2*)(p.in[17] + i * 512 + h * 128 + 2 * lane);
#pragma unroll
      for (int tt = 0; tt < 8; ++tt) zo[tt] = *(const unsigned*)(Z + (size_t)(r0 + 8 * wave + tt) * ZW + 1536 + h * 128 + 2 * lane);
#pragma unroll
      for (int tt = 0; tt < 8; ++tt) { const int t = 8 * wave + tt; const f32x2 hv = *(const f32x2*)(hbuf + t * 132 + 2 * lane); head_out(p, i, h, r0 + t, lane, hv.x, hv.y, zo[tt], on); } }
    __syncthreads();
}

__device__ __forceinline__ void mlstm_out2(const Params& p, int i, int itA, int itB, unsigned char* smem) {
    const int tid = otid(), lane = tid & 63, wave = tid >> 6, fr = lane & 15, fq = lane >> 4, hh = wave >> 2, wl = wave & 3, tl = tid & 255;
    const int item_ = hh ? itB : itA; const bool active = item_ < 1024; const int item = active ? item_ : 0;
    const int b = item >> 9, h = (item >> 7) & 3, c = item & 127, r0 = b * SEQL + c * 64;
    unsigned char* sb = smem + hh * 65536;
    float* d_l = (float*)sb;
    float* M_l = d_l + 64;
    float* wg_l = d_l + 128;
    float* mt_l = d_l + 192;
    float* den_l = d_l + 256;
    float* rs_l = d_l + 320;
    float* qn_l = d_l + 384;
    bf16* q_l = (bf16*)(sb + 2048);
    bf16* k_l = q_l + 64 * 136;
    float* hbuf = (float*)(sb + 2048);
    bf16* vT = k_l + 64 * 136;
    bf16* Sw = vT + 128 * 72;
    const float* G = (const float*)(p.ws + WS_GATES);
    const bf16* Z = (const bf16*)(p.ws + WS_ZU);
    bf16x8 Bc[2][4];
#pragma unroll
    for (int n = 0; n < 2; ++n) { const bf16* cp = (const bf16*)(p.ws + WS_CST) + (size_t)item * 16384 + (16 * (2 * wl + n) + fr) * 128 + 8 * fq;
#pragma unroll
        for (int ks = 0; ks < 4; ++ks) Bc[n][ks] = *(const bf16x8*)(cp + 32 * ks); }
    if (wl == 0) {
        const float ig = G[(size_t)(r0 + lane) * 8 + h], lf = logsigmoidf(G[(size_t)(r0 + lane) * 8 + 4 + h]);
        const float bs = scan_add(lf, lane), d = ig - bs, gmax = scan_max(d, lane);
        const float mc = ((const float*)(p.ws + WS_MS))[item];
        const float Mt = fmaxf(mc, gmax);
        d_l[lane] = d; M_l[lane] = Mt; wg_l[lane] = __expf(mc - Mt); mt_l[lane] = bs + Mt;
    }
    { u32x4 wv[12];
#pragma unroll
      for (int it = 0; it < 12; ++it) { const int q = tl + it * 256, which = q >> 10, idx = q & 1023, s = (which == 2) ? (idx & 63) : (idx >> 4), ch = (which == 2) ? (idx >> 6) : (idx & 15); wv[it] = *(const u32x4*)(Z + (size_t)(r0 + s) * ZW + which * 512 + h * 128 + ch * 8); }
#pragma unroll
      for (int it = 0; it < 12; ++it) { const int q = tl + it * 256, which = q >> 10, idx = q & 1023, s = (which == 2) ? (idx & 63) : (idx >> 4), ch = (which == 2) ? (idx >> 6) : (idx & 15); const u32x4 w = wv[it];
        if (which == 0) *(u32x4*)(q_l + s * 136 + ch * 8) = w;
        else if (which == 1) { u32x4 o; o.x = pk2(bflo(w.x) * KSCALE, bfhi(w.x) * KSCALE); o.y = pk2(bflo(w.y) * KSCALE, bfhi(w.y) * KSCALE);
            o.z = pk2(bflo(w.z) * KSCALE, bfhi(w.z) * KSCALE); o.w = pk2(bflo(w.w) * KSCALE, bfhi(w.w) * KSCALE); *(u32x4*)(k_l + s * 136 + ch * 8) = o; }
        else { bf16* dst = vT + (ch * 8) * 72 + s;
            dst[0 * 72] = (bf16)(w.x & 0xffff); dst[1 * 72] = (bf16)(w.x >> 16); dst[2 * 72] = (bf16)(w.y & 0xffff); dst[3 * 72] = (bf16)(w.y >> 16);
            dst[4 * 72] = (bf16)(w.z & 0xffff); dst[5 * 72] = (bf16)(w.z >> 16); dst[6 * 72] = (bf16)(w.w & 0xffff); dst[7 * 72] = (bf16)(w.w >> 16); } } }
    __syncthreads();
    {
        const int mt = wl;
        f32x4 a4[4];
#pragma unroll
        for (int n = 0; n < 4; ++n) a4[n] = (f32x4){0.f, 0.f, 0.f, 0.f};
#pragma unroll
        for (int ks = 0; ks < 4; ++ks) { const bf16x8 A = *(const bf16x8*)(q_l + (16 * mt + fr) * 136 + 32 * ks + 8 * fq);
#pragma unroll
            for (int n = 0; n < 4; ++n) if (n <= mt) { const bf16x8 B = *(const bf16x8*)(k_l + (16 * n + fr) * 136 + 32 * ks + 8 * fq); a4[n] = __builtin_amdgcn_mfma_f32_16x16x32_bf16(A, B, a4[n], 0, 0, 0); } }
        float rsum[4] = {0.f, 0.f, 0.f, 0.f};
#pragma unroll
        for (int n = 0; n < 4; ++n) { const int s = 16 * n + fr; const float ds = d_l[s];
#pragma unroll
            for (int j = 0; j < 4; ++j) { const int t = 16 * mt + 4 * fq + j; const float wv = (s <= t) ? __expf(ds - M_l[t]) : 0.f; const float val = a4[n][j] * wv; rsum[j] += val; Sw[t * 72 + s] = (bf16)f2bf(val); } }
#pragma unroll
        for (int j = 0; j < 4; ++j) { float v = rsum[j]; v += shx(v, 1); v += shx(v, 2); v += shx(v, 4); v += shx(v, 8); if (fr == 0) rs_l[16 * mt + 4 * fq + j] = v; }
        { const int t = tl >> 2, part = tl & 3; const float* NS = (const float*)(p.ws + WS_NS) + item * 128 + part * 32; float v = 0.f;
#pragma unroll
          for (int g = 0; g < 4; ++g) { const u32x4 qa = *(const u32x4*)(q_l + t * 136 + part * 32 + 8 * g); const f32x4 n0 = *(const f32x4*)(NS + 8 * g), n1 = *(const f32x4*)(NS + 8 * g + 4);
              v += bflo(qa.x) * n0.x + bfhi(qa.x) * n0.y + bflo(qa.y) * n0.z + bfhi(qa.y) * n0.w + bflo(qa.z) * n1.x + bfhi(qa.z) * n1.y + bflo(qa.w) * n1.z + bfhi(qa.w) * n1.w; }
          v += shx(v, 1); v += shx(v, 2); if (part == 0) qn_l[t] = v; }
    }
    __syncthreads();
    if (tl < 64) { const int t = tl; const float den = wg_l[t] * qn_l[t] + rs_l[t]; den_l[t] = __builtin_amdgcn_rcpf(fmaxf(fabsf(den), __expf(-mt_l[t]))); }
    f32x4 acc[2][4];
#pragma unroll
    for (int n = 0; n < 2; ++n)
#pragma unroll
        for (int mt = 0; mt < 4; ++mt) acc[n][mt] = (f32x4){0.f, 0.f, 0.f, 0.f};
#pragma unroll
    for (int ks = 0; ks < 4; ++ks)
#pragma unroll
        for (int mt = 0; mt < 4; ++mt) { const bf16x8 A = *(const bf16x8*)(q_l + (16 * mt + fr) * 136 + 32 * ks + 8 * fq);
#pragma unroll
            for (int n = 0; n < 2; ++n) acc[n][mt] = __builtin_amdgcn_mfma_f32_16x16x32_bf16(A, Bc[n][ks], acc[n][mt], 0, 0, 0); }
#pragma unroll
    for (int mt = 0; mt < 4; ++mt)
#pragma unroll
        for (int j = 0; j < 4; ++j) { const float wgv = wg_l[16 * mt + 4 * fq + j]; acc[0][mt][j] *= wgv; acc[1][mt][j] *= wgv; }
#pragma unroll
    for (int ks = 0; ks < 2; ++ks)
#pragma unroll
        for (int mt = 0; mt < 4; ++mt) { const bf16x8 A = *(const bf16x8*)(Sw + (16 * mt + fr) * 72 + 32 * ks + 8 * fq);
#pragma unroll
            for (int n = 0; n < 2; ++n) { const bf16x8 B = *(const bf16x8*)(vT + (16 * (2 * wl + n) + fr) * 72 + 32 * ks + 8 * fq); acc[n][mt] = __builtin_amdgcn_mfma_f32_16x16x32_bf16(A, B, acc[n][mt], 0, 0, 0); } }
    __syncthreads();
#pragma unroll
    for (int n = 0; n < 2; ++n)
#pragma unroll
        for (int mt = 0; mt < 4; ++mt)
#pragma unroll
            for (int j = 0; j < 4; ++j) { const int t = 16 * mt + 4 * fq + j; hbuf[t * 132 + 16 * (2 * wl + n) + fr] = acc[n][mt][j] * den_l[t]; }
    __syncthreads();
    { unsigned zo[16]; const f32x2 on = *(const f32x2*)(p.in[17] + i * 512 + h * 128 + 2 * lane);
#pragma unroll
      for (int tt = 0; tt < 16; ++tt) zo[tt] = *(const unsigned*)(Z + (size_t)(r0 + 16 * wl + tt) * ZW + 1536 + h * 128 + 2 * lane);
#pragma unroll
      for (int tt = 0; tt < 16; ++tt) { const int t = 16 * wl + tt; const f32x2 hv = *(const f32x2*)(hbuf + t * 132 + 2 * lane);
          const float ss = wave_sum(hv.x * hv.x + hv.y * hv.y); const float rstd = rsqrtf(ss * (1.f / 128.f) + EPS);
          if (active) { unsigned* CAT = (unsigned*)((bf16*)(p.ws + WS_CAT) + (size_t)(r0 + t) * DM + h * 128);
              CAT[lane] = pk2(hv.x * rstd * on.x * sigmoidf_(bflo(zo[tt])), hv.y * rstd * on.y * sigmoidf_(bfhi(zo[tt]))); } } }
    __syncthreads();
}

__device__ __forceinline__ void mlstm_sample(const Params& p, int i, int item, unsigned char* smem) {
    const int tid = otid(), lane = tid & 63, wave = tid >> 6;
    const int s = item >> 2, h = item & 3, r0 = RP + 8 * s;
    float* qq = (float*)smem;
    float* kk = qq + 1024;
    float* vv = kk + 1024;
    float* qT = vv + 1024;
    float* kwT = qT + 1024;
    float* part = kwT + 1024;
    float* S_l = part + 4096;
    float* sc = S_l + 64;
    const bf16* Z = (const bf16*)(p.ws + WS_ZU);
    const float* G = (const float*)(p.ws + WS_GATES);
    const size_t sidx = (size_t)((i * 128 + s) * 4 + h);
    const float* n0 = p.in[5] + sidx * 128;
    { bf16 zv[6];
#pragma unroll
      for (int it = 0; it < 6; ++it) { const int q = tid + it * NTHR, which = q >> 10, t = (q >> 7) & 7, d = q & 127; zv[it] = Z[(size_t)(r0 + t) * ZW + which * 512 + h * 128 + d]; }
#pragma unroll
      for (int it = 0; it < 6; ++it) { const int q = tid + it * NTHR, which = q >> 10; float v = bf2f(zv[it]); if (which == 1) v *= KSCALE; qq[q] = v; } }
    if (wave == 0) {
        const int t = lane & 7;
        const float ig = G[(size_t)(r0 + t) * 8 + h], lf = logsigmoidf(G[(size_t)(r0 + t) * 8 + 4 + h]);
        float bs = 0.f;
        for (int u = 0; u < 8; ++u) { const float x = shi(lf, u); if (u <= t) bs += x; }
        const float d = ig - bs; float gmax = -INFINITY;
        for (int u = 0; u < 8; ++u) { const float x = shi(d, u); if (u <= t) gmax = fmaxf(gmax, x); }
        const float m0 = p.in[6][sidx];
        const float Mt = fmaxf(m0, gmax), bL = shi(bs, 7), a = bL - bs + ig;
        float amax = -INFINITY;
        for (int u = 0; u < 8; ++u) amax = fmaxf(amax, shi(a, u));
        const float mnew = fmaxf(bL + m0, amax);
        if (lane < 8) { sc[t] = d; sc[8 + t] = Mt; sc[16 + t] = __expf(m0 - Mt); sc[24 + t] = bs + Mt; sc[32 + t] = __expf(a - mnew); }
        if (lane == 0) { sc[56] = __expf(bL + m0 - mnew); sc[57] = mnew; }
    }
    __syncthreads();
    { const int pr = tid >> 3, part = tid & 7, t = pr >> 3, u = pr & 7; float dot = 0.f;
#pragma unroll
        for (int d = 0; d < 16; ++d) dot += qq[t * 128 + part * 16 + d] * kk[u * 128 + part * 16 + d];
        dot += shx(dot, 1); dot += shx(dot, 2); dot += shx(dot, 4);
        if (part == 0) S_l[pr] = (u <= t) ? dot * __expf(sc[u] - sc[8 + t]) : 0.f; }
    if (tid < 64) { const int t = tid >> 3, part = tid & 7; float dot = 0.f;
#pragma unroll
        for (int d = 0; d < 16; ++d) dot += qq[t * 128 + part * 16 + d] * n0[part * 16 + d];
        dot += shx(dot, 1); dot += shx(dot, 2); dot += shx(dot, 4);
        if (part == 0) sc[40 + t] = dot; }
    for (int idx = tid; idx < 1024; idx += NTHR) { const int dk = idx >> 3, t = idx & 7; qT[idx] = qq[t * 128 + dk]; kwT[idx] = kk[t * 128 + dk] * sc[32 + t]; }
    __syncthreads();
    if (tid < 8) { float rs = 0.f; for (int u = 0; u < 8; ++u) rs += S_l[tid * 8 + u];
        const float den = sc[16 + tid] * sc[40 + tid] + rs; sc[48 + tid] = fmaxf(fabsf(den), __expf(-sc[24 + tid])); }
    {
        const int e = tid & 127, g = tid >> 7; const float wc = sc[56];
        float vr[8], acc[8];
#pragma unroll
        for (int u = 0; u < 8; ++u) { vr[u] = vv[u * 128 + e]; acc[u] = 0.f; }
        const float* Cin = p.in[4] + sidx * 16384; float* Cout = p.out + O_SC + sidx * 16384;
        float cin[32];
#pragma unroll
        for (int k = 0; k < 32; ++k) cin[k] = __builtin_nontemporal_load(Cin + (g * 32 + k) * 128 + e);
#pragma unroll
        for (int k = 0; k < 32; ++k) { const int dk = g * 32 + k; const float cv = cin[k];
            const f32x4 q0 = *(const f32x4*)(qT + dk * 8), q1 = *(const f32x4*)(qT + dk * 8 + 4), k0 = *(const f32x4*)(kwT + dk * 8), k1 = *(const f32x4*)(kwT + dk * 8 + 4);
            acc[0] += q0.x * cv; acc[1] += q0.y * cv; acc[2] += q0.z * cv; acc[3] += q0.w * cv; acc[4] += q1.x * cv; acc[5] += q1.y * cv; acc[6] += q1.z * cv; acc[7] += q1.w * cv;
            float cn = wc * cv;
            cn += k0.x * vr[0] + k0.y * vr[1] + k0.z * vr[2] + k0.w * vr[3] + k1.x * vr[4] + k1.y * vr[5] + k1.z * vr[6] + k1.w * vr[7];
            __builtin_nontemporal_store(cn, Cout + dk * 128 + e); }
#pragma unroll
        for (int u = 0; u < 8; ++u) part[(g * 8 + u) * 128 + e] = acc[u];
        if (tid < 128) { float nn = wc * n0[tid];
#pragma unroll
            for (int u = 0; u < 8; ++u) nn += kwT[tid * 8 + u];
            p.out[O_SN + sidx * 128 + tid] = nn; }
        if (tid == 0) p.out[O_SM + sidx] = sc[57];
    }
    __syncthreads();
    {
        const int t = wave; float hv[2];
        const unsigned zo = *(const unsigned*)(Z + (size_t)(r0 + t) * ZW + 1536 + h * 128 + 2 * lane); const f32x2 on = *(const f32x2*)(p.in[17] + i * 512 + h * 128 + 2 * lane);
#pragma unroll
        for (int k = 0; k < 2; ++k) { const int e = 2 * lane + k;
            float num = (part[(0 * 8 + t) * 128 + e] + part[(1 * 8 + t) * 128 + e]) + (part[(2 * 8 + t) * 128 + e] + part[(3 * 8 + t) * 128 + e]);
            num *= sc[16 + t];
#pragma unroll
            for (int u = 0; u < 8; ++u) num += S_l[t * 8 + u] * vv[u * 128 + e];
            hv[k] = num / sc[48 + t]; }
        head_out(p, i, h, r0 + t, lane, hv[0], hv[1], zo, on);
    }
    __syncthreads();
}

__device__ __forceinline__ void unpack8(const u32x4 w, float (&v)[8]) { v[0] = bflo(w.x); v[1] = bfhi(w.x); v[2] = bflo(w.y); v[3] = bfhi(w.y); v[4] = bflo(w.z); v[5] = bfhi(w.z); v[6] = bflo(w.w); v[7] = bfhi(w.w); }
__device__ __forceinline__ void ld8f(const float* s, float (&v)[8]) { const f32x4 a = *(const f32x4*)s, b = *(const f32x4*)(s + 4); v[0] = a.x; v[1] = a.y; v[2] = a.z; v[3] = a.w; v[4] = b.x; v[5] = b.y; v[6] = b.z; v[7] = b.w; }
__device__ __forceinline__ void st8f(float* d, const float (&v)[8]) { *(f32x4*)d = (f32x4){v[0], v[1], v[2], v[3]}; *(f32x4*)(d + 4) = (f32x4){v[4], v[5], v[6], v[7]}; }
__device__ __forceinline__ void shortconv(const Params& p, int i) {
    const bf16* Z = (const bf16*)(p.ws + WS_ZU); bf16* CAT = (bf16*)(p.ws + WS_CAT);
    const float* cw = p.in[18] + i * 3 * 512;
    float cw0[8], cw1[8], cw2[8]; int chc = -1;
    for (int idx = obid() * NTHR + otid(); idx < R * 64; idx += gridDim.x * NTHR) {
        const int row = idx >> 6, ch = (idx & 63) * 8;
        if (ch != chc) { chc = ch; ld8f(cw + ch, cw0); ld8f(cw + 512 + ch, cw1); ld8f(cw + 1024 + ch, cw2); }
        const bool prm = row < RP; const int t = prm ? (row & (SEQL - 1)) : ((row - RP) & 7), S = prm ? SEQL : 8, sq = prm ? (row >> 13) : ((row - RP) >> 3);
        float pr[3][8];
#pragma unroll
        for (int j = 0; j < 3; ++j) { const int tt = t - 2 + j;
            if (tt >= 0) { const bf16* zr = Z + (size_t)(row - 2 + j) * ZW; const u32x4 a = *(const u32x4*)(zr + 2560 + ch), b = *(const u32x4*)(zr + 3072 + ch);
                pr[j][0] = bflo(a.x) * bflo(b.x); pr[j][1] = bfhi(a.x) * bfhi(b.x); pr[j][2] = bflo(a.y) * bflo(b.y); pr[j][3] = bfhi(a.y) * bfhi(b.y);
                pr[j][4] = bflo(a.z) * bflo(b.z); pr[j][5] = bfhi(a.z) * bfhi(b.z); pr[j][6] = bflo(a.w) * bflo(b.w); pr[j][7] = bfhi(a.w) * bfhi(b.w); }
            else if (!prm) { const float* st = p.in[7] + ((size_t)(i * 128 + sq) * 2 + (2 + tt)) * 512 + ch; const f32x4 a = *(const f32x4*)st, b = *(const f32x4*)(st + 4);
                pr[j][0] = a.x; pr[j][1] = a.y; pr[j][2] = a.z; pr[j][3] = a.w; pr[j][4] = b.x; pr[j][5] = b.y; pr[j][6] = b.z; pr[j][7] = b.w; }
            else {
#pragma unroll
                for (int e = 0; e < 8; ++e) pr[j][e] = 0.f; } }
        const u32x4 zb = *(const u32x4*)(Z + (size_t)row * ZW + 2048 + ch);
        float zbf[8] = {bflo(zb.x), bfhi(zb.x), bflo(zb.y), bfhi(zb.y), bflo(zb.z), bfhi(zb.z), bflo(zb.w), bfhi(zb.w)};
        float o[8];
#pragma unroll
        for (int e = 0; e < 8; ++e) o[e] = zbf[e] * (cw0[e] * pr[0][e] + cw1[e] * pr[1][e] + cw2[e] * pr[2][e]);
        *(u32x4*)(CAT + (size_t)row * DM + 512 + ch) = (u32x4){pk2(o[0], o[1]), pk2(o[2], o[3]), pk2(o[4], o[5]), pk2(o[6], o[7])};
        if (t >= S - 2) { float* dst = p.out + (prm ? O_PSC + ((size_t)(i * 2 + sq) * 2 + (t - (S - 2))) * 512 : O_SSC + ((size_t)(i * 128 + sq) * 2 + (t - (S - 2))) * 512) + ch;
            *(f32x4*)dst = (f32x4){pr[2][0], pr[2][1], pr[2][2], pr[2][3]}; *(f32x4*)(dst + 4) = (f32x4){pr[2][4], pr[2][5], pr[2][6], pr[2][7]}; }
    }
}


__device__ __forceinline__ void cache_shift(const Params& p, int jl, int bsel, int nsel) {
    const int tid = otid();
    for (int idx = bsel * NTHR + tid; idx < 2 * 128 * 7680; idx += nsel * NTHR) { const int kv = idx / (128 * 7680), r = idx - kv * (128 * 7680), s = r / 7680, q = r - s * 7680;
        const float* src = (kv ? p.in[9] : p.in[8]) + ((size_t)(jl * 128 + s) * 128 + 8) * 256 + 4 * q; float* dst = p.out + (kv ? O_SWV : O_SWK) + ((size_t)(jl * 128 + s) * 128) * 256 + 4 * q;
        __builtin_nontemporal_store(__builtin_nontemporal_load((const f32x4*)src), (f32x4*)dst); }
}

template <int NH>
__device__ __forceinline__ void attn_wave(const bf16* K_l, const bf16* Vt_l, int ldvt, int kt0, const bf16x8 (*Bq)[2], int qidx, int kmin, const float* sinkp, bf16* orow, bool store, int fr, int fq) {
    f32x4 s[NH][9];
    float sk[NH], mx[NH];
#pragma unroll
    for (int h = 0; h < NH; ++h) { sk[h] = sinkp[h] * 1.4426950408889634f; mx[h] = sk[h]; }
#pragma unroll
    for (int kt = 0; kt < 9; ++kt) {
        const bf16x8 A0 = *(const bf16x8*)(K_l + (16 * (kt0 + kt) + fr) * 72 + 8 * fq), A1 = *(const bf16x8*)(K_l + (16 * (kt0 + kt) + fr) * 72 + 32 + 8 * fq);
#pragma unroll
        for (int h = 0; h < NH; ++h) { f32x4 a = (f32x4){0.f, 0.f, 0.f, 0.f};
            a = __builtin_amdgcn_mfma_f32_16x16x32_bf16(A0, Bq[h][0], a, 0, 0, 0); a = __builtin_amdgcn_mfma_f32_16x16x32_bf16(A1, Bq[h][1], a, 0, 0, 0);
#pragma unroll
            for (int j = 0; j < 4; ++j) { const int kidx = 16 * (kt0 + kt) + 4 * fq + j;
                const bool valid = (kt == 0) ? ((kidx > qidx - 128) && (kidx >= kmin)) : (kt == 8) ? (kidx <= qidx) : (kidx >= kmin);
                a[j] = valid ? a[j] * 0.18033688011112042f : -INFINITY; mx[h] = fmaxf(mx[h], a[j]); }
            s[h][kt] = a; } }
    float inv[NH];
#pragma unroll
    for (int h = 0; h < NH; ++h) { mx[h] = fmaxf(mx[h], shx(mx[h], 16)); mx[h] = fmaxf(mx[h], shx(mx[h], 32)); }
#pragma unroll
    for (int h = 0; h < NH; ++h) { float sum = 0.f;
#pragma unroll
        for (int kt = 0; kt < 9; ++kt)
#pragma unroll
            for (int j = 0; j < 4; ++j) { const float e = __builtin_amdgcn_exp2f(s[h][kt][j] - mx[h]); s[h][kt][j] = e; sum += e; }
        inv[h] = sum; }
#pragma unroll
    for (int h = 0; h < NH; ++h) { float sum = inv[h]; sum += shx(sum, 16); sum += shx(sum, 32); inv[h] = __builtin_amdgcn_rcpf(sum + __builtin_amdgcn_exp2f(sk[h] - mx[h])); }
    bf16x8 Bp[NH][5];
#pragma unroll
    for (int h = 0; h < NH; ++h)
#pragma unroll
        for (int pp = 0; pp < 5; ++pp) { u32x4 w; w.x = pk2(s[h][2 * pp][0], s[h][2 * pp][1]); w.y = pk2(s[h][2 * pp][2], s[h][2 * pp][3]);
            if (pp < 4) { w.z = pk2(s[h][2 * pp + 1][0], s[h][2 * pp + 1][1]); w.w = pk2(s[h][2 * pp + 1][2], s[h][2 * pp + 1][3]); } else { w.z = 0u; w.w = 0u; }
            Bp[h][pp] = __builtin_bit_cast(bf16x8, w); }
#pragma unroll
    for (int dt = 0; dt < 4; ++dt) { f32x4 a[NH];
#pragma unroll
        for (int h = 0; h < NH; ++h) a[h] = (f32x4){0.f, 0.f, 0.f, 0.f};
#pragma unroll
        for (int pp = 0; pp < 5; ++pp) { const bf16* vp = Vt_l + (16 * dt + fr) * ldvt + 16 * (kt0 + 2 * pp) + 4 * fq;
            const u32x2 lo = *(const u32x2*)vp, hi = *(const u32x2*)(vp + 16); const bf16x8 V = __builtin_bit_cast(bf16x8, (u32x4){lo.x, lo.y, hi.x, hi.y});
#pragma unroll
            for (int h = 0; h < NH; ++h) a[h] = __builtin_amdgcn_mfma_f32_16x16x32_bf16(V, Bp[h][pp], a[h], 0, 0, 0); }
        if (store) {
#pragma unroll
            for (int h = 0; h < NH; ++h) *(u32x2*)(orow + 64 * h + 16 * dt + 4 * fq) = (u32x2){pk2(a[h][0] * inv[h], a[h][1] * inv[h]), pk2(a[h][2] * inv[h], a[h][3] * inv[h])}; } }
}

__device__ __forceinline__ void attn_phase(const Params& p, int jl, unsigned char* smem) {
    const bf16* Z = (const bf16*)(p.ws + WS_ZU); bf16* CAT = (bf16*)(p.ws + WS_CAT);
    const float* sinkp = p.in[23] + jl * 16;
    for (int u = obid(); u < 768; u += gridDim.x) { const int tidu = otid(), lane = tidu & 63, wave = tidu >> 6, fr = lane & 15, fq = lane >> 4;
        if (u < 512) {
            const int b = u >> 8, kvh = (u >> 6) & 3, qb = u & 63, q0 = qb * 128, rb = b * SEQL;
            bf16x8 Bq[4][2];
            { const bf16* qp = Z + (size_t)(rb + q0 + 16 * wave + fr) * QKVW + kvh * 256 + 8 * fq;
#pragma unroll
              for (int hq = 0; hq < 4; ++hq) { Bq[hq][0] = *(const bf16x8*)(qp + hq * 64); Bq[hq][1] = *(const bf16x8*)(qp + hq * 64 + 32); } }
            bf16* K_l = (bf16*)smem;
            bf16* Vt_l = K_l + 256 * 72;
            { u32x4 wv[8];
#pragma unroll
              for (int it = 0; it < 8; ++it) { const int q = tidu + it * NTHR, which = q >> 11, idx = q & 2047, kidx = which ? (idx & 255) : (idx >> 3), ch = which ? (idx >> 8) : (idx & 7); const int pos = q0 - 128 + kidx;
                wv[it] = (u32x4){0u, 0u, 0u, 0u};
                if (pos >= 0) wv[it] = *(const u32x4*)(Z + (size_t)(rb + pos) * QKVW + (which ? 1280 : 1024) + kvh * 64 + ch * 8); }
#pragma unroll
              for (int it = 0; it < 8; ++it) { const int q = tidu + it * NTHR, which = q >> 11, idx = q & 2047, kidx = which ? (idx & 255) : (idx >> 3), ch = which ? (idx >> 8) : (idx & 7); const u32x4 w = wv[it];
                if (!which) *(u32x4*)(K_l + kidx * 72 + ch * 8) = w;
                else { bf16* dst = Vt_l + (ch * 8) * 296 + kidx;
                    dst[0 * 296] = (bf16)(w.x & 0xffff); dst[1 * 296] = (bf16)(w.x >> 16); dst[2 * 296] = (bf16)(w.y & 0xffff); dst[3 * 296] = (bf16)(w.y >> 16);
                    dst[4 * 296] = (bf16)(w.z & 0xffff); dst[5 * 296] = (bf16)(w.z >> 16); dst[6 * 296] = (bf16)(w.w & 0xffff); dst[7 * 296] = (bf16)(w.w >> 16); } } }
            for (int q = tidu; q < 64 * 32; q += NTHR) Vt_l[(q >> 5) * 296 + 256 + (q & 31)] = 0;
            __syncthreads();
            const int row = rb + q0 + 16 * wave + fr;
#pragma unroll
            for (int hg = 0; hg < 2; ++hg) { const int h = kvh * 4 + 2 * hg;
                attn_wave<2>(K_l, Vt_l, 296, wave, Bq + 2 * hg, 128 + 16 * wave + fr, qb == 0 ? 128 : 0, sinkp + h, CAT + (size_t)row * DM + h * 64, true, fr, fq); }
            __syncthreads();
        } else {
            const int us = u - 512, s = us >> 1, kvp = us & 1;
            bf16x8 Bq1[2];
            { const bf16* qp = Z + (size_t)(RP + 8 * s + (fr & 7)) * QKVW + (8 * kvp + wave) * 64 + 8 * fq; Bq1[0] = *(const bf16x8*)qp; Bq1[1] = *(const bf16x8*)(qp + 32); }
            bf16* K_l = (bf16*)smem;
            bf16* Vt_l = K_l + 2 * 144 * 72;
            { f32x4 va[9], vb[9];
              const float* ck = p.in[8] + ((size_t)(jl * 128 + s) * 128) * 256; const float* cv = p.in[9] + ((size_t)(jl * 128 + s) * 128) * 256;
#pragma unroll
              for (int it = 0; it < 9; ++it) { const int q = tidu + it * NTHR, which = q / 2304, r = q - which * 2304, kvl = r / 1152, r2 = r - kvl * 1152, kidx = which ? (r2 % 144) : (r2 >> 3), ch = which ? (r2 / 144) : (r2 & 7); const int kvh = 2 * kvp + kvl;
                va[it] = (f32x4){0.f, 0.f, 0.f, 0.f}; vb[it] = va[it];
                if (kidx < 128) { const float* src = (which ? cv : ck) + (size_t)kidx * 256 + kvh * 64 + ch * 8; va[it] = *(const f32x4*)src; vb[it] = *(const f32x4*)(src + 4); }
                else if (kidx < 136) { const u32x4 w = *(const u32x4*)(Z + (size_t)(RP + 8 * s + kidx - 128) * QKVW + (which ? 1280 : 1024) + kvh * 64 + ch * 8);
                    va[it] = (f32x4){bflo(w.x), bfhi(w.x), bflo(w.y), bfhi(w.y)}; vb[it] = (f32x4){bflo(w.z), bfhi(w.z), bflo(w.w), bfhi(w.w)}; } }
#pragma unroll
              for (int it = 0; it < 9; ++it) { const int q = tidu + it * NTHR, which = q / 2304, r = q - which * 2304, kvl = r / 1152, r2 = r - kvl * 1152, kidx = which ? (r2 % 144) : (r2 >> 3), ch = which ? (r2 / 144) : (r2 & 7);
                const f32x4 a = va[it], c = vb[it];
                if (!which) *(u32x4*)(K_l + (kvl * 144 + kidx) * 72 + ch * 8) = (u32x4){pk2(a[0], a[1]), pk2(a[2], a[3]), pk2(c[0], c[1]), pk2(c[2], c[3])};
                else { bf16* dst = Vt_l + (kvl * 64 + ch * 8) * 168 + kidx; const unsigned p0 = pk2(a[0], a[1]), p1 = pk2(a[2], a[3]), p2 = pk2(c[0], c[1]), p3 = pk2(c[2], c[3]);
                    dst[0 * 168] = (bf16)(p0 & 0xffff); dst[1 * 168] = (bf16)(p0 >> 16); dst[2 * 168] = (bf16)(p1 & 0xffff); dst[3 * 168] = (bf16)(p1 >> 16);
                    dst[4 * 168] = (bf16)(p2 & 0xffff); dst[5 * 168] = (bf16)(p2 >> 16); dst[6 * 168] = (bf16)(p3 & 0xffff); dst[7 * 168] = (bf16)(p3 >> 16); } } }
            for (int q = tidu; q < 2 * 64 * 16; q += NTHR) Vt_l[(q >> 4) * 168 + 144 + (q & 15)] = 0;
            __syncthreads();
            const int kvl = wave >> 2, h = 8 * kvp + wave, row = RP + 8 * s + (fr & 7);
            attn_wave<1>(K_l + kvl * 144 * 72, Vt_l + kvl * 64 * 168, 168, 0, &Bq1, 128 + (fr & 7), 0, sinkp + h, CAT + (size_t)row * DM + h * 64, fr < 8, fr, fq);
            __syncthreads();
        }
    }
}

__device__ __forceinline__ void ffnfix_phase(const Params& p, int l) {
    const bf16* UB = (const bf16*)(p.ws + WS_UB); bf16* ACT = (bf16*)(p.ws + WS_ACT);
    const float* cw = p.in[26] + (size_t)l * 3 * FF2;
    for (int idx = obid() * NTHR + otid(); idx < 256 * 352; idx += gridDim.x * NTHR) {
        const int hr = idx / 352, cc = idx - hr * 352, col = cc * 8, hh = hr >> 1, rr = hr & 1;
        const bool seqstart = (hh & 63) == 0;
        const bf16* own0 = UB + (size_t)(hh * 4 + 0) * FF2; const bf16* own1 = UB + (size_t)(hh * 4 + 1) * FF2;
        const bf16* pm2 = UB + (size_t)((hh - 1) * 4 + 2) * FF2; const bf16* pm1 = UB + (size_t)((hh - 1) * 4 + 3) * FF2;
        float g2[8], g1[8], g0[8], a2[8], a1[8], a0[8];
        if (rr == 0) {
            if (seqstart) {
#pragma unroll
                for (int e = 0; e < 8; ++e) { g2[e] = 0.f; g1[e] = 0.f; a2[e] = 0.f; a1[e] = 0.f; } }
            else { unpack8(*(const u32x4*)(pm2 + col), g2); unpack8(*(const u32x4*)(pm2 + FF + col), a2); unpack8(*(const u32x4*)(pm1 + col), g1); unpack8(*(const u32x4*)(pm1 + FF + col), a1); }
            unpack8(*(const u32x4*)(own0 + col), g0); unpack8(*(const u32x4*)(own0 + FF + col), a0);
        } else {
            if (seqstart) {
#pragma unroll
                for (int e = 0; e < 8; ++e) { g2[e] = 0.f; a2[e] = 0.f; } }
            else { unpack8(*(const u32x4*)(pm1 + col), g2); unpack8(*(const u32x4*)(pm1 + FF + col), a2); }
            unpack8(*(const u32x4*)(own0 + col), g1); unpack8(*(const u32x4*)(own0 + FF + col), a1);
            unpack8(*(const u32x4*)(own1 + col), g0); unpack8(*(const u32x4*)(own1 + FF + col), a0);
        }
        float wg[3][8], wa[3][8];
#pragma unroll
        for (int j = 0; j < 3; ++j) { ld8f(cw + j * FF2 + col, wg[j]); ld8f(cw + j * FF2 + FF + col, wa[j]); }
        float o[8];
#pragma unroll
        for (int e = 0; e < 8; ++e) { const float cgv = wg[0][e] * g2[e] + wg[1][e] * g1[e] + wg[2][e] * g0[e], cav = wa[0][e] * a2[e] + wa[1][e] * a1[e] + wa[2][e] * a0[e]; o[e] = cgv * sigmoidf_(cgv) * cav; }
        *(u32x4*)(ACT + (size_t)(hh * 128 + rr) * FF + col) = (u32x4){pk2(o[0], o[1]), pk2(o[2], o[3]), pk2(o[4], o[5]), pk2(o[6], o[7])};
    }
    for (int idx = obid() * NTHR + otid(); idx < 4 * (FF2 / 8); idx += gridDim.x * NTHR) { const int br = idx / (FF2 / 8), c = (idx - br * (FF2 / 8)) * 8, b = br >> 1, r = br & 1;
        float v[8]; unpack8(*(const u32x4*)(UB + (size_t)((64 * b + 63) * 4 + 2 + r) * FF2 + c), v);
        st8f(p.out + O_PFFN + ((size_t)(l * 2 + b) * 2 + r) * FF2 + c, v); }
}

#define XB_TMO      128
#define XB_XCNT(j)  (256  + 64 * (j))
#define XB_XSUB(j)  (1280 + 64 * (j))
#define XB_XGEN(j)  (2304 + 64 * (j))
#define XB_TOP      3328
#define XB_TOPGEN   3392
#define XCD_BAR_WORDS 3456
#define XB_SPIN_CAP (1u << 18)

__device__ __forceinline__ unsigned xb_ld(unsigned* p)              { return __hip_atomic_load(p, __ATOMIC_RELAXED, __HIP_MEMORY_SCOPE_AGENT); }
__device__ __forceinline__ unsigned xb_add(unsigned* p, unsigned v) { return __hip_atomic_fetch_add(p, v, __ATOMIC_RELAXED, __HIP_MEMORY_SCOPE_AGENT); }
__device__ __forceinline__ unsigned xb_xcc_id() { return (unsigned)__builtin_amdgcn_s_getreg((3 << 11) | 20) & 0xFu; }
#define XB_SPIN(cond, bar) do { unsigned _sp = 0; while (cond) { __builtin_amdgcn_s_sleep(1); \
    if ((++_sp & 255u) == 0u) { if (xb_ld(&(bar)[XB_TMO])) break; if (_sp > XB_SPIN_CAP) { atomicAdd(&(bar)[XB_TMO], 1u); break; } } } } while (0)

struct XcdBarrier {
    unsigned* bar; unsigned x;
    volatile LAS unsigned* st;
};

__device__ __forceinline__ XcdBarrier xcd_barrier_post(unsigned* bar, volatile LAS unsigned* st) {
    XcdBarrier b; b.bar = bar; b.x = xb_xcc_id(); b.st = st;
    if (threadIdx.x == 0) (void)xb_add(&bar[XB_XCNT(b.x)], 1u);
    return b;
}
__device__ __forceinline__ void xcd_barrier_complete(unsigned* bar, unsigned x, unsigned& nloc, unsigned& nx) {
    const unsigned G = gridDim.x * gridDim.y * gridDim.z;
    unsigned sum, cnt, mine, sp = 0u;
    for (;;) {
        sum = 0u; cnt = 0u; mine = 0u;
#pragma unroll
        for (unsigned j = 0; j < 16; ++j) { const unsigned c = xb_ld(&bar[XB_XCNT(j)]); sum += c; cnt += (c > 0u) ? 1u : 0u; mine = (j == x) ? c : mine; }
        if (sum == G) break;
        __builtin_amdgcn_s_sleep(1);
        if ((++sp & 255u) == 0u) { if (xb_ld(&bar[XB_TMO])) break; if (sp > XB_SPIN_CAP) { atomicAdd(&bar[XB_TMO], 1u); break; } }
    }
    nloc = mine > 0u ? mine : 1u; nx = cnt > 0u ? cnt : 1u;
}

__device__ __forceinline__ void xcd_barrier(const XcdBarrier& b) {
    asm volatile("s_waitcnt vmcnt(0)" ::: "memory");
    __syncthreads();
    if (threadIdx.x == 0) {
        unsigned* bar = b.bar;
        __builtin_amdgcn_s_waitcnt(0);
        unsigned nloc = b.st[0], nx = b.st[1];
        if (nloc == 0u) { xcd_barrier_complete(bar, b.x, nloc, nx); b.st[0] = nloc; b.st[1] = nx; }
        const unsigned old = xb_add(&bar[XB_XSUB(b.x)], 1u);
        const unsigned gen = old / nloc;
        if (old + 1u == (gen + 1u) * nloc) {
            __builtin_amdgcn_fence(__ATOMIC_RELEASE, "agent");
            asm volatile("s_waitcnt vmcnt(0)" ::: "memory");
            const unsigned og = xb_add(&bar[XB_TOP], 1u);
            const unsigned tg = og / nx;
            if (og + 1u == (tg + 1u) * nx) xb_add(&bar[XB_TOPGEN], 1u);
            else XB_SPIN(xb_ld(&bar[XB_TOPGEN]) == tg, bar);
            __builtin_amdgcn_fence(__ATOMIC_ACQUIRE, "agent");
            xb_add(&bar[XB_XGEN(b.x)], 1u);
            asm volatile("s_waitcnt vmcnt(0)" ::: "memory");
        } else {
            XB_SPIN(xb_ld(&bar[XB_XGEN(b.x)]) == gen, bar);
            __builtin_amdgcn_fence(__ATOMIC_ACQUIRE, "agent");
            asm volatile("s_waitcnt vmcnt(0)" ::: "memory");
        }
    }
    __syncthreads();
}

__global__ void __launch_bounds__(NTHR, 2) mega(Params p) {
    extern __shared__ __attribute__((aligned(16))) unsigned char lds[];
    cg::grid_group grid = cg::this_grid();
    unsigned char* ws = p.ws;
    volatile LAS unsigned* bst = (volatile LAS unsigned*)((LAS unsigned char*)lds + 147392);
    if (threadIdx.x < 2) bst[threadIdx.x] = 0u;
    __syncthreads();
    XcdBarrier bar; bar.bar = (unsigned*)ws; bar.x = 0; bar.st = bst;
    if (p.hi - p.lo > 1) bar = xcd_barrier_post((unsigned*)ws, bst);
    for (int step = p.lo; step < p.hi; ++step) {
        int nrep = 1; bool skip = false;
        if (step == 0) nrep += (PROBE_PRE & 1); else if (step == 1) nrep += (PROBE_PRE >> 1) & 1; else { const int l_ = (step - 2) / 10, st_ = (step - 2) % 10; nrep += (((l_ & 1) ? PROBE_ODD : PROBE_EVEN) >> st_) & 1; }
        for (int rep = 0; rep < nrep; ++rep) {
            if (PROBE_BAR == 2 && rep > 0) xcd_barrier(bar);
        if (step == 0) prologue(p, lds);
        else if (step == 1) {
            pg8::Gemm g{(const pg8::bf16_t*)(ws + WS_AC), (const pg8::bf16_t*)(ws + WS_ZU), 256, MODW, DM}; pg8::StaticOrder S; S.init(256, MODW, gridDim.x, obid());
            EpiMod E{(float*)(ws + WS_MOD), p.in[14]};
            pg8::gemm_phase<EpiMod, pg8::StaticOrder, true, true>((PG8_LAS unsigned char*)lds, g, S, E);
        } else {
            const int l = (step - 2) / 10, st = (step - 2) % 10; const bool even = !(l & 1); const int i = l >> 1;
            if (st == 0) norm_phase(p, l, 1, lds);
            else if (st == 6) norm_phase(p, l, 2, lds);
            else if (st == 1 || st == 5 || st == 7 || st == 9) {
                pg8::Gemm g; EpiMain E; E.X = p.out; E.O = (bf16*)(ws + WS_ZU); E.gate = nullptr; E.ldc = 0; E.mode = 0; E.cw = nullptr; E.stp = nullptr; E.sout = nullptr; E.qn = nullptr; E.kn = nullptr; E.lyr = i; E.wsb = ws;
                if (st == 1) { g.A = (const pg8::bf16_t*)(ws + WS_H); g.M = R; g.K = DM;
                    if (even) { g.Bt = (const pg8::bf16_t*)(ws + WS_WIN) + (size_t)i * ZW * DM; g.N = ZW; E.ldc = ZW; } else { g.Bt = (const pg8::bf16_t*)(ws + WS_WQKV) + (size_t)i * QKVW * DM; g.N = QKVW; E.ldc = QKVW; E.mode = 3;
                        E.qn = p.in[21] + i * 64; E.kn = p.in[22] + i * 64; } }
                else if (st == 5) { g.A = (const pg8::bf16_t*)(ws + WS_CAT); g.M = RP; g.K = DM; g.N = DM; g.Bt = (const pg8::bf16_t*)(ws + (even ? WS_WAO : WS_WCO)) + (size_t)i * DM * DM;
                    E.mode = 1; E.gate = (const float*)(ws + WS_MOD) + l * 6144 + 2048; }
                else if (st == 7) { g.A = (const pg8::bf16_t*)(ws + WS_H); g.M = R; g.K = DM; g.N = FF2; g.Bt = (const pg8::bf16_t*)(ws + WS_WUP) + (size_t)l * FF2 * DM; E.mode = 2;
                    E.cw = p.in[26] + (size_t)l * 3 * FF2; E.stp = p.in[10] + (size_t)l * 128 * 2 * FF2; E.sout = p.out + O_SFFN + (size_t)l * 128 * 2 * FF2; }
                else { g.A = (const pg8::bf16_t*)(ws + WS_ACT); g.M = RP; g.K = FF; g.N = DM; g.Bt = (const pg8::bf16_t*)(ws + WS_WDN) + (size_t)l * DM * FF; E.mode = 1; E.gate = (const float*)(ws + WS_MOD) + l * 6144 + 5120; }
                if (rep > 0 && E.mode == 1) { E.mode = 0; E.O = (bf16*)(ws + WS_H); E.ldc = DM; }
                if (rep > 0 && E.mode == 1) { E.mode = 0; E.O = (bf16*)(ws + WS_H); E.ldc = DM; }
                pg8::StaticOrder S; S.init(g.M, g.N, gridDim.x, obid());
                pg8::gemm_phase<EpiMain, pg8::StaticOrder, true, true>((PG8_LAS unsigned char*)lds, g, S, E);
                if (E.mode == 3 && rep == 0) { const int G_ = gridDim.x, n2 = S.nwg - G_;
                    if (n2 > 0 && n2 < G_) { if (obid() >= n2) cache_shift(p, i, obid() - n2, G_ - n2); } else cache_shift(p, i, obid(), G_); }
                if (E.mode == 1) mini_gemm((const bf16*)g.A, (const bf16*)g.Bt, g.K, p.out, E.gate, lds);
            }
            else if (st == 2) {
                if (even) { const int G_ = gridDim.x; int il = obid(), is = obid();
                    for (int k = 0; il < 1024 || is < 512; ++k) { const bool do_s = (is < 512) && ((k & 1) || il >= 1024);
                        if (do_s) { mlstm_sample(p, i, is, lds); is += G_; } else { mlstm_local(p, i, il, lds); il += G_; } }
                    shortconv(p, i); }
                else { skip = true; continue; }
            }
            else if (st == 3) { if (even) mlstm_scan(p, i, lds); else attn_phase(p, i, lds); }
            else if (st == 4) { if (!even) { skip = true; continue; } for (int it = obid(); it < 1024; it += 2 * gridDim.x) mlstm_out2(p, i, it, it + gridDim.x, lds); }
            else if (st == 8) ffnfix_phase(p, l);
        }
        }
        if (skip) continue;
        if (step + 1 < p.hi) { if (step == 0) grid.sync(); else { xcd_barrier(bar); if (PROBE_BAR == 1) xcd_barrier(bar); } }
    }
}

#ifndef NLAUNCH_MODE
#define NLAUNCH_MODE 1
#endif
extern "C" void kernel_launch(void* const* d_in, const int* in_sizes, int n_in, void* d_out, int out_size, void* d_ws, size_t ws_size, hipStream_t stream) {
    static int grid = 0;
    if (grid == 0) {
        if (n_in != 28 || (size_t)out_size != O_END || ws_size < WS_END) { fprintf(stderr, "kernel_launch: unexpected shapes: n_in %d out %d ws %zu\n", n_in, out_size, ws_size); grid = -1; return; }
        int dev = 0, cus = 0, per_cu = 0;
        hipGetDevice(&dev); hipDeviceGetAttribute(&cus, hipDeviceAttributeMultiprocessorCount, dev);
        if (hipFuncSetAttribute((const void*)mega, hipFuncAttributeMaxDynamicSharedMemorySize, LDS_BYTES) != hipSuccess) { fprintf(stderr, "kernel_launch: hipFuncSetAttribute failed\n"); grid = -1; return; }
        if (hipOccupancyMaxActiveBlocksPerMultiprocessor(&per_cu, (const void*)mega, NTHR, LDS_BYTES) != hipSuccess || per_cu < 1) { fprintf(stderr, "kernel_launch: occupancy query says %d\n", per_cu); per_cu = 1; }
        (void)hipGetLastError();
        grid = cus * 1;
    }
    if (grid < 0) return;
    Params p{};
    for (int k = 0; k < 28; ++k) p.in[k] = (const float*)d_in[k];
    p.out = (float*)d_out; p.ws = (unsigned char*)d_ws;
    const int NSTEPS = 42;
    if (hipMemsetAsync(d_ws, 0, 16384, stream) != hipSuccess) { fprintf(stderr, "memset failed\n"); return; }
#if NLAUNCH_MODE == 1
    p.lo = 0; p.hi = NSTEPS;
    void* args[] = {&p};
    hipError_t e = hipLaunchCooperativeKernel((const void*)mega, dim3(grid), dim3(NTHR), args, LDS_BYTES, stream);
    if (e != hipSuccess) fprintf(stderr, "cooperative launch failed: %s (grid %d)\n", hipGetErrorString(e), grid);
#else
    for (int s = 0; s < NSTEPS; ++s) { if (s >= 2 && ((s - 2) % 10) == 4 && (((s - 2) / 10) & 1)) continue; p.lo = s; p.hi = s + 1; hipLaunchKernelGGL(mega, dim3(grid), dim3(NTHR), LDS_BYTES, stream, p); }
#endif
}
```
